# Optimizing an MI355X kernel written in HIP

```python
import math
import jax, jax.numpy as jnp
from jax import lax
import numpy as np

D_MODEL = 1024
BATCH = 2
SEQ = 16384
DEPTH = 4

CTX_LEN = 256
GRID_W = 64

ATTN_WIDTH = D_MODEL // 2
RWKV_WIDTH = D_MODEL - ATTN_WIDTH
ATTN_QK_DIM = 64
ATTN_V_DIM = 2 * ATTN_QK_DIM
ATTN_HEADS = ATTN_WIDTH // ATTN_V_DIM
ROPE_THETA = 10000.0
Q_BLOCK = 128
SUBLN_EPS = 1e-5
RWKV_HEAD = 64
RWKV_HEADS = RWKV_WIDTH // RWKV_HEAD
DECAY_LORA = 32
AAA_LORA = 32
MV_LORA = 32
GATE_LORA = 96
LNX_EPS = 64e-5
IN_SIZES = (ATTN_WIDTH, ATTN_WIDTH, ATTN_WIDTH,
            RWKV_WIDTH, RWKV_WIDTH, RWKV_WIDTH,
            2 * DECAY_LORA, 2 * AAA_LORA, GATE_LORA)
N_IN = sum(IN_SIZES)
D_FF = 2816
N_EXPERTS = 8
TOP_K = 2
D_FF_EXPERT = 3584
NORM_EPS = 1e-6

kernel_name = "hybrid_diffattn_rwkv7_moe_dit"


def _rms_norm(x, g, eps=NORM_EPS):
    xf = x.astype(jnp.float32)
    y = xf * lax.rsqrt(jnp.mean(xf * xf, axis=-1, keepdims=True) + eps)
    return y.astype(x.dtype) * g


def _split_in(p):
    return jnp.split(p, np.cumsum(IN_SIZES)[:-1].tolist(), axis=-1)


def _axial_rope_tables(n_tokens, dtype):
    rows = n_tokens // GRID_W
    row = jnp.repeat(jnp.arange(rows), GRID_W).astype(jnp.float32)
    col = jnp.tile(jnp.arange(GRID_W), rows).astype(jnp.float32)
    axis_dim = ATTN_QK_DIM // 2
    inv_freq = ROPE_THETA ** (-jnp.arange(0, axis_dim, 2, dtype=jnp.float32) / axis_dim)
    tabs = []
    for pos in (row, col):
        ang = (pos[:, None] * inv_freq[None, :])[None, :, None, None, :]
        tabs += [jnp.cos(ang).astype(dtype), jnp.sin(ang).astype(dtype)]
    return tuple(tabs)


def _rotate(x, cos, sin):
    h = x.shape[-1] // 2
    x1, x2 = x[..., :h], x[..., h:]
    return jnp.concatenate([x1 * cos - x2 * sin, x1 * sin + x2 * cos], axis=-1)


def _apply_axial_rope(x, rope):
    cos_r, sin_r, cos_c, sin_c = rope
    a = ATTN_QK_DIM // 2
    return jnp.concatenate([_rotate(x[..., :a], cos_r, sin_r),
                            _rotate(x[..., a:], cos_c, sin_c)], axis=-1)


def _diff_mix(q, keys, vals, lam):
    s = jnp.einsum("bqhmd,bkhmd->bhmqk", q, keys, preferred_element_type=jnp.float32)
    p = jax.nn.softmax(s * (ATTN_QK_DIM ** -0.5), axis=-1)
    w = p[:, :, 0] - lam * p[:, :, 1]
    return jnp.einsum("bhqk,bkhd->bqhd", w.astype(vals.dtype), vals)


def _subln(o, g, lam_init):
    b, t = o.shape[:2]
    return (_rms_norm(o, g, SUBLN_EPS) * (1.0 - lam_init)).reshape(b, t, ATTN_WIDTH)


def _diff_attention_group(pq, pk, pv, cq, ck, cv, rope, lam_p, subln_g, lam_init, need_ctx):
    b, t, _ = pq.shape

    def qk_heads(z):
        return z.reshape(z.shape[0], z.shape[1], ATTN_HEADS, 2, ATTN_QK_DIM)

    def v_heads(z):
        return z.reshape(z.shape[0], z.shape[1], ATTN_HEADS, ATTN_V_DIM)

    q = _apply_axial_rope(qk_heads(pq), rope)
    k = _apply_axial_rope(qk_heads(pk), rope)
    qc, kc, vc = qk_heads(cq), qk_heads(ck), v_heads(cv)
    lp = lam_p.astype(jnp.float32)
    lam = jnp.exp(jnp.sum(lp[0] * lp[1])) - jnp.exp(jnp.sum(lp[2] * lp[3])) + lam_init
    keys = jnp.concatenate([kc, k], axis=1)
    vals = jnp.concatenate([vc, v_heads(pv)], axis=1)
    n_blk = t // Q_BLOCK
    qb = jnp.moveaxis(q.reshape(b, n_blk, Q_BLOCK, ATTN_HEADS, 2, ATTN_QK_DIM), 1, 0)
    ob = lax.map(lambda blk: _diff_mix(blk, keys, vals, lam), qb)
    o_lat = jnp.moveaxis(ob, 0, 1).reshape(b, t, ATTN_HEADS, ATTN_V_DIM)
    out_lat = _subln(o_lat, subln_g, lam_init)
    out_ctx = _subln(_diff_mix(qc, kc, vc, lam), subln_g, lam_init) if need_ctx else None
    return out_lat, out_ctx


def _shift_mix(p, mu_prev, mu_next):
    z = jnp.zeros_like(p[:, :1])
    p_prev = jnp.concatenate([z, p[:, :-1]], axis=1)
    p_next = jnp.concatenate([p[:, 1:], z], axis=1)
    return p + mu_prev * (p_prev - p) + mu_next * (p_next - p)


def _heads(z):
    return z.reshape(z.shape[0], z.shape[1], RWKV_HEADS, RWKV_HEAD).astype(jnp.float32)


def _wkv_scan(s0, r, w, k, v, kk, a, reverse):
    def step(s, inp):
        r_t, w_t, k_t, v_t, kk_t, a_t = inp
        sa = jnp.einsum("bhvk,bhk->bhv", s, -kk_t)
        s = (s * w_t[:, :, None, :] + sa[..., None] * (kk_t * a_t)[:, :, None, :]
             + v_t[..., None] * k_t[:, :, None, :])
        return s, jnp.einsum("bhvk,bhk->bhv", s, r_t)

    xs = tuple(jnp.moveaxis(z, 1, 0) for z in (r, w, k, v, kk, a))
    s_fin, ys = lax.scan(step, s0, xs, reverse=reverse)
    return jnp.moveaxis(ys, 0, 1), s_fin


def _rwkv_prepare(seg, mu, w0, w2, a0, a2, g2, k_k, k_a, vres):
    r, k, v, wd, ad, gd = seg
    r = _shift_mix(r, mu[0, 0], mu[0, 1])
    k = _shift_mix(k, mu[1, 0], mu[1, 1])
    v = _shift_mix(v, mu[2, 0], mu[2, 1])
    if vres is not None:
        v_first, v0, v1, v2 = vres
        v = v + (v_first - v) * jax.nn.sigmoid(v0 + (v @ v1) @ v2)
    g = jax.nn.sigmoid(gd) @ g2
    kk = _heads(k * k_k)
    kk = kk * lax.rsqrt(jnp.maximum(jnp.sum(kk * kk, axis=-1, keepdims=True), 1e-24))
    kf = k.astype(jnp.float32)
    dirs = []
    for d in range(2):
        wl = (w0[d] + jnp.tanh(wd[..., d * DECAY_LORA:(d + 1) * DECAY_LORA]) @ w2[d]).astype(jnp.float32)
        decay = jnp.exp(-jnp.exp(-jax.nn.softplus(-wl) - 0.5))
        a = jax.nn.sigmoid((a0[d] + ad[..., d * AAA_LORA:(d + 1) * AAA_LORA] @ a2[d]).astype(jnp.float32))
        kd = kf * (1.0 + (a - 1.0) * k_a.astype(jnp.float32))
        dirs.append((_heads(decay), _heads(a), _heads(kd)))
    return {"r": _heads(r), "v": _heads(v), "g": g, "kk": kk, "dirs": dirs, "v_raw": v}


def _rwkv_finish(y, p, r_k, ln_w, ln_b):
    mean = jnp.mean(y, axis=-1, keepdims=True)
    var = jnp.mean(jnp.square(y - mean), axis=-1, keepdims=True)
    o = (y - mean) * lax.rsqrt(var + LNX_EPS)
    o = (o * ln_w.astype(jnp.float32).reshape(RWKV_HEADS, RWKV_HEAD)
         + ln_b.astype(jnp.float32).reshape(RWKV_HEADS, RWKV_HEAD))
    rkh = r_k.astype(jnp.float32).reshape(RWKV_HEADS, RWKV_HEAD)
    for _, _, kd in p["dirs"]:
        o = o + jnp.sum(p["r"] * kd * rkh, axis=-1, keepdims=True) * p["v"]
    b, t = o.shape[:2]
    return o.reshape(b, t, RWKV_WIDTH).astype(p["g"].dtype) * p["g"]


def _rwkv_group(seg_lat, seg_ctx, mu, w0, w2, a0, a2, g2, k_k, k_a, r_k, ln_w, ln_b, vres, need_ctx):
    if vres is None:
        vres_l = vres_c = None
    else:
        vf_l, vf_c, v0, v1, v2 = vres
        vres_l, vres_c = (vf_l, v0, v1, v2), (vf_c, v0, v1, v2)
    pl = _rwkv_prepare(seg_lat, mu, w0, w2, a0, a2, g2, k_k, k_a, vres_l)
    pc = _rwkv_prepare(seg_ctx, mu, w0, w2, a0, a2, g2, k_k, k_a, vres_c)
    b = seg_lat[0].shape[0]
    ys_l, ys_c = [], []
    for d, rev in enumerate((False, True)):
        s0 = jnp.zeros((b, RWKV_HEADS, RWKV_HEAD, RWKV_HEAD), jnp.float32)
        dc, dl = pc["dirs"][d], pl["dirs"][d]
        yc, s_ctx = _wkv_scan(s0, pc["r"], dc[0], dc[2], pc["v"], pc["kk"], dc[1], rev)
        yl, _ = _wkv_scan(s_ctx, pl["r"], dl[0], dl[2], pl["v"], pl["kk"], dl[1], rev)
        ys_l.append(yl)
        ys_c.append(yc)
    out_lat = _rwkv_finish(ys_l[0] + ys_l[1], pl, r_k, ln_w, ln_b)
    out_ctx = _rwkv_finish(ys_c[0] + ys_c[1], pc, r_k, ln_w, ln_b) if need_ctx else None
    return out_lat, out_ctx, (pl["v_raw"], pc["v_raw"])


def _swiglu(h, w1, w3, w2):
    return (jax.nn.silu(h @ w1) * (h @ w3)) @ w2


def _moe_swiglu(h, router_w, w1, w3, w2):
    shp = h.shape
    hf = h.reshape(-1, shp[-1])
    logits = jnp.matmul(hf, router_w, preferred_element_type=jnp.float32)
    top_v, top_i = lax.top_k(logits, TOP_K)
    gates = jax.nn.softmax(top_v, axis=-1)
    comb = jnp.sum(jax.nn.one_hot(top_i, N_EXPERTS, dtype=jnp.float32) * gates[..., None], axis=1)
    comb = comb.astype(h.dtype)
    y = jnp.zeros_like(hf)
    for e in range(N_EXPERTS):
        y = y + comb[:, e:e + 1] * _swiglu(hf, w1[e], w3[e], w2[e])
    return y.reshape(shp)


def _channel_mixer(h, l, ffn_w1, ffn_w3, ffn_w2, router_w, exp_w1, exp_w3, exp_w2):
    i = l // 2
    if l % 2 == 0:
        return _swiglu(h, ffn_w1[i], ffn_w3[i], ffn_w2[i])
    return _moe_swiglu(h, router_w[i], exp_w1[i], exp_w3[i], exp_w2[i])


def setup_inputs(seed: int = 0) -> dict:
    key = jax.random.key(seed)
    keys = iter(jax.random.split(key, 48))
    f32 = jnp.float32
    n_dense = (DEPTH + 1) // 2
    n_moe = DEPTH // 2
    D = D_MODEL

    def normal(shape, scale):
        return jax.random.normal(next(keys), shape, f32) * scale

    def uniform(shape, lo, hi):
        return jax.random.uniform(next(keys), shape, f32, lo, hi)

    return {
        "x": normal((BATCH, SEQ, D), 1.0),
        "c": normal((BATCH, D), 1.0),
        "ctx": normal((BATCH, CTX_LEN, D), 1.0),
        "c_ctx": normal((D,), 1.0),
        "ada_w": normal((DEPTH, D, 6 * D), D ** -0.5),
        "ada_b": normal((DEPTH, 6 * D), 0.01),
        "norm1_g": 1.0 + normal((DEPTH, D), 0.02),
        "norm2_g": 1.0 + normal((DEPTH, D), 0.02),
        "w_in": normal((DEPTH, D, N_IN), D ** -0.5),
        "w_out": normal((DEPTH, D, D), D ** -0.5),
        "diff_lambda": normal((DEPTH, 4, ATTN_QK_DIM), 0.1),
        "subln_g": 1.0 + normal((DEPTH, ATTN_V_DIM), 0.02),
        "rwkv_mu": uniform((DEPTH, 3, 2, RWKV_WIDTH), 0.0, 0.5),
        "rwkv_w0": uniform((DEPTH, 2, RWKV_WIDTH), -6.0, -1.0),
        "rwkv_w2": normal((DEPTH, 2, DECAY_LORA, RWKV_WIDTH), 0.1),
        "rwkv_a0": normal((DEPTH, 2, RWKV_WIDTH), 0.1),
        "rwkv_a2": normal((DEPTH, 2, AAA_LORA, RWKV_WIDTH), 0.1),
        "rwkv_v0": 1.0 + normal((DEPTH - 1, RWKV_WIDTH), 0.1),
        "rwkv_v1": normal((DEPTH - 1, RWKV_WIDTH, MV_LORA), RWKV_WIDTH ** -0.5),
        "rwkv_v2": normal((DEPTH - 1, MV_LORA, RWKV_WIDTH), 0.1),
        "rwkv_g2": normal((DEPTH, GATE_LORA, RWKV_WIDTH), GATE_LORA ** -0.5),
        "rwkv_k_k": 0.85 + normal((DEPTH, RWKV_WIDTH), 0.02),
        "rwkv_k_a": 1.0 + normal((DEPTH, RWKV_WIDTH), 0.02),
        "rwkv_r_k": normal((DEPTH, RWKV_WIDTH), 0.1),
        "lnx_w": 1.0 + normal((DEPTH, RWKV_WIDTH), 0.02),
        "lnx_b": normal((DEPTH, RWKV_WIDTH), 0.01),
        "ffn_w1": normal((n_dense, D, D_FF), D ** -0.5),
        "ffn_w3": normal((n_dense, D, D_FF), D ** -0.5),
        "ffn_w2": normal((n_dense, D_FF, D), D_FF ** -0.5),
        "router_w": normal((n_moe, D, N_EXPERTS), D ** -0.5),
        "exp_w1": normal((n_moe, N_EXPERTS, D, D_FF_EXPERT), D ** -0.5),
        "exp_w3": normal((n_moe, N_EXPERTS, D, D_FF_EXPERT), D ** -0.5),
        "exp_w2": normal((n_moe, N_EXPERTS, D_FF_EXPERT, D), D_FF_EXPERT ** -0.5),
        "final_g": 1.0 + normal((D,), 0.02),
    }


def reference(x, c, ctx, c_ctx, ada_w, ada_b, norm1_g, norm2_g, w_in, w_out,
              diff_lambda, subln_g, rwkv_mu, rwkv_w0, rwkv_w2, rwkv_a0, rwkv_a2,
              rwkv_v0, rwkv_v1, rwkv_v2, rwkv_g2, rwkv_k_k, rwkv_k_a, rwkv_r_k,
              lnx_w, lnx_b, ffn_w1, ffn_w3, ffn_w2, router_w, exp_w1, exp_w3, exp_w2,
              final_g):
    rope = _axial_rope_tables(x.shape[1], x.dtype)
    xc = ctx
    v_first = None
    for l in range(DEPTH):
        need_ctx = l < DEPTH - 1
        lam_init = 0.8 - 0.6 * math.exp(-0.3 * l)
        mod = jax.nn.silu(c) @ ada_w[l] + ada_b[l]
        mod_c = jax.nn.silu(c_ctx) @ ada_w[l] + ada_b[l]
        sh1, sc1, gt1, sh2, sc2, gt2 = jnp.split(mod[:, None, :], 6, axis=-1)
        csh1, csc1, cgt1, csh2, csc2, cgt2 = jnp.split(mod_c[None, None, :], 6, axis=-1)

        h = _rms_norm(x, norm1_g[l]) * (1.0 + sc1) + sh1
        hc = _rms_norm(xc, norm1_g[l]) * (1.0 + csc1) + csh1
        pl = _split_in(h @ w_in[l])
        pc = _split_in(hc @ w_in[l])
        att_l, att_c = _diff_attention_group(pl[0], pl[1], pl[2], pc[0], pc[1], pc[2], rope,
                                             diff_lambda[l], subln_g[l], lam_init, need_ctx)
        vres = None if l == 0 else (v_first[0], v_first[1], rwkv_v0[l - 1], rwkv_v1[l - 1], rwkv_v2[l - 1])
        rw_l, rw_c, v_raw = _rwkv_group(tuple(pl[3:]), tuple(pc[3:]), rwkv_mu[l], rwkv_w0[l], rwkv_w2[l],
                                        rwkv_a0[l], rwkv_a2[l], rwkv_g2[l], rwkv_k_k[l], rwkv_k_a[l],
                                        rwkv_r_k[l], lnx_w[l], lnx_b[l], vres, need_ctx)
        if l == 0:
            v_first = v_raw
        x = x + gt1 * (jnp.concatenate([att_l, rw_l], axis=-1) @ w_out[l])

        h = _rms_norm(x, norm2_g[l]) * (1.0 + sc2) + sh2
        x = x + gt2 * _channel_mixer(h, l, ffn_w1, ffn_w3, ffn_w2, router_w, exp_w1, exp_w3, exp_w2)

        if need_ctx:
            xc = xc + cgt1 * (jnp.concatenate([att_c, rw_c], axis=-1) @ w_out[l])
            hc = _rms_norm(xc, norm2_g[l]) * (1.0 + csc2) + csh2
            xc = xc + cgt2 * _channel_mixer(hc, l, ffn_w1, ffn_w3, ffn_w2, router_w, exp_w1, exp_w3, exp_w2)
    return _rms_norm(x, final_g)
```

```cpp
#define MK_MULTI 1
#include <hip/hip_runtime.h>
#include <cstdio>
#include <cstdint>
__device__ __forceinline__ int opaque_tid() { int t = (int)threadIdx.x; asm volatile("" : "+v"(t)); return t; }
template <class T> __device__ __forceinline__ T* opaque_ptr(T* p) { asm volatile("" : "+s"(p)); return p; }
namespace pg8 {
#define PG8_LAS __attribute__((address_space(3)))
typedef unsigned short bf16_t;
typedef short bf16x8 __attribute__((ext_vector_type(8)));
typedef float f32x4 __attribute__((ext_vector_type(4)));
typedef unsigned u32x4 __attribute__((ext_vector_type(4)));
constexpr int BM = 256, BK = 64, HALF = 128, HTB = HALF * BK * 2  , STAGE_BYTES = 8 * HTB, NXCD = 8, WGM = 8;

__host__ __device__ __forceinline__ int lds_byte(int r, int c) { const int st = (r >> 4) * 2 + (c >> 5), rr = r & 15, cc = c & 31, ob = rr * 64 + cc * 2; return st * 1024 + (ob ^ (((ob >> 9) & 1) << 5)); }
__host__ __device__ __forceinline__ void stage_rc(int b, int& R, int& C) { const int st = b / 1024, sb = b % 1024, swz = sb ^ (((sb >> 9) & 1) << 5); R = (st >> 1) * 16 + swz / 64; C = (st & 1) * 32 + (swz % 64) / 2; }
__host__ __device__ __forceinline__ int perm32(int rho) { const int n = rho >> 4, i = rho & 15; return 8 * (i >> 2) + 4 * n + (i & 3); }

struct Unit { int pm, pn; };
struct Gemm { const bf16_t* A; const bf16_t* Bt; int M, N, K; };

struct StaticOrder {
    int nM, nN, nwg, G, c;
    __host__ __device__ void init(int M, int N, int G_, int c_) { nM = M / BM; nN = N / BM; nwg = nM * nN; G = G_; c = c_; }
    __host__ __device__ bool next(int i, Unit& u) const {
        const long L = (long)i * G + c; if (L >= nwg) return false;
        int wgid = (int)L; { const int q = nwg / NXCD, r = nwg % NXCD, xcd = wgid % NXCD, off = wgid / NXCD; wgid = (xcd < r ? xcd * (q + 1) : r * (q + 1) + (xcd - r) * q) + off; }
        const int nig = WGM * nN, gid = wgid / nig, fm = gid * WGM, gsz = (nM - fm) < WGM ? (nM - fm) : WGM;
        u.pm = fm + ((wgid % nig) % gsz); u.pn = (wgid % nig) / gsz; return true;
    }
    __device__ __forceinline__ void a_ready(const Unit&) const {}
    __device__ __forceinline__ void done(const Unit&) const {}
};

__device__ __forceinline__ unsigned cvt_pk_bf16(float lo, float hi) { unsigned r; asm volatile("v_cvt_pk_bf16_f32 %0, %1, %2" : "=v"(r) : "v"(lo), "v"(hi)); return r; }
typedef float f32x2 __attribute__((ext_vector_type(2)));
__device__ __forceinline__ float silu_acc(float a) { return a * __builtin_amdgcn_rcpf(1.0f + __builtin_amdgcn_exp2f(-1.4426950408889634f * a)); }
struct EpiStoreBf16 {
    static constexpr bool PERM = true, AFTER_DRAIN = false;
    bf16_t* O; int ldc; int ncolt;
    __device__ __forceinline__ void operator()(const f32x4 (&acc)[2][2][4][2], const Unit& u, int wr, int wc, int fr, int fq) const {
        const int row0 = u.pm * BM + wr * 64 + fr; const int pnl = ncolt ? (u.pn % ncolt) : u.pn;
        const int col0 = pnl * BM + wc * 32 + 8 * fq;
#pragma unroll
        for (int ai = 0; ai < 2; ++ai)
#pragma unroll
            for (int m = 0; m < 4; ++m) { bf16_t* rowp = O + (size_t)(row0 + ai * HALF + m * 16) * ldc + col0;
#pragma unroll
                for (int bj = 0; bj < 2; ++bj) { const f32x4 v0 = acc[ai][bj][m][0], v1 = acc[ai][bj][m][1];
                    u32x4 w; w.x = cvt_pk_bf16(v0[0], v0[1]); w.y = cvt_pk_bf16(v0[2], v0[3]); w.z = cvt_pk_bf16(v1[0], v1[1]); w.w = cvt_pk_bf16(v1[2], v1[3]);
                    *(u32x4*)(rowp + bj * HALF) = w; } }
    }
};
struct EpiSwiGLU {
    static constexpr bool PERM = true, AFTER_DRAIN = false;
    bf16_t* O; int ldc; int ncolt;
    __device__ __forceinline__ void operator()(const f32x4 (&acc)[2][2][4][2], const Unit& u, int wr, int wc, int fr, int fq) const {
        const int row0 = u.pm * BM + wr * 64 + fr; const int pnl = ncolt ? (u.pn % ncolt) : u.pn;
        const int col0 = pnl * HALF + wc * 32 + 8 * fq;
#pragma unroll
        for (int ai = 0; ai < 2; ++ai)
#pragma unroll
            for (int m = 0; m < 4; ++m) { bf16_t* rowp = O + (size_t)(row0 + ai * HALF + m * 16) * ldc + col0;
                const f32x4 a0 = acc[ai][0][m][0], a1 = acc[ai][0][m][1], b0 = acc[ai][1][m][0], b1 = acc[ai][1][m][1];
                u32x4 w;
                w.x = cvt_pk_bf16(silu_acc(a0[0]) * b0[0], silu_acc(a0[1]) * b0[1]); w.y = cvt_pk_bf16(silu_acc(a0[2]) * b0[2], silu_acc(a0[3]) * b0[3]);
                w.z = cvt_pk_bf16(silu_acc(a1[0]) * b1[0], silu_acc(a1[1]) * b1[1]); w.w = cvt_pk_bf16(silu_acc(a1[2]) * b1[2], silu_acc(a1[3]) * b1[3]);
                *(u32x4*)rowp = w; }
    }
};
struct EpiResid {
    static constexpr bool PERM = false, AFTER_DRAIN = false;
    const float* srcLat; const float* srcCtx; float* dstLat; float* dstCtx; const float* gate3;
    __device__ __forceinline__ void operator()(const f32x4 (&acc)[2][2][4][2], const Unit& u, int wr, int wc, int fr, int fq) const {
        const int b = u.pm / 65, j = u.pm - b * 65; const int which = (j == 0) ? 2 : b;
        const float* src = (j == 0) ? srcCtx + (size_t)b * 256 * 1024 : srcLat + ((size_t)b * 16384 + (size_t)(j - 1) * 256) * 1024;
        float* dst = (j == 0) ? dstCtx + (size_t)b * 256 * 1024 : dstLat + ((size_t)b * 16384 + (size_t)(j - 1) * 256) * 1024;
        const float* gp = gate3 + (size_t)which * 6144;
        const int col0 = u.pn * BM + wc * 32 + 4 * fq;
        f32x4 gv[2][2];
#pragma unroll
        for (int bj = 0; bj < 2; ++bj)
#pragma unroll
            for (int n = 0; n < 2; ++n) gv[bj][n] = *(const f32x4*)(gp + col0 + bj * HALF + n * 16);
#pragma unroll
        for (int ai = 0; ai < 2; ++ai)
#pragma unroll
            for (int m = 0; m < 4; ++m) { const size_t off = (size_t)(ai * HALF + wr * 64 + m * 16 + fr) * 1024 + col0;
#pragma unroll
                for (int bj = 0; bj < 2; ++bj)
#pragma unroll
                    for (int n = 0; n < 2; ++n) { const f32x4 x = *(const f32x4*)(src + off + bj * HALF + n * 16);
                        *(f32x4*)(dst + off + bj * HALF + n * 16) = x + gv[bj][n] * acc[ai][bj][m][n]; }
                if (m & 1) asm volatile("" ::: "memory"); }
    }
};
struct MoeOrder {
    int t0, t1, t2, t3, t4, t5, t6, t7; int ncol, G, c;
    __device__ __forceinline__ void init(const unsigned* cnt  , int ncol_, int G_, int c_) {
        ncol = ncol_; G = G_; c = c_;
#define MO_T(e) (((int)__hip_atomic_load(cnt + 64 * (e), __ATOMIC_RELAXED, __HIP_MEMORY_SCOPE_AGENT) + 255) >> 8)
        t0 = MO_T(0); t1 = MO_T(1); t2 = MO_T(2); t3 = MO_T(3); t4 = MO_T(4); t5 = MO_T(5); t6 = MO_T(6); t7 = MO_T(7);
#undef MO_T
    }
    __device__ __forceinline__ bool next(int i, Unit& u) const {
        int L = i * G + c; int e = 0, r0 = 0, te = t0; bool found = false;
#define MO_STEP(k, tk) if (!found) { if (L < (tk) * ncol) { e = (k); te = (tk); found = true; } else { L -= (tk) * ncol; r0 += (tk); } }
        MO_STEP(0, t0) MO_STEP(1, t1) MO_STEP(2, t2) MO_STEP(3, t3) MO_STEP(4, t4) MO_STEP(5, t5) MO_STEP(6, t6) MO_STEP(7, t7)
#undef MO_STEP
        if (!found) return false;
        u.pm = r0 + L % te; u.pn = e * ncol + L / te; return true;
    }
    __device__ __forceinline__ void a_ready(const Unit&) const {}
    __device__ __forceinline__ void done(const Unit&) const {}
};
template <class Epi, class Sched, bool ALIGN_EPI = false, bool SP2 = false>
__device__ __forceinline__ void gemm_phase(PG8_LAS unsigned char* lds, const Gemm g, const Sched& S, const Epi& E) {
    const int tid = opaque_tid(), wid = __builtin_amdgcn_readfirstlane(tid >> 6), lane = tid & 63, wr = wid >> 2, wc = wid & 3, fr = lane & 15, fq = lane >> 4;
    const int K = g.K, nt = K / BK;
    unsigned voffA[2], voffB[2];
#pragma unroll
    for (int i = 0; i < 2; ++i) { int R, C; stage_rc(tid * 16 + i * 8192, R, C); const int Rb = Epi::PERM ? ((R & ~31) + perm32(R & 31)) : R;
        voffA[i] = (unsigned)(R * K + C) * 2u; voffB[i] = (unsigned)(Rb * K + C) * 2u; }
    const size_t kstep = (size_t)(BK * 2);
    const size_t hstep = (size_t)HALF * K * 2;
    const size_t tstep = 2 * hstep;
    const unsigned ldsw = (unsigned)wid * 1024u;
    const int aoff = lds_byte(wr * 64 + fr, fq * 8), boff = lds_byte(wc * 32 + fr, fq * 8);
#define PG8_SA(b, h) (((b) * 2 + (h)) * HTB)
#define PG8_SB(b, h) ((4 + (b) * 2 + (h)) * HTB)
#define PG8_STAGE(bufoff, gbase, voff) do { _Pragma("unroll") for (int _i = 0; _i < 2; ++_i) \
        __builtin_amdgcn_global_load_lds((const unsigned*)((const char*)(gbase) + (voff)[_i]), (PG8_LAS unsigned*)(lds + (bufoff) + ldsw + _i * 8192), 16, 0, 0); } while (0)
#define PG8_LDA(dst, b, h) do { _Pragma("unroll") for (int m = 0; m < 4; ++m) _Pragma("unroll") for (int k = 0; k < 2; ++k) dst[m][k] = *(const PG8_LAS bf16x8*)(lds + PG8_SA(b, h) + aoff + m * 2048 + k * 1024); } while (0)
#define PG8_LDB(dst, b, h) do { _Pragma("unroll") for (int n = 0; n < 2; ++n) _Pragma("unroll") for (int k = 0; k < 2; ++k) dst[n][k] = *(const PG8_LAS bf16x8*)(lds + PG8_SB(b, h) + boff + n * 2048 + k * 1024); } while (0)
#define PG8_MMA(ai, bj, At, Bt) do { __builtin_amdgcn_s_setprio(1); _Pragma("unroll") for (int m = 0; m < 4; ++m) _Pragma("unroll") for (int n = 0; n < 2; ++n) _Pragma("unroll") for (int k = 0; k < 2; ++k) \
        acc[ai][bj][m][n] = __builtin_amdgcn_mfma_f32_16x16x32_bf16(Bt[n][k], At[m][k], acc[ai][bj][m][n], 0, 0, 0); __builtin_amdgcn_s_setprio(0); } while (0)
#define PG8_WAIT_V(n) asm volatile("s_waitcnt vmcnt(" #n ")" ::: "memory")
#define PG8_WAIT_L(n) asm volatile("s_waitcnt lgkmcnt(" #n ")" ::: "memory")
#define PG8_BAR __builtin_amdgcn_s_barrier()
#define PG8_SCHED __builtin_amdgcn_sched_barrier(0)
    Unit cur, nxt; int ui = 0;
    if (!S.next(0, cur)) return;
    f32x4 acc[2][2][4][2];
#pragma unroll
    for (int a = 0; a < 2; ++a)
#pragma unroll
        for (int b = 0; b < 2; ++b)
#pragma unroll
            for (int m = 0; m < 4; ++m)
#pragma unroll
                for (int n = 0; n < 2; ++n) acc[a][b][m][n] = (f32x4){0.f, 0.f, 0.f, 0.f};
    bf16x8 At[4][2], B0[2][2], B1[2][2];
    const char* cA = (const char*)g.A + (size_t)cur.pm * tstep; const char* cB = (const char*)g.Bt + (size_t)cur.pn * tstep;
    S.a_ready(cur);
    if constexpr (SP2) {
        PG8_STAGE(PG8_SB(0, 0), cB, voffB); PG8_STAGE(PG8_SB(0, 1), cB + hstep, voffB); PG8_STAGE(PG8_SA(0, 0), cA, voffA); PG8_STAGE(PG8_SA(0, 1), cA + hstep, voffA);
        if (wr == 1) PG8_BAR;
        PG8_WAIT_V(2); PG8_BAR;
        PG8_STAGE(PG8_SB(1, 0), cB + kstep, voffB); PG8_STAGE(PG8_SA(1, 0), cA + kstep, voffA); PG8_STAGE(PG8_SB(1, 1), cB + hstep + kstep, voffB);
        PG8_WAIT_V(6); PG8_BAR;
    } else {
        PG8_STAGE(PG8_SB(0, 0), cB, voffB); PG8_STAGE(PG8_SA(0, 0), cA, voffA); PG8_STAGE(PG8_SB(0, 1), cB + hstep, voffB); PG8_STAGE(PG8_SA(0, 1), cA + hstep, voffA);
        if (wr == 1) PG8_BAR;
        PG8_WAIT_V(4); PG8_BAR;
        PG8_STAGE(PG8_SB(1, 0), cB + kstep, voffB); PG8_STAGE(PG8_SA(1, 0), cA + kstep, voffA); PG8_STAGE(PG8_SB(1, 1), cB + hstep + kstep, voffB);
        PG8_WAIT_V(6); PG8_BAR;
    }
    for (;;) {
        const bool has_next = S.next(ui + 1, nxt);
        const char* nA = has_next ? (const char*)g.A + (size_t)nxt.pm * tstep : cA; const char* nB = has_next ? (const char*)g.Bt + (size_t)nxt.pn * tstep : cB;
        for (int t = 0; t < nt; t += 2) {
            const bool last = (t == nt - 2);
            const char* a1 = cA + (size_t)(t + 1) * kstep;
            const char* a2 = last ? nA : cA + (size_t)(t + 2) * kstep; const char* b2 = last ? nB : cB + (size_t)(t + 2) * kstep;
            const char* a3 = a2 + kstep; const char* b3 = b2 + kstep;
            if (last && has_next) S.a_ready(nxt);
            if constexpr (SP2) {
            PG8_LDB(B0, 0, 0); PG8_LDB(B1, 0, 1); PG8_SCHED; PG8_LDA(At, 0, 0); PG8_STAGE(PG8_SA(1, 1), a1 + hstep, voffA);
            PG8_WAIT_V(8); PG8_WAIT_L(0); PG8_BAR; PG8_MMA(0, 0, At, B0); PG8_MMA(0, 1, At, B1); PG8_BAR; PG8_SCHED;
            PG8_LDA(At, 0, 1); PG8_STAGE(PG8_SB(0, 0), b2, voffB); PG8_STAGE(PG8_SB(0, 1), b2 + hstep, voffB); PG8_STAGE(PG8_SA(0, 0), a2, voffA);
            PG8_WAIT_V(8); PG8_WAIT_L(0); PG8_BAR; PG8_MMA(1, 0, At, B0); PG8_MMA(1, 1, At, B1); PG8_BAR; PG8_SCHED;
            PG8_LDB(B0, 1, 0); PG8_LDB(B1, 1, 1); PG8_SCHED; PG8_LDA(At, 1, 0); PG8_STAGE(PG8_SA(0, 1), a2 + hstep, voffA);
            PG8_WAIT_V(8); PG8_WAIT_L(0); PG8_BAR; PG8_MMA(0, 0, At, B0); PG8_MMA(0, 1, At, B1); PG8_BAR; PG8_SCHED;
            PG8_LDA(At, 1, 1); PG8_STAGE(PG8_SB(1, 0), b3, voffB); PG8_STAGE(PG8_SB(1, 1), b3 + hstep, voffB); PG8_STAGE(PG8_SA(1, 0), a3, voffA);
            PG8_WAIT_V(8); PG8_WAIT_L(0); PG8_BAR; PG8_MMA(1, 0, At, B0); PG8_MMA(1, 1, At, B1); PG8_BAR; PG8_SCHED;
            } else {
            PG8_LDB(B0, 0, 0); PG8_SCHED; PG8_LDA(At, 0, 0); PG8_STAGE(PG8_SA(1, 1), a1 + hstep, voffA);
            PG8_WAIT_L(8); PG8_BAR; PG8_WAIT_L(0); PG8_MMA(0, 0, At, B0); PG8_BAR; PG8_SCHED;
            PG8_LDB(B1, 0, 1); PG8_STAGE(PG8_SB(0, 0), b2, voffB);
            PG8_BAR; PG8_WAIT_L(0); PG8_MMA(0, 1, At, B1); PG8_BAR;
            PG8_LDA(At, 0, 1); PG8_STAGE(PG8_SA(0, 0), a2, voffA);
            PG8_BAR; PG8_WAIT_L(0); PG8_MMA(1, 0, At, B0); PG8_BAR; PG8_SCHED;
            PG8_STAGE(PG8_SB(0, 1), b2 + hstep, voffB);
            PG8_WAIT_V(6); PG8_BAR; PG8_MMA(1, 1, At, B1); PG8_BAR;
            PG8_LDB(B0, 1, 0); PG8_SCHED; PG8_LDA(At, 1, 0); PG8_STAGE(PG8_SA(0, 1), a2 + hstep, voffA);
            PG8_WAIT_L(8); PG8_BAR; PG8_WAIT_L(0); PG8_MMA(0, 0, At, B0); PG8_BAR; PG8_SCHED;
            PG8_LDB(B1, 1, 1); PG8_STAGE(PG8_SB(1, 0), b3, voffB);
            PG8_BAR; PG8_WAIT_L(0); PG8_MMA(0, 1, At, B1); PG8_BAR;
            PG8_LDA(At, 1, 1); PG8_STAGE(PG8_SA(1, 0), a3, voffA);
            PG8_BAR; PG8_WAIT_L(0); PG8_MMA(1, 0, At, B0); PG8_BAR; PG8_SCHED;
            PG8_STAGE(PG8_SB(1, 1), b3 + hstep, voffB);
            PG8_WAIT_V(6); PG8_BAR; PG8_MMA(1, 1, At, B1); PG8_BAR;
            }
        }
        if constexpr (ALIGN_EPI) { if (wr == 0) PG8_BAR; }
        if constexpr (!Epi::AFTER_DRAIN) { E(acc, cur, wr, wc, fr, fq); S.done(cur); }
        if (!has_next) break;
#pragma unroll
        for (int a = 0; a < 2; ++a)
#pragma unroll
            for (int b = 0; b < 2; ++b)
#pragma unroll
                for (int m = 0; m < 4; ++m)
#pragma unroll
                    for (int n = 0; n < 2; ++n) acc[a][b][m][n] = (f32x4){0.f, 0.f, 0.f, 0.f};
        cur = nxt; cA = nA; cB = nB; ++ui;
        if constexpr (ALIGN_EPI) { if (wr == 1) PG8_BAR; }
    }
    PG8_WAIT_V(0);
    if constexpr (!ALIGN_EPI) { if (wr == 0) PG8_BAR; }
    PG8_BAR;
    if constexpr (Epi::AFTER_DRAIN) { E.fused(acc, cur, wr, wc, fr, fq, lds, wid, lane); S.done(cur); }
#undef PG8_SA
#undef PG8_SB
#undef PG8_STAGE
#undef PG8_LDA
#undef PG8_LDB
#undef PG8_MMA
#undef PG8_WAIT_V
#undef PG8_WAIT_L
#undef PG8_BAR
#undef PG8_SCHED
}
}
constexpr int NB = 2, SEQ = 16384, CL = 256, DM = 1024, NPB = SEQ + CL  , NR = NB * NPB  , DEPTH = 4;
constexpr int NIN = 3296, NINP = 3328, DFF = 2816, NEXP = 8, DFE = 3584;
constexpr int NWAVES = 8, NTHR = 512;
constexpr float QSCALE = 0.125f * 1.4426950408889634f;
constexpr int PC_Q = 0, PC_K = 512, PC_V = 1024, PC_R = 1536, PC_RK = 2048, PC_RV = 2560, PC_LORA = 3072;

constexpr size_t MiB = 1u << 20;
constexpr size_t WS_CTL = 0, CTL_ZERO_BYTES = 1 * MiB;
constexpr size_t WS_MOD = 1 * MiB;
constexpr size_t WS_ROPE = 2 * MiB;
constexpr size_t WS_LAM = 2 * MiB + 65536;
constexpr size_t WS_XC = 3 * MiB;
constexpr size_t WS_ROUTE = 5 * MiB;
constexpr size_t WS_WINT = 8 * MiB;
constexpr size_t WS_WOUTT = 34 * MiB;
constexpr size_t WS_W13T = 42 * MiB;
constexpr size_t WS_W2T = 64 * MiB;
constexpr size_t WS_VFIRST = 76 * MiB;
constexpr size_t WS_HN = 110 * MiB;
constexpr size_t WS_P = 175 * MiB;
constexpr size_t WS_SPK = 387 * MiB;
constexpr size_t WS_DPK = 485 * MiB;
constexpr size_t WS_Y = 680 * MiB;
constexpr size_t WS_G = 810 * MiB;
constexpr size_t WS_BONUS = 843 * MiB;
constexpr size_t WS_LORA = 845 * MiB;
constexpr size_t WS_END = 848 * MiB;
constexpr int LO_W2 = 0, LO_A2 = 131072, LO_V2 = 262144, LO_G2 = 262144 + 49152, LO_TOTAL = 262144 + 49152 + 196608;
constexpr size_t WS_HF = 175 * MiB;
constexpr size_t WS_W13E = 175 * MiB;
constexpr size_t WS_W2E = 287 * MiB;
constexpr size_t WS_AG = 343 * MiB;
constexpr size_t WS_HMOE = 412 * MiB;
constexpr size_t WS_YEXP = 654 * MiB;
static_assert(WS_WINT + (size_t)4 * NINP * DM * 2 <= WS_WOUTT && WS_WOUTT + (size_t)4 * DM * DM * 2 <= WS_W13T && WS_W13T + (size_t)2 * 2 * DFF * DM * 2 <= WS_W2T && WS_W2T + (size_t)2 * DM * DFF * 2 <= WS_VFIRST, "ws map 1");
static_assert(WS_VFIRST + (size_t)NR * 512 * 2 <= WS_HN && WS_HN + (size_t)NR * DM * 2 <= WS_P && WS_P + (size_t)NR * NINP * 2 <= WS_SPK && WS_SPK + (size_t)NB * 8 * NPB * 192 * 2 <= WS_DPK, "ws map 2");
static_assert(WS_DPK + (size_t)2 * NB * 8 * NPB * 192 * 2 <= WS_Y && WS_Y + (size_t)2 * NR * 512 * 4 <= WS_G && WS_G + (size_t)NR * 512 * 2 <= WS_BONUS && WS_BONUS + (size_t)NR * 8 * 4 <= WS_LORA && WS_LORA + (size_t)LO_TOTAL * 4 <= WS_END, "ws map 3");
static_assert(WS_HF + (size_t)NR * DFF * 2 <= WS_LORA && WS_W13E + (size_t)8 * 2 * DFE * DM * 2 <= WS_W2E && WS_W2E + (size_t)8 * DM * DFE * 2 <= WS_AG && WS_AG + (size_t)35328 * DM * 2 <= WS_HMOE && WS_HMOE + (size_t)35328 * DFE * 2 <= WS_YEXP && WS_YEXP + (size_t)35328 * DM * 2 <= WS_LORA, "ws map 4");
constexpr int CW_TMO = 0;
constexpr int CW_BAR = 4096;
constexpr int CW_QS = 16384;
constexpr int CW_QA = 20480;
constexpr int CW_CNT = 24576;

constexpr int RING_BYTES = 131072;
constexpr int LDSCTL_OFF = RING_BYTES, MISC_OFF = LDSCTL_OFF + 320;
constexpr int LDS_BYTES = 147456;

#define GAS __attribute__((address_space(1)))
#define LAS __attribute__((address_space(3)))
typedef unsigned short bf16;
typedef unsigned v4u __attribute__((ext_vector_type(4)));
typedef unsigned v2u __attribute__((ext_vector_type(2)));
typedef float f32x4 __attribute__((ext_vector_type(4)));
typedef _Float16 h4 __attribute__((ext_vector_type(4)));
#define LDS_WAIT() asm volatile("s_waitcnt lgkmcnt(0)" ::: "memory")
__device__ __forceinline__ unsigned f2bf(float f) { unsigned u = __builtin_bit_cast(unsigned, f); return (u + 0x7fffu + ((u >> 16) & 1u)) >> 16; }
__device__ __forceinline__ unsigned pk2(float lo, float hi) { return f2bf(lo) | (f2bf(hi) << 16); }
__device__ __forceinline__ float bf2f(bf16 h) { return __builtin_bit_cast(float, (unsigned)h << 16); }
__device__ __forceinline__ float bflo(unsigned w) { return __builtin_bit_cast(float, w << 16); }
__device__ __forceinline__ float bfhi(unsigned w) { return __builtin_bit_cast(float, w & 0xffff0000u); }
__device__ __forceinline__ float sigmoid_f(float x) { return 1.0f / (1.0f + __expf(-x)); }
__device__ __forceinline__ float tanh_f(float x) { return 1.0f - 2.0f / (__expf(2.0f * x) + 1.0f); }
__device__ __forceinline__ float wave_sum(float v) {
#pragma unroll
    for (int o = 1; o < 64; o <<= 1) v += __shfl_xor(v, o);
    return v;
}
#define XB_TMO      128
#define XB_XCNT(j)  (256  + 64 * (j))
#define XB_XSUB(j)  (1280 + 64 * (j))
#define XB_XGEN(j)  (2304 + 64 * (j))
#define XB_TOP      3328
#define XB_TOPGEN   3392
#define XCD_BAR_WORDS 3456
#define XB_SPIN_CAP (1u << 18)

__device__ __forceinline__ unsigned xb_ld(unsigned* p)              { return __hip_atomic_load(p, __ATOMIC_RELAXED, __HIP_MEMORY_SCOPE_AGENT); }
__device__ __forceinline__ unsigned xb_add(unsigned* p, unsigned v) { return __hip_atomic_fetch_add(p, v, __ATOMIC_RELAXED, __HIP_MEMORY_SCOPE_AGENT); }
__device__ __forceinline__ unsigned xb_xcc_id() { return (unsigned)__builtin_amdgcn_s_getreg((3 << 11) | 20) & 0xFu; }
#define XB_SPIN(cond, bar) do { unsigned _sp = 0; while (cond) { __builtin_amdgcn_s_sleep(1); \
    if ((++_sp & 255u) == 0u) { if (xb_ld(&(bar)[XB_TMO])) break; if (_sp > XB_SPIN_CAP) { atomicAdd(&(bar)[XB_TMO], 1u); break; } } } } while (0)

struct XcdBarrier {
    unsigned* bar; unsigned x;
    volatile LAS unsigned* st;
};

__device__ __forceinline__ XcdBarrier xcd_barrier_post(unsigned* bar, volatile LAS unsigned* st) {
    XcdBarrier b; b.bar = bar; b.x = xb_xcc_id(); b.st = st;
    if (threadIdx.x == 0) (void)xb_add(&bar[XB_XCNT(b.x)], 1u);
    return b;
}
__device__ __forceinline__ void xcd_barrier_complete(unsigned* bar, unsigned x, unsigned& nloc, unsigned& nx) {
    const unsigned G = gridDim.x * gridDim.y * gridDim.z;
    unsigned sum, cnt, mine, sp = 0u;
    for (;;) {
        sum = 0u; cnt = 0u; mine = 0u;
#pragma unroll
        for (unsigned j = 0; j < 16; ++j) { const unsigned c = xb_ld(&bar[XB_XCNT(j)]); sum += c; cnt += (c > 0u) ? 1u : 0u; mine = (j == x) ? c : mine; }
        if (sum == G) break;
        __builtin_amdgcn_s_sleep(1);
        if ((++sp & 255u) == 0u) { if (xb_ld(&bar[XB_TMO])) break; if (sp > XB_SPIN_CAP) { atomicAdd(&bar[XB_TMO], 1u); break; } }
    }
    nloc = mine > 0u ? mine : 1u; nx = cnt > 0u ? cnt : 1u;
}

__device__ __forceinline__ void xcd_barrier(const XcdBarrier& b) {
    asm volatile("s_waitcnt vmcnt(0)" ::: "memory");
    __syncthreads();
    if (threadIdx.x == 0) {
        unsigned* bar = b.bar;
        __builtin_amdgcn_s_waitcnt(0);
        unsigned nloc = b.st[0], nx = b.st[1];
        if (nloc == 0u) { xcd_barrier_complete(bar, b.x, nloc, nx); b.st[0] = nloc; b.st[1] = nx; }
        const unsigned old = xb_add(&bar[XB_XSUB(b.x)], 1u);
        const unsigned gen = old / nloc;
        if (old + 1u == (gen + 1u) * nloc) {
            __builtin_amdgcn_fence(__ATOMIC_RELEASE, "agent");
            asm volatile("s_waitcnt vmcnt(0)" ::: "memory");
            const unsigned og = xb_add(&bar[XB_TOP], 1u);
            const unsigned tg = og / nx;
            if (og + 1u == (tg + 1u) * nx) xb_add(&bar[XB_TOPGEN], 1u);
            else XB_SPIN(xb_ld(&bar[XB_TOPGEN]) == tg, bar);
            __builtin_amdgcn_fence(__ATOMIC_ACQUIRE, "agent");
            xb_add(&bar[XB_XGEN(b.x)], 1u);
            asm volatile("s_waitcnt vmcnt(0)" ::: "memory");
        } else {
            XB_SPIN(xb_ld(&bar[XB_XGEN(b.x)]) == gen, bar);
            __builtin_amdgcn_fence(__ATOMIC_ACQUIRE, "agent");
            asm volatile("s_waitcnt vmcnt(0)" ::: "memory");
        }
    }
    __syncthreads();
}
struct Args { const float* in[34]; float* out; unsigned char* ws; int ph_lo, ph_hi; };
namespace att {
using bf16x8 = __attribute__((ext_vector_type(8))) short;
using s16x4  = __attribute__((ext_vector_type(4))) short;
using f32x16 = __attribute__((ext_vector_type(16))) float;
using u32x4  = __attribute__((ext_vector_type(4))) unsigned;
constexpr int KVBLK = 64;
constexpr size_t SHM_V = KVBLK * 128 * 2, SHM_K = KVBLK * 128 * 2;
constexpr float THR2 = 11.5f;
#define KSWZ(row, colB) ((row) * 256 + ((colB) ^ (((row) & 7) << 4)))
#define SBAR() __builtin_amdgcn_sched_barrier(0)
__device__ __forceinline__ int crow(int r, int hi) { return (r & 3) + 8 * (r >> 2) + 4 * hi; }
__device__ __forceinline__ unsigned cvtpk(float lo, float hi) { unsigned r; asm volatile("v_cvt_pk_bf16_f32 %0, %1, %2" : "=v"(r) : "v"(lo), "v"(hi)); return r; }
__device__ __forceinline__ bf16x8 ld8(const bf16* p) { return *reinterpret_cast<const bf16x8*>(p); }

__device__ __forceinline__ void partialSM(f32x16& p0, f32x16& p1, float& m_reg, float& mn, float& alpha) {
  float pmax = p0[0];
#pragma unroll
  for (int r = 1; r < 16; ++r) pmax = fmaxf(pmax, p0[r]);
#pragma unroll
  for (int r = 0; r < 16; ++r) pmax = fmaxf(pmax, p1[r]);
  { auto rr = __builtin_amdgcn_permlane32_swap(__float_as_uint(pmax), __float_as_uint(pmax), false, false);
    pmax = fmaxf(__uint_as_float(rr[0]), __uint_as_float(rr[1])); }
  if (__builtin_expect(__all(pmax - m_reg <= THR2), 1)) { mn = m_reg; alpha = 1.f; }
  else { mn = fmaxf(m_reg, pmax); alpha = __builtin_amdgcn_exp2f(m_reg - mn); m_reg = mn; }
#pragma unroll
  for (int r = 0; r < 16; ++r) p0[r] = p0[r] - mn;
#pragma unroll
  for (int r = 0; r < 16; ++r) p1[r] = p1[r] - mn;
#pragma unroll
  for (int r = 0; r < 16; ++r) p0[r] = __builtin_amdgcn_exp2f(p0[r]);
}
__device__ __forceinline__ void finishSM(f32x16& p0, f32x16& p1, float alpha, float& l_reg, bf16x8& pa0, bf16x8& pa1, bf16x8& pa2, bf16x8& pa3) {
#pragma unroll
  for (int r = 0; r < 16; ++r) p1[r] = __builtin_amdgcn_exp2f(p1[r]);
  float ps = 0;
#pragma unroll
  for (int r = 0; r < 16; ++r) ps += p0[r];
#pragma unroll
  for (int r = 0; r < 16; ++r) ps += p1[r];
  { auto rr = __builtin_amdgcn_permlane32_swap(__float_as_uint(ps), __float_as_uint(ps), false, false);
    ps = __uint_as_float(rr[0]) + __uint_as_float(rr[1]); }
  l_reg = l_reg * alpha + ps;
#define PK4(P, BASE, OUT) do { unsigned a0 = cvtpk(P[BASE + 0], P[BASE + 1]), a1 = cvtpk(P[BASE + 2], P[BASE + 3]);   \
    unsigned b0 = cvtpk(P[BASE + 4], P[BASE + 5]), b1 = cvtpk(P[BASE + 6], P[BASE + 7]);                              \
    auto r0 = __builtin_amdgcn_permlane32_swap(a0, b0, false, false); auto r1 = __builtin_amdgcn_permlane32_swap(a1, b1, false, false); \
    u32x4 w = {r0[0], r1[0], r0[1], r1[1]}; OUT = *reinterpret_cast<bf16x8*>(&w); } while (0)
  PK4(p0, 0, pa0); PK4(p0, 8, pa1); PK4(p1, 0, pa2); PK4(p1, 8, pa3);
#undef PK4
}
__device__ __forceinline__ void qkt(f32x16& p0, f32x16& p1, const bf16* Ks, const bf16x8* qr, int r32, int hi, int cbase) {
  p0 = f32x16{}; p1 = f32x16{};
#pragma unroll
  for (int d0 = 0; d0 < 4; ++d0) { int cb = (cbase + d0 * 16 + hi * 8) * 2;
    bf16x8 b0 = *reinterpret_cast<const bf16x8*>((const char*)Ks + KSWZ(r32, cb));
    bf16x8 b1 = *reinterpret_cast<const bf16x8*>((const char*)Ks + KSWZ(32 + r32, cb));
    p0 = __builtin_amdgcn_mfma_f32_32x32x16_bf16(b0, qr[d0], p0, 0, 0, 0);
    p1 = __builtin_amdgcn_mfma_f32_32x32x16_bf16(b1, qr[d0], p1, 0, 0, 0); }
}
__device__ __forceinline__ int v_st(int k, int c) { const int kk = (k & ~0xC) | ((k & 4) << 1) | ((k & 8) >> 1); return ((kk >> 3) * 4 + (c >> 5)) * 512 + ((kk & 7) * 32 + (c & 31)) * 2; }
__device__ __forceinline__ int v_rd_base(int lane) { return ((lane & 3) << 3) | (((lane >> 2) & 3) << 6) | (((lane >> 4) & 1) << 5) | (((lane >> 5) & 1) << 8); }
constexpr int v_rd_off(int d0, int ks, int half) { return d0 * 512 + ks * 4096 + half * 2048; }
template <int OFF> __device__ __forceinline__ s16x4 tr_read(int vb) {
  s16x4 r; asm volatile("ds_read_b64_tr_b16 %0, %1 offset:%2" : "=&v"(r) : "v"(vb), "i"(OFF) : "memory"); return r;
}
template <int D0> __device__ __forceinline__ void pv_one(f32x16& od, int vb, bf16x8 pa0, bf16x8 pa1, bf16x8 pa2, bf16x8 pa3) {
  const s16x4 l0 = tr_read<v_rd_off(D0, 0, 0)>(vb), h0 = tr_read<v_rd_off(D0, 0, 1)>(vb), l1 = tr_read<v_rd_off(D0, 1, 0)>(vb), h1 = tr_read<v_rd_off(D0, 1, 1)>(vb);
  const s16x4 l2 = tr_read<v_rd_off(D0, 2, 0)>(vb), h2 = tr_read<v_rd_off(D0, 2, 1)>(vb), l3 = tr_read<v_rd_off(D0, 3, 0)>(vb), h3 = tr_read<v_rd_off(D0, 3, 1)>(vb);
  asm volatile("s_waitcnt lgkmcnt(0)" ::: "memory"); SBAR();
#define PK(L, H) (bf16x8){L[0], L[1], L[2], L[3], H[0], H[1], H[2], H[3]}
  od = __builtin_amdgcn_mfma_f32_32x32x16_bf16(pa0, PK(l0, h0), od, 0, 0, 0);
  od = __builtin_amdgcn_mfma_f32_32x32x16_bf16(pa1, PK(l1, h1), od, 0, 0, 0);
  od = __builtin_amdgcn_mfma_f32_32x32x16_bf16(pa2, PK(l2, h2), od, 0, 0, 0);
  od = __builtin_amdgcn_mfma_f32_32x32x16_bf16(pa3, PK(l3, h3), od, 0, 0, 0);
#undef PK
}
__device__ __forceinline__ void pv_d0(f32x16* o, int vb, bf16x8 pa0, bf16x8 pa1, bf16x8 pa2, bf16x8 pa3) {
  pv_one<0>(o[0], vb, pa0, pa1, pa2, pa3); pv_one<1>(o[1], vb, pa0, pa1, pa2, pa3); pv_one<2>(o[2], vb, pa0, pa1, pa2, pa3); pv_one<3>(o[3], vb, pa0, pa1, pa2, pa3);
}

__device__ __forceinline__ void attn_unit(const bf16* __restrict__ P, int qrow0, int krow0, int NT, int h, float lam, float oml, const float* __restrict__ subg, bf16* __restrict__ AO, char* lds) {
  constexpr int LDK = NINP;
  const int tid = opaque_tid(), wid = __builtin_amdgcn_readfirstlane(tid >> 6), lane = tid & 63, r32 = lane & 31, hi = lane >> 5;
  const int mp = wid >> 2, wq = wid & 3;
  bf16* V_lds = (bf16*)lds; bf16* K_lds = (bf16*)(lds + 2 * SHM_V);
  float* ws = (float*)(lds + 2 * SHM_V + 2 * SHM_K) + wid * 64; float* li_l = ws; float* al_l = ws + 32;
  float m_reg = -1e30f, l_reg = 0; f32x16 o[4] = {}; bf16x8 qr[4];
  const bf16* Qw = P + (size_t)(qrow0 + wq * 32 + r32) * LDK + PC_Q + h * 128 + mp * 64 + hi * 8;
#pragma unroll
  for (int d0 = 0; d0 < 4; ++d0) qr[d0] = ld8(Qw + d0 * 16);
  const bf16* Kh = P + (size_t)krow0 * LDK + PC_K + h * 128; const bf16* Vh = P + (size_t)krow0 * LDK + PC_V + h * 128;
  const int cbase = mp * 64;
  const int sr = tid >> 4, sc = (tid & 15) * 8, vst0 = v_st(sr, sc), vst1 = v_st(32 + sr, sc);
  const int vb0 = (int)(uintptr_t)V_lds + v_rd_base(lane);
  struct { bf16x8 vs0, vs1, ks0, ks1; } sr_[2];
#define SLOAD(i, k0) do { sr_[i].vs0 = ld8(&Vh[(size_t)((k0) + sr) * LDK + sc]); sr_[i].vs1 = ld8(&Vh[(size_t)((k0) + 32 + sr) * LDK + sc]); \
    sr_[i].ks0 = ld8(&Kh[(size_t)((k0) + sr) * LDK + sc]); sr_[i].ks1 = ld8(&Kh[(size_t)((k0) + 32 + sr) * LDK + sc]); } while (0)
#define SWRITE(b, i) do { *(bf16x8*)((char*)V_lds + (b) * SHM_V + vst0) = sr_[i].vs0;          \
    *(bf16x8*)((char*)V_lds + (b) * SHM_V + vst1) = sr_[i].vs1; int kc = sc * 2;               \
    *(bf16x8*)((char*)K_lds + (b) * SHM_K + KSWZ(sr, kc)) = sr_[i].ks0;                       \
    *(bf16x8*)((char*)K_lds + (b) * SHM_K + KSWZ(32 + sr, kc)) = sr_[i].ks1; } while (0)
#define SWAIT() asm volatile("s_waitcnt vmcnt(4)" ::: "memory")
#define RESC(a) do { if (__any((a) < 1.f)) { if (hi == 0) al_l[r32] = (a); asm volatile("s_waitcnt lgkmcnt(0)" ::: "memory"); \
    _Pragma("unroll") for (int d = 0; d < 4; ++d) _Pragma("unroll") for (int r = 0; r < 16; ++r) o[d][r] *= al_l[crow(r, hi)]; } } while (0)
  f32x16 pA0, pA1, pB0, pB1; float mnA, mnB, alA, alB; bf16x8 pa0, pa1, pa2, pa3;
  constexpr int SE = 0, SO = 1;
  SLOAD(SE, 0); asm volatile("s_waitcnt vmcnt(0)" ::: "memory"); SWRITE(0, SE); __syncthreads();
  qkt(pA0, pA1, K_lds, qr, r32, hi, cbase); partialSM(pA0, pA1, m_reg, mnA, alA);
  SLOAD(SO, KVBLK); if (2 < NT) SLOAD(SE, 2 * KVBLK);
  SWAIT(); SWRITE(1, SO); __syncthreads();
  for (int j = 1; j + 1 < NT; j += 2) {
    SBAR(); qkt(pB0, pB1, (bf16*)((char*)K_lds + SHM_K), qr, r32, hi, cbase);
    finishSM(pA0, pA1, alA, l_reg, pa0, pa1, pa2, pa3); SBAR();
    SLOAD(SO, (j + 2) * KVBLK); SBAR();
    pv_d0(o, vb0, pa0, pa1, pa2, pa3); partialSM(pB0, pB1, m_reg, mnB, alB);
    __syncthreads(); SWAIT(); SWRITE(0, SE);
    RESC(alB); __syncthreads();
    SBAR(); qkt(pA0, pA1, K_lds, qr, r32, hi, cbase);
    finishSM(pB0, pB1, alB, l_reg, pa0, pa1, pa2, pa3); SBAR();
    if (j + 3 < NT) SLOAD(SE, (j + 3) * KVBLK); SBAR();
    pv_d0(o, vb0 + (int)SHM_V, pa0, pa1, pa2, pa3); partialSM(pA0, pA1, m_reg, mnA, alA);
    __syncthreads(); SWAIT(); SWRITE(1, SO);
    RESC(alA); __syncthreads();
  }
  SBAR(); qkt(pB0, pB1, (bf16*)((char*)K_lds + SHM_K), qr, r32, hi, cbase);
  finishSM(pA0, pA1, alA, l_reg, pa0, pa1, pa2, pa3); SBAR();
  pv_d0(o, vb0, pa0, pa1, pa2, pa3); partialSM(pB0, pB1, m_reg, mnB, alB);
  __syncthreads(); RESC(alB);
  finishSM(pB0, pB1, alB, l_reg, pa0, pa1, pa2, pa3); SBAR();
  pv_d0(o, vb0 + (int)SHM_V, pa0, pa1, pa2, pa3);
  if (hi == 0) li_l[r32] = l_reg; asm volatile("s_waitcnt lgkmcnt(0)" ::: "memory");
  float rli[16];
#pragma unroll
  for (int r = 0; r < 16; ++r) rli[r] = __builtin_amdgcn_rcpf(li_l[crow(r, hi)]);
  __syncthreads();
  { float* OB = (float*)lds + mp * (128 * 128) + (wq * 32) * 128;
#pragma unroll
    for (int r = 0; r < 16; ++r) { const int orow = crow(r, hi);
#pragma unroll
      for (int d0 = 0; d0 < 4; ++d0) OB[orow * 128 + d0 * 32 + r32] = o[d0][r] * rli[r]; } }
  __syncthreads();
  { const int row = tid >> 2, qd = tid & 3;
    const f32x4* A4 = (const f32x4*)((const float*)lds + row * 128 + qd * 32); const f32x4* B4 = A4 + (128 * 128) / 4;
    f32x4 dv[8]; float ss = 0.f;
#pragma unroll
    for (int j = 0; j < 8; ++j) { dv[j] = A4[j] - lam * B4[j]; ss += (dv[j][0] * dv[j][0] + dv[j][1] * dv[j][1]) + (dv[j][2] * dv[j][2] + dv[j][3] * dv[j][3]); }
    ss += __shfl_xor(ss, 1); ss += __shfl_xor(ss, 2);
    const float rstd = __builtin_amdgcn_rsqf(ss * (1.0f / 128.0f) + 1e-5f) ;
    const f32x4* g4 = (const f32x4*)(subg + qd * 32);
    bf16* op = AO + (size_t)(qrow0 + row) * DM + h * 128 + qd * 32;
#pragma unroll
    for (int j = 0; j < 4; ++j) { const f32x4 g0 = g4[2 * j], g1 = g4[2 * j + 1]; const f32x4 a = dv[2 * j] * rstd, b = dv[2 * j + 1] * rstd;
      u32x4 w; w.x = cvtpk(a[0] * g0[0] * oml, a[1] * g0[1] * oml); w.y = cvtpk(a[2] * g0[2] * oml, a[3] * g0[3] * oml);
      w.z = cvtpk(b[0] * g1[0] * oml, b[1] * g1[1] * oml); w.w = cvtpk(b[2] * g1[2] * oml, b[3] * g1[3] * oml);
      *(u32x4*)(op + j * 8) = w; } }
  __syncthreads();
#undef SLOAD
#undef SWRITE
#undef SWAIT
#undef RESC
}
#undef SBAR
}
__device__ __forceinline__ float dpp_rowsum16(float x) {
    x += __builtin_bit_cast(float, __builtin_amdgcn_update_dpp(0, __builtin_bit_cast(int, x), 0xB1, 0xF, 0xF, true));
    x += __builtin_bit_cast(float, __builtin_amdgcn_update_dpp(0, __builtin_bit_cast(int, x), 0x4E, 0xF, 0xF, true));
    x += __builtin_bit_cast(float, __builtin_amdgcn_update_dpp(0, __builtin_bit_cast(int, x), 0x141, 0xF, 0xF, true));
    x += __builtin_bit_cast(float, __builtin_amdgcn_update_dpp(0, __builtin_bit_cast(int, x), 0x140, 0xF, 0xF, true));
    return x;
}
constexpr int SC_CH = 32, SC_STEPF = 16 * 20 + 32;
__device__ __forceinline__ int scan_pos(int n, int d) { return d == 0 ? n : (n < CL ? (CL - 1) - n : (NPB + CL - 1) - n); }
__device__ __forceinline__ void scan_unit(int d, int b, int h, int rh, const _Float16* __restrict__ SPK, const _Float16* __restrict__ DPK, float* __restrict__ Y, LAS unsigned char* lds) {
    const int tid = opaque_tid(), wid = __builtin_amdgcn_readfirstlane(tid >> 6), lane = tid & 63, ri = lane >> 4, q = lane & 15;
    LAS float* stg = (LAS float*)lds;
    LAS float* ybuf = stg + 2 * SC_CH * SC_STEPF;
    const _Float16* sp = SPK + (size_t)((b * 8 + h) * NPB) * 192;
    const _Float16* dp = DPK + (size_t)(((d * 2 + b) * 8 + h) * NPB) * 192;
    const int sidx = tid >> 4, sq = tid & 15;
    h4 g_r, g_kk, g_v, g_w, g_b, g_kd;
#define SC_LOAD(c) do { const int p_ = scan_pos((c) * SC_CH + sidx, d); const _Float16* s_ = sp + (size_t)p_ * 192 + sq * 4; const _Float16* d_ = dp + (size_t)p_ * 192 + sq * 4; \
        g_r = *(const h4*)(s_); g_kk = *(const h4*)(s_ + 64); g_w = *(const h4*)(d_); g_b = *(const h4*)(d_ + 64); g_kd = *(const h4*)(d_ + 128); \
        if (sq < 8) g_v = *(const h4*)(sp + (size_t)p_ * 192 + 128 + rh * 32 + sq * 4); } while (0)
#define SC_CVT(x) ((f32x4){(float)(x)[0], (float)(x)[1], (float)(x)[2], (float)(x)[3]})
#define SC_WRITE(buf) do { LAS f32x4* o_ = (LAS f32x4*)(stg + ((buf) * SC_CH + sidx) * SC_STEPF + sq * 20); \
        o_[0] = SC_CVT(g_w); o_[1] = SC_CVT(g_b); o_[2] = SC_CVT(g_kd); o_[3] = SC_CVT(g_kk); o_[4] = SC_CVT(g_r); \
        if (sq < 8) *(LAS f32x4*)(stg + ((buf) * SC_CH + sidx) * SC_STEPF + 320 + sq * 4) = SC_CVT(g_v); } while (0)
    f32x4 s = {0.f, 0.f, 0.f, 0.f};
    constexpr int NCH = NPB / SC_CH;
    SC_LOAD(0); SC_WRITE(0); __syncthreads();
    for (int c = 0; c < NCH; ++c) {
        const int buf = c & 1;
        if (c + 1 < NCH) SC_LOAD(c + 1);
        const LAS float* sb = stg + buf * SC_CH * SC_STEPF;
        LAS float* yb = ybuf + buf * SC_CH * 32;
#pragma unroll 4
        for (int n = 0; n < SC_CH; ++n) {
            const LAS f32x4* in4 = (const LAS f32x4*)(sb + n * SC_STEPF + q * 20);
            const f32x4 w = in4[0], bb = in4[1], kd = in4[2], kk = in4[3], rr = in4[4];
            const float vv = sb[n * SC_STEPF + 320 + wid * 4 + ri];
            float sa = (s[0] * kk[0] + s[1] * kk[1]) + (s[2] * kk[2] + s[3] * kk[3]);
            sa = -dpp_rowsum16(sa);
            s = s - s * w; s = s + sa * bb; s = s + vv * kd;
            float yp = (s[0] * rr[0] + s[1] * rr[1]) + (s[2] * rr[2] + s[3] * rr[3]);
            yp = dpp_rowsum16(yp);
            if (q == 0) yb[n * 32 + wid * 4 + ri] = yp;
        }
        if (c + 1 < NCH) SC_WRITE(buf ^ 1);
        __syncthreads();
        { const int n = tid >> 4, r2 = (tid & 15) * 2; const int p_ = scan_pos(c * SC_CH + n, d);
          const float y0 = yb[n * 32 + r2], y1 = yb[n * 32 + r2 + 1];
          float* yo = Y + ((size_t)d * NR + (size_t)b * NPB + p_) * 512 + h * 64 + rh * 32 + r2;
          *(float2*)yo = make_float2(y0, y1); }
    }
    __syncthreads();
#undef SC_LOAD
#undef SC_CVT
#undef SC_WRITE
}

__device__ __forceinline__ void transpose_item(const float* __restrict__ W, int K, int N, bf16* __restrict__ WT, int out_row0, int k0, int n0, LAS float* scr, int lane) {
#pragma unroll 8
    for (int i = 0; i < 32; ++i) { const int kk = 2 * i + (lane >> 5); scr[kk * 33 + (lane & 31)] = W[(size_t)(k0 + kk) * N + n0 + (lane & 31)]; }
    LDS_WAIT(); asm volatile("" ::: "memory");
    const int c = lane & 7;
#pragma unroll
    for (int j = 0; j < 4; ++j) { const int n = (lane >> 3) + 8 * j; const LAS float* s = scr + (8 * c) * 33 + n;
        v4u o; o.x = pk2(s[0 * 33], s[1 * 33]); o.y = pk2(s[2 * 33], s[3 * 33]); o.z = pk2(s[4 * 33], s[5 * 33]); o.w = pk2(s[6 * 33], s[7 * 33]);
        *(v4u*)(WT + (size_t)(out_row0 + n) * K + k0 + 8 * c) = o; }
    LDS_WAIT(); asm volatile("" ::: "memory");
}
__device__ __forceinline__ void transpose_matrix_item(const float* W, int K, int N, bf16* WT, int item, int il_half  , LAS float* scr, int lane) {
    const int nblk = N / 32, kb = item / nblk, nb = item - kb * nblk, n0 = 32 * nb;
    const int orow = (il_half < 0) ? n0 : ((n0 >> 7) * 256 + il_half * 128 + (n0 & 127));
    transpose_item(W, K, N, WT, orow, 64 * kb, n0, scr, lane);
}

struct Ptrs {
    const float* in[34]; float* out; unsigned char* ws;
};
#define IN_X 0
#define IN_C 1
#define IN_CTX 2
#define IN_CCTX 3
#define IN_ADAW 4
#define IN_ADAB 5
#define IN_N1G 6
#define IN_N2G 7
#define IN_WIN 8
#define IN_WOUT 9
#define IN_DLAM 10
#define IN_SUBG 11
#define IN_MU 12
#define IN_W0 13
#define IN_W2 14
#define IN_A0 15
#define IN_A2 16
#define IN_V0 17
#define IN_V1 18
#define IN_V2 19
#define IN_G2 20
#define IN_KK 21
#define IN_KA 22
#define IN_RK 23
#define IN_LNW 24
#define IN_LNB 25
#define IN_FW1 26
#define IN_FW3 27
#define IN_FW2 28
#define IN_ROUTER 29
#define IN_EW1 30
#define IN_EW3 31
#define IN_EW2 32
#define IN_FINALG 33

__device__ __forceinline__ void phase_prologue(const Args& a, LAS unsigned char* lds, int vcu, int G) {
    const int tid = opaque_tid(), lane = tid & 63, wave = __builtin_amdgcn_readfirstlane(tid >> 6);
    unsigned char* ws = opaque_ptr(a.ws);
    LAS float* scr = (LAS float*)(lds + wave * 8704);
    LAS float* sl = (LAS float*)(lds + 73728);
    for (int i = tid; i < 3072; i += NTHR) { const float v = (i < 2048) ? a.in[IN_C][i] : a.in[IN_CCTX][i - 2048]; sl[i] = v * sigmoid_f(v); }
    __syncthreads();
    const int gw = vcu * NWAVES + wave, NGW = G * NWAVES;
    constexpr int T_MOD = 4 * 96;
    constexpr int I_WIN = 16 * (NIN / 32), I_WOUT = 16 * 32, I_F13 = 16 * (DFF / 32), I_F2 = (DFF / 64) * 32;
    constexpr int T_WIN = 4 * I_WIN, T_WOUT = 4 * I_WOUT, T_F1 = 2 * I_F13, T_F3 = 2 * I_F13, T_F2 = 2 * I_F2;
    constexpr int T_PAD = 4 * 32, T_ROPE = 64, T_LAM = 4;
    constexpr int NT = T_MOD + T_WIN + T_WOUT + T_F1 + T_F3 + T_F2 + T_PAD + T_ROPE + T_LAM;
    float* MOD = (float*)(ws + WS_MOD);
    for (int it = gw; it < NT; it += NGW) {
        int r = it;
        if (r < T_MOD) {
            const int l = r / 96, jg = r - l * 96; const float* aw = a.in[IN_ADAW] + (size_t)l * 1024 * 6144 + jg * 64 + lane;
            float a0 = 0.f, a1 = 0.f, a2 = 0.f;
#pragma unroll 8
            for (int i = 0; i < 1024; ++i) { const float w = aw[(size_t)i * 6144]; a0 += sl[i] * w; a1 += sl[1024 + i] * w; a2 += sl[2048 + i] * w; }
            const float bb = a.in[IN_ADAB][l * 6144 + jg * 64 + lane];
            MOD[(l * 3 + 0) * 6144 + jg * 64 + lane] = a0 + bb; MOD[(l * 3 + 1) * 6144 + jg * 64 + lane] = a1 + bb; MOD[(l * 3 + 2) * 6144 + jg * 64 + lane] = a2 + bb;
            continue; }
        r -= T_MOD;
        if (r < T_WIN) { const int l = r / I_WIN; transpose_matrix_item(a.in[IN_WIN] + (size_t)l * DM * NIN, DM, NIN, (bf16*)(ws + WS_WINT) + (size_t)l * NINP * DM, r - l * I_WIN, -1, scr, lane); continue; }
        r -= T_WIN;
        if (r < T_WOUT) { const int l = r / I_WOUT; transpose_matrix_item(a.in[IN_WOUT] + (size_t)l * DM * DM, DM, DM, (bf16*)(ws + WS_WOUTT) + (size_t)l * DM * DM, r - l * I_WOUT, -1, scr, lane); continue; }
        r -= T_WOUT;
        if (r < T_F1) { const int l = r / I_F13; transpose_matrix_item(a.in[IN_FW1] + (size_t)l * DM * DFF, DM, DFF, (bf16*)(ws + WS_W13T) + (size_t)l * 2 * DFF * DM, r - l * I_F13, 0, scr, lane); continue; }
        r -= T_F1;
        if (r < T_F3) { const int l = r / I_F13; transpose_matrix_item(a.in[IN_FW3] + (size_t)l * DM * DFF, DM, DFF, (bf16*)(ws + WS_W13T) + (size_t)l * 2 * DFF * DM, r - l * I_F13, 1, scr, lane); continue; }
        r -= T_F3;
        if (r < T_F2) { const int l = r / I_F2; transpose_matrix_item(a.in[IN_FW2] + (size_t)l * DFF * DM, DFF, DM, (bf16*)(ws + WS_W2T) + (size_t)l * DM * DFF, r - l * I_F2, -1, scr, lane); continue; }
        r -= T_F2;
        if (r < T_PAD) { const int l = r >> 5, row = NIN + (r & 31); v4u z = {0u, 0u, 0u, 0u}; v4u* o = (v4u*)((bf16*)(ws + WS_WINT) + ((size_t)l * NINP + row) * DM) + lane * 2; o[0] = z; o[1] = z; continue; }
        r -= T_PAD;
        if (r < T_ROPE) { const int e = r * 64 + lane, pos = e >> 4, j = e & 15;
            const float inv = __builtin_amdgcn_exp2f(-(float)(2 * j) * (13.287712379549449f / 32.0f)); const float ang = (float)pos * inv;
            float2* T = (float2*)(ws + WS_ROPE); T[e] = make_float2(cosf(ang), sinf(ang)); continue; }
        r -= T_ROPE;
        { const int l = r; const float* lp = a.in[IN_DLAM] + l * 256;
          const float s0 = wave_sum(lp[lane] * lp[64 + lane]), s1 = wave_sum(lp[128 + lane] * lp[192 + lane]);
          const float li = 0.8f - 0.6f * expf(-0.3f * (float)l);
          if (lane == 0) { float* L = (float*)(ws + WS_LAM); L[l * 2] = expf(s0) - expf(s1) + li; L[l * 2 + 1] = 1.0f - li; } }
    }
    { float* LT = (float*)(ws + WS_LORA);
      for (int o = (vcu * NTHR + tid); o < LO_TOTAL; o += G * NTHR) {
          float v;
          if (o < LO_A2) { const int m = o >> 14, r = o & 16383, chn = r >> 5, j = r & 31; v = a.in[IN_W2][((size_t)m * 32 + j) * 512 + chn]; }
          else if (o < LO_V2) { const int q = o - LO_A2; const int m = q >> 14, r = q & 16383, chn = r >> 5, j = r & 31; v = a.in[IN_A2][((size_t)m * 32 + j) * 512 + chn]; }
          else if (o < LO_G2) { const int q = o - LO_V2; const int m = q >> 14, r = q & 16383, chn = r >> 5, j = r & 31; v = a.in[IN_V2][((size_t)m * 32 + j) * 512 + chn]; }
          else { const int q = o - LO_G2; const int m = q / 49152, r = q - m * 49152, chn = r / 96, j = r - chn * 96; v = a.in[IN_G2][((size_t)m * 96 + j) * 512 + chn]; }
          LT[o] = v; } }
}

__device__ __forceinline__ void phase_norm(const Args& a, LAS unsigned char* lds, int vcu, int G, int l, int which_norm, bool moe) {
    const int tid = opaque_tid(), lane = tid & 63, wave = __builtin_amdgcn_readfirstlane(tid >> 6);
    unsigned char* ws = opaque_ptr(a.ws);
    LAS float* tabA = (LAS float*)lds; LAS float* tabB = tabA + 3072; LAS float* rwT = tabB + 3072;
    const float* MOD = (const float*)(ws + WS_MOD) + (size_t)l * 3 * 6144;
    const float* ng = a.in[which_norm ? IN_N2G : IN_N1G] + l * 1024;
    const int off_sh = which_norm ? 3072 : 0, off_sc = off_sh + 1024;
    for (int i = tid; i < 3072; i += NTHR) { const int w = i >> 10, c = i & 1023; tabA[i] = ng[c] * (1.0f + MOD[w * 6144 + off_sc + c]); tabB[i] = MOD[w * 6144 + off_sh + c]; }
    if (moe) { const float* rw = a.in[IN_ROUTER] + (size_t)(l >> 1) * 1024 * 8; for (int i = tid; i < 8192; i += NTHR) { const int c = i >> 3, e = i & 7; rwT[e * 1024 + c] = rw[i]; } }
    __syncthreads();
    const float* srcLat = (l == 0 && which_norm == 0) ? a.in[IN_X] : a.out;
    const float* srcCtx = (l == 0 && which_norm == 0) ? a.in[IN_CTX] : (const float*)(ws + WS_XC);
    bf16* HN = (bf16*)(ws + WS_HN);
    const int gw = vcu * NWAVES + wave, NGW = G * NWAVES;
    for (int R = gw; R < NR; R += NGW) {
        const int b = R / NPB, p = R - b * NPB; const int w = (p < CL) ? 2 : b;
        const float* xr = (p < CL) ? srcCtx + (size_t)(b * CL + p) * 1024 : srcLat + ((size_t)b * SEQ + (p - CL)) * 1024;
        const f32x4* x4 = (const f32x4*)xr + lane;
        f32x4 v[4]; float ss = 0.f;
#pragma unroll
        for (int j = 0; j < 4; ++j) { v[j] = x4[64 * j]; ss += (v[j][0] * v[j][0] + v[j][1] * v[j][1]) + (v[j][2] * v[j][2] + v[j][3] * v[j][3]); }
        const float rstd = 1.0f / sqrtf(wave_sum(ss) * (1.0f / 1024.0f) + 1e-6f);
        const LAS f32x4* A4 = (const LAS f32x4*)(tabA + w * 1024) + lane; const LAS f32x4* B4 = (const LAS f32x4*)(tabB + w * 1024) + lane;
        unsigned long long* o8 = (unsigned long long*)(HN + (size_t)R * 1024) + lane;
#pragma unroll
        for (int j = 0; j < 4; ++j) { v[j] = (v[j] * rstd) * A4[64 * j] + B4[64 * j];
            o8[64 * j] = (unsigned long long)pk2(v[j][0], v[j][1]) | ((unsigned long long)pk2(v[j][2], v[j][3]) << 32); }
        if (moe) {
            float lg[8];
#pragma unroll
            for (int e = 0; e < 8; ++e) { const LAS f32x4* r4 = (const LAS f32x4*)(rwT + e * 1024) + lane; float s = 0.f;
#pragma unroll
                for (int j = 0; j < 4; ++j) { const f32x4 rr = r4[64 * j]; s += (v[j][0] * rr[0] + v[j][1] * rr[1]) + (v[j][2] * rr[2] + v[j][3] * rr[3]); }
                lg[e] = wave_sum(s); }
            int e1 = 0; float v1 = lg[0];
#pragma unroll
            for (int e = 1; e < 8; ++e) if (lg[e] > v1) { v1 = lg[e]; e1 = e; }
            int e2 = -1; float v2 = -3.0e38f;
#pragma unroll
            for (int e = 0; e < 8; ++e) if (e != e1 && lg[e] > v2) { v2 = lg[e]; e2 = e; }
            if (lane == 0) {
                const float g1 = 1.0f / (1.0f + __expf(v2 - v1)), g2 = 1.0f - g1;
                unsigned* cnt = (unsigned*)(ws + WS_CTL) + CW_CNT + (((l >> 1) * 2 + b) * 8) * 64;
                const unsigned p1 = atomicAdd(cnt + 64 * e1, 1u), p2 = atomicAdd(cnt + 64 * e2, 1u);
                unsigned* ro = (unsigned*)(ws + WS_ROUTE) + (size_t)R * 8;
                ro[0] = (unsigned)e1; ro[1] = (unsigned)e2; ro[2] = p1; ro[3] = p2; ro[4] = __float_as_uint(g1); ro[5] = __float_as_uint(g2);
            }
        }
    }
    if (moe) {
        LAS float* scr = (LAS float*)(lds + 57344 + wave * 8704);
        const int li = l >> 1;
        constexpr int I_13 = 16 * (DFE / 32), I_2 = (DFE / 64) * 32;
        constexpr int NTK = 8 * (2 * I_13 + I_2);
        for (int it = gw; it < NTK; it += NGW) {
            const int e = it / (2 * I_13 + I_2); int r = it - e * (2 * I_13 + I_2);
            if (r < I_13) { transpose_matrix_item(a.in[IN_EW1] + ((size_t)li * 8 + e) * DM * DFE, DM, DFE, (bf16*)(ws + WS_W13E) + (size_t)e * 2 * DFE * DM, r, 0, scr, lane); continue; }
            r -= I_13;
            if (r < I_13) { transpose_matrix_item(a.in[IN_EW3] + ((size_t)li * 8 + e) * DM * DFE, DM, DFE, (bf16*)(ws + WS_W13E) + (size_t)e * 2 * DFE * DM, r, 1, scr, lane); continue; }
            r -= I_13;
            transpose_matrix_item(a.in[IN_EW2] + ((size_t)li * 8 + e) * DFE * DM, DFE, DM, (bf16*)(ws + WS_W2E) + (size_t)e * DM * DFE, r, -1, scr, lane);
        }
    }
}
__device__ __forceinline__ void phase_prep(const Args& a, LAS unsigned char* lds, int G, int l) {
    const int tid = opaque_tid(), lane = tid & 63, wave = __builtin_amdgcn_readfirstlane(tid >> 6);
    unsigned char* ws = opaque_ptr(a.ws);
    bf16* P = (bf16*)(ws + WS_P);
    _Float16* SPK = (_Float16*)(ws + WS_SPK); _Float16* DPK = (_Float16*)(ws + WS_DPK); _Float16* VF = (_Float16*)(ws + WS_VFIRST); _Float16* GG = (_Float16*)(ws + WS_G);
    float* BON = (float*)(ws + WS_BONUS); const float* LT = (const float*)(ws + WS_LORA);
    LAS float* wdT = (LAS float*)lds;
    LAS float* adS = wdT + 32 * 64;
    LAS float* gdS = adS + 32 * 64;
    LAS float* vlS = gdS + 32 * 96;
    LAS float* vS  = vlS + 32 * 32;
    const int ch = tid, h = wave, c = lane;
    const float* mu = a.in[IN_MU] + (size_t)l * 3 * 2 * 512;
    const float mur0 = mu[0 * 512 + ch], mur1 = mu[1 * 512 + ch], muk0 = mu[2 * 512 + ch], muk1 = mu[3 * 512 + ch], muv0 = mu[4 * 512 + ch], muv1 = mu[5 * 512 + ch];
    const float k_k = a.in[IN_KK][l * 512 + ch], k_a = a.in[IN_KA][l * 512 + ch], r_k = a.in[IN_RK][l * 512 + ch];
    const float v0c = (l > 0) ? a.in[IN_V0][(l - 1) * 512 + ch] : 0.f;
    for (int tile = blockIdx.x; tile < NB * 520; tile += G) {
        const int b = tile / 520, tt = tile - b * 520, p0 = tt * 32;
        const int seg_lo = (tt < 8) ? 0 : CL, seg_hi = (tt < 8) ? CL : NPB;
        const size_t R0 = (size_t)b * NPB + p0;
        for (int idx = tid; idx < 32 * 224; idx += NTHR) { const int i = idx / 224, cc = idx - i * 224; const float val = bf2f(P[(R0 + i) * NINP + PC_LORA + cc]);
            if (cc < 64) wdT[i * 64 + cc] = tanh_f(val); else if (cc < 128) adS[i * 64 + cc - 64] = val; else gdS[i * 96 + cc - 128] = sigmoid_f(val); }
        { const bf16* vc = P + R0 * NINP + PC_RV + ch;
          float prev = (p0 > seg_lo) ? bf2f(*(vc - NINP)) : 0.f, cur = bf2f(vc[0]);
#pragma unroll 1
          for (int i = 0; i < 32; ++i) { const float nxt = (p0 + i + 1 < seg_hi) ? bf2f(vc[(size_t)(i + 1) * NINP]) : 0.f;
              vS[i * 512 + ch] = cur + muv0 * (prev - cur) + muv1 * (nxt - cur); prev = cur; cur = nxt; } }
        __syncthreads();
        if (l > 0) { const int j = tid & 31, i0 = tid >> 5; const float* v1p = a.in[IN_V1] + (size_t)(l - 1) * 512 * 32 + j; float acc0 = 0.f, acc1 = 0.f;
#pragma unroll 8
            for (int cc = 0; cc < 512; ++cc) { const float w = v1p[cc * 32]; acc0 += vS[i0 * 512 + cc] * w; acc1 += vS[(i0 + 16) * 512 + cc] * w; }
            vlS[i0 * 32 + j] = acc0; vlS[(i0 + 16) * 32 + j] = acc1; }
        __syncthreads();
        if (l > 0) { float v2c[32];
            { const f32x4* w4 = (const f32x4*)(LT + LO_V2 + ((size_t)(l - 1) * 512 + ch) * 32);
#pragma unroll
              for (int j = 0; j < 8; ++j) { const f32x4 t = w4[j]; v2c[4 * j] = t[0]; v2c[4 * j + 1] = t[1]; v2c[4 * j + 2] = t[2]; v2c[4 * j + 3] = t[3]; } }
#pragma unroll 1
            for (int i = 0; i < 32; ++i) { float z = v0c;
#pragma unroll
                for (int j = 0; j < 32; ++j) z += vlS[i * 32 + j] * v2c[j];
                const float vp = vS[i * 512 + ch], vf = (float)VF[(R0 + i) * 512 + ch]; vS[i * 512 + ch] = vp + (vf - vp) * sigmoid_f(z); } }
        else {
#pragma unroll 1
            for (int i = 0; i < 32; ++i) VF[(R0 + i) * 512 + ch] = (_Float16)vS[i * 512 + ch]; }
        asm volatile("" ::: "memory");
        { float g2c[96];
          { const f32x4* w4 = (const f32x4*)(LT + LO_G2 + ((size_t)l * 512 + ch) * 96);
#pragma unroll
            for (int j = 0; j < 24; ++j) { const f32x4 t = w4[j]; g2c[4 * j] = t[0]; g2c[4 * j + 1] = t[1]; g2c[4 * j + 2] = t[2]; g2c[4 * j + 3] = t[3]; } }
#pragma unroll 1
          for (int i = 0; i < 32; ++i) { float g = 0.f;
#pragma unroll
              for (int jc = 0; jc < 3; ++jc) {
#pragma unroll
                  for (int j = 0; j < 32; ++j) g += gdS[i * 96 + jc * 32 + j] * g2c[jc * 32 + j];
                  __builtin_amdgcn_sched_barrier(0); }
              GG[(R0 + i) * 512 + ch] = (_Float16)g; } }
        asm volatile("" ::: "memory");
#pragma unroll 1
        for (int d = 0; d < 2; ++d) {
          float w2c[32], a2c[32];
          { const f32x4* w4 = (const f32x4*)(LT + LO_W2 + (((size_t)l * 2 + d) * 512 + ch) * 32); const f32x4* a4 = (const f32x4*)(LT + LO_A2 + (((size_t)l * 2 + d) * 512 + ch) * 32);
#pragma unroll
            for (int j = 0; j < 8; ++j) { const f32x4 t = w4[j], u = a4[j]; w2c[4 * j] = t[0]; w2c[4 * j + 1] = t[1]; w2c[4 * j + 2] = t[2]; w2c[4 * j + 3] = t[3];
                a2c[4 * j] = u[0]; a2c[4 * j + 1] = u[1]; a2c[4 * j + 2] = u[2]; a2c[4 * j + 3] = u[3]; } }
          const float w0d = a.in[IN_W0][(l * 2 + d) * 512 + ch], a0d = a.in[IN_A0][(l * 2 + d) * 512 + ch];
          const bf16* rc = P + R0 * NINP + PC_R + ch; const bf16* kc = P + R0 * NINP + PC_RK + ch;
          float rprev = (p0 > seg_lo) ? bf2f(*(rc - NINP)) : 0.f, rcur = bf2f(rc[0]);
          float kprev = (p0 > seg_lo) ? bf2f(*(kc - NINP)) : 0.f, kcur = bf2f(kc[0]);
#pragma unroll 1
          for (int i = 0; i < 32; ++i) {
              const bool hn = (p0 + i + 1 < seg_hi);
              const float rnxt = hn ? bf2f(rc[(size_t)(i + 1) * NINP]) : 0.f, knxt = hn ? bf2f(kc[(size_t)(i + 1) * NINP]) : 0.f;
              const float rs = rcur + mur0 * (rprev - rcur) + mur1 * (rnxt - rcur);
              const float ks = kcur + muk0 * (kprev - kcur) + muk1 * (knxt - kcur);
              rprev = rcur; rcur = rnxt; kprev = kcur; kcur = knxt;
              const float t = ks * k_k; const float ssq = wave_sum(t * t); const float kk = t * (1.0f / sqrtf(fmaxf(ssq, 1e-24f)));
              const int p = p0 + i;
              float wl = w0d, al = a0d;
#pragma unroll
              for (int j = 0; j < 32; ++j) { wl += wdT[i * 64 + d * 32 + j] * w2c[j]; al += adS[i * 64 + d * 32 + j] * a2c[j]; }
              const float e = 0.6065306597126334f * sigmoid_f(wl);
              const float omw = -expm1f(-e);
              const float av = sigmoid_f(al);
              const float bb = kk * av, kd = ks * (1.0f + (av - 1.0f) * k_a);
              _Float16* dpk = DPK + ((size_t)(((d * 2 + b) * 8 + h) * NPB) + p) * 192 + c;
              dpk[0] = (_Float16)omw; dpk[64] = (_Float16)bb; dpk[128] = (_Float16)kd;
              const float bs = wave_sum(rs * kd * r_k);
              if (d == 0) { _Float16* spk = SPK + ((size_t)((b * 8 + h) * NPB) + p) * 192 + c;
                  spk[0] = (_Float16)rs; spk[64] = (_Float16)kk; spk[128] = (_Float16)vS[i * 512 + ch];
                  if (c == 0) BON[(R0 + i) * 8 + h] = bs; }
              else if (c == 0) BON[(R0 + i) * 8 + h] += bs;
          }
          asm volatile("" ::: "memory");
        }
        __syncthreads();
    }
    { const float2* RT = (const float2*)(ws + WS_ROPE);
      const int gw = blockIdx.x * NWAVES + wave, NGW = G * NWAVES; const int g = lane & 31, sub = lane >> 5;
      for (int rp = gw; rp < NR / 2; rp += NGW) {
          const int R = rp * 2 + sub; const int b = R / NPB, p = R - b * NPB;
          v4u* pp = (v4u*)(P + (size_t)R * NINP + g * 32);
          v4u x[4];
#pragma unroll
          for (int j = 0; j < 4; ++j) x[j] = pp[j];
          if (p < CL && g >= 16) continue;
          float e[32];
#pragma unroll
          for (int j = 0; j < 4; ++j)
#pragma unroll
              for (int k = 0; k < 4; ++k) { e[j * 8 + 2 * k] = bflo(x[j][k]); e[j * 8 + 2 * k + 1] = bfhi(x[j][k]); }
          if (p >= CL) { const int t = p - CL; const int pos = (g & 1) ? (t & 63) : (t >> 6);
#pragma unroll
              for (int j = 0; j < 16; ++j) { const float2 cs = RT[pos * 16 + j]; const float x1 = e[j], x2 = e[16 + j]; e[j] = x1 * cs.x - x2 * cs.y; e[16 + j] = x1 * cs.y + x2 * cs.x; } }
          const float sc = (g < 16) ? QSCALE : 1.0f;
#pragma unroll
          for (int j = 0; j < 4; ++j) { v4u o;
#pragma unroll
              for (int k = 0; k < 4; ++k) o[k] = pk2(e[j * 8 + 2 * k] * sc, e[j * 8 + 2 * k + 1] * sc);
              pp[j] = o; }
      } }
}

__device__ __forceinline__ void phase_mix(const Args& a, LAS unsigned char* lds, volatile LAS unsigned* MISC, int l, unsigned xcc) {
    const int tid = opaque_tid();
    unsigned char* ws = opaque_ptr(a.ws);
    unsigned* ctl = (unsigned*)(ws + WS_CTL);
    const bf16* P = (const bf16*)(ws + WS_P);
    { int xq = (int)(xcc & 7u), tried = 0;
      while (tried < 8) {
          if (tid == 0) MISC[16] = atomicAdd(ctl + CW_QS + (l * 8 + xq) * 64, 1u);
          __syncthreads(); const unsigned idx = MISC[16]; __syncthreads();
          if (idx >= 8u) { xq = (xq + 1) & 7; ++tried; continue; }
          const int su = xq * 8 + (int)idx; const int chain = su >> 1, rh = su & 1; const int d = chain >> 4, b = (chain >> 3) & 1, h = chain & 7;
#ifndef NO_SCAN
          scan_unit(d, b, h, rh, (const _Float16*)(ws + WS_SPK), (const _Float16*)(ws + WS_DPK), (float*)(ws + WS_Y), lds);
#endif
      } }
    { const float* L = (const float*)(ws + WS_LAM); const float lam = L[l * 2], oml = L[l * 2 + 1];
      const float* subg = a.in[IN_SUBG] + l * 128; bf16* AO = (bf16*)(ws + WS_HN);
      int xq = (int)(xcc & 7u), tried = 0;
      while (tried < 8) {
          if (tid == 0) MISC[16] = atomicAdd(ctl + CW_QA + (l * 8 + xq) * 64, 1u);
          __syncthreads(); const unsigned idx = MISC[16]; __syncthreads();
          if (idx >= 130u) { xq = (xq + 1) & 7; ++tried; continue; }
          const int b = xq >> 2, h = xq & 3;
#ifndef NO_ATTN
          if (idx < 128u) att::attn_unit(P, b * NPB + CL + (int)idx * 128, b * NPB, NPB / 64, h, lam, oml, subg, AO, (char*)lds);
          else att::attn_unit(P, b * NPB + ((int)idx - 128) * 128, b * NPB, CL / 64, h, lam, oml, subg, AO, (char*)lds);
#endif
      } }
}

__device__ __forceinline__ void phase_finish(const Args& a, int G, int l) {
    const int tid = opaque_tid(), lane = tid & 63, wave = __builtin_amdgcn_readfirstlane(tid >> 6);
    unsigned char* ws = opaque_ptr(a.ws);
    const float* Y = (const float*)(ws + WS_Y); const _Float16* SPK = (const _Float16*)(ws + WS_SPK); const _Float16* GG = (const _Float16*)(ws + WS_G); const float* BON = (const float*)(ws + WS_BONUS);
    bf16* AO = (bf16*)(ws + WS_HN);
    const int ch = tid, h = wave, c = lane;
    const float lw = a.in[IN_LNW][l * 512 + ch], lb = a.in[IN_LNB][l * 512 + ch];
    for (int R = blockIdx.x; R < NR; R += G) {
        const int b = R / NPB, p = R - b * NPB;
        const float y = Y[(size_t)R * 512 + ch] + Y[((size_t)NR + R) * 512 + ch];
        const float mean = wave_sum(y) * (1.0f / 64.0f); const float dv = y - mean; const float var = wave_sum(dv * dv) * (1.0f / 64.0f);
        float o = dv * (1.0f / sqrtf(var + 64e-5f)) * lw + lb;
        const float vv = (float)SPK[((size_t)((b * 8 + h) * NPB) + p) * 192 + 128 + c];
        o += BON[(size_t)R * 8 + h] * vv;
        o *= (float)GG[(size_t)R * 512 + ch];
        AO[(size_t)R * 1024 + 512 + ch] = (bf16)f2bf(o);
    }
}

__device__ __forceinline__ void phase_gather(const Args& a, int vcu, int G, int l, int half) {
    const int tid = opaque_tid(), lane = tid & 63, wave = __builtin_amdgcn_readfirstlane(tid >> 6);
    unsigned char* ws = opaque_ptr(a.ws);
    const unsigned* cnt = (const unsigned*)(ws + WS_CTL) + CW_CNT + (((l >> 1) * 2 + half) * 8) * 64;
    int off[8]; { int r = 0;
#pragma unroll
        for (int e = 0; e < 8; ++e) { off[e] = r; const int n = (int)__hip_atomic_load(cnt + 64 * e, __ATOMIC_RELAXED, __HIP_MEMORY_SCOPE_AGENT); r += ((n + 255) >> 8) << 8; } }
    const bf16* HN = (const bf16*)(ws + WS_HN); bf16* AG = (bf16*)(ws + WS_AG);
    const int gw = vcu * NWAVES + wave, NGW = G * NWAVES;
    for (int rr = gw; rr < NPB; rr += NGW) {
        const int R = half * NPB + rr;
        unsigned* ro = (unsigned*)(ws + WS_ROUTE) + (size_t)R * 8;
        const int e1 = (int)ro[0], e2 = (int)ro[1]; const int p1 = (int)ro[2], p2 = (int)ro[3];
        int o1 = 0, o2 = 0;
#pragma unroll
        for (int e = 0; e < 8; ++e) { if (e == e1) o1 = off[e]; if (e == e2) o2 = off[e]; }
        const int s1 = o1 + p1, s2 = o2 + p2;
        const v4u* src = (const v4u*)(HN + (size_t)R * 1024) + lane * 2; const v4u x0 = src[0], x1 = src[1];
        v4u* d1 = (v4u*)(AG + (size_t)s1 * 1024) + lane * 2; v4u* d2 = (v4u*)(AG + (size_t)s2 * 1024) + lane * 2;
        d1[0] = x0; d1[1] = x1; d2[0] = x0; d2[1] = x1;
        if (lane == 0) { ro[6] = (unsigned)s1; ro[7] = (unsigned)s2; }
    }
}
__device__ __forceinline__ void phase_combine(const Args& a, int vcu, int G, int l, int half) {
    const int tid = opaque_tid(), lane = tid & 63, wave = __builtin_amdgcn_readfirstlane(tid >> 6);
    unsigned char* ws = opaque_ptr(a.ws);
    const bf16* YE = (const bf16*)(ws + WS_YEXP);
    const float* MOD = (const float*)(ws + WS_MOD) + (size_t)l * 3 * 6144 + 5120;
    const int gw = vcu * NWAVES + wave, NGW = G * NWAVES;
    for (int rr = gw; rr < NPB; rr += NGW) {
        const int R = half * NPB + rr; const int b = half, p = rr; const int w = (p < CL) ? 2 : b;
        const unsigned* ro = (const unsigned*)(ws + WS_ROUTE) + (size_t)R * 8;
        const float g1 = __uint_as_float(ro[4]), g2 = __uint_as_float(ro[5]); const int s1 = (int)ro[6], s2 = (int)ro[7];
        float* xr = (p < CL) ? (float*)(ws + WS_XC) + (size_t)(b * CL + p) * 1024 : a.out + ((size_t)b * SEQ + (p - CL)) * 1024;
        const f32x4* gt = (const f32x4*)(MOD + (size_t)w * 6144);
        const v4u* y1 = (const v4u*)(YE + (size_t)s1 * 1024); const v4u* y2 = (const v4u*)(YE + (size_t)s2 * 1024);
#pragma unroll
        for (int j = 0; j < 2; ++j) { const int c8 = lane + 64 * j;
            const v4u u1 = y1[c8], u2 = y2[c8]; f32x4* xp = (f32x4*)xr + c8 * 2; f32x4 x0 = xp[0], x1 = xp[1]; const f32x4 t0 = gt[c8 * 2], t1 = gt[c8 * 2 + 1];
            x0[0] += t0[0] * (g1 * bflo(u1[0]) + g2 * bflo(u2[0])); x0[1] += t0[1] * (g1 * bfhi(u1[0]) + g2 * bfhi(u2[0]));
            x0[2] += t0[2] * (g1 * bflo(u1[1]) + g2 * bflo(u2[1])); x0[3] += t0[3] * (g1 * bfhi(u1[1]) + g2 * bfhi(u2[1]));
            x1[0] += t1[0] * (g1 * bflo(u1[2]) + g2 * bflo(u2[2])); x1[1] += t1[1] * (g1 * bfhi(u1[2]) + g2 * bfhi(u2[2]));
            x1[2] += t1[2] * (g1 * bflo(u1[3]) + g2 * bflo(u2[3])); x1[3] += t1[3] * (g1 * bfhi(u1[3]) + g2 * bfhi(u2[3]));
            xp[0] = x0; xp[1] = x1; }
    }
}
__device__ __forceinline__ void phase_final(const Args& a, int vcu, int G) {
    const int tid = opaque_tid(), lane = tid & 63, wave = __builtin_amdgcn_readfirstlane(tid >> 6);
    const int gw = vcu * NWAVES + wave, NGW = G * NWAVES;
    const f32x4* g4 = (const f32x4*)a.in[IN_FINALG] + lane;
    for (int r = gw; r < NB * SEQ; r += NGW) {
        f32x4* x4 = (f32x4*)(a.out + (size_t)r * 1024) + lane; f32x4 v[4]; float ss = 0.f;
#pragma unroll
        for (int j = 0; j < 4; ++j) { v[j] = x4[64 * j]; ss += (v[j][0] * v[j][0] + v[j][1] * v[j][1]) + (v[j][2] * v[j][2] + v[j][3] * v[j][3]); }
        const float rstd = 1.0f / sqrtf(wave_sum(ss) * (1.0f / 1024.0f) + 1e-6f);
#pragma unroll
        for (int j = 0; j < 4; ++j) x4[64 * j] = (v[j] * rstd) * g4[64 * j];
    }
}
#ifndef MK_MULTI
#define MK_MULTI 0
#endif
constexpr int N_PHASES = 1 + 2 * 9 + 2 * 15 + 1;

__global__ void __launch_bounds__(NTHR, 2) mk_fwd(Args args) {
    extern __shared__ __attribute__((aligned(16))) unsigned char lds_raw[];
    LAS unsigned char* lds = (LAS unsigned char*)lds_raw;
    volatile LAS unsigned* MISC = (volatile LAS unsigned*)(lds + MISC_OFF);
    const int tid = threadIdx.x;
    const int G = gridDim.x; const int bx = blockIdx.x; const int vcu = (G % 8 == 0) ? (bx % 8) * (G / 8) + bx / 8 : bx;
    unsigned char* ws = args.ws;
    unsigned* ctl = (unsigned*)(ws + WS_CTL);
    for (int u = tid; u < (LDS_BYTES - LDSCTL_OFF) / 4; u += NTHR) ((LAS unsigned*)(lds + LDSCTL_OFF))[u] = 0u;
    __syncthreads();
    const int lo = args.ph_lo, hi = args.ph_hi;
    XcdBarrier bar; bar.bar = ctl + CW_BAR; bar.x = xb_xcc_id(); bar.st = MISC + 8;
    if (hi - lo > 1) bar = xcd_barrier_post(ctl + CW_BAR, MISC + 8);
    const unsigned xcc = bar.x;
    int seq = 0;
#ifndef PH_MASK
#define PH_MASK 0xFFFFFFFFu
#endif
#define PH_ON(b) ((PH_MASK >> (b)) & 1u)
#define PH_BEGIN if (lo <= seq && seq < hi) { unsigned char* ws = opaque_ptr(args.ws); (void)ws;
#define PH_END   if (seq + 1 < hi) xcd_barrier(bar); } ++seq;

    PH_BEGIN if (PH_ON(0)) phase_prologue(args, lds, vcu, G); PH_END

    for (int l = 0; l < DEPTH; ++l) {
        const bool moe = (l & 1) != 0;
        const float* MODl = (const float*)(ws + WS_MOD) + (size_t)l * 3 * 6144;
        PH_BEGIN if (PH_ON(1)) phase_norm(args, lds, vcu, G, l, 0, false); PH_END
        PH_BEGIN {
            pg8::Gemm g{(const pg8::bf16_t*)(ws + WS_HN), (const pg8::bf16_t*)(ws + WS_WINT) + (size_t)l * NINP * DM, NR, NINP, DM};
            pg8::StaticOrder S; S.init(NR, NINP, G, bx);
            pg8::EpiStoreBf16 E{(pg8::bf16_t*)(ws + WS_P), NINP, 0};
            if (PH_ON(2)) pg8::gemm_phase<pg8::EpiStoreBf16, pg8::StaticOrder, true, true>(lds, g, S, E);
        } PH_END
        PH_BEGIN if (PH_ON(3)) phase_prep(args, lds, G, l); PH_END
        PH_BEGIN if (PH_ON(4)) phase_mix(args, lds, MISC, l, xcc); PH_END
        PH_BEGIN if (PH_ON(5)) phase_finish(args, G, l); PH_END
        PH_BEGIN {
            pg8::Gemm g{(const pg8::bf16_t*)(ws + WS_HN), (const pg8::bf16_t*)(ws + WS_WOUTT) + (size_t)l * DM * DM, NR, DM, DM};
            pg8::StaticOrder S; S.init(NR, DM, G, bx);
            pg8::EpiResid E{(l == 0) ? args.in[IN_X] : args.out, (l == 0) ? args.in[IN_CTX] : (const float*)(ws + WS_XC), args.out, (float*)(ws + WS_XC), MODl + 2048};
            if (PH_ON(6)) pg8::gemm_phase<pg8::EpiResid, pg8::StaticOrder, true, true>(lds, g, S, E);
        } PH_END
        PH_BEGIN if (PH_ON(7)) phase_norm(args, lds, vcu, G, l, 1, moe); PH_END
        if (!moe) {
            PH_BEGIN {
                pg8::Gemm g{(const pg8::bf16_t*)(ws + WS_HN), (const pg8::bf16_t*)(ws + WS_W13T) + (size_t)(l >> 1) * 2 * DFF * DM, NR, 2 * DFF, DM};
                pg8::StaticOrder S; S.init(NR, 2 * DFF, G, bx);
                pg8::EpiSwiGLU E{(pg8::bf16_t*)(ws + WS_HF), DFF, 0};
                if (PH_ON(8)) pg8::gemm_phase<pg8::EpiSwiGLU, pg8::StaticOrder, true, true>(lds, g, S, E);
            } PH_END
            PH_BEGIN {
                pg8::Gemm g{(const pg8::bf16_t*)(ws + WS_HF), (const pg8::bf16_t*)(ws + WS_W2T) + (size_t)(l >> 1) * DM * DFF, NR, DM, DFF};
                pg8::StaticOrder S; S.init(NR, DM, G, bx);
                pg8::EpiResid E{args.out, (const float*)(ws + WS_XC), args.out, (float*)(ws + WS_XC), MODl + 5120};
                if (PH_ON(9)) pg8::gemm_phase<pg8::EpiResid, pg8::StaticOrder, true, true>(lds, g, S, E);
            } PH_END
        } else {
            for (int half = 0; half < 2; ++half) {
                const unsigned* cnt = (const unsigned*)ctl + CW_CNT + (((l >> 1) * 2 + half) * 8) * 64;
                PH_BEGIN if (PH_ON(10)) phase_gather(args, vcu, G, l, half); PH_END
                PH_BEGIN {
                    pg8::Gemm g{(const pg8::bf16_t*)(ws + WS_AG), (const pg8::bf16_t*)(ws + WS_W13E), 35328, 8 * 2 * DFE, DM};
                    pg8::MoeOrder S; S.init(cnt, (2 * DFE) / 256, G, bx);
                    pg8::EpiSwiGLU E{(pg8::bf16_t*)(ws + WS_HMOE), DFE, (2 * DFE) / 256};
                    if (PH_ON(11)) pg8::gemm_phase<pg8::EpiSwiGLU, pg8::MoeOrder, true, true>(lds, g, S, E);
                } PH_END
                PH_BEGIN {
                    pg8::Gemm g{(const pg8::bf16_t*)(ws + WS_HMOE), (const pg8::bf16_t*)(ws + WS_W2E), 35328, 8 * DM, DFE};
                    pg8::MoeOrder S; S.init(cnt, DM / 256, G, bx);
                    pg8::EpiStoreBf16 E{(pg8::bf16_t*)(ws + WS_YEXP), DM, DM / 256};
                    if (PH_ON(12)) pg8::gemm_phase<pg8::EpiStoreBf16, pg8::MoeOrder, true, true>(lds, g, S, E);
                } PH_END
                PH_BEGIN if (PH_ON(13)) phase_combine(args, vcu, G, l, half); PH_END
            }
        }
    }
    PH_BEGIN if (PH_ON(14)) phase_final(args, vcu, G); PH_END
#undef PH_BEGIN
#undef PH_END
}

extern "C" void kernel_launch(void* const* d_in, const int* in_sizes, int n_in, void* d_out, int out_size, void* d_ws, size_t ws_size, hipStream_t stream) {
    static int grid = 0;
    if (grid == 0) {
        if (n_in != 34 || out_size != NB * SEQ * DM || ws_size < WS_END) { fprintf(stderr, "kernel_launch: unexpected shapes (n_in %d out %d ws %zu, need %zu)\n", n_in, out_size, ws_size, (size_t)WS_END); grid = -1; return; }
        int dev = 0, cus = 0, per_cu = 0;
        if (hipGetDevice(&dev) != hipSuccess || hipDeviceGetAttribute(&cus, hipDeviceAttributeMultiprocessorCount, dev) != hipSuccess) { grid = -1; return; }
        if (hipFuncSetAttribute((const void*)mk_fwd, hipFuncAttributeMaxDynamicSharedMemorySize, LDS_BYTES) != hipSuccess) { fprintf(stderr, "kernel_launch: hipFuncSetAttribute failed\n"); grid = -1; return; }
        if (hipOccupancyMaxActiveBlocksPerMultiprocessor(&per_cu, (const void*)mk_fwd, NTHR, LDS_BYTES) != hipSuccess || per_cu < 1) fprintf(stderr, "kernel_launch: occupancy query reports %d blocks per CU\n", per_cu);
        (void)hipGetLastError();
        grid = cus;
    }
    if (grid < 0) return;
    if (hipMemsetAsync((char*)d_ws + WS_CTL, 0, CTL_ZERO_BYTES, stream) != hipSuccess) return;
    Args a{};
    for (int i = 0; i < 34; ++i) a.in[i] = (const float*)d_in[i];
    a.out = (float*)d_out; a.ws = (unsigned char*)d_ws;
#if MK_MULTI
    for (int s = 0; s < N_PHASES; ++s) { a.ph_lo = s; a.ph_hi = s + 1; hipLaunchKernelGGL(mk_fwd, dim3(grid), dim3(NTHR), LDS_BYTES, stream, a); }
#else
    a.ph_lo = 0; a.ph_hi = N_PHASES;
    hipLaunchKernelGGL(mk_fwd, dim3(grid), dim3(NTHR), LDS_BYTES, stream, a);
#endif
    const hipError_t le = hipPeekAtLastError();
    if (le != hipSuccess) fprintf(stderr, "kernel_launch: launch failed: %s\n", hipGetErrorName(le));
}
```

```cpp
#include <hip/hip_runtime.h>
#include <cstdio>
#include <cstdint>
__device__ __forceinline__ int opaque_tid() { int t = (int)threadIdx.x; asm volatile("" : "+v"(t)); return t; }
template <class T> __device__ __forceinline__ T* opaque_ptr(T* p) { asm volatile("" : "+s"(p)); return p; }
namespace pg8 {
#define PG8_LAS __attribute__((address_space(3)))
typedef unsigned short bf16_t;
typedef short bf16x8 __attribute__((ext_vector_type(8)));
typedef float f32x4 __attribute__((ext_vector_type(4)));
typedef unsigned u32x4 __attribute__((ext_vector_type(4)));
constexpr int BM = 256, BK = 64, HALF = 128, HTB = HALF * BK * 2  , STAGE_BYTES = 8 * HTB, NXCD = 8, WGM = 8;

__host__ __device__ __forceinline__ int lds_byte(int r, int c) { const int st = (r >> 4) * 2 + (c >> 5), rr = r & 15, cc = c & 31, ob = rr * 64 + cc * 2; return st * 1024 + (ob ^ (((ob >> 9) & 1) << 5)); }
__host__ __device__ __forceinline__ void stage_rc(int b, int& R, int& C) { const int st = b / 1024, sb = b % 1024, swz = sb ^ (((sb >> 9) & 1) << 5); R = (st >> 1) * 16 + swz / 64; C = (st & 1) * 32 + (swz % 64) / 2; }
__host__ __device__ __forceinline__ int perm32(int rho) { const int n = rho >> 4, i = rho & 15; return 8 * (i >> 2) + 4 * n + (i & 3); }

struct Unit { int pm, pn; };
struct Gemm { const bf16_t* A; const bf16_t* Bt; int M, N, K; };

struct StaticOrder {
    int nM, nN, nwg, G, c;
    __host__ __device__ void init(int M, int N, int G_, int c_) { nM = M / BM; nN = N / BM; nwg = nM * nN; G = G_; c = c_; }
    __host__ __device__ bool next(int i, Unit& u) const {
        const long L = (long)i * G + c; if (L >= nwg) return false;
        int wgid = (int)L; { const int q = nwg / NXCD, r = nwg % NXCD, xcd = wgid % NXCD, off = wgid / NXCD; wgid = (xcd < r ? xcd * (q + 1) : r * (q + 1) + (xcd - r) * q) + off; }
        const int nig = WGM * nN, gid = wgid / nig, fm = gid * WGM, gsz = (nM - fm) < WGM ? (nM - fm) : WGM;
        u.pm = fm + ((wgid % nig) % gsz); u.pn = (wgid % nig) / gsz; return true;
    }
    __device__ __forceinline__ void a_ready(const Unit&) const {}
    __device__ __forceinline__ void done(const Unit&) const {}
};

__device__ __forceinline__ unsigned cvt_pk_bf16(float lo, float hi) { unsigned r; asm volatile("v_cvt_pk_bf16_f32 %0, %1, %2" : "=v"(r) : "v"(lo), "v"(hi)); return r; }
typedef float f32x2 __attribute__((ext_vector_type(2)));
__device__ __forceinline__ float silu_acc(float a) { return a * __builtin_amdgcn_rcpf(1.0f + __builtin_amdgcn_exp2f(-1.4426950408889634f * a)); }
struct EpiStoreBf16 {
    static constexpr bool PERM = true, AFTER_DRAIN = false;
    bf16_t* O; int ldc; int ncolt;
    __device__ __forceinline__ void operator()(const f32x4 (&acc)[2][2][4][2], const Unit& u, int wr, int wc, int fr, int fq) const {
        const int row0 = u.pm * BM + wr * 64 + fr; const int pnl = ncolt ? (u.pn % ncolt) : u.pn;
        const int col0 = pnl * BM + wc * 32 + 8 * fq;
#pragma unroll
        for (int ai = 0; ai < 2; ++ai)
#pragma unroll
            for (int m = 0; m < 4; ++m) { bf16_t* rowp = O + (size_t)(row0 + ai * HALF + m * 16) * ldc + col0;
#pragma unroll
                for (int bj = 0; bj < 2; ++bj) { const f32x4 v0 = acc[ai][bj][m][0], v1 = acc[ai][bj][m][1];
                    u32x4 w; w.x = cvt_pk_bf16(v0[0], v0[1]); w.y = cvt_pk_bf16(v0[2], v0[3]); w.z = cvt_pk_bf16(v1[0], v1[1]); w.w = cvt_pk_bf16(v1[2], v1[3]);
                    *(u32x4*)(rowp + bj * HALF) = w; } }
    }
};
struct EpiSwiGLU {
    static constexpr bool PERM = true, AFTER_DRAIN = false;
    bf16_t* O; int ldc; int ncolt;
    __device__ __forceinline__ void operator()(const f32x4 (&acc)[2][2][4][2], const Unit& u, int wr, int wc, int fr, int fq) const {
        const int row0 = u.pm * BM + wr * 64 + fr; const int pnl = ncolt ? (u.pn % ncolt) : u.pn;
        const int col0 = pnl * HALF + wc * 32 + 8 * fq;
#pragma unroll
        for (int ai = 0; ai < 2; ++ai)
#pragma unroll
            for (int m = 0; m < 4; ++m) { bf16_t* rowp = O + (size_t)(row0 + ai * HALF + m * 16) * ldc + col0;
                const f32x4 a0 = acc[ai][0][m][0], a1 = acc[ai][0][m][1], b0 = acc[ai][1][m][0], b1 = acc[ai][1][m][1];
                u32x4 w;
                w.x = cvt_pk_bf16(silu_acc(a0[0]) * b0[0], silu_acc(a0[1]) * b0[1]); w.y = cvt_pk_bf16(silu_acc(a0[2]) * b0[2], silu_acc(a0[3]) * b0[3]);
                w.z = cvt_pk_bf16(silu_acc(a1[0]) * b1[0], silu_acc(a1[1]) * b1[1]); w.w = cvt_pk_bf16(silu_acc(a1[2]) * b1[2], silu_acc(a1[3]) * b1[3]);
                *(u32x4*)rowp = w; }
    }
};
struct EpiResid {
    static constexpr bool PERM = false, AFTER_DRAIN = false;
    const float* srcLat; const float* srcCtx; float* dstLat; float* dstCtx; const float* gate3;
    __device__ __forceinline__ void operator()(const f32x4 (&acc)[2][2][4][2], const Unit& u, int wr, int wc, int fr, int fq) const {
        const int b = u.pm / 65, j = u.pm - b * 65; const int which = (j == 0) ? 2 : b;
        const float* src = (j == 0) ? srcCtx + (size_t)b * 256 * 1024 : srcLat + ((size_t)b * 16384 + (size_t)(j - 1) * 256) * 1024;
        float* dst = (j == 0) ? dstCtx + (size_t)b * 256 * 1024 : dstLat + ((size_t)b * 16384 + (size_t)(j - 1) * 256) * 1024;
        const float* gp = gate3 + (size_t)which * 6144;
        const int col0 = u.pn * BM + wc * 32 + 4 * fq;
        f32x4 gv[2][2];
#pragma unroll
        for (int bj = 0; bj < 2; ++bj)
#pragma unroll
            for (int n = 0; n < 2; ++n) gv[bj][n] = *(const f32x4*)(gp + col0 + bj * HALF + n * 16);
#pragma unroll
        for (int ai = 0; ai < 2; ++ai)
#pragma unroll
            for (int m = 0; m < 4; ++m) { const size_t off = (size_t)(ai * HALF + wr * 64 + m * 16 + fr) * 1024 + col0;
#pragma unroll
                for (int bj = 0; bj < 2; ++bj)
#pragma unroll
                    for (int n = 0; n < 2; ++n) { const f32x4 x = *(const f32x4*)(src + off + bj * HALF + n * 16);
                        *(f32x4*)(dst + off + bj * HALF + n * 16) = x + gv[bj][n] * acc[ai][bj][m][n]; }
                if (m & 1) asm volatile("" ::: "memory"); }
    }
};
struct MoeOrder {
    int t0, t1, t2, t3, t4, t5, t6, t7; int ncol, G, c;
    __device__ __forceinline__ void init(const unsigned* cnt  , int ncol_, int G_, int c_) {
        ncol = ncol_; G = G_; c = c_;
#define MO_T(e) (((int)__hip_atomic_load(cnt + 64 * (e), __ATOMIC_RELAXED, __HIP_MEMORY_SCOPE_AGENT) + 255) >> 8)
        t0 = MO_T(0); t1 = MO_T(1); t2 = MO_T(2); t3 = MO_T(3); t4 = MO_T(4); t5 = MO_T(5); t6 = MO_T(6); t7 = MO_T(7);
#undef MO_T
    }
    __device__ __forceinline__ bool next(int i, Unit& u) const {
        int L = i * G + c; int e = 0, r0 = 0, te = t0; bool found = false;
#define MO_STEP(k, tk) if (!found) { if (L < (tk) * ncol) { e = (k); te = (tk); found = true; } else { L -= (tk) * ncol; r0 += (tk); } }
        MO_STEP(0, t0) MO_STEP(1, t1) MO_STEP(2, t2) MO_STEP(3, t3) MO_STEP(4, t4) MO_STEP(5, t5) MO_STEP(6, t6) MO_STEP(7, t7)
#undef MO_STEP
        if (!found) return false;
        u.pm = r0 + L % te; u.pn = e * ncol + L / te; return true;
    }
    __device__ __forceinline__ void a_ready(const Unit&) const {}
    __device__ __forceinline__ void done(const Unit&) const {}
};
template <class Epi, class Sched, bool ALIGN_EPI = false, bool SP2 = false>
__device__ __forceinline__ void gemm_phase(PG8_LAS unsigned char* lds, const Gemm g, const Sched& S, const Epi& E) {
    const int tid = opaque_tid(), wid = __builtin_amdgcn_readfirstlane(tid >> 6), lane = tid & 63, wr = wid >> 2, wc = wid & 3, fr = lane & 15, fq = lane >> 4;
    const int K = g.K, nt = K / BK;
    unsigned voffA[2], voffB[2];
#pragma unroll
    for (int i = 0; i < 2; ++i) { int R, C; stage_rc(tid * 16 + i * 8192, R, C); const int Rb = Epi::PERM ? ((R & ~31) + perm32(R & 31)) : R;
        voffA[i] = (unsigned)(R * K + C) * 2u; voffB[i] = (unsigned)(Rb * K + C) * 2u; }
    const size_t kstep = (size_t)(BK * 2);
    const size_t hstep = (size_t)HALF * K * 2;
    const size_t tstep = 2 * hstep;
    const unsigned ldsw = (unsigned)wid * 1024u;
    const int aoff = lds_byte(wr * 64 + fr, fq * 8), boff = lds_byte(wc * 32 + fr, fq * 8);
#define PG8_SA(b, h) (((b) * 2 + (h)) * HTB)
#define PG8_SB(b, h) ((4 + (b) * 2 + (h)) * HTB)
#define PG8_STAGE(bufoff, gbase, voff) do { _Pragma("unroll") for (int _i = 0; _i < 2; ++_i) \
        __builtin_amdgcn_global_load_lds((const unsigned*)((const char*)(gbase) + (voff)[_i]), (PG8_LAS unsigned*)(lds + (bufoff) + ldsw + _i * 8192), 16, 0, 0); } while (0)
#define PG8_LDA(dst, b, h) do { _Pragma("unroll") for (int m = 0; m < 4; ++m) _Pragma("unroll") for (int k = 0; k < 2; ++k) dst[m][k] = *(const PG8_LAS bf16x8*)(lds + PG8_SA(b, h) + aoff + m * 2048 + k * 1024); } while (0)
#define PG8_LDB(dst, b, h) do { _Pragma("unroll") for (int n = 0; n < 2; ++n) _Pragma("unroll") for (int k = 0; k < 2; ++k) dst[n][k] = *(const PG8_LAS bf16x8*)(lds + PG8_SB(b, h) + boff + n * 2048 + k * 1024); } while (0)
#define PG8_MMA(ai, bj, At, Bt) do { __builtin_amdgcn_s_setprio(1); _Pragma("unroll") for (int m = 0; m < 4; ++m) _Pragma("unroll") for (int n = 0; n < 2; ++n) _Pragma("unroll") for (int k = 0; k < 2; ++k) \
        acc[ai][bj][m][n] = __builtin_amdgcn_mfma_f32_16x16x32_bf16(Bt[n][k], At[m][k], acc[ai][bj][m][n], 0, 0, 0); __builtin_amdgcn_s_setprio(0); } while (0)
#define PG8_WAIT_V(n) asm volatile("s_waitcnt vmcnt(" #n ")" ::: "memory")
#define PG8_WAIT_L(n) asm volatile("s_waitcnt lgkmcnt(" #n ")" ::: "memory")
#define PG8_BAR __builtin_amdgcn_s_barrier()
#define PG8_SCHED __builtin_amdgcn_sched_barrier(0)
    Unit cur, nxt; int ui = 0;
    if (!S.next(0, cur)) return;
    f32x4 acc[2][2][4][2];
#pragma unroll
    for (int a = 0; a < 2; ++a)
#pragma unroll
        for (int b = 0; b < 2; ++b)
#pragma unroll
            for (int m = 0; m < 4; ++m)
#pragma unroll
                for (int n = 0; n < 2; ++n) acc[a][b][m][n] = (f32x4){0.f, 0.f, 0.f, 0.f};
    bf16x8 At[4][2], B0[2][2], B1[2][2];
    const char* cA = (const char*)g.A + (size_t)cur.pm * tstep; const char* cB = (const char*)g.Bt + (size_t)cur.pn * tstep;
    S.a_ready(cur);
    if constexpr (SP2) {
        PG8_STAGE(PG8_SB(0, 0), cB, voffB); PG8_STAGE(PG8_SB(0, 1), cB + hstep, voffB); PG8_STAGE(PG8_SA(0, 0), cA, voffA); PG8_STAGE(PG8_SA(0, 1), cA + hstep, voffA);
        if (wr == 1) PG8_BAR;
        PG8_WAIT_V(2); PG8_BAR;
        PG8_STAGE(PG8_SB(1, 0), cB + kstep, voffB); PG8_STAGE(PG8_SA(1, 0), cA + kstep, voffA); PG8_STAGE(PG8_SB(1, 1), cB + hstep + kstep, voffB);
        PG8_WAIT_V(6); PG8_BAR;
    } else {
        PG8_STAGE(PG8_SB(0, 0), cB, voffB); PG8_STAGE(PG8_SA(0, 0), cA, voffA); PG8_STAGE(PG8_SB(0, 1), cB + hstep, voffB); PG8_STAGE(PG8_SA(0, 1), cA + hstep, voffA);
        if (wr == 1) PG8_BAR;
        PG8_WAIT_V(4); PG8_BAR;
        PG8_STAGE(PG8_SB(1, 0), cB + kstep, voffB); PG8_STAGE(PG8_SA(1, 0), cA + kstep, voffA); PG8_STAGE(PG8_SB(1, 1), cB + hstep + kstep, voffB);
        PG8_WAIT_V(6); PG8_BAR;
    }
    for (;;) {
        const bool has_next = S.next(ui + 1, nxt);
        const char* nA = has_next ? (const char*)g.A + (size_t)nxt.pm * tstep : cA; const char* nB = has_next ? (const char*)g.Bt + (size_t)nxt.pn * tstep : cB;
        for (int t = 0; t < nt; t += 2) {
            const bool last = (t == nt - 2);
            const char* a1 = cA + (size_t)(t + 1) * kstep;
            const char* a2 = last ? nA : cA + (size_t)(t + 2) * kstep; const char* b2 = last ? nB : cB + (size_t)(t + 2) * kstep;
            const char* a3 = a2 + kstep; const char* b3 = b2 + kstep;
            if (last && has_next) S.a_ready(nxt);
            if constexpr (SP2) {
            PG8_LDB(B0, 0, 0); PG8_LDB(B1, 0, 1); PG8_SCHED; PG8_LDA(At, 0, 0); PG8_STAGE(PG8_SA(1, 1), a1 + hstep, voffA);
            PG8_WAIT_V(8); PG8_WAIT_L(0); PG8_BAR; PG8_MMA(0, 0, At, B0); PG8_MMA(0, 1, At, B1); PG8_BAR; PG8_SCHED;
            PG8_LDA(At, 0, 1); PG8_STAGE(PG8_SB(0, 0), b2, voffB); PG8_STAGE(PG8_SB(0, 1), b2 + hstep, voffB); PG8_STAGE(PG8_SA(0, 0), a2, voffA);
            PG8_WAIT_V(8); PG8_WAIT_L(0); PG8_BAR; PG8_MMA(1, 0, At, B0); PG8_MMA(1, 1, At, B1); PG8_BAR; PG8_SCHED;
            PG8_LDB(B0, 1, 0); PG8_LDB(B1, 1, 1); PG8_SCHED; PG8_LDA(At, 1, 0); PG8_STAGE(PG8_SA(0, 1), a2 + hstep, voffA);
            PG8_WAIT_V(8); PG8_WAIT_L(0); PG8_BAR; PG8_MMA(0, 0, At, B0); PG8_MMA(0, 1, At, B1); PG8_BAR; PG8_SCHED;
            PG8_LDA(At, 1, 1); PG8_STAGE(PG8_SB(1, 0), b3, voffB); PG8_STAGE(PG8_SB(1, 1), b3 + hstep, voffB); PG8_STAGE(PG8_SA(1, 0), a3, voffA);
            PG8_WAIT_V(8); PG8_WAIT_L(0); PG8_BAR; PG8_MMA(1, 0, At, B0); PG8_MMA(1, 1, At, B1); PG8_BAR; PG8_SCHED;
            } else {
            PG8_LDB(B0, 0, 0); PG8_SCHED; PG8_LDA(At, 0, 0); PG8_STAGE(PG8_SA(1, 1), a1 + hstep, voffA);
            PG8_WAIT_L(8); PG8_BAR; PG8_WAIT_L(0); PG8_MMA(0, 0, At, B0); PG8_BAR; PG8_SCHED;
            PG8_LDB(B1, 0, 1); PG8_STAGE(PG8_SB(0, 0), b2, voffB);
            PG8_BAR; PG8_WAIT_L(0); PG8_MMA(0, 1, At, B1); PG8_BAR;
            PG8_LDA(At, 0, 1); PG8_STAGE(PG8_SA(0, 0), a2, voffA);
            PG8_BAR; PG8_WAIT_L(0); PG8_MMA(1, 0, At, B0); PG8_BAR; PG8_SCHED;
            PG8_STAGE(PG8_SB(0, 1), b2 + hstep, voffB);
            PG8_WAIT_V(6); PG8_BAR; PG8_MMA(1, 1, At, B1); PG8_BAR;
            PG8_LDB(B0, 1, 0); PG8_SCHED; PG8_LDA(At, 1, 0); PG8_STAGE(PG8_SA(0, 1), a2 + hstep, voffA);
            PG8_WAIT_L(8); PG8_BAR; PG8_WAIT_L(0); PG8_MMA(0, 0, At, B0); PG8_BAR; PG8_SCHED;
            PG8_LDB(B1, 1, 1); PG8_STAGE(PG8_SB(1, 0), b3, voffB);
            PG8_BAR; PG8_WAIT_L(0); PG8_MMA(0, 1, At, B1); PG8_BAR;
            PG8_LDA(At, 1, 1); PG8_STAGE(PG8_SA(1, 0), a3, voffA);
            PG8_BAR; PG8_WAIT_L(0); PG8_MMA(1, 0, At, B0); PG8_BAR; PG8_SCHED;
            PG8_STAGE(PG8_SB(1, 1), b3 + hstep, voffB);
            PG8_WAIT_V(6); PG8_BAR; PG8_MMA(1, 1, At, B1); PG8_BAR;
            }
        }
        if constexpr (ALIGN_EPI) { if (wr == 0) PG8_BAR; }
        if constexpr (!Epi::AFTER_DRAIN) { E(acc, cur, wr, wc, fr, fq); S.done(cur); }
        if (!has_next) break;
#pragma unroll
        for (int a = 0; a < 2; ++a)
#pragma unroll
            for (int b = 0; b < 2; ++b)
#pragma unroll
                for (int m = 0; m < 4; ++m)
#pragma unroll
                    for (int n = 0; n < 2; ++n) acc[a][b][m][n] = (f32x4){0.f, 0.f, 0.f, 0.f};
        cur = nxt; cA = nA; cB = nB; ++ui;
        if constexpr (ALIGN_EPI) { if (wr == 1) PG8_BAR; }
    }
    PG8_WAIT_V(0);
    if constexpr (!ALIGN_EPI) { if (wr == 0) PG8_BAR; }
    PG8_BAR;
    if constexpr (Epi::AFTER_DRAIN) { E.fused(acc, cur, wr, wc, fr, fq, lds, wid, lane); S.done(cur); }
#undef PG8_SA
#undef PG8_SB
#undef PG8_STAGE
#undef PG8_LDA
#undef PG8_LDB
#undef PG8_MMA
#undef PG8_WAIT_V
#undef PG8_WAIT_L
#undef PG8_BAR
#undef PG8_SCHED
}
}
constexpr int NB = 2, SEQ = 16384, CL = 256, DM = 1024, NPB = SEQ + CL  , NR = NB * NPB  , DEPTH = 4;
constexpr int NIN = 3296, NINP = 3328, DFF = 2816, NEXP = 8, DFE = 3584;
constexpr int NWAVES = 8, NTHR = 512;
constexpr float QSCALE = 0.125f * 1.4426950408889634f;
constexpr int PC_Q = 0, PC_K = 512, PC_V = 1024, PC_R = 1536, PC_RK = 2048, PC_RV = 2560, PC_LORA = 3072;

constexpr size_t MiB = 1u << 20;
constexpr size_t WS_CTL = 0, CTL_ZERO_BYTES = 1 * MiB;
constexpr size_t WS_MOD = 1 * MiB;
constexpr size_t WS_ROPE = 2 * MiB;
constexpr size_t WS_LAM = 2 * MiB + 65536;
constexpr size_t WS_XC = 3 * MiB;
constexpr size_t WS_ROUTE = 5 * MiB;
constexpr size_t WS_WINT = 8 * MiB;
constexpr size_t WS_WOUTT = 34 * MiB;
constexpr size_t WS_W13T = 42 * MiB;
constexpr size_t WS_W2T = 64 * MiB;
constexpr size_t WS_VFIRST = 76 * MiB;
constexpr size_t WS_HN = 110 * MiB;
constexpr size_t WS_P = 175 * MiB;
constexpr size_t WS_SPK = 387 * MiB;
constexpr size_t WS_DPK = 485 * MiB;
constexpr size_t WS_Y = 680 * MiB;
constexpr size_t WS_G = 810 * MiB;
constexpr size_t WS_BONUS = 843 * MiB;
constexpr size_t WS_LORA = 845 * MiB;
constexpr size_t WS_END = 848 * MiB;
constexpr int LO_W2 = 0, LO_A2 = 131072, LO_V2 = 262144, LO_G2 = 262144 + 49152, LO_TOTAL = 262144 + 49152 + 196608;
constexpr size_t WS_HF = 175 * MiB;
constexpr size_t WS_W13E = 175 * MiB;
constexpr size_t WS_W2E = 287 * MiB;
constexpr size_t WS_AG = 343 * MiB;
constexpr size_t WS_HMOE = 412 * MiB;
constexpr size_t WS_YEXP = 654 * MiB;
static_assert(WS_WINT + (size_t)4 * NINP * DM * 2 <= WS_WOUTT && WS_WOUTT + (size_t)4 * DM * DM * 2 <= WS_W13T && WS_W13T + (size_t)2 * 2 * DFF * DM * 2 <= WS_W2T && WS_W2T + (size_t)2 * DM * DFF * 2 <= WS_VFIRST, "ws map 1");
static_assert(WS_VFIRST + (size_t)NR * 512 * 2 <= WS_HN && WS_HN + (size_t)NR * DM * 2 <= WS_P && WS_P + (size_t)NR * NINP * 2 <= WS_SPK && WS_SPK + (size_t)NB * 8 * NPB * 192 * 2 <= WS_DPK, "ws map 2");
static_assert(WS_DPK + (size_t)2 * NB * 8 * NPB * 192 * 2 <= WS_Y && WS_Y + (size_t)2 * NR * 512 * 4 <= WS_G && WS_G + (size_t)NR * 512 * 2 <= WS_BONUS && WS_BONUS + (size_t)NR * 8 * 4 <= WS_LORA && WS_LORA + (size_t)LO_TOTAL * 4 <= WS_END, "ws map 3");
static_assert(WS_HF + (size_t)NR * DFF * 2 <= WS_LORA && WS_W13E + (size_t)8 * 2 * DFE * DM * 2 <= WS_W2E && WS_W2E + (size_t)8 * DM * DFE * 2 <= WS_AG && WS_AG + (size_t)35328 * DM * 2 <= WS_HMOE && WS_HMOE + (size_t)35328 * DFE * 2 <= WS_YEXP && WS_YEXP + (size_t)35328 * DM * 2 <= WS_LORA, "ws map 4");
constexpr int CW_TMO = 0;
constexpr int CW_BAR = 4096;
constexpr int CW_QS = 16384;
constexpr int CW_QA = 20480;
constexpr int CW_CNT = 24576;

constexpr int RING_BYTES = 131072;
constexpr int LDSCTL_OFF = RING_BYTES, MISC_OFF = LDSCTL_OFF + 320;
constexpr int LDS_BYTES = 147456;

#define GAS __attribute__((address_space(1)))
#define LAS __attribute__((address_space(3)))
typedef unsigned short bf16;
typedef unsigned v4u __attribute__((ext_vector_type(4)));
typedef unsigned v2u __attribute__((ext_vector_type(2)));
typedef float f32x4 __attribute__((ext_vector_type(4)));
typedef _Float16 h4 __attribute__((ext_vector_type(4)));
#define LDS_WAIT() asm volatile("s_waitcnt lgkmcnt(0)" ::: "memory")
__device__ __forceinline__ unsigned f2bf(float f) { unsigned u = __builtin_bit_cast(unsigned, f); return (u + 0x7fffu + ((u >> 16) & 1u)) >> 16; }
__device__ __forceinline__ unsigned pk2(float lo, float hi) { return f2bf(lo) | (f2bf(hi) << 16); }
__device__ __forceinline__ float bf2f(bf16 h) { return __builtin_bit_cast(float, (unsigned)h << 16); }
__device__ __forceinline__ float bflo(unsigned w) { return __builtin_bit_cast(float, w << 16); }
__device__ __forceinline__ float bfhi(unsigned w) { return __builtin_bit_cast(float, w & 0xffff0000u); }
__device__ __forceinline__ float sigmoid_f(float x) { return 1.0f / (1.0f + __expf(-x)); }
__device__ __forceinline__ float tanh_f(float x) { return 1.0f - 2.0f / (__expf(2.0f * x) + 1.0f); }
__device__ __forceinline__ float wave_sum(float v) {
#pragma unroll
    for (int o = 1; o < 64; o <<= 1) v += __shfl_xor(v, o);
    return v;
}
#define XB_TMO      128
#define XB_XCNT(j)  (256  + 64 * (j))
#define XB_XSUB(j)  (1280 + 64 * (j))
#define XB_XGEN(j)  (2304 + 64 * (j))
#define XB_TOP      3328
#define XB_TOPGEN   3392
#define XCD_BAR_WORDS 3456
#define XB_SPIN_CAP (1u << 18)

__device__ __forceinline__ unsigned xb_ld(unsigned* p)              { return __hip_atomic_load(p, __ATOMIC_RELAXED, __HIP_MEMORY_SCOPE_AGENT); }
__device__ __forceinline__ unsigned xb_add(unsigned* p, unsigned v) { return __hip_atomic_fetch_add(p, v, __ATOMIC_RELAXED, __HIP_MEMORY_SCOPE_AGENT); }
__device__ __forceinline__ unsigned xb_xcc_id() { return (unsigned)__builtin_amdgcn_s_getreg((3 << 11) | 20) & 0xFu; }
#define XB_SPIN(cond, bar) do { unsigned _sp = 0; while (cond) { __builtin_amdgcn_s_sleep(1); \
    if ((++_sp & 255u) == 0u) { if (xb_ld(&(bar)[XB_TMO])) break; if (_sp > XB_SPIN_CAP) { atomicAdd(&(bar)[XB_TMO], 1u); break; } } } } while (0)

struct XcdBarrier {
    unsigned* bar; unsigned x;
    volatile LAS unsigned* st;
};

__device__ __forceinline__ XcdBarrier xcd_barrier_post(unsigned* bar, volatile LAS unsigned* st) {
    XcdBarrier b; b.bar = bar; b.x = xb_xcc_id(); b.st = st;
    if (threadIdx.x == 0) (void)xb_add(&bar[XB_XCNT(b.x)], 1u);
    return b;
}
__device__ __forceinline__ void xcd_barrier_complete(unsigned* bar, unsigned x, unsigned& nloc, unsigned& nx) {
    const unsigned G = gridDim.x * gridDim.y * gridDim.z;
    unsigned sum, cnt, mine, sp = 0u;
    for (;;) {
        sum = 0u; cnt = 0u; mine = 0u;
#pragma unroll
        for (unsigned j = 0; j < 16; ++j) { const unsigned c = xb_ld(&bar[XB_XCNT(j)]); sum += c; cnt += (c > 0u) ? 1u : 0u; mine = (j == x) ? c : mine; }
        if (sum == G) break;
        __builtin_amdgcn_s_sleep(1);
        if ((++sp & 255u) == 0u) { if (xb_ld(&bar[XB_TMO])) break; if (sp > XB_SPIN_CAP) { atomicAdd(&bar[XB_TMO], 1u); break; } }
    }
    nloc = mine > 0u ? mine : 1u; nx = cnt > 0u ? cnt : 1u;
}

__device__ __forceinline__ void xcd_barrier(const XcdBarrier& b) {
    asm volatile("s_waitcnt vmcnt(0)" ::: "memory");
    __syncthreads();
    if (threadIdx.x == 0) {
        unsigned* bar = b.bar;
        __builtin_amdgcn_s_waitcnt(0);
        unsigned nloc = b.st[0], nx = b.st[1];
        if (nloc == 0u) { xcd_barrier_complete(bar, b.x, nloc, nx); b.st[0] = nloc; b.st[1] = nx; }
        const unsigned old = xb_add(&bar[XB_XSUB(b.x)], 1u);
        const unsigned gen = old / nloc;
        if (old + 1u == (gen + 1u) * nloc) {
            __builtin_amdgcn_fence(__ATOMIC_RELEASE, "agent");
            asm volatile("s_waitcnt vmcnt(0)" ::: "memory");
            const unsigned og = xb_add(&bar[XB_TOP], 1u);
            const unsigned tg = og / nx;
            if (og + 1u == (tg + 1u) * nx) xb_add(&bar[XB_TOPGEN], 1u);
            else XB_SPIN(xb_ld(&bar[XB_TOPGEN]) == tg, bar);
            __builtin_amdgcn_fence(__ATOMIC_ACQUIRE, "agent");
            xb_add(&bar[XB_XGEN(b.x)], 1u);
            asm volatile("s_waitcnt vmcnt(0)" ::: "memory");
        } else {
            XB_SPIN(xb_ld(&bar[XB_XGEN(b.x)]) == gen, bar);
            __builtin_amdgcn_fence(__ATOMIC_ACQUIRE, "agent");
            asm volatile("s_waitcnt vmcnt(0)" ::: "memory");
        }
    }
    __syncthreads();
}
struct Args { const float* in[34]; float* out; unsigned char* ws; int ph_lo, ph_hi; };
namespace att {
using bf16x8 = __attribute__((ext_vector_type(8))) short;
using s16x4  = __attribute__((ext_vector_type(4))) short;
using f32x16 = __attribute__((ext_vector_type(16))) float;
using u32x4  = __attribute__((ext_vector_type(4))) unsigned;
constexpr int KVBLK = 64;
constexpr size_t SHM_V = KVBLK * 128 * 2, SHM_K = KVBLK * 128 * 2;
constexpr float THR2 = 11.5f;
#define KSWZ(row, colB) ((row) * 256 + ((colB) ^ (((row) & 7) << 4)))
#define SBAR() __builtin_amdgcn_sched_barrier(0)
__device__ __forceinline__ int crow(int r, int hi) { return (r & 3) + 8 * (r >> 2) + 4 * hi; }
__device__ __forceinline__ unsigned cvtpk(float lo, float hi) { unsigned r; asm volatile("v_cvt_pk_bf16_f32 %0, %1, %2" : "=v"(r) : "v"(lo), "v"(hi)); return r; }
__device__ __forceinline__ bf16x8 ld8(const bf16* p) { return *reinterpret_cast<const bf16x8*>(p); }

__device__ __forceinline__ void partialSM(f32x16& p0, f32x16& p1, float& m_reg, float& mn, float& alpha) {
  float pmax = p0[0];
#pragma unroll
  for (int r = 1; r < 16; ++r) pmax = fmaxf(pmax, p0[r]);
#pragma unroll
  for (int r = 0; r < 16; ++r) pmax = fmaxf(pmax, p1[r]);
  { auto rr = __builtin_amdgcn_permlane32_swap(__float_as_uint(pmax), __float_as_uint(pmax), false, false);
    pmax = fmaxf(__uint_as_float(rr[0]), __uint_as_float(rr[1])); }
  if (__builtin_expect(__all(pmax - m_reg <= THR2), 1)) { mn = m_reg; alpha = 1.f; }
  else { mn = fmaxf(m_reg, pmax); alpha = __builtin_amdgcn_exp2f(m_reg - mn); m_reg = mn; }
#pragma unroll
  for (int r = 0; r < 16; ++r) p0[r] = p0[r] - mn;
#pragma unroll
  for (int r = 0; r < 16; ++r) p1[r] = p1[r] - mn;
#pragma unroll
  for (int r = 0; r < 16; ++r) p0[r] = __builtin_amdgcn_exp2f(p0[r]);
}
__device__ __forceinline__ void finishSM(f32x16& p0, f32x16& p1, float alpha, float& l_reg, bf16x8& pa0, bf16x8& pa1, bf16x8& pa2, bf16x8& pa3) {
#pragma unroll
  for (int r = 0; r < 16; ++r) p1[r] = __builtin_amdgcn_exp2f(p1[r]);
  float ps = 0;
#pragma unroll
  for (int r = 0; r < 16; ++r) ps += p0[r];
#pragma unroll
  for (int r = 0; r < 16; ++r) ps += p1[r];
  { auto rr = __builtin_amdgcn_permlane32_swap(__float_as_uint(ps), __float_as_uint(ps), false, false);
    ps = __uint_as_float(rr[0]) + __uint_as_float(rr[1]); }
  l_reg = l_reg * alpha + ps;
#define PK4(P, BASE, OUT) do { unsigned a0 = cvtpk(P[BASE + 0], P[BASE + 1]), a1 = cvtpk(P[BASE + 2], P[BASE + 3]);   \
    unsigned b0 = cvtpk(P[BASE + 4], P[BASE + 5]), b1 = cvtpk(P[BASE + 6], P[BASE + 7]);                              \
    auto r0 = __builtin_amdgcn_permlane32_swap(a0, b0, false, false); auto r1 = __builtin_amdgcn_permlane32_swap(a1, b1, false, false); \
    u32x4 w = {r0[0], r1[0], r0[1], r1[1]}; OUT = *reinterpret_cast<bf16x8*>(&w); } while (0)
  PK4(p0, 0, pa0); PK4(p0, 8, pa1); PK4(p1, 0, pa2); PK4(p1, 8, pa3);
#undef PK4
}
__device__ __forceinline__ void qkt(f32x16& p0, f32x16& p1, const bf16* Ks, const bf16x8* qr, int r32, int hi, int cbase) {
  p0 = f32x16{}; p1 = f32x16{};
#pragma unroll
  for (int d0 = 0; d0 < 4; ++d0) { int cb = (cbase + d0 * 16 + hi * 8) * 2;
    bf16x8 b0 = *reinterpret_cast<const bf16x8*>((const char*)Ks + KSWZ(r32, cb));
    bf16x8 b1 = *reinterpret_cast<const bf16x8*>((const char*)Ks + KSWZ(32 + r32, cb));
    p0 = __builtin_amdgcn_mfma_f32_32x32x16_bf16(b0, qr[d0], p0, 0, 0, 0);
    p1 = __builtin_amdgcn_mfma_f32_32x32x16_bf16(b1, qr[d0], p1, 0, 0, 0); }
}
__device__ __forceinline__ int v_st(int k, int c) { const int kk = (k & ~0xC) | ((k & 4) << 1) | ((k & 8) >> 1); return ((kk >> 3) * 4 + (c >> 5)) * 512 + ((kk & 7) * 32 + (c & 31)) * 2; }
__device__ __forceinline__ int v_rd_base(int lane) { return ((lane & 3) << 3) | (((lane >> 2) & 3) << 6) | (((lane >> 4) & 1) << 5) | (((lane >> 5) & 1) << 8); }
constexpr int v_rd_off(int d0, int ks, int half) { return d0 * 512 + ks * 4096 + half * 2048; }
template <int OFF> __device__ __forceinline__ s16x4 tr_read(int vb) {
  s16x4 r; asm volatile("ds_read_b64_tr_b16 %0, %1 offset:%2" : "=&v"(r) : "v"(vb), "i"(OFF) : "memory"); return r;
}
template <int D0> __device__ __forceinline__ void pv_one(f32x16& od, int vb, bf16x8 pa0, bf16x8 pa1, bf16x8 pa2, bf16x8 pa3) {
  const s16x4 l0 = tr_read<v_rd_off(D0, 0, 0)>(vb), h0 = tr_read<v_rd_off(D0, 0, 1)>(vb), l1 = tr_read<v_rd_off(D0, 1, 0)>(vb), h1 = tr_read<v_rd_off(D0, 1, 1)>(vb);
  const s16x4 l2 = tr_read<v_rd_off(D0, 2, 0)>(vb), h2 = tr_read<v_rd_off(D0, 2, 1)>(vb), l3 = tr_read<v_rd_off(D0, 3, 0)>(vb), h3 = tr_read<v_rd_off(D0, 3, 1)>(vb);
  asm volatile("s_waitcnt lgkmcnt(0)" ::: "memory"); SBAR();
#define PK(L, H) (bf16x8){L[0], L[1], L[2], L[3], H[0], H[1], H[2], H[3]}
  od = __builtin_amdgcn_mfma_f32_32x32x16_bf16(pa0, PK(l0, h0), od, 0, 0, 0);
  od = __builtin_amdgcn_mfma_f32_32x32x16_bf16(pa1, PK(l1, h1), od, 0, 0, 0);
  od = __builtin_amdgcn_mfma_f32_32x32x16_bf16(pa2, PK(l2, h2), od, 0, 0, 0);
  od = __builtin_amdgcn_mfma_f32_32x32x16_bf16(pa3, PK(l3, h3), od, 0, 0, 0);
#undef PK
}
__device__ __forceinline__ void pv_d0(f32x16* o, int vb, bf16x8 pa0, bf16x8 pa1, bf16x8 pa2, bf16x8 pa3) {
  pv_one<0>(o[0], vb, pa0, pa1, pa2, pa3); pv_one<1>(o[1], vb, pa0, pa1, pa2, pa3); pv_one<2>(o[2], vb, pa0, pa1, pa2, pa3); pv_one<3>(o[3], vb, pa0, pa1, pa2, pa3);
}

__device__ __forceinline__ void attn_unit(const bf16* __restrict__ P, int qrow0, int krow0, int NT, int h, float lam, float oml, const float* __restrict__ subg, bf16* __restrict__ AO, char* lds) {
  constexpr int LDK = NINP;
  const int tid = opaque_tid(), wid = __builtin_amdgcn_readfirstlane(tid >> 6), lane = tid & 63, r32 = lane & 31, hi = lane >> 5;
  const int mp = wid >> 2, wq = wid & 3;
  bf16* V_lds = (bf16*)lds; bf16* K_lds = (bf16*)(lds + 2 * SHM_V);
  float* ws = (float*)(lds + 2 * SHM_V + 2 * SHM_K) + wid * 64; float* li_l = ws; float* al_l = ws + 32;
  float m_reg = -1e30f, l_reg = 0; f32x16 o[4] = {}; bf16x8 qr[4];
  const bf16* Qw = P + (size_t)(qrow0 + wq * 32 + r32) * LDK + PC_Q + h * 128 + mp * 64 + hi * 8;
#pragma unroll
  for (int d0 = 0; d0 < 4; ++d0) qr[d0] = ld8(Qw + d0 * 16);
  const bf16* Kh = P + (size_t)krow0 * LDK + PC_K + h * 128; const bf16* Vh = P + (size_t)krow0 * LDK + PC_V + h * 128;
  const int cbase = mp * 64;
  const int sr = tid >> 4, sc = (tid & 15) * 8, vst0 = v_st(sr, sc), vst1 = v_st(32 + sr, sc);
  const int vb0 = (int)(uintptr_t)V_lds + v_rd_base(lane);
  struct { bf16x8 vs0, vs1, ks0, ks1; } sr_[2];
#define SLOAD(i, k0) do { sr_[i].vs0 = ld8(&Vh[(size_t)((k0) + sr) * LDK + sc]); sr_[i].vs1 = ld8(&Vh[(size_t)((k0) + 32 + sr) * LDK + sc]); \
    sr_[i].ks0 = ld8(&Kh[(size_t)((k0) + sr) * LDK + sc]); sr_[i].ks1 = ld8(&Kh[(size_t)((k0) + 32 + sr) * LDK + sc]); } while (0)
#define SWRITE(b, i) do { *(bf16x8*)((char*)V_lds + (b) * SHM_V + vst0) = sr_[i].vs0;          \
    *(bf16x8*)((char*)V_lds + (b) * SHM_V + vst1) = sr_[i].vs1; int kc = sc * 2;               \
    *(bf16x8*)((char*)K_lds + (b) * SHM_K + KSWZ(sr, kc)) = sr_[i].ks0;                       \
    *(bf16x8*)((char*)K_lds + (b) * SHM_K + KSWZ(32 + sr, kc)) = sr_[i].ks1; } while (0)
#define SWAIT() asm volatile("s_waitcnt vmcnt(4)" ::: "memory")
#define RESC(a) do { if (__any((a) < 1.f)) { if (hi == 0) al_l[r32] = (a); asm volatile("s_waitcnt lgkmcnt(0)" ::: "memory"); \
    _Pragma("unroll") for (int d = 0; d < 4; ++d) _Pragma("unroll") for (int r = 0; r < 16; ++r) o[d][r] *= al_l[crow(r, hi)]; } } while (0)
  f32x16 pA0, pA1, pB0, pB1; float mnA, mnB, alA, alB; bf16x8 pa0, pa1, pa2, pa3;
  constexpr int SE = 0, SO = 1;
  SLOAD(SE, 0); asm volatile("s_waitcnt vmcnt(0)" ::: "memory"); SWRITE(0, SE); __syncthreads();
  qkt(pA0, pA1, K_lds, qr, r32, hi, cbase); partialSM(pA0, pA1, m_reg, mnA, alA);
  SLOAD(SO, KVBLK); if (2 < NT) SLOAD(SE, 2 * KVBLK);
  SWAIT(); SWRITE(1, SO); __syncthreads();
  for (int j = 1; j + 1 < NT; j += 2) {
    SBAR(); qkt(pB0, pB1, (bf16*)((char*)K_lds + SHM_K), qr, r32, hi, cbase);
    finishSM(pA0, pA1, alA, l_reg, pa0, pa1, pa2, pa3); SBAR();
    SLOAD(SO, (j + 2) * KVBLK); SBAR();
    pv_d0(o, vb0, pa0, pa1, pa2, pa3); partialSM(pB0, pB1, m_reg, mnB, alB);
    __syncthreads(); SWAIT(); SWRITE(0, SE);
    RESC(alB); __syncthreads();
    SBAR(); qkt(pA0, pA1, K_lds, qr, r32, hi, cbase);
    finishSM(pB0, pB1, alB, l_reg, pa0, pa1, pa2, pa3); SBAR();
    if (j + 3 < NT) SLOAD(SE, (j + 3) * KVBLK); SBAR();
    pv_d0(o, vb0 + (int)SHM_V, pa0, pa1, pa2, pa3); partialSM(pA0, pA1, m_reg, mnA, alA);
    __syncthreads(); SWAIT(); SWRITE(1, SO);
    RESC(alA); __syncthreads();
  }
  SBAR(); qkt(pB0, pB1, (bf16*)((char*)K_lds + SHM_K), qr, r32, hi, cbase);
  finishSM(pA0, pA1, alA, l_reg, pa0, pa1, pa2, pa3); SBAR();
  pv_d0(o, vb0, pa0, pa1, pa2, pa3); partialSM(pB0, pB1, m_reg, mnB, alB);
  __syncthreads(); RESC(alB);
  finishSM(pB0, pB1, alB, l_reg, pa0, pa1, pa2, pa3); SBAR();
  pv_d0(o, vb0 + (int)SHM_V, pa0, pa1, pa2, pa3);
  if (hi == 0) li_l[r32] = l_reg; asm volatile("s_waitcnt lgkmcnt(0)" ::: "memory");
  float rli[16];
#pragma unroll
  for (int r = 0; r < 16; ++r) rli[r] = __builtin_amdgcn_rcpf(li_l[crow(r, hi)]);
  __syncthreads();
  { float* OB = (float*)lds + mp * (128 * 128) + (wq * 32) * 128;
#pragma unroll
    for (int r = 0; r < 16; ++r) { const int orow = crow(r, hi);
#pragma unroll
      for (int d0 = 0; d0 < 4; ++d0) OB[orow * 128 + d0 * 32 + r32] = o[d0][r] * rli[r]; } }
  __syncthreads();
  { const int row = tid >> 2, qd = tid & 3;
    const f32x4* A4 = (const f32x4*)((const float*)lds + row * 128 + qd * 32); const f32x4* B4 = A4 + (128 * 128) / 4;
    f32x4 dv[8]; float ss = 0.f;
#pragma unroll
    for (int j = 0; j < 8; ++j) { dv[j] = A4[j] - lam * B4[j]; ss += (dv[j][0] * dv[j][0] + dv[j][1] * dv[j][1]) + (dv[j][2] * dv[j][2] + dv[j][3] * dv[j][3]); }
    ss += __shfl_xor(ss, 1); ss += __shfl_xor(ss, 2);
    const float rstd = __builtin_amdgcn_rsqf(ss * (1.0f / 128.0f) + 1e-5f) ;
    const f32x4* g4 = (const f32x4*)(subg + qd * 32);
    bf16* op = AO + (size_t)(qrow0 + row) * DM + h * 128 + qd * 32;
#pragma unroll
    for (int j = 0; j < 4; ++j) { const f32x4 g0 = g4[2 * j], g1 = g4[2 * j + 1]; const f32x4 a = dv[2 * j] * rstd, b = dv[2 * j + 1] * rstd;
      u32x4 w; w.x = cvtpk(a[0] * g0[0] * oml, a[1] * g0[1] * oml); w.y = cvtpk(a[2] * g0[2] * oml, a[3] * g0[3] * oml);
      w.z = cvtpk(b[0] * g1[0] * oml, b[1] * g1[1] * oml); w.w = cvtpk(b[2] * g1[2] * oml, b[3] * g1[3] * oml);
      *(u32x4*)(op + j * 8) = w; } }
  __syncthreads();
#undef SLOAD
#undef SWRITE
#undef SWAIT
#undef RESC
}
#undef SBAR
}
__device__ __forceinline__ float dpp_rowsum16(float x) {
    x += __builtin_bit_cast(float, __builtin_amdgcn_update_dpp(0, __builtin_bit_cast(int, x), 0xB1, 0xF, 0xF, true));
    x += __builtin_bit_cast(float, __builtin_amdgcn_update_dpp(0, __builtin_bit_cast(int, x), 0x4E, 0xF, 0xF, true));
    x += __builtin_bit_cast(float, __builtin_amdgcn_update_dpp(0, __builtin_bit_cast(int, x), 0x141, 0xF, 0xF, true));
    x += __builtin_bit_cast(float, __builtin_amdgcn_update_dpp(0, __builtin_bit_cast(int, x), 0x140, 0xF, 0xF, true));
    return x;
}
constexpr int SC_CH = 32, SC_STEPF = 16 * 20 + 32;
__device__ __forceinline__ int scan_pos(int n, int d) { return d == 0 ? n : (n < CL ? (CL - 1) - n : (NPB + CL - 1) - n); }
__device__ __forceinline__ void scan_unit(int d, int b, int h, int rh, const _Float16* __restrict__ SPK, const _Float16* __restrict__ DPK, float* __restrict__ Y, LAS unsigned char* lds) {
    const int tid = opaque_tid(), wid = __builtin_amdgcn_readfirstlane(tid >> 6), lane = tid & 63, ri = lane >> 4, q = lane & 15;
    LAS float* stg = (LAS float*)lds;
    LAS float* ybuf = stg + 2 * SC_CH * SC_STEPF;
    const _Float16* sp = SPK + (size_t)((b * 8 + h) * NPB) * 192;
    const _Float16* dp = DPK + (size_t)(((d * 2 + b) * 8 + h) * NPB) * 192;
    const int sidx = tid >> 4, sq = tid & 15;
    h4 g_r, g_kk, g_v, g_w, g_b, g_kd;
#define SC_LOAD(c) do { const int p_ = scan_pos((c) * SC_CH + sidx, d); const _Float16* s_ = sp + (size_t)p_ * 192 + sq * 4; const _Float16* d_ = dp + (size_t)p_ * 192 + sq * 4; \
        g_r = *(const h4*)(s_); g_kk = *(const h4*)(s_ + 64); g_w = *(const h4*)(d_); g_b = *(const h4*)(d_ + 64); g_kd = *(const h4*)(d_ + 128); \
        if (sq < 8) g_v = *(const h4*)(sp + (size_t)p_ * 192 + 128 + rh * 32 + sq * 4); } while (0)
#define SC_CVT(x) ((f32x4){(float)(x)[0], (float)(x)[1], (float)(x)[2], (float)(x)[3]})
#define SC_WRITE(buf) do { LAS f32x4* o_ = (LAS f32x4*)(stg + ((buf) * SC_CH + sidx) * SC_STEPF + sq * 20); \
        o_[0] = SC_CVT(g_w); o_[1] = SC_CVT(g_b); o_[2] = SC_CVT(g_kd); o_[3] = SC_CVT(g_kk); o_[4] = SC_CVT(g_r); \
        if (sq < 8) *(LAS f32x4*)(stg + ((buf) * SC_CH + sidx) * SC_STEPF + 320 + sq * 4) = SC_CVT(g_v); } while (0)
    f32x4 s = {0.f, 0.f, 0.f, 0.f};
    constexpr int NCH = NPB / SC_CH;
    SC_LOAD(0); SC_WRITE(0); __syncthreads();
    for (int c = 0; c < NCH; ++c) {
        const int buf = c & 1;
        if (c + 1 < NCH) SC_LOAD(c + 1);
        const LAS float* sb = stg + buf * SC_CH * SC_STEPF;
        LAS float* yb = ybuf + buf * SC_CH * 32;
#pragma unroll 4
        for (int n = 0; n < SC_CH; ++n) {
            const LAS f32x4* in4 = (const LAS f32x4*)(sb + n * SC_STEPF + q * 20);
            const f32x4 w = in4[0], bb = in4[1], kd = in4[2], kk = in4[3], rr = in4[4];
            const float vv = sb[n * SC_STEPF + 320 + wid * 4 + ri];
            float sa = (s[0] * kk[0] + s[1] * kk[1]) + (s[2] * kk[2] + s[3] * kk[3]);
            sa = -dpp_rowsum16(sa);
            s = s - s * w; s = s + sa * bb; s = s + vv * kd;
            float yp = (s[0] * rr[0] + s[1] * rr[1]) + (s[2] * rr[2] + s[3] * rr[3]);
            yp = dpp_rowsum16(yp);
            if (q == 0) yb[n * 32 + wid * 4 + ri] = yp;
        }
        if (c + 1 < NCH) SC_WRITE(buf ^ 1);
        __syncthreads();
        { const int n = tid >> 4, r2 = (tid & 15) * 2; const int p_ = scan_pos(c * SC_CH + n, d);
          const float y0 = yb[n * 32 + r2], y1 = yb[n * 32 + r2 + 1];
          float* yo = Y + ((size_t)d * NR + (size_t)b * NPB + p_) * 512 + h * 64 + rh * 32 + r2;
          *(float2*)yo = make_float2(y0, y1); }
    }
    __syncthreads();
#undef SC_LOAD
#undef SC_CVT
#undef SC_WRITE
}

__device__ __forceinline__ void transpose_item(const float* __restrict__ W, int K, int N, bf16* __restrict__ WT, int out_row0, int k0, int n0, LAS float* scr, int lane) {
#pragma unroll 8
    for (int i = 0; i < 32; ++i) { const int kk = 2 * i + (lane >> 5); scr[kk * 33 + (lane & 31)] = W[(size_t)(k0 + kk) * N + n0 + (lane & 31)]; }
    LDS_WAIT(); asm volatile("" ::: "memory");
    const int c = lane & 7;
#pragma unroll
    for (int j = 0; j < 4; ++j) { const int n = (lane >> 3) + 8 * j; const LAS float* s = scr + (8 * c) * 33 + n;
        v4u o; o.x = pk2(s[0 * 33], s[1 * 33]); o.y = pk2(s[2 * 33], s[3 * 33]); o.z = pk2(s[4 * 33], s[5 * 33]); o.w = pk2(s[6 * 33], s[7 * 33]);
        *(v4u*)(WT + (size_t)(out_row0 + n) * K + k0 + 8 * c) = o; }
    LDS_WAIT(); asm volatile("" ::: "memory");
}
__device__ __forceinline__ void transpose_matrix_item(const float* W, int K, int N, bf16* WT, int item, int il_half  , LAS float* scr, int lane) {
    const int nblk = N / 32, kb = item / nblk, nb = item - kb * nblk, n0 = 32 * nb;
    const int orow = (il_half < 0) ? n0 : ((n0 >> 7) * 256 + il_half * 128 + (n0 & 127));
    transpose_item(W, K, N, WT, orow, 64 * kb, n0, scr, lane);
}

struct Ptrs {
    const float* in[34]; float* out; unsigned char* ws;
};
#define IN_X 0
#define IN_C 1
#define IN_CTX 2
#define IN_CCTX 3
#define IN_ADAW 4
#define IN_ADAB 5
#define IN_N1G 6
#define IN_N2G 7
#define IN_WIN 8
#define IN_WOUT 9
#define IN_DLAM 10
#define IN_SUBG 11
#define IN_MU 12
#define IN_W0 13
#define IN_W2 14
#define IN_A0 15
#define IN_A2 16
#define IN_V0 17
#define IN_V1 18
#define IN_V2 19
#define IN_G2 20
#define IN_KK 21
#define IN_KA 22
#define IN_RK 23
#define IN_LNW 24
#define IN_LNB 25
#define IN_FW1 26
#define IN_FW3 27
#define IN_FW2 28
#define IN_ROUTER 29
#define IN_EW1 30
#define IN_EW3 31
#define IN_EW2 32
#define IN_FINALG 33

__device__ __forceinline__ void phase_prologue(const Args& a, LAS unsigned char* lds, int vcu, int G) {
    const int tid = opaque_tid(), lane = tid & 63, wave = __builtin_amdgcn_readfirstlane(tid >> 6);
    unsigned char* ws = opaque_ptr(a.ws);
    LAS float* scr = (LAS float*)(lds + wave * 8704);
    LAS float* sl = (LAS float*)(lds + 73728);
    for (int i = tid; i < 3072; i += NTHR) { const float v = (i < 2048) ? a.in[IN_C][i] : a.in[IN_CCTX][i - 2048]; sl[i] = v * sigmoid_f(v); }
    __syncthreads();
    const int gw = vcu * NWAVES + wave, NGW = G * NWAVES;
    constexpr int T_MOD = 4 * 96;
    constexpr int I_WIN = 16 * (NIN / 32), I_WOUT = 16 * 32, I_F13 = 16 * (DFF / 32), I_F2 = (DFF / 64) * 32;
    constexpr int T_WIN = 4 * I_WIN, T_WOUT = 4 * I_WOUT, T_F1 = 2 * I_F13, T_F3 = 2 * I_F13, T_F2 = 2 * I_F2;
    constexpr int T_PAD = 4 * 32, T_ROPE = 64, T_LAM = 4;
    constexpr int NT = T_MOD + T_WIN + T_WOUT + T_F1 + T_F3 + T_F2 + T_PAD + T_ROPE + T_LAM;
    float* MOD = (float*)(ws + WS_MOD);
    for (int it = gw; it < NT; it += NGW) {
        int r = it;
        if (r < T_MOD) {
            const int l = r / 96, jg = r - l * 96; const float* aw = a.in[IN_ADAW] + (size_t)l * 1024 * 6144 + jg * 64 + lane;
            float a0 = 0.f, a1 = 0.f, a2 = 0.f;
#pragma unroll 8
            for (int i = 0; i < 1024; ++i) { const float w = aw[(size_t)i * 6144]; a0 += sl[i] * w; a1 += sl[1024 + i] * w; a2 += sl[2048 + i] * w; }
            const float bb = a.in[IN_ADAB][l * 6144 + jg * 64 + lane];
            MOD[(l * 3 + 0) * 6144 + jg * 64 + lane] = a0 + bb; MOD[(l * 3 + 1) * 6144 + jg * 64 + lane] = a1 + bb; MOD[(l * 3 + 2) * 6144 + jg * 64 + lane] = a2 + bb;
            continue; }
        r -= T_MOD;
        if (r < T_WIN) { const int l = r / I_WIN; transpose_matrix_item(a.in[IN_WIN] + (size_t)l * DM * NIN, DM, NIN, (bf16*)(ws + WS_WINT) + (size_t)l * NINP * DM, r - l * I_WIN, -1, scr, lane); continue; }
        r -= T_WIN;
        if (r < T_WOUT) { const int l = r / I_WOUT; transpose_matrix_item(a.in[IN_WOUT] + (size_t)l * DM * DM, DM, DM, (bf16*)(ws + WS_WOUTT) + (size_t)l * DM * DM, r - l * I_WOUT, -1, scr, lane); continue; }
        r -= T_WOUT;
        if (r < T_F1) { const int l = r / I_F13; transpose_matrix_item(a.in[IN_FW1] + (size_t)l * DM * DFF, DM, DFF, (bf16*)(ws + WS_W13T) + (size_t)l * 2 * DFF * DM, r - l * I_F13, 0, scr, lane); continue; }
        r -= T_F1;
        if (r < T_F3) { const int l = r / I_F13; transpose_matrix_item(a.in[IN_FW3] + (size_t)l * DM * DFF, DM, DFF, (bf16*)(ws + WS_W13T) + (size_t)l * 2 * DFF * DM, r - l * I_F13, 1, scr, lane); continue; }
        r -= T_F3;
        if (r < T_F2) { const int l = r / I_F2; transpose_matrix_item(a.in[IN_FW2] + (size_t)l * DFF * DM, DFF, DM, (bf16*)(ws + WS_W2T) + (size_t)l * DM * DFF, r - l * I_F2, -1, scr, lane); continue; }
        r -= T_F2;
        if (r < T_PAD) { const int l = r >> 5, row = NIN + (r & 31); v4u z = {0u, 0u, 0u, 0u}; v4u* o = (v4u*)((bf16*)(ws + WS_WINT) + ((size_t)l * NINP + row) * DM) + lane * 2; o[0] = z; o[1] = z; continue; }
        r -= T_PAD;
        if (r < T_ROPE) { const int e = r * 64 + lane, pos = e >> 4, j = e & 15;
            const float inv = __builtin_amdgcn_exp2f(-(float)(2 * j) * (13.287712379549449f / 32.0f)); const float ang = (float)pos * inv;
            float2* T = (float2*)(ws + WS_ROPE); T[e] = make_float2(cosf(ang), sinf(ang)); continue; }
        r -= T_ROPE;
        { const int l = r; const float* lp = a.in[IN_DLAM] + l * 256;
          const float s0 = wave_sum(lp[lane] * lp[64 + lane]), s1 = wave_sum(lp[128 + lane] * lp[192 + lane]);
          const float li = 0.8f - 0.6f * expf(-0.3f * (float)l);
          if (lane == 0) { float* L = (float*)(ws + WS_LAM); L[l * 2] = expf(s0) - expf(s1) + li; L[l * 2 + 1] = 1.0f - li; } }
    }
    { float* LT = (float*)(ws + WS_LORA);
      for (int o = (vcu * NTHR + tid); o < LO_TOTAL; o += G * NTHR) {
          float v;
          if (o < LO_A2) { const int m = o >> 14, r = o & 16383, chn = r >> 5, j = r & 31; v = a.in[IN_W2][((size_t)m * 32 + j) * 512 + chn]; }
          else if (o < LO_V2) { const int q = o - LO_A2; const int m = q >> 14, r = q & 16383, chn = r >> 5, j = r & 31; v = a.in[IN_A2][((size_t)m * 32 + j) * 512 + chn]; }
          else if (o < LO_G2) { const int q = o - LO_V2; const int m = q >> 14, r = q & 16383, chn = r >> 5, j = r & 31; v = a.in[IN_V2][((size_t)m * 32 + j) * 512 + chn]; }
          else { const int q = o - LO_G2; const int m = q / 49152, r = q - m * 49152, chn = r / 96, j = r - chn * 96; v = a.in[IN_G2][((size_t)m * 96 + j) * 512 + chn]; }
          LT[o] = v; } }
}

__device__ __forceinline__ void phase_norm(const Args& a, LAS unsigned char* lds, int vcu, int G, int l, int which_norm, bool moe) {
    const int tid = opaque_tid(), lane = tid & 63, wave = __builtin_amdgcn_readfirstlane(tid >> 6);
    unsigned char* ws = opaque_ptr(a.ws);
    LAS float* tabA = (LAS float*)lds; LAS float* tabB = tabA + 3072; LAS float* rwT = tabB + 3072;
    const float* MOD = (const float*)(ws + WS_MOD) + (size_t)l * 3 * 6144;
    const float* ng = a.in[which_norm ? IN_N2G : IN_N1G] + l * 1024;
    const int off_sh = which_norm ? 3072 : 0, off_sc = off_sh + 1024;
    for (int i = tid; i < 3072; i += NTHR) { const int w = i >> 10, c = i & 1023; tabA[i] = ng[c] * (1.0f + MOD[w * 6144 + off_sc + c]); tabB[i] = MOD[w * 6144 + off_sh + c]; }
    if (moe) { const float* rw = a.in[IN_ROUTER] + (size_t)(l >> 1) * 1024 * 8; for (int i = tid; i < 8192; i += NTHR) { const int c = i >> 3, e = i & 7; rwT[e * 1024 + c] = rw[i]; } }
    __syncthreads();
    const float* srcLat = (l == 0 && which_norm == 0) ? a.in[IN_X] : a.out;
    const float* srcCtx = (l == 0 && which_norm == 0) ? a.in[IN_CTX] : (const float*)(ws + WS_XC);
    bf16* HN = (bf16*)(ws + WS_HN);
    const int gw = vcu * NWAVES + wave, NGW = G * NWAVES;
    for (int R = gw; R < NR; R += NGW) {
        const int b = R / NPB, p = R - b * NPB; const int w = (p < CL) ? 2 : b;
        const float* xr = (p < CL) ? srcCtx + (size_t)(b * CL + p) * 1024 : srcLat + ((size_t)b * SEQ + (p - CL)) * 1024;
        const f32x4* x4 = (const f32x4*)xr + lane;
        f32x4 v[4]; float ss = 0.f;
#pragma unroll
        for (int j = 0; j < 4; ++j) { v[j] = x4[64 * j]; ss += (v[j][0] * v[j][0] + v[j][1] * v[j][1]) + (v[j][2] * v[j][2] + v[j][3] * v[j][3]); }
        const float rstd = 1.0f / sqrtf(wave_sum(ss) * (1.0f / 1024.0f) + 1e-6f);
        const LAS f32x4* A4 = (const LAS f32x4*)(tabA + w * 1024) + lane; const LAS f32x4* B4 = (const LAS f32x4*)(tabB + w * 1024) + lane;
        unsigned long long* o8 = (unsigned long long*)(HN + (size_t)R * 1024) + lane;
#pragma unroll
        for (int j = 0; j < 4; ++j) { v[j] = (v[j] * rstd) * A4[64 * j] + B4[64 * j];
            o8[64 * j] = (unsigned long long)pk2(v[j][0], v[j][1]) | ((unsigned long long)pk2(v[j][2], v[j][3]) << 32); }
        if (moe) {
            float lg[8];
#pragma unroll
            for (int e = 0; e < 8; ++e) { const LAS f32x4* r4 = (const LAS f32x4*)(rwT + e * 1024) + lane; float s = 0.f;
#pragma unroll
                for (int j = 0; j < 4; ++j) { const f32x4 rr = r4[64 * j]; s += (v[j][0] * rr[0] + v[j][1] * rr[1]) + (v[j][2] * rr[2] + v[j][3] * rr[3]); }
                lg[e] = wave_sum(s); }
            int e1 = 0; float v1 = lg[0];
#pragma unroll
            for (int e = 1; e < 8; ++e) if (lg[e] > v1) { v1 = lg[e]; e1 = e; }
            int e2 = -1; float v2 = -3.0e38f;
#pragma unroll
            for (int e = 0; e < 8; ++e) if (e != e1 && lg[e] > v2) { v2 = lg[e]; e2 = e; }
            if (lane == 0) {
                const float g1 = 1.0f / (1.0f + __expf(v2 - v1)), g2 = 1.0f - g1;
                unsigned* cnt = (unsigned*)(ws + WS_CTL) + CW_CNT + (((l >> 1) * 2 + b) * 8) * 64;
                const unsigned p1 = atomicAdd(cnt + 64 * e1, 1u), p2 = atomicAdd(cnt + 64 * e2, 1u);
                unsigned* ro = (unsigned*)(ws + WS_ROUTE) + (size_t)R * 8;
                ro[0] = (unsigned)e1; ro[1] = (unsigned)e2; ro[2] = p1; ro[3] = p2; ro[4] = __float_as_uint(g1); ro[5] = __float_as_uint(g2);
            }
        }
    }
    if (moe) {
        LAS float* scr = (LAS float*)(lds + 57344 + wave * 8704);
        const int li = l >> 1;
        constexpr int I_13 = 16 * (DFE / 32), I_2 = (DFE / 64) * 32;
        constexpr int NTK = 8 * (2 * I_13 + I_2);
        for (int it = gw; it < NTK; it += NGW) {
            const int e = it / (2 * I_13 + I_2); int r = it - e * (2 * I_13 + I_2);
            if (r < I_13) { transpose_matrix_item(a.in[IN_EW1] + ((size_t)li * 8 + e) * DM * DFE, DM, DFE, (bf16*)(ws + WS_W13E) + (size_t)e * 2 * DFE * DM, r, 0, scr, lane); continue; }
            r -= I_13;
            if (r < I_13) { transpose_matrix_item(a.in[IN_EW3] + ((size_t)li * 8 + e) * DM * DFE, DM, DFE, (bf16*)(ws + WS_W13E) + (size_t)e * 2 * DFE * DM, r, 1, scr, lane); continue; }
            r -= I_13;
            transpose_matrix_item(a.in[IN_EW2] + ((size_t)li * 8 + e) * DFE * DM, DFE, DM, (bf16*)(ws + WS_W2E) + (size_t)e * DM * DFE, r, -1, scr, lane);
        }
    }
}
__device__ __forceinline__ void phase_prep(const Args& a, LAS unsigned char* lds, int G, int l) {
    const int tid = opaque_tid(), lane = tid & 63, wave = __builtin_amdgcn_readfirstlane(tid >> 6);
    unsigned char* ws = opaque_ptr(a.ws);
    bf16* P = (bf16*)(ws + WS_P);
    _Float16* SPK = (_Float16*)(ws + WS_SPK); _Float16* DPK = (_Float16*)(ws + WS_DPK); _Float16* VF = (_Float16*)(ws + WS_VFIRST); _Float16* GG = (_Float16*)(ws + WS_G);
    float* BON = (float*)(ws + WS_BONUS); const float* LT = (const float*)(ws + WS_LORA);
    LAS float* wdT = (LAS float*)lds;
    LAS float* adS = wdT + 32 * 64;
    LAS float* gdS = adS + 32 * 64;
    LAS float* vlS = gdS + 32 * 96;
    LAS float* vS  = vlS + 32 * 32;
    const int ch = tid, h = wave, c = lane;
    const float* mu = a.in[IN_MU] + (size_t)l * 3 * 2 * 512;
    const float mur0 = mu[0 * 512 + ch], mur1 = mu[1 * 512 + ch], muk0 = mu[2 * 512 + ch], muk1 = mu[3 * 512 + ch], muv0 = mu[4 * 512 + ch], muv1 = mu[5 * 512 + ch];
    const float k_k = a.in[IN_KK][l * 512 + ch], k_a = a.in[IN_KA][l * 512 + ch], r_k = a.in[IN_RK][l * 512 + ch];
    const float v0c = (l > 0) ? a.in[IN_V0][(l - 1) * 512 + ch] : 0.f;
    for (int tile = blockIdx.x; tile < NB * 520; tile += G) {
        const int b = tile / 520, tt = tile - b * 520, p0 = tt * 32;
        const int seg_lo = (tt < 8) ? 0 : CL, seg_hi = (tt < 8) ? CL : NPB;
        const size_t R0 = (size_t)b * NPB + p0;
        for (int idx = tid; idx < 32 * 224; idx += NTHR) { const int i = idx / 224, cc = idx - i * 224; const float val = bf2f(P[(R0 + i) * NINP + PC_LORA + cc]);
            if (cc < 64) wdT[i * 64 + cc] = tanh_f(val); else if (cc < 128) adS[i * 64 + cc - 64] = val; else gdS[i * 96 + cc - 128] = sigmoid_f(val); }
        { const bf16* vc = P + R0 * NINP + PC_RV + ch;
          float prev = (p0 > seg_lo) ? bf2f(*(vc - NINP)) : 0.f, cur = bf2f(vc[0]);
#pragma unroll 1
          for (int i = 0; i < 32; ++i) { const float nxt = (p0 + i + 1 < seg_hi) ? bf2f(vc[(size_t)(i + 1) * NINP]) : 0.f;
              vS[i * 512 + ch] = cur + muv0 * (prev - cur) + muv1 * (nxt - cur); prev = cur; cur = nxt; } }
        __syncthreads();
        if (l > 0) { const int j = tid & 31, i0 = tid >> 5; const float* v1p = a.in[IN_V1] + (size_t)(l - 1) * 512 * 32 + j; float acc0 = 0.f, acc1 = 0.f;
#pragma unroll 8
            for (int cc = 0; cc < 512; ++cc) { const float w = v1p[cc * 32]; acc0 += vS[i0 * 512 + cc] * w; acc1 += vS[(i0 + 16) * 512 + cc] * w; }
            vlS[i0 * 32 + j] = acc0; vlS[(i0 + 16) * 32 + j] = acc1; }
        __syncthreads();
        if (l > 0) { float v2c[32];
            { const f32x4* w4 = (const f32x4*)(LT + LO_V2 + ((size_t)(l - 1) * 512 + ch) * 32);
#pragma unroll
              for (int j = 0; j < 8; ++j) { const f32x4 t = w4[j]; v2c[4 * j] = t[0]; v2c[4 * j + 1] = t[1]; v2c[4 * j + 2] = t[2]; v2c[4 * j + 3] = t[3]; } }
#pragma unroll 1
            for (int i = 0; i < 32; ++i) { float z = v0c;
#pragma unroll
                for (int j = 0; j < 32; ++j) z += vlS[i * 32 + j] * v2c[j];
                const float vp = vS[i * 512 + ch], vf = (float)VF[(R0 + i) * 512 + ch]; vS[i * 512 + ch] = vp + (vf - vp) * sigmoid_f(z); } }
        else {
#pragma unroll 1
            for (int i = 0; i < 32; ++i) VF[(R0 + i) * 512 + ch] = (_Float16)vS[i * 512 + ch]; }
        asm volatile("" ::: "memory");
        { float g2c[96];
          { const f32x4* w4 = (const f32x4*)(LT + LO_G2 + ((size_t)l * 512 + ch) * 96);
#pragma unroll
            for (int j = 0; j < 24; ++j) { const f32x4 t = w4[j]; g2c[4 * j] = t[0]; g2c[4 * j + 1] = t[1]; g2c[4 * j + 2] = t[2]; g2c[4 * j + 3] = t[3]; } }
#pragma unroll 1
          for (int i = 0; i < 32; ++i) { float g = 0.f;
#pragma unroll
              for (int jc = 0; jc < 3; ++jc) {
#pragma unroll
                  for (int j = 0; j < 32; ++j) g += gdS[i * 96 + jc * 32 + j] * g2c[jc * 32 + j];
                  __builtin_amdgcn_sched_barrier(0); }
              GG[(R0 + i) * 512 + ch] = (_Float16)g; } }
        asm volatile("" ::: "memory");
#pragma unroll 1
        for (int d = 0; d < 2; ++d) {
          float w2c[32], a2c[32];
          { const f32x4* w4 = (const f32x4*)(LT + LO_W2 + (((size_t)l * 2 + d) * 512 + ch) * 32); const f32x4* a4 = (const f32x4*)(LT + LO_A2 + (((size_t)l * 2 + d) * 512 + ch) * 32);
#pragma unroll
            for (int j = 0; j < 8; ++j) { const f32x4 t = w4[j], u = a4[j]; w2c[4 * j] = t[0]; w2c[4 * j + 1] = t[1]; w2c[4 * j + 2] = t[2]; w2c[4 * j + 3] = t[3];
                a2c[4 * j] = u[0]; a2c[4 * j + 1] = u[1]; a2c[4 * j + 2] = u[2]; a2c[4 * j + 3] = u[3]; } }
          const float w0d = a.in[IN_W0][(l * 2 + d) * 512 + ch], a0d = a.in[IN_A0][(l * 2 + d) * 512 + ch];
          const bf16* rc = P + R0 * NINP + PC_R + ch; const bf16* kc = P + R0 * NINP + PC_RK + ch;
          float rprev = (p0 > seg_lo) ? bf2f(*(rc - NINP)) : 0.f, rcur = bf2f(rc[0]);
          float kprev = (p0 > seg_lo) ? bf2f(*(kc - NINP)) : 0.f, kcur = bf2f(kc[0]);
#pragma unroll 1
          for (int i = 0; i < 32; ++i) {
              const bool hn = (p0 + i + 1 < seg_hi);
              const float rnxt = hn ? bf2f(rc[(size_t)(i + 1) * NINP]) : 0.f, knxt = hn ? bf2f(kc[(size_t)(i + 1) * NINP]) : 0.f;
              const float rs = rcur + mur0 * (rprev - rcur) + mur1 * (rnxt - rcur);
              const float ks = kcur + muk0 * (kprev - kcur) + muk1 * (knxt - kcur);
              rprev = rcur; rcur = rnxt; kprev = kcur; kcur = knxt;
              const float t = ks * k_k; const float ssq = wave_sum(t * t); const float kk = t * (1.0f / sqrtf(fmaxf(ssq, 1e-24f)));
              const int p = p0 + i;
              float wl = w0d, al = a0d;
#pragma unroll
              for (int j = 0; j < 32; ++j) { wl += wdT[i * 64 + d * 32 + j] * w2c[j]; al += adS[i * 64 + d * 32 + j] * a2c[j]; }
              const float e = 0.6065306597126334f * sigmoid_f(wl);
              const float omw = -expm1f(-e);
              const float av = sigmoid_f(al);
              const float bb = kk * av, kd = ks * (1.0f + (av - 1.0f) * k_a);
              _Float16* dpk = DPK + ((size_t)(((d * 2 + b) * 8 + h) * NPB) + p) * 192 + c;
              dpk[0] = (_Float16)omw; dpk[64] = (_Float16)bb; dpk[128] = (_Float16)kd;
              const float bs = wave_sum(rs * kd * r_k);
              if (d == 0) { _Float16* spk = SPK + ((size_t)((b * 8 + h) * NPB) + p) * 192 + c;
                  spk[0] = (_Float16)rs; spk[64] = (_Float16)kk; spk[128] = (_Float16)vS[i * 512 + ch];
                  if (c == 0) BON[(R0 + i) * 8 + h] = bs; }
              else if (c == 0) BON[(R0 + i) * 8 + h] += bs;
          }
          asm volatile("" ::: "memory");
        }
        __syncthreads();
    }
    { const float2* RT = (const float2*)(ws + WS_ROPE);
      const int gw = blockIdx.x * NWAVES + wave, NGW = G * NWAVES; const int g = lane & 31, sub = lane >> 5;
      for (int rp = gw; rp < NR / 2; rp += NGW) {
          const int R = rp * 2 + sub; const int b = R / NPB, p = R - b * NPB;
          v4u* pp = (v4u*)(P + (size_t)R * NINP + g * 32);
          v4u x[4];
#pragma unroll
          for (int j = 0; j < 4; ++j) x[j] = pp[j];
          if (p < CL && g >= 16) continue;
          float e[32];
#pragma unroll
          for (int j = 0; j < 4; ++j)
#pragma unroll
              for (int k = 0; k < 4; ++k) { e[j * 8 + 2 * k] = bflo(x[j][k]); e[j * 8 + 2 * k + 1] = bfhi(x[j][k]); }
          if (p >= CL) { const int t = p - CL; const int pos = (g & 1) ? (t & 63) : (t >> 6);
#pragma unroll
              for (int j = 0; j < 16; ++j) { const float2 cs = RT[pos * 16 + j]; const float x1 = e[j], x2 = e[16 + j]; e[j] = x1 * cs.x - x2 * cs.y; e[16 + j] = x1 * cs.y + x2 * cs.x; } }
          const float sc = (g < 16) ? QSCALE : 1.0f;
#pragma unroll
          for (int j = 0; j < 4; ++j) { v4u o;
#pragma unroll
              for (int k = 0; k < 4; ++k) o[k] = pk2(e[j * 8 + 2 * k] * sc, e[j * 8 + 2 * k + 1] * sc);
              pp[j] = o; }
      } }
}

__device__ __forceinline__ void phase_mix(const Args& a, LAS unsigned char* lds, volatile LAS unsigned* MISC, int l, unsigned xcc) {
    const int tid = opaque_tid();
    unsigned char* ws = opaque_ptr(a.ws);
    unsigned* ctl = (unsigned*)(ws + WS_CTL);
    const bf16* P = (const bf16*)(ws + WS_P);
    { int xq = (int)(xcc & 7u), tried = 0;
      while (tried < 8) {
          if (tid == 0) MISC[16] = atomicAdd(ctl + CW_QS + (l * 8 + xq) * 64, 1u);
          __syncthreads(); const unsigned idx = MISC[16]; __syncthreads();
          if (idx >= 8u) { xq = (xq + 1) & 7; ++tried; continue; }
          const int su = xq * 8 + (int)idx; const int chain = su >> 1, rh = su & 1; const int d = chain >> 4, b = (chain >> 3) & 1, h = chain & 7;
#ifndef NO_SCAN
          scan_unit(d, b, h, rh, (const _Float16*)(ws + WS_SPK), (const _Float16*)(ws + WS_DPK), (float*)(ws + WS_Y), lds);
#endif
      } }
    { const float* L = (const float*)(ws + WS_LAM); const float lam = L[l * 2], oml = L[l * 2 + 1];
      const float* subg = a.in[IN_SUBG] + l * 128; bf16* AO = (bf16*)(ws + WS_HN);
      int xq = (int)(xcc & 7u), tried = 0;
      while (tried < 8) {
          if (tid == 0) MISC[16] = atomicAdd(ctl + CW_QA + (l * 8 + xq) * 64, 1u);
          __syncthreads(); const unsigned idx = MISC[16]; __syncthreads();
          if (idx >= 130u) { xq = (xq + 1) & 7; ++tried; continue; }
          const int b = xq >> 2, h = xq & 3;
#ifndef NO_ATTN
          if (idx < 128u) att::attn_unit(P, b * NPB + CL + (int)idx * 128, b * NPB, NPB / 64, h, lam, oml, subg, AO, (char*)lds);
          else att::attn_unit(P, b * NPB + ((int)idx - 128) * 128, b * NPB, CL / 64, h, lam, oml, subg, AO, (char*)lds);
#endif
      } }
}

__device__ __forceinline__ void phase_finish(const Args& a, int G, int l) {
    const int tid = opaque_tid(), lane = tid & 63, wave = __builtin_amdgcn_readfirstlane(tid >> 6);
    unsigned char* ws = opaque_ptr(a.ws);
    const float* Y = (const float*)(ws + WS_Y); const _Float16* SPK = (const _Float16*)(ws + WS_SPK); const _Float16* GG = (const _Float16*)(ws + WS_G); const float* BON = (const float*)(ws + WS_BONUS);
    bf16* AO = (bf16*)(ws + WS_HN);
    const int ch = tid, h = wave, c = lane;
    const float lw = a.in[IN_LNW][l * 512 + ch], lb = a.in[IN_LNB][l * 512 + ch];
    for (int R = blockIdx.x; R < NR; R += G) {
        const int b = R / NPB, p = R - b * NPB;
        const float y = Y[(size_t)R * 512 + ch] + Y[((size_t)NR + R) * 512 + ch];
        const float mean = wave_sum(y) * (1.0f / 64.0f); const float dv = y - mean; const float var = wave_sum(dv * dv) * (1.0f / 64.0f);
        float o = dv * (1.0f / sqrtf(var + 64e-5f)) * lw + lb;
        const float vv = (float)SPK[((size_t)((b * 8 + h) * NPB) + p) * 192 + 128 + c];
        o += BON[(size_t)R * 8 + h] * vv;
        o *= (float)GG[(size_t)R * 512 + ch];
        AO[(size_t)R * 1024 + 512 + ch] = (bf16)f2bf(o);
    }
}

__device__ __forceinline__ void phase_gather(const Args& a, int vcu, int G, int l, int half) {
    const int tid = opaque_tid(), lane = tid & 63, wave = __builtin_amdgcn_readfirstlane(tid >> 6);
    unsigned char* ws = opaque_ptr(a.ws);
    const unsigned* cnt = (const unsigned*)(ws + WS_CTL) + CW_CNT + (((l >> 1) * 2 + half) * 8) * 64;
    int off[8]; { int r = 0;
#pragma unroll
        for (int e = 0; e < 8; ++e) { off[e] = r; const int n = (int)__hip_atomic_load(cnt + 64 * e, __ATOMIC_RELAXED, __HIP_MEMORY_SCOPE_AGENT); r += ((n + 255) >> 8) << 8; } }
    const bf16* HN = (const bf16*)(ws + WS_HN); bf16* AG = (bf16*)(ws + WS_AG);
    const int gw = vcu * NWAVES + wave, NGW = G * NWAVES;
    for (int rr = gw; rr < NPB; rr += NGW) {
        const int R = half * NPB + rr;
        unsigned* ro = (unsigned*)(ws + WS_ROUTE) + (size_t)R * 8;
        const int e1 = (int)ro[0], e2 = (int)ro[1]; const int p1 = (int)ro[2], p2 = (int)ro[3];
        int o1 = 0, o2 = 0;
#pragma unroll
        for (int e = 0; e < 8; ++e) { if (e == e1) o1 = off[e]; if (e == e2) o2 = off[e]; }
        const int s1 = o1 + p1, s2 = o2 + p2;
        const v4u* src = (const v4u*)(HN + (size_t)R * 1024) + lane * 2; const v4u x0 = src[0], x1 = src[1];
        v4u* d1 = (v4u*)(AG + (size_t)s1 * 1024) + lane * 2; v4u* d2 = (v4u*)(AG + (size_t)s2 * 1024) + lane * 2;
        d1[0] = x0; d1[1] = x1; d2[0] = x0; d2[1] = x1;
        if (lane == 0) { ro[6] = (unsigned)s1; ro[7] = (unsigned)s2; }
    }
}
__device__ __forceinline__ void phase_combine(const Args& a, int vcu, int G, int l, int half) {
    const int tid = opaque_tid(), lane = tid & 63, wave = __builtin_amdgcn_readfirstlane(tid >> 6);
    unsigned char* ws = opaque_ptr(a.ws);
    const bf16* YE = (const bf16*)(ws + WS_YEXP);
    const float* MOD = (const float*)(ws + WS_MOD) + (size_t)l * 3 * 6144 + 5120;
    const int gw = vcu * NWAVES + wave, NGW = G * NWAVES;
    for (int rr = gw; rr < NPB; rr += NGW) {
        const int R = half * NPB + rr; const int b = half, p = rr; const int w = (p < CL) ? 2 : b;
        const unsigned* ro = (const unsigned*)(ws + WS_ROUTE) + (size_t)R * 8;
        const float g1 = __uint_as_float(ro[4]), g2 = __uint_as_float(ro[5]); const int s1 = (int)ro[6], s2 = (int)ro[7];
        float* xr = (p < CL) ? (float*)(ws + WS_XC) + (size_t)(b * CL + p) * 1024 : a.out + ((size_t)b * SEQ + (p - CL)) * 1024;
        const f32x4* gt = (const f32x4*)(MOD + (size_t)w * 6144);
        const v4u* y1 = (const v4u*)(YE + (size_t)s1 * 1024); const v4u* y2 = (const v4u*)(YE + (size_t)s2 * 1024);
#pragma unroll
        for (int j = 0; j < 2; ++j) { const int c8 = lane + 64 * j;
            const v4u u1 = y1[c8], u2 = y2[c8]; f32x4* xp = (f32x4*)xr + c8 * 2; f32x4 x0 = xp[0], x1 = xp[1]; const f32x4 t0 = gt[c8 * 2], t1 = gt[c8 * 2 + 1];
            x0[0] += t0[0] * (g1 * bflo(u1[0]) + g2 * bflo(u2[0])); x0[1] += t0[1] * (g1 * bfhi(u1[0]) + g2 * bfhi(u2[0]));
            x0[2] += t0[2] * (g1 * bflo(u1[1]) + g2 * bflo(u2[1])); x0[3] += t0[3] * (g1 * bfhi(u1[1]) + g2 * bfhi(u2[1]));
            x1[0] += t1[0] * (g1 * bflo(u1[2]) + g2 * bflo(u2[2])); x1[1] += t1[1] * (g1 * bfhi(u1[2]) + g2 * bfhi(u2[2]));
            x1[2] += t1[2] * (g1 * bflo(u1[3]) + g2 * bflo(u2[3])); x1[3] += t1[3] * (g1 * bfhi(u1[3]) + g2 * bfhi(u2[3]));
            xp[0] = x0; xp[1] = x1; }
    }
}
__device__ __forceinline__ void phase_final(const Args& a, int vcu, int G) {
    const int tid = opaque_tid(), lane = tid & 63, wave = __builtin_amdgcn_readfirstlane(tid >> 6);
    const int gw = vcu * NWAVES + wave, NGW = G * NWAVES;
    const f32x4* g4 = (const f32x4*)a.in[IN_FINALG] + lane;
    for (int r = gw; r < NB * SEQ; r += NGW) {
        f32x4* x4 = (f32x4*)(a.out + (size_t)r * 1024) + lane; f32x4 v[4]; float ss = 0.f;
#pragma unroll
        for (int j = 0; j < 4; ++j) { v[j] = x4[64 * j]; ss += (v[j][0] * v[j][0] + v[j][1] * v[j][1]) + (v[j][2] * v[j][2] + v[j][3] * v[j][3]); }
        const float rstd = 1.0f / sqrtf(wave_sum(ss) * (1.0f / 1024.0f) + 1e-6f);
#pragma unroll
        for (int j = 0; j < 4; ++j) x4[64 * j] = (v[j] * rstd) * g4[64 * j];
    }
}
#ifndef MK_MULTI
#define MK_MULTI 0
#endif
constexpr int N_PHASES = 1 + 2 * 9 + 2 * 15 + 1;

__global__ void __launch_bounds__(NTHR, 2) mk_fwd(Args args) {
    extern __shared__ __attribute__((aligned(16))) unsigned char lds_raw[];
    LAS unsigned char* lds = (LAS unsigned char*)lds_raw;
    volatile LAS unsigned* MISC = (volatile LAS unsigned*)(lds + MISC_OFF);
    const int tid = threadIdx.x;
    const int G = gridDim.x; const int bx = blockIdx.x; const int vcu = (G % 8 == 0) ? (bx % 8) * (G / 8) + bx / 8 : bx;
    unsigned char* ws = args.ws;
    unsigned* ctl = (unsigned*)(ws + WS_CTL);
    for (int u = tid; u < (LDS_BYTES - LDSCTL_OFF) / 4; u += NTHR) ((LAS unsigned*)(lds + LDSCTL_OFF))[u] = 0u;
    __syncthreads();
    const int lo = args.ph_lo, hi = args.ph_hi;
    XcdBarrier bar; bar.bar = ctl + CW_BAR; bar.x = xb_xcc_id(); bar.st = MISC + 8;
    if (hi - lo > 1) bar = xcd_barrier_post(ctl + CW_BAR, MISC + 8);
    const unsigned xcc = bar.x;
    int seq = 0;
#ifndef PH_MASK
#define PH_MASK 0xFFFFFFFFu
#endif
#define PH_ON(b) ((PH_MASK >> (b)) & 1u)
#define PH_BEGIN if (lo <= seq && seq < hi) { unsigned char* ws = opaque_ptr(args.ws); (void)ws;
#define PH_END   if (seq + 1 < hi) xcd_barrier(bar); } ++seq;

    PH_BEGIN if (PH_ON(0)) phase_prologue(args, lds, vcu, G); PH_END

    for (int l = 0; l < DEPTH; ++l) {
        const bool moe = (l & 1) != 0;
        const float* MODl = (const float*)(ws + WS_MOD) + (size_t)l * 3 * 6144;
        PH_BEGIN if (PH_ON(1)) phase_norm(args, lds, vcu, G, l, 0, false); PH_END
        PH_BEGIN {
            pg8::Gemm g{(const pg8::bf16_t*)(ws + WS_HN), (const pg8::bf16_t*)(ws + WS_WINT) + (size_t)l * NINP * DM, NR, NINP, DM};
            pg8::StaticOrder S; S.init(NR, NINP, G, bx);
            pg8::EpiStoreBf16 E{(pg8::bf16_t*)(ws + WS_P), NINP, 0};
            if (PH_ON(2)) pg8::gemm_phase<pg8::EpiStoreBf16, pg8::StaticOrder, true, true>(lds, g, S, E);
        } PH_END
        PH_BEGIN if (PH_ON(3)) phase_prep(args, lds, G, l); PH_END
        PH_BEGIN if (PH_ON(4)) phase_mix(args, lds, MISC, l, xcc); PH_END
        PH_BEGIN if (PH_ON(5)) phase_finish(args, G, l); PH_END
        PH_BEGIN {
            pg8::Gemm g{(const pg8::bf16_t*)(ws + WS_HN), (const pg8::bf16_t*)(ws + WS_WOUTT) + (size_t)l * DM * DM, NR, DM, DM};
            pg8::StaticOrder S; S.init(NR, DM, G, bx);
            pg8::EpiResid E{(l == 0) ? args.in[IN_X] : args.out, (l == 0) ? args.in[IN_CTX] : (const float*)(ws + WS_XC), args.out, (float*)(ws + WS_XC), MODl + 2048};
            if (PH_ON(6)) pg8::gemm_phase<pg8::EpiResid, pg8::StaticOrder, true, true>(lds, g, S, E);
        } PH_END
        PH_BEGIN if (PH_ON(7)) phase_norm(args, lds, vcu, G, l, 1, moe); PH_END
        if (!moe) {
            PH_BEGIN {
                pg8::Gemm g{(const pg8::bf16_t*)(ws + WS_HN), (const pg8::bf16_t*)(ws + WS_W13T) + (size_t)(l >> 1) * 2 * DFF * DM, NR, 2 * DFF, DM};
                pg8::StaticOrder S; S.init(NR, 2 * DFF, G, bx);
                pg8::EpiSwiGLU E{(pg8::bf16_t*)(ws + WS_HF), DFF, 0};
                if (PH_ON(8)) pg8::gemm_phase<pg8::EpiSwiGLU, pg8::StaticOrder, true, true>(lds, g, S, E);
            } PH_END
            PH_BEGIN {
                pg8::Gemm g{(const pg8::bf16_t*)(ws + WS_HF), (const pg8::bf16_t*)(ws + WS_W2T) + (size_t)(l >> 1) * DM * DFF, NR, DM, DFF};
                pg8::StaticOrder S; S.init(NR, DM, G, bx);
                pg8::EpiResid E{args.out, (const float*)(ws + WS_XC), args.out, (float*)(ws + WS_XC), MODl + 5120};
                if (PH_ON(9)) pg8::gemm_phase<pg8::EpiResid, pg8::StaticOrder, true, true>(lds, g, S, E);
            } PH_END
        } else {
            for (int half = 0; half < 2; ++half) {
                const unsigned* cnt = (const unsigned*)ctl + CW_CNT + (((l >> 1) * 2 + half) * 8) * 64;
                PH_BEGIN if (PH_ON(10)) phase_gather(args, vcu, G, l, half); PH_END
                PH_BEGIN {
                    pg8::Gemm g{(const pg8::bf16_t*)(ws + WS_AG), (const pg8::bf16_t*)(ws + WS_W13E), 35328, 8 * 2 * DFE, DM};
                    pg8::MoeOrder S; S.init(cnt, (2 * DFE) / 256, G, bx);
                    pg8::EpiSwiGLU E{(pg8::bf16_t*)(ws + WS_HMOE), DFE, (2 * DFE) / 256};
                    if (PH_ON(11)) pg8::gemm_phase<pg8::EpiSwiGLU, pg8::MoeOrder, true, true>(lds, g, S, E);
                } PH_END
                PH_BEGIN {
                    pg8::Gemm g{(const pg8::bf16_t*)(ws + WS_HMOE), (const pg8::bf16_t*)(ws + WS_W2E), 35328, 8 * DM, DFE};
                    pg8::MoeOrder S; S.init(cnt, DM / 256, G, bx);
                    pg8::EpiStoreBf16 E{(pg8::bf16_t*)(ws + WS_YEXP), DM, DM / 256};
                    if (PH_ON(12)) pg8::gemm_phase<pg8::EpiStoreBf16, pg8::MoeOrder, true, true>(lds, g, S, E);
                } PH_END
                PH_BEGIN if (PH_ON(13)) phase_combine(args, vcu, G, l, half); PH_END
            }
        }
    }
    PH_BEGIN if (PH_ON(14)) phase_final(args, vcu, G); PH_END
#undef PH_BEGIN
#undef PH_END
}

extern "C" void kernel_launch(void* const* d_in, const int* in_sizes, int n_in, void* d_out, int out_size, void* d_ws, size_t ws_size, hipStream_t stream) {
    static int grid = 0;
    if (grid == 0) {
        if (n_in != 34 || out_size != NB * SEQ * DM || ws_size < WS_END) { fprintf(stderr, "kernel_launch: unexpected shapes (n_in %d out %d ws %zu, need %zu)\n", n_in, out_size, ws_size, (size_t)WS_END); grid = -1; return; }
        int dev = 0, cus = 0, per_cu = 0;
        if (hipGetDevice(&dev) != hipSuccess || hipDeviceGetAttribute(&cus, hipDeviceAttributeMultiprocessorCount, dev) != hipSuccess) { grid = -1; return; }
        if (hipFuncSetAttribute((const void*)mk_fwd, hipFuncAttributeMaxDynamicSharedMemorySize, LDS_BYTES) != hipSuccess) { fprintf(stderr, "kernel_launch: hipFuncSetAttribute failed\n"); grid = -1; return; }
        if (hipOccupancyMaxActiveBlocksPerMultiprocessor(&per_cu, (const void*)mk_fwd, NTHR, LDS_BYTES) != hipSuccess || per_cu < 1) fprintf(stderr, "kernel_launch: occupancy query reports %d blocks per CU\n", per_cu);
        (void)hipGetLastError();
        grid = cus;
    }
    if (grid < 0) return;
    if (hipMemsetAsync((char*)d_ws + WS_CTL, 0, CTL_ZERO_BYTES, stream) != hipSuccess) return;
    Args a{};
    for (int i = 0; i < 34; ++i) a.in[i] = (const float*)d_in[i];
    a.out = (float*)d_out; a.ws = (unsigned char*)d_ws;
#if MK_MULTI
    for (int s = 0; s < N_PHASES; ++s) { a.ph_lo = s; a.ph_hi = s + 1; hipLaunchKernelGGL(mk_fwd, dim3(grid), dim3(NTHR), LDS_BYTES, stream, a); }
#else
    a.ph_lo = 0; a.ph_hi = N_PHASES;
    hipLaunchKernelGGL(mk_fwd, dim3(grid), dim3(NTHR), LDS_BYTES, stream, a);
#endif
    const hipError_t le = hipPeekAtLastError();
    if (le != hipSuccess) fprintf(stderr, "kernel_launch: launch failed: %s\n", hipGetErrorName(le));
}
```

```cpp
#include <hip/hip_runtime.h>
#include <cstdio>
#include <cstdint>
__device__ __forceinline__ int opaque_tid() { int t = (int)threadIdx.x; asm volatile("" : "+v"(t)); return t; }
template <class T> __device__ __forceinline__ T* opaque_ptr(T* p) { asm volatile("" : "+s"(p)); return p; }
namespace pg8 {
#define PG8_LAS __attribute__((address_space(3)))
typedef unsigned short bf16_t;
typedef short bf16x8 __attribute__((ext_vector_type(8)));
typedef float f32x4 __attribute__((ext_vector_type(4)));
typedef unsigned u32x4 __attribute__((ext_vector_type(4)));
constexpr int BM = 256, BK = 64, HALF = 128, HTB = HALF * BK * 2  , STAGE_BYTES = 8 * HTB, NXCD = 8, WGM = 8;

__host__ __device__ __forceinline__ int lds_byte(int r, int c) { const int st = (r >> 4) * 2 + (c >> 5), rr = r & 15, cc = c & 31, ob = rr * 64 + cc * 2; return st * 1024 + (ob ^ (((ob >> 9) & 1) << 5)); }
__host__ __device__ __forceinline__ void stage_rc(int b, int& R, int& C) { const int st = b / 1024, sb = b % 1024, swz = sb ^ (((sb >> 9) & 1) << 5); R = (st >> 1) * 16 + swz / 64; C = (st & 1) * 32 + (swz % 64) / 2; }
__host__ __device__ __forceinline__ int perm32(int rho) { const int n = rho >> 4, i = rho & 15; return 8 * (i >> 2) + 4 * n + (i & 3); }

struct Unit { int pm, pn; };
struct Gemm { const bf16_t* A; const bf16_t* Bt; int M, N, K; };

struct StaticOrder {
    int nM, nN, nwg, G, c;
    __host__ __device__ void init(int M, int N, int G_, int c_) { nM = M / BM; nN = N / BM; nwg = nM * nN; G = G_; c = c_; }
    __host__ __device__ bool next(int i, Unit& u) const {
        const long L = (long)i * G + c; if (L >= nwg) return false;
        int wgid = (int)L; { const int q = nwg / NXCD, r = nwg % NXCD, xcd = wgid % NXCD, off = wgid / NXCD; wgid = (xcd < r ? xcd * (q + 1) : r * (q + 1) + (xcd - r) * q) + off; }
        const int nig = WGM * nN, gid = wgid / nig, fm = gid * WGM, gsz = (nM - fm) < WGM ? (nM - fm) : WGM;
        u.pm = fm + ((wgid % nig) % gsz); u.pn = (wgid % nig) / gsz; return true;
    }
    __device__ __forceinline__ void a_ready(const Unit&) const {}
    __device__ __forceinline__ void done(const Unit&) const {}
};

__device__ __forceinline__ unsigned cvt_pk_bf16(float lo, float hi) { unsigned r; asm volatile("v_cvt_pk_bf16_f32 %0, %1, %2" : "=v"(r) : "v"(lo), "v"(hi)); return r; }
typedef float f32x2 __attribute__((ext_vector_type(2)));
__device__ __forceinline__ float silu_acc(float a) { return a * __builtin_amdgcn_rcpf(1.0f + __builtin_amdgcn_exp2f(-1.4426950408889634f * a)); }
struct EpiStoreBf16 {
    static constexpr bool PERM = true, AFTER_DRAIN = false;
    bf16_t* O; int ldc; int ncolt;
    __device__ __forceinline__ void operator()(const f32x4 (&acc)[2][2][4][2], const Unit& u, int wr, int wc, int fr, int fq) const {
        const int row0 = u.pm * BM + wr * 64 + fr; const int pnl = ncolt ? (u.pn % ncolt) : u.pn;
        const int col0 = pnl * BM + wc * 32 + 8 * fq;
#pragma unroll
        for (int ai = 0; ai < 2; ++ai)
#pragma unroll
            for (int m = 0; m < 4; ++m) { bf16_t* rowp = O + (size_t)(row0 + ai * HALF + m * 16) * ldc + col0;
#pragma unroll
                for (int bj = 0; bj < 2; ++bj) { const f32x4 v0 = acc[ai][bj][m][0], v1 = acc[ai][bj][m][1];
                    u32x4 w; w.x = cvt_pk_bf16(v0[0], v0[1]); w.y = cvt_pk_bf16(v0[2], v0[3]); w.z = cvt_pk_bf16(v1[0], v1[1]); w.w = cvt_pk_bf16(v1[2], v1[3]);
                    *(u32x4*)(rowp + bj * HALF) = w; } }
    }
};
struct EpiStoreSplit {
    static constexpr bool PERM = true, AFTER_DRAIN = false;
    bf16_t* O0; int ld0; bf16_t* O1; int ld1; int nt0;
    __device__ __forceinline__ void operator()(const f32x4 (&acc)[2][2][4][2], const Unit& u, int wr, int wc, int fr, int fq) const {
        const int row0 = u.pm * BM + wr * 64 + fr; const bool first = u.pn < nt0; const int pnl = first ? u.pn : u.pn - nt0; const int ldc = first ? ld0 : ld1; bf16_t* O = first ? O0 : O1;
        const int col0 = pnl * BM + wc * 32 + 8 * fq;
#pragma unroll
        for (int ai = 0; ai < 2; ++ai)
#pragma unroll
            for (int m = 0; m < 4; ++m) { bf16_t* rowp = O + (size_t)(row0 + ai * HALF + m * 16) * ldc + col0;
#pragma unroll
                for (int bj = 0; bj < 2; ++bj) { const f32x4 v0 = acc[ai][bj][m][0], v1 = acc[ai][bj][m][1];
                    u32x4 w; w.x = cvt_pk_bf16(v0[0], v0[1]); w.y = cvt_pk_bf16(v0[2], v0[3]); w.z = cvt_pk_bf16(v1[0], v1[1]); w.w = cvt_pk_bf16(v1[2], v1[3]);
                    *(u32x4*)(rowp + bj * HALF) = w; } }
    }
};
struct EpiSwiGLU {
    static constexpr bool PERM = true, AFTER_DRAIN = false;
    bf16_t* O; int ldc; int ncolt;
    __device__ __forceinline__ void operator()(const f32x4 (&acc)[2][2][4][2], const Unit& u, int wr, int wc, int fr, int fq) const {
        const int row0 = u.pm * BM + wr * 64 + fr; const int pnl = ncolt ? (u.pn % ncolt) : u.pn;
        const int col0 = pnl * HALF + wc * 32 + 8 * fq;
#pragma unroll
        for (int ai = 0; ai < 2; ++ai)
#pragma unroll
            for (int m = 0; m < 4; ++m) { bf16_t* rowp = O + (size_t)(row0 + ai * HALF + m * 16) * ldc + col0;
                const f32x4 a0 = acc[ai][0][m][0], a1 = acc[ai][0][m][1], b0 = acc[ai][1][m][0], b1 = acc[ai][1][m][1];
                u32x4 w;
                w.x = cvt_pk_bf16(silu_acc(a0[0]) * b0[0], silu_acc(a0[1]) * b0[1]); w.y = cvt_pk_bf16(silu_acc(a0[2]) * b0[2], silu_acc(a0[3]) * b0[3]);
                w.z = cvt_pk_bf16(silu_acc(a1[0]) * b1[0], silu_acc(a1[1]) * b1[1]); w.w = cvt_pk_bf16(silu_acc(a1[2]) * b1[2], silu_acc(a1[3]) * b1[3]);
                *(u32x4*)rowp = w; }
    }
};
struct EpiResid {
    static constexpr bool PERM = false, AFTER_DRAIN = false;
    const float* srcLat; const float* srcCtx; float* dstLat; float* dstCtx; const float* gate3;
    __device__ __forceinline__ void operator()(const f32x4 (&acc)[2][2][4][2], const Unit& u, int wr, int wc, int fr, int fq) const {
        const int b = u.pm / 65, j = u.pm - b * 65; const int which = (j == 0) ? 2 : b;
        const float* src = (j == 0) ? srcCtx + (size_t)b * 256 * 1024 : srcLat + ((size_t)b * 16384 + (size_t)(j - 1) * 256) * 1024;
        float* dst = (j == 0) ? dstCtx + (size_t)b * 256 * 1024 : dstLat + ((size_t)b * 16384 + (size_t)(j - 1) * 256) * 1024;
        const float* gp = gate3 + (size_t)which * 6144;
        const int col0 = u.pn * BM + wc * 32 + 4 * fq;
        f32x4 gv[2][2];
#pragma unroll
        for (int bj = 0; bj < 2; ++bj)
#pragma unroll
            for (int n = 0; n < 2; ++n) gv[bj][n] = *(const f32x4*)(gp + col0 + bj * HALF + n * 16);
#pragma unroll
        for (int ai = 0; ai < 2; ++ai)
#pragma unroll
            for (int m = 0; m < 4; ++m) { const size_t off = (size_t)(ai * HALF + wr * 64 + m * 16 + fr) * 1024 + col0;
#pragma unroll
                for (int bj = 0; bj < 2; ++bj)
#pragma unroll
                    for (int n = 0; n < 2; ++n) { const f32x4 x = *(const f32x4*)(src + off + bj * HALF + n * 16);
                        *(f32x4*)(dst + off + bj * HALF + n * 16) = x + gv[bj][n] * acc[ai][bj][m][n]; }
                if (m & 1) asm volatile("" ::: "memory"); }
    }
};
struct MoeOrder {
    int t0, t1, t2, t3, t4, t5, t6, t7; int ncol, G, c;
    __device__ __forceinline__ void init(const unsigned* cnt  , int ncol_, int G_, int c_) {
        ncol = ncol_; G = G_; c = c_;
#define MO_T(e) (((int)__hip_atomic_load(cnt + 64 * (e), __ATOMIC_RELAXED, __HIP_MEMORY_SCOPE_AGENT) + 255) >> 8)
        t0 = MO_T(0); t1 = MO_T(1); t2 = MO_T(2); t3 = MO_T(3); t4 = MO_T(4); t5 = MO_T(5); t6 = MO_T(6); t7 = MO_T(7);
#undef MO_T
    }
    __device__ __forceinline__ bool next(int i, Unit& u) const {
        int L = i * G + c; int e = 0, r0 = 0, te = t0; bool found = false;
#define MO_STEP(k, tk) if (!found) { if (L < (tk) * ncol) { e = (k); te = (tk); found = true; } else { L -= (tk) * ncol; r0 += (tk); } }
        MO_STEP(0, t0) MO_STEP(1, t1) MO_STEP(2, t2) MO_STEP(3, t3) MO_STEP(4, t4) MO_STEP(5, t5) MO_STEP(6, t6) MO_STEP(7, t7)
#undef MO_STEP
        if (!found) return false;
        u.pm = r0 + L % te; u.pn = e * ncol + L / te; return true;
    }
    __device__ __forceinline__ void a_ready(const Unit&) const {}
    __device__ __forceinline__ void done(const Unit&) const {}
};
template <class Epi, class Sched, bool ALIGN_EPI = false, bool SP2 = false>
__device__ __forceinline__ void gemm_phase(PG8_LAS unsigned char* lds, const Gemm g, const Sched& S, const Epi& E) {
    const int tid = opaque_tid(), wid = __builtin_amdgcn_readfirstlane(tid >> 6), lane = tid & 63, wr = wid >> 2, wc = wid & 3, fr = lane & 15, fq = lane >> 4;
    const int K = g.K, nt = K / BK;
    unsigned voffA[2], voffB[2];
#pragma unroll
    for (int i = 0; i < 2; ++i) { int R, C; stage_rc(tid * 16 + i * 8192, R, C); const int Rb = Epi::PERM ? ((R & ~31) + perm32(R & 31)) : R;
        voffA[i] = (unsigned)(R * K + C) * 2u; voffB[i] = (unsigned)(Rb * K + C) * 2u; }
    const size_t kstep = (size_t)(BK * 2);
    const size_t hstep = (size_t)HALF * K * 2;
    const size_t tstep = 2 * hstep;
    const unsigned ldsw = (unsigned)wid * 1024u;
    const int aoff = lds_byte(wr * 64 + fr, fq * 8), boff = lds_byte(wc * 32 + fr, fq * 8);
#define PG8_SA(b, h) (((b) * 2 + (h)) * HTB)
#define PG8_SB(b, h) ((4 + (b) * 2 + (h)) * HTB)
#define PG8_STAGE(bufoff, gbase, voff) do { _Pragma("unroll") for (int _i = 0; _i < 2; ++_i) \
        __builtin_amdgcn_global_load_lds((const unsigned*)((const char*)(gbase) + (voff)[_i]), (PG8_LAS unsigned*)(lds + (bufoff) + ldsw + _i * 8192), 16, 0, 0); } while (0)
#define PG8_LDA(dst, b, h) do { _Pragma("unroll") for (int m = 0; m < 4; ++m) _Pragma("unroll") for (int k = 0; k < 2; ++k) dst[m][k] = *(const PG8_LAS bf16x8*)(lds + PG8_SA(b, h) + aoff + m * 2048 + k * 1024); } while (0)
#define PG8_LDB(dst, b, h) do { _Pragma("unroll") for (int n = 0; n < 2; ++n) _Pragma("unroll") for (int k = 0; k < 2; ++k) dst[n][k] = *(const PG8_LAS bf16x8*)(lds + PG8_SB(b, h) + boff + n * 2048 + k * 1024); } while (0)
#define PG8_MMA(ai, bj, At, Bt) do { __builtin_amdgcn_s_setprio(1); _Pragma("unroll") for (int m = 0; m < 4; ++m) _Pragma("unroll") for (int n = 0; n < 2; ++n) _Pragma("unroll") for (int k = 0; k < 2; ++k) \
        acc[ai][bj][m][n] = __builtin_amdgcn_mfma_f32_16x16x32_bf16(Bt[n][k], At[m][k], acc[ai][bj][m][n], 0, 0, 0); __builtin_amdgcn_s_setprio(0); } while (0)
#define PG8_WAIT_V(n) asm volatile("s_waitcnt vmcnt(" #n ")" ::: "memory")
#define PG8_WAIT_L(n) asm volatile("s_waitcnt lgkmcnt(" #n ")" ::: "memory")
#define PG8_BAR __builtin_amdgcn_s_barrier()
#define PG8_SCHED __builtin_amdgcn_sched_barrier(0)
    Unit cur, nxt; int ui = 0;
    if (!S.next(0, cur)) return;
    f32x4 acc[2][2][4][2];
#pragma unroll
    for (int a = 0; a < 2; ++a)
#pragma unroll
        for (int b = 0; b < 2; ++b)
#pragma unroll
            for (int m = 0; m < 4; ++m)
#pragma unroll
                for (int n = 0; n < 2; ++n) acc[a][b][m][n] = (f32x4){0.f, 0.f, 0.f, 0.f};
    bf16x8 At[4][2], B0[2][2], B1[2][2];
    const char* cA = (const char*)g.A + (size_t)cur.pm * tstep; const char* cB = (const char*)g.Bt + (size_t)cur.pn * tstep;
    S.a_ready(cur);
    if constexpr (SP2) {
        PG8_STAGE(PG8_SB(0, 0), cB, voffB); PG8_STAGE(PG8_SB(0, 1), cB + hstep, voffB); PG8_STAGE(PG8_SA(0, 0), cA, voffA); PG8_STAGE(PG8_SA(0, 1), cA + hstep, voffA);
        if (wr == 1) PG8_BAR;
        PG8_WAIT_V(2); PG8_BAR;
        PG8_STAGE(PG8_SB(1, 0), cB + kstep, voffB); PG8_STAGE(PG8_SA(1, 0), cA + kstep, voffA); PG8_STAGE(PG8_SB(1, 1), cB + hstep + kstep, voffB);
        PG8_WAIT_V(6); PG8_BAR;
    } else {
        PG8_STAGE(PG8_SB(0, 0), cB, voffB); PG8_STAGE(PG8_SA(0, 0), cA, voffA); PG8_STAGE(PG8_SB(0, 1), cB + hstep, voffB); PG8_STAGE(PG8_SA(0, 1), cA + hstep, voffA);
        if (wr == 1) PG8_BAR;
        PG8_WAIT_V(4); PG8_BAR;
        PG8_STAGE(PG8_SB(1, 0), cB + kstep, voffB); PG8_STAGE(PG8_SA(1, 0), cA + kstep, voffA); PG8_STAGE(PG8_SB(1, 1), cB + hstep + kstep, voffB);
        PG8_WAIT_V(6); PG8_BAR;
    }
    for (;;) {
        const bool has_next = S.next(ui + 1, nxt);
        const char* nA = has_next ? (const char*)g.A + (size_t)nxt.pm * tstep : cA; const char* nB = has_next ? (const char*)g.Bt + (size_t)nxt.pn * tstep : cB;
        for (int t = 0; t < nt; t += 2) {
            const bool last = (t == nt - 2);
            const char* a1 = cA + (size_t)(t + 1) * kstep;
            const char* a2 = last ? nA : cA + (size_t)(t + 2) * kstep; const char* b2 = last ? nB : cB + (size_t)(t + 2) * kstep;
            const char* a3 = a2 + kstep; const char* b3 = b2 + kstep;
            if (last && has_next) S.a_ready(nxt);
            if constexpr (SP2) {
            PG8_LDB(B0, 0, 0); PG8_LDB(B1, 0, 1); PG8_SCHED; PG8_LDA(At, 0, 0); PG8_STAGE(PG8_SA(1, 1), a1 + hstep, voffA);
            PG8_WAIT_V(8); PG8_WAIT_L(0); PG8_BAR; PG8_MMA(0, 0, At, B0); PG8_MMA(0, 1, At, B1); PG8_BAR; PG8_SCHED;
            PG8_LDA(At, 0, 1); PG8_STAGE(PG8_SB(0, 0), b2, voffB); PG8_STAGE(PG8_SB(0, 1), b2 + hstep, voffB); PG8_STAGE(PG8_SA(0, 0), a2, voffA);
            PG8_WAIT_V(8); PG8_WAIT_L(0); PG8_BAR; PG8_MMA(1, 0, At, B0); PG8_MMA(1, 1, At, B1); PG8_BAR; PG8_SCHED;
            PG8_LDB(B0, 1, 0); PG8_LDB(B1, 1, 1); PG8_SCHED; PG8_LDA(At, 1, 0); PG8_STAGE(PG8_SA(0, 1), a2 + hstep, voffA);
            PG8_WAIT_V(8); PG8_WAIT_L(0); PG8_BAR; PG8_MMA(0, 0, At, B0); PG8_MMA(0, 1, At, B1); PG8_BAR; PG8_SCHED;
            PG8_LDA(At, 1, 1); PG8_STAGE(PG8_SB(1, 0), b3, voffB); PG8_STAGE(PG8_SB(1, 1), b3 + hstep, voffB); PG8_STAGE(PG8_SA(1, 0), a3, voffA);
            PG8_WAIT_V(8); PG8_WAIT_L(0); PG8_BAR; PG8_MMA(1, 0, At, B0); PG8_MMA(1, 1, At, B1); PG8_BAR; PG8_SCHED;
            } else {
            PG8_LDB(B0, 0, 0); PG8_SCHED; PG8_LDA(At, 0, 0); PG8_STAGE(PG8_SA(1, 1), a1 + hstep, voffA);
            PG8_WAIT_L(8); PG8_BAR; PG8_WAIT_L(0); PG8_MMA(0, 0, At, B0); PG8_BAR; PG8_SCHED;
            PG8_LDB(B1, 0, 1); PG8_STAGE(PG8_SB(0, 0), b2, voffB);
            PG8_BAR; PG8_WAIT_L(0); PG8_MMA(0, 1, At, B1); PG8_BAR;
            PG8_LDA(At, 0, 1); PG8_STAGE(PG8_SA(0, 0), a2, voffA);
            PG8_BAR; PG8_WAIT_L(0); PG8_MMA(1, 0, At, B0); PG8_BAR; PG8_SCHED;
            PG8_STAGE(PG8_SB(0, 1), b2 + hstep, voffB);
            PG8_WAIT_V(6); PG8_BAR; PG8_MMA(1, 1, At, B1); PG8_BAR;
            PG8_LDB(B0, 1, 0); PG8_SCHED; PG8_LDA(At, 1, 0); PG8_STAGE(PG8_SA(0, 1), a2 + hstep, voffA);
            PG8_WAIT_L(8); PG8_BAR; PG8_WAIT_L(0); PG8_MMA(0, 0, At, B0); PG8_BAR; PG8_SCHED;
            PG8_LDB(B1, 1, 1); PG8_STAGE(PG8_SB(1, 0), b3, voffB);
            PG8_BAR; PG8_WAIT_L(0); PG8_MMA(0, 1, At, B1); PG8_BAR;
            PG8_LDA(At, 1, 1); PG8_STAGE(PG8_SA(1, 0), a3, voffA);
            PG8_BAR; PG8_WAIT_L(0); PG8_MMA(1, 0, At, B0); PG8_BAR; PG8_SCHED;
            PG8_STAGE(PG8_SB(1, 1), b3 + hstep, voffB);
            PG8_WAIT_V(6); PG8_BAR; PG8_MMA(1, 1, At, B1); PG8_BAR;
            }
        }
        if constexpr (ALIGN_EPI) { if (wr == 0) PG8_BAR; }
        if constexpr (!Epi::AFTER_DRAIN) { E(acc, cur, wr, wc, fr, fq); S.done(cur); }
        if (!has_next) break;
#pragma unroll
        for (int a = 0; a < 2; ++a)
#pragma unroll
            for (int b = 0; b < 2; ++b)
#pragma unroll
                for (int m = 0; m < 4; ++m)
#pragma unroll
                    for (int n = 0; n < 2; ++n) acc[a][b][m][n] = (f32x4){0.f, 0.f, 0.f, 0.f};
        cur = nxt; cA = nA; cB = nB; ++ui;
        if constexpr (ALIGN_EPI) { if (wr == 1) PG8_BAR; }
    }
    PG8_WAIT_V(0);
    if constexpr (!ALIGN_EPI) { if (wr == 0) PG8_BAR; }
    PG8_BAR;
    if constexpr (Epi::AFTER_DRAIN) { E.fused(acc, cur, wr, wc, fr, fq, lds, wid, lane); S.done(cur); }
#undef PG8_SA
#undef PG8_SB
#undef PG8_STAGE
#undef PG8_LDA
#undef PG8_LDB
#undef PG8_MMA
#undef PG8_WAIT_V
#undef PG8_WAIT_L
#undef PG8_BAR
#undef PG8_SCHED
}
}
constexpr int NB = 2, SEQ = 16384, CL = 256, DM = 1024, NPB = SEQ + CL  , NR = NB * NPB  , DEPTH = 4;
constexpr int NIN = 3296, NINP = 3328, DFF = 2816, NEXP = 8, DFE = 3584;
constexpr int NWAVES = 8, NTHR = 512;
constexpr float QSCALE = 0.125f * 1.4426950408889634f;
constexpr int PC_Q = 0, PC_K = 512, PC_V = 1024, PC_R = 0, PC_RK = 512, PC_RV = 1024, PC_LORA = 1536;

constexpr size_t MiB = 1u << 20;
constexpr size_t WS_CTL = 0, CTL_ZERO_BYTES = 1 * MiB;
constexpr size_t WS_MOD = 1 * MiB;
constexpr size_t WS_ROPE = 2 * MiB;
constexpr size_t WS_LAM = 2 * MiB + 65536;
constexpr size_t WS_XC = 3 * MiB;
constexpr size_t WS_ROUTE = 5 * MiB;
constexpr size_t WS_WINT = 8 * MiB;
constexpr size_t WS_WOUTT = 34 * MiB;
constexpr size_t WS_W13T = 42 * MiB;
constexpr size_t WS_W2T = 64 * MiB;
constexpr size_t WS_VFIRST = 76 * MiB;
constexpr size_t WS_HN = 110 * MiB;
constexpr size_t WS_PA = 175 * MiB;
constexpr size_t WS_G = 273 * MiB;
constexpr size_t WS_BONUS = 306 * MiB;
constexpr size_t WS_OPS = 308 * MiB;
constexpr size_t WS_PR = 308 * MiB;
constexpr size_t WS_SPK = 715 * MiB;
constexpr size_t WS_DPK = 813 * MiB;
constexpr size_t WS_Y = 813 * MiB;
constexpr size_t WS_LORA = 1008 * MiB;
constexpr size_t WS_END = 1010 * MiB;
constexpr int LO_W2 = 0, LO_A2 = 131072, LO_V2 = 262144, LO_G2 = 262144 + 49152, LO_TOTAL = 262144 + 49152 + 196608;
constexpr int LDPA = 1536, LDPR = 1792;
constexpr int OPS_REC = 12288, NCHUNK = NPB / 16;
constexpr int OR_QT = 9216, OR_VT = 9728, OR_WC = 11776;
constexpr size_t WS_HF = 175 * MiB;
constexpr size_t WS_W13E = 175 * MiB;
constexpr size_t WS_W2E = 287 * MiB;
constexpr size_t WS_AG = 343 * MiB;
constexpr size_t WS_HMOE = 412 * MiB;
constexpr size_t WS_YEXP = 654 * MiB;
static_assert(WS_WINT + (size_t)4 * NINP * DM * 2 <= WS_WOUTT && WS_WOUTT + (size_t)4 * DM * DM * 2 <= WS_W13T && WS_W13T + (size_t)2 * 2 * DFF * DM * 2 <= WS_W2T && WS_W2T + (size_t)2 * DM * DFF * 2 <= WS_VFIRST, "ws map 1");
static_assert(WS_VFIRST + (size_t)NR * 512 * 2 <= WS_HN && WS_HN + (size_t)NR * DM * 2 <= WS_PA && WS_PA + (size_t)NR * LDPA * 2 <= WS_G && WS_G + (size_t)NR * 512 * 2 <= WS_BONUS && WS_BONUS + (size_t)NR * 8 * 4 <= WS_OPS, "ws map 2");
static_assert(WS_OPS + (size_t)32 * NCHUNK * OPS_REC <= WS_SPK && WS_PR + (size_t)NR * LDPR * 2 <= WS_SPK && WS_SPK + (size_t)NB * 8 * NPB * 192 * 2 <= WS_DPK && WS_DPK + (size_t)2 * NB * 8 * NPB * 192 * 2 <= WS_LORA && WS_Y + (size_t)2 * NR * 512 * 4 <= WS_LORA && WS_LORA + (size_t)LO_TOTAL * 4 <= WS_END, "ws map 3");
static_assert(WS_HF + (size_t)NR * DFF * 2 <= WS_LORA && WS_W13E + (size_t)8 * 2 * DFE * DM * 2 <= WS_W2E && WS_W2E + (size_t)8 * DM * DFE * 2 <= WS_AG && WS_AG + (size_t)35328 * DM * 2 <= WS_HMOE && WS_HMOE + (size_t)35328 * DFE * 2 <= WS_YEXP && WS_YEXP + (size_t)35328 * DM * 2 <= WS_LORA, "ws map 4");
constexpr int CW_TMO = 0;
constexpr int CW_BAR = 4096;
constexpr int CW_QS = 16384;
constexpr int CW_QA = 20480;
constexpr int CW_CNT = 24576;

constexpr int RING_BYTES = 131072;
constexpr int LDSCTL_OFF = RING_BYTES, MISC_OFF = LDSCTL_OFF + 320;
constexpr int LDS_BYTES = 147456;

#define GAS __attribute__((address_space(1)))
#define LAS __attribute__((address_space(3)))
typedef unsigned short bf16;
typedef unsigned v4u __attribute__((ext_vector_type(4)));
typedef unsigned v2u __attribute__((ext_vector_type(2)));
typedef float f32x4 __attribute__((ext_vector_type(4)));
typedef _Float16 h4 __attribute__((ext_vector_type(4)));
#define LDS_WAIT() asm volatile("s_waitcnt lgkmcnt(0)" ::: "memory")
__device__ __forceinline__ unsigned f2bf(float f) { unsigned u = __builtin_bit_cast(unsigned, f); return (u + 0x7fffu + ((u >> 16) & 1u)) >> 16; }
__device__ __forceinline__ unsigned pk2(float lo, float hi) { return f2bf(lo) | (f2bf(hi) << 16); }
__device__ __forceinline__ float bf2f(bf16 h) { return __builtin_bit_cast(float, (unsigned)h << 16); }
__device__ __forceinline__ float bflo(unsigned w) { return __builtin_bit_cast(float, w << 16); }
__device__ __forceinline__ float bfhi(unsigned w) { return __builtin_bit_cast(float, w & 0xffff0000u); }
__device__ __forceinline__ float sigmoid_f(float x) { return 1.0f / (1.0f + __expf(-x)); }
__device__ __forceinline__ float tanh_f(float x) { return 1.0f - 2.0f / (__expf(2.0f * x) + 1.0f); }
__device__ __forceinline__ float wave_sum(float v) {
#pragma unroll
    for (int o = 1; o < 64; o <<= 1) v += __shfl_xor(v, o);
    return v;
}
#define XB_TMO      128
#define XB_XCNT(j)  (256  + 64 * (j))
#define XB_XSUB(j)  (1280 + 64 * (j))
#define XB_XGEN(j)  (2304 + 64 * (j))
#define XB_TOP      3328
#define XB_TOPGEN   3392
#define XCD_BAR_WORDS 3456
#define XB_SPIN_CAP (1u << 18)

__device__ __forceinline__ unsigned xb_ld(unsigned* p)              { return __hip_atomic_load(p, __ATOMIC_RELAXED, __HIP_MEMORY_SCOPE_AGENT); }
__device__ __forceinline__ unsigned xb_add(unsigned* p, unsigned v) { return __hip_atomic_fetch_add(p, v, __ATOMIC_RELAXED, __HIP_MEMORY_SCOPE_AGENT); }
__device__ __forceinline__ unsigned xb_xcc_id() { return (unsigned)__builtin_amdgcn_s_getreg((3 << 11) | 20) & 0xFu; }
#define XB_SPIN(cond, bar) do { unsigned _sp = 0; while (cond) { __builtin_amdgcn_s_sleep(1); \
    if ((++_sp & 255u) == 0u) { if (xb_ld(&(bar)[XB_TMO])) break; if (_sp > XB_SPIN_CAP) { atomicAdd(&(bar)[XB_TMO], 1u); break; } } } } while (0)

struct XcdBarrier {
    unsigned* bar; unsigned x;
    volatile LAS unsigned* st;
};

__device__ __forceinline__ XcdBarrier xcd_barrier_post(unsigned* bar, volatile LAS unsigned* st) {
    XcdBarrier b; b.bar = bar; b.x = xb_xcc_id(); b.st = st;
    if (threadIdx.x == 0) (void)xb_add(&bar[XB_XCNT(b.x)], 1u);
    return b;
}
__device__ __forceinline__ void xcd_barrier_complete(unsigned* bar, unsigned x, unsigned& nloc, unsigned& nx) {
    const unsigned G = gridDim.x * gridDim.y * gridDim.z;
    unsigned sum, cnt, mine, sp = 0u;
    for (;;) {
        sum = 0u; cnt = 0u; mine = 0u;
#pragma unroll
        for (unsigned j = 0; j < 16; ++j) { const unsigned c = xb_ld(&bar[XB_XCNT(j)]); sum += c; cnt += (c > 0u) ? 1u : 0u; mine = (j == x) ? c : mine; }
        if (sum == G) break;
        __builtin_amdgcn_s_sleep(1);
        if ((++sp & 255u) == 0u) { if (xb_ld(&bar[XB_TMO])) break; if (sp > XB_SPIN_CAP) { atomicAdd(&bar[XB_TMO], 1u); break; } }
    }
    nloc = mine > 0u ? mine : 1u; nx = cnt > 0u ? cnt : 1u;
}

__device__ __forceinline__ void xcd_barrier(const XcdBarrier& b) {
    asm volatile("s_waitcnt vmcnt(0)" ::: "memory");
    __syncthreads();
    if (threadIdx.x == 0) {
        unsigned* bar = b.bar;
        __builtin_amdgcn_s_waitcnt(0);
        unsigned nloc = b.st[0], nx = b.st[1];
        if (nloc == 0u) { xcd_barrier_complete(bar, b.x, nloc, nx); b.st[0] = nloc; b.st[1] = nx; }
        const unsigned old = xb_add(&bar[XB_XSUB(b.x)], 1u);
        const unsigned gen = old / nloc;
        if (old + 1u == (gen + 1u) * nloc) {
            __builtin_amdgcn_fence(__ATOMIC_RELEASE, "agent");
            asm volatile("s_waitcnt vmcnt(0)" ::: "memory");
            const unsigned og = xb_add(&bar[XB_TOP], 1u);
            const unsigned tg = og / nx;
            if (og + 1u == (tg + 1u) * nx) xb_add(&bar[XB_TOPGEN], 1u);
            else XB_SPIN(xb_ld(&bar[XB_TOPGEN]) == tg, bar);
            __builtin_amdgcn_fence(__ATOMIC_ACQUIRE, "agent");
            xb_add(&bar[XB_XGEN(b.x)], 1u);
            asm volatile("s_waitcnt vmcnt(0)" ::: "memory");
        } else {
            XB_SPIN(xb_ld(&bar[XB_XGEN(b.x)]) == gen, bar);
            __builtin_amdgcn_fence(__ATOMIC_ACQUIRE, "agent");
            asm volatile("s_waitcnt vmcnt(0)" ::: "memory");
        }
    }
    __syncthreads();
}
struct Args { const float* in[34]; float* out; unsigned char* ws; int ph_lo, ph_hi; };
namespace att {
using bf16x8 = __attribute__((ext_vector_type(8))) short;
using s16x4  = __attribute__((ext_vector_type(4))) short;
using f32x16 = __attribute__((ext_vector_type(16))) float;
using u32x4  = __attribute__((ext_vector_type(4))) unsigned;
constexpr int KVBLK = 64;
constexpr size_t SHM_V = KVBLK * 128 * 2, SHM_K = KVBLK * 128 * 2;
constexpr float THR2 = 11.5f;
#define KSWZ(row, colB) ((row) * 256 + ((colB) ^ (((row) & 7) << 4)))
#define SBAR() __builtin_amdgcn_sched_barrier(0)
__device__ __forceinline__ int crow(int r, int hi) { return (r & 3) + 8 * (r >> 2) + 4 * hi; }
__device__ __forceinline__ unsigned cvtpk(float lo, float hi) { unsigned r; asm volatile("v_cvt_pk_bf16_f32 %0, %1, %2" : "=v"(r) : "v"(lo), "v"(hi)); return r; }
__device__ __forceinline__ bf16x8 ld8(const bf16* p) { return *reinterpret_cast<const bf16x8*>(p); }

__device__ __forceinline__ void partialSM(f32x16& p0, f32x16& p1, float& m_reg, float& mn, float& alpha) {
  float pmax = p0[0];
#pragma unroll
  for (int r = 1; r < 16; ++r) pmax = fmaxf(pmax, p0[r]);
#pragma unroll
  for (int r = 0; r < 16; ++r) pmax = fmaxf(pmax, p1[r]);
  { auto rr = __builtin_amdgcn_permlane32_swap(__float_as_uint(pmax), __float_as_uint(pmax), false, false);
    pmax = fmaxf(__uint_as_float(rr[0]), __uint_as_float(rr[1])); }
  if (__builtin_expect(__all(pmax - m_reg <= THR2), 1)) { mn = m_reg; alpha = 1.f; }
  else { mn = fmaxf(m_reg, pmax); alpha = __builtin_amdgcn_exp2f(m_reg - mn); m_reg = mn; }
#pragma unroll
  for (int r = 0; r < 16; ++r) p0[r] = p0[r] - mn;
#pragma unroll
  for (int r = 0; r < 16; ++r) p1[r] = p1[r] - mn;
#pragma unroll
  for (int r = 0; r < 16; ++r) p0[r] = __builtin_amdgcn_exp2f(p0[r]);
}
__device__ __forceinline__ void finishSM(f32x16& p0, f32x16& p1, float alpha, float& l_reg, bf16x8& pa0, bf16x8& pa1, bf16x8& pa2, bf16x8& pa3) {
#pragma unroll
  for (int r = 0; r < 16; ++r) p1[r] = __builtin_amdgcn_exp2f(p1[r]);
  float ps = 0;
#pragma unroll
  for (int r = 0; r < 16; ++r) ps += p0[r];
#pragma unroll
  for (int r = 0; r < 16; ++r) ps += p1[r];
  { auto rr = __builtin_amdgcn_permlane32_swap(__float_as_uint(ps), __float_as_uint(ps), false, false);
    ps = __uint_as_float(rr[0]) + __uint_as_float(rr[1]); }
  l_reg = l_reg * alpha + ps;
#define PK4(P, BASE, OUT) do { unsigned a0 = cvtpk(P[BASE + 0], P[BASE + 1]), a1 = cvtpk(P[BASE + 2], P[BASE + 3]);   \
    unsigned b0 = cvtpk(P[BASE + 4], P[BASE + 5]), b1 = cvtpk(P[BASE + 6], P[BASE + 7]);                              \
    auto r0 = __builtin_amdgcn_permlane32_swap(a0, b0, false, false); auto r1 = __builtin_amdgcn_permlane32_swap(a1, b1, false, false); \
    u32x4 w = {r0[0], r1[0], r0[1], r1[1]}; OUT = *reinterpret_cast<bf16x8*>(&w); } while (0)
  PK4(p0, 0, pa0); PK4(p0, 8, pa1); PK4(p1, 0, pa2); PK4(p1, 8, pa3);
#undef PK4
}
__device__ __forceinline__ void qkt(f32x16& p0, f32x16& p1, const bf16* Ks, const bf16x8* qr, int r32, int hi, int cbase) {
  p0 = f32x16{}; p1 = f32x16{};
#pragma unroll
  for (int d0 = 0; d0 < 4; ++d0) { int cb = (cbase + d0 * 16 + hi * 8) * 2;
    bf16x8 b0 = *reinterpret_cast<const bf16x8*>((const char*)Ks + KSWZ(r32, cb));
    bf16x8 b1 = *reinterpret_cast<const bf16x8*>((const char*)Ks + KSWZ(32 + r32, cb));
    p0 = __builtin_amdgcn_mfma_f32_32x32x16_bf16(b0, qr[d0], p0, 0, 0, 0);
    p1 = __builtin_amdgcn_mfma_f32_32x32x16_bf16(b1, qr[d0], p1, 0, 0, 0); }
}
__device__ __forceinline__ int v_st(int k, int c) { const int kk = (k & ~0xC) | ((k & 4) << 1) | ((k & 8) >> 1); return ((kk >> 3) * 4 + (c >> 5)) * 512 + ((kk & 7) * 32 + (c & 31)) * 2; }
__device__ __forceinline__ int v_rd_base(int lane) { return ((lane & 3) << 3) | (((lane >> 2) & 3) << 6) | (((lane >> 4) & 1) << 5) | (((lane >> 5) & 1) << 8); }
constexpr int v_rd_off(int d0, int ks, int half) { return d0 * 512 + ks * 4096 + half * 2048; }
template <int OFF> __device__ __forceinline__ s16x4 tr_read(int vb) {
  s16x4 r; asm volatile("ds_read_b64_tr_b16 %0, %1 offset:%2" : "=&v"(r) : "v"(vb), "i"(OFF) : "memory"); return r;
}
template <int D0> __device__ __forceinline__ void pv_one(f32x16& od, int vb, bf16x8 pa0, bf16x8 pa1, bf16x8 pa2, bf16x8 pa3) {
  const s16x4 l0 = tr_read<v_rd_off(D0, 0, 0)>(vb), h0 = tr_read<v_rd_off(D0, 0, 1)>(vb), l1 = tr_read<v_rd_off(D0, 1, 0)>(vb), h1 = tr_read<v_rd_off(D0, 1, 1)>(vb);
  const s16x4 l2 = tr_read<v_rd_off(D0, 2, 0)>(vb), h2 = tr_read<v_rd_off(D0, 2, 1)>(vb), l3 = tr_read<v_rd_off(D0, 3, 0)>(vb), h3 = tr_read<v_rd_off(D0, 3, 1)>(vb);
  asm volatile("s_waitcnt lgkmcnt(0)" ::: "memory"); SBAR();
#define PK(L, H) (bf16x8){L[0], L[1], L[2], L[3], H[0], H[1], H[2], H[3]}
  od = __builtin_amdgcn_mfma_f32_32x32x16_bf16(pa0, PK(l0, h0), od, 0, 0, 0);
  od = __builtin_amdgcn_mfma_f32_32x32x16_bf16(pa1, PK(l1, h1), od, 0, 0, 0);
  od = __builtin_amdgcn_mfma_f32_32x32x16_bf16(pa2, PK(l2, h2), od, 0, 0, 0);
  od = __builtin_amdgcn_mfma_f32_32x32x16_bf16(pa3, PK(l3, h3), od, 0, 0, 0);
#undef PK
}
__device__ __forceinline__ void pv_d0(f32x16* o, int vb, bf16x8 pa0, bf16x8 pa1, bf16x8 pa2, bf16x8 pa3) {
  pv_one<0>(o[0], vb, pa0, pa1, pa2, pa3); pv_one<1>(o[1], vb, pa0, pa1, pa2, pa3); pv_one<2>(o[2], vb, pa0, pa1, pa2, pa3); pv_one<3>(o[3], vb, pa0, pa1, pa2, pa3);
}

__device__ __forceinline__ void attn_unit(const bf16* __restrict__ P, int qrow0, int krow0, int NT, int h, float lam, float oml, const float* __restrict__ subg, bf16* __restrict__ AO, char* lds) {
  constexpr int LDK = LDPA;
  const int tid = opaque_tid(), wid = __builtin_amdgcn_readfirstlane(tid >> 6), lane = tid & 63, r32 = lane & 31, hi = lane >> 5;
  const int mp = wid >> 2, wq = wid & 3;
  bf16* V_lds = (bf16*)lds; bf16* K_lds = (bf16*)(lds + 2 * SHM_V);
  float* ws = (float*)(lds + 2 * SHM_V + 2 * SHM_K) + wid * 64; float* li_l = ws; float* al_l = ws + 32;
  float m_reg = -1e30f, l_reg = 0; f32x16 o[4] = {}; bf16x8 qr[4];
  const bf16* Qw = P + (size_t)(qrow0 + wq * 32 + r32) * LDK + PC_Q + h * 128 + mp * 64 + hi * 8;
#pragma unroll
  for (int d0 = 0; d0 < 4; ++d0) qr[d0] = ld8(Qw + d0 * 16);
  const bf16* Kh = P + (size_t)krow0 * LDK + PC_K + h * 128; const bf16* Vh = P + (size_t)krow0 * LDK + PC_V + h * 128;
  const int cbase = mp * 64;
  const int sr = tid >> 4, sc = (tid & 15) * 8, vst0 = v_st(sr, sc), vst1 = v_st(32 + sr, sc);
  const int vb0 = (int)(uintptr_t)V_lds + v_rd_base(lane);
  struct { bf16x8 vs0, vs1, ks0, ks1; } sr_[2];
#define SLOAD(i, k0) do { sr_[i].vs0 = ld8(&Vh[(size_t)((k0) + sr) * LDK + sc]); sr_[i].vs1 = ld8(&Vh[(size_t)((k0) + 32 + sr) * LDK + sc]); \
    sr_[i].ks0 = ld8(&Kh[(size_t)((k0) + sr) * LDK + sc]); sr_[i].ks1 = ld8(&Kh[(size_t)((k0) + 32 + sr) * LDK + sc]); } while (0)
#define SWRITE(b, i) do { *(bf16x8*)((char*)V_lds + (b) * SHM_V + vst0) = sr_[i].vs0;          \
    *(bf16x8*)((char*)V_lds + (b) * SHM_V + vst1) = sr_[i].vs1; int kc = sc * 2;               \
    *(bf16x8*)((char*)K_lds + (b) * SHM_K + KSWZ(sr, kc)) = sr_[i].ks0;                       \
    *(bf16x8*)((char*)K_lds + (b) * SHM_K + KSWZ(32 + sr, kc)) = sr_[i].ks1; } while (0)
#define SWAIT() asm volatile("s_waitcnt vmcnt(4)" ::: "memory")
#define RESC(a) do { if (__any((a) < 1.f)) { if (hi == 0) al_l[r32] = (a); asm volatile("s_waitcnt lgkmcnt(0)" ::: "memory"); \
    _Pragma("unroll") for (int d = 0; d < 4; ++d) _Pragma("unroll") for (int r = 0; r < 16; ++r) o[d][r] *= al_l[crow(r, hi)]; } } while (0)
  f32x16 pA0, pA1, pB0, pB1; float mnA, mnB, alA, alB; bf16x8 pa0, pa1, pa2, pa3;
  constexpr int SE = 0, SO = 1;
  SLOAD(SE, 0); asm volatile("s_waitcnt vmcnt(0)" ::: "memory"); SWRITE(0, SE); __syncthreads();
  qkt(pA0, pA1, K_lds, qr, r32, hi, cbase); partialSM(pA0, pA1, m_reg, mnA, alA);
  SLOAD(SO, KVBLK); if (2 < NT) SLOAD(SE, 2 * KVBLK);
  SWAIT(); SWRITE(1, SO); __syncthreads();
  for (int j = 1; j + 1 < NT; j += 2) {
    SBAR(); qkt(pB0, pB1, (bf16*)((char*)K_lds + SHM_K), qr, r32, hi, cbase);
    finishSM(pA0, pA1, alA, l_reg, pa0, pa1, pa2, pa3); SBAR();
    SLOAD(SO, (j + 2) * KVBLK); SBAR();
    pv_d0(o, vb0, pa0, pa1, pa2, pa3); partialSM(pB0, pB1, m_reg, mnB, alB);
    __syncthreads(); SWAIT(); SWRITE(0, SE);
    RESC(alB); __syncthreads();
    SBAR(); qkt(pA0, pA1, K_lds, qr, r32, hi, cbase);
    finishSM(pB0, pB1, alB, l_reg, pa0, pa1, pa2, pa3); SBAR();
    if (j + 3 < NT) SLOAD(SE, (j + 3) * KVBLK); SBAR();
    pv_d0(o, vb0 + (int)SHM_V, pa0, pa1, pa2, pa3); partialSM(pA0, pA1, m_reg, mnA, alA);
    __syncthreads(); SWAIT(); SWRITE(1, SO);
    RESC(alA); __syncthreads();
  }
  SBAR(); qkt(pB0, pB1, (bf16*)((char*)K_lds + SHM_K), qr, r32, hi, cbase);
  finishSM(pA0, pA1, alA, l_reg, pa0, pa1, pa2, pa3); SBAR();
  pv_d0(o, vb0, pa0, pa1, pa2, pa3); partialSM(pB0, pB1, m_reg, mnB, alB);
  __syncthreads(); RESC(alB);
  finishSM(pB0, pB1, alB, l_reg, pa0, pa1, pa2, pa3); SBAR();
  pv_d0(o, vb0 + (int)SHM_V, pa0, pa1, pa2, pa3);
  if (hi == 0) li_l[r32] = l_reg; asm volatile("s_waitcnt lgkmcnt(0)" ::: "memory");
  float rli[16];
#pragma unroll
  for (int r = 0; r < 16; ++r) rli[r] = __builtin_amdgcn_rcpf(li_l[crow(r, hi)]);
  __syncthreads();
  { float* OB = (float*)lds + mp * (128 * 128) + (wq * 32) * 128;
#pragma unroll
    for (int r = 0; r < 16; ++r) { const int orow = crow(r, hi);
#pragma unroll
      for (int d0 = 0; d0 < 4; ++d0) OB[orow * 128 + d0 * 32 + r32] = o[d0][r] * rli[r]; } }
  __syncthreads();
  { const int row = tid >> 2, qd = tid & 3;
    const f32x4* A4 = (const f32x4*)((const float*)lds + row * 128 + qd * 32); const f32x4* B4 = A4 + (128 * 128) / 4;
    f32x4 dv[8]; float ss = 0.f;
#pragma unroll
    for (int j = 0; j < 8; ++j) { dv[j] = A4[j] - lam * B4[j]; ss += (dv[j][0] * dv[j][0] + dv[j][1] * dv[j][1]) + (dv[j][2] * dv[j][2] + dv[j][3] * dv[j][3]); }
    ss += __shfl_xor(ss, 1); ss += __shfl_xor(ss, 2);
    const float rstd = __builtin_amdgcn_rsqf(ss * (1.0f / 128.0f) + 1e-5f) ;
    const f32x4* g4 = (const f32x4*)(subg + qd * 32);
    bf16* op = AO + (size_t)(qrow0 + row) * DM + h * 128 + qd * 32;
#pragma unroll
    for (int j = 0; j < 4; ++j) { const f32x4 g0 = g4[2 * j], g1 = g4[2 * j + 1]; const f32x4 a = dv[2 * j] * rstd, b = dv[2 * j + 1] * rstd;
      u32x4 w; w.x = cvtpk(a[0] * g0[0] * oml, a[1] * g0[1] * oml); w.y = cvtpk(a[2] * g0[2] * oml, a[3] * g0[3] * oml);
      w.z = cvtpk(b[0] * g1[0] * oml, b[1] * g1[1] * oml); w.w = cvtpk(b[2] * g1[2] * oml, b[3] * g1[3] * oml);
      *(u32x4*)(op + j * 8) = w; } }
  __syncthreads();
#undef SLOAD
#undef SWRITE
#undef SWAIT
#undef RESC
}
#undef SBAR
}
__device__ __forceinline__ int scan_pos(int n, int d) { return d == 0 ? n : (n < CL ? (CL - 1) - n : (NPB + CL - 1) - n); }
typedef short sbf16x8 __attribute__((ext_vector_type(8)));
typedef float f32x2_t __attribute__((ext_vector_type(2))); typedef __bf16 bf16x2_t __attribute__((ext_vector_type(2)));
__device__ __forceinline__ unsigned cvtpk_bf(float lo, float hi) { f32x2_t v = {lo, hi}; bf16x2_t b = __builtin_convertvector(v, bf16x2_t); return __builtin_bit_cast(unsigned, b); }
__device__ __forceinline__ void scan_chain(int chain, const unsigned char* __restrict__ OPS, float* __restrict__ Y, LAS unsigned char* lds) {
    const int tid = opaque_tid(), wid = __builtin_amdgcn_readfirstlane(tid >> 6), lane = tid & 63, v15 = lane & 15, q = lane >> 4;
    const int d = chain >> 4, b = (chain >> 3) & 1, h = chain & 7;
    const unsigned char* rec = OPS + (size_t)chain * NCHUNK * OPS_REC;
    v4u g0, g1;
#define SCL_LOAD(c) do { const v4u* r_ = (const v4u*)(rec + (size_t)(c) * OPS_REC); g0 = r_[tid]; if (tid < 256) g1 = r_[512 + tid]; } while (0)
#define SCL_WRITE(buf) do { LAS v4u* o_ = (LAS v4u*)(lds + (buf) * OPS_REC); o_[tid] = g0; if (tid < 256) o_[512 + tid] = g1; } while (0)
    f32x4 S[4];
#pragma unroll
    for (int rt = 0; rt < 4; ++rt) S[rt] = (f32x4){0.f, 0.f, 0.f, 0.f};
    float* yo = Y + ((size_t)d * NR + (size_t)b * NPB) * 512 + h * 64 + wid * 16 + v15;
    SCL_LOAD(0); SCL_WRITE(0); __syncthreads();
    for (int c = 0; c < NCHUNK; ++c) {
        const int buf = c & 1;
        if (c + 1 < NCHUNK) SCL_LOAD(c + 1);
        if (wid < 4) {
            const LAS unsigned char* rb = lds + buf * OPS_REC;
            const LAS sbf16x8* T8 = (const LAS sbf16x8*)rb + lane;
            const sbf16x8 XT0 = T8[0], XT1 = T8[64], RT0 = T8[128], RT1 = T8[192], MT = T8[256], BK0 = T8[320], BK1 = T8[384], BK2 = T8[448], BK3 = T8[512];
            const v2u qt = *(const LAS v2u*)(rb + OR_QT + lane * 8);
            const v2u vq = *(const LAS v2u*)(rb + OR_VT + ((wid * 16 + v15) * 16 + 4 * q) * 2);
            const LAS f32x4* W4 = (const LAS f32x4*)(rb + OR_WC) + q;
            const f32x4 wc0 = W4[0], wc1 = W4[4], wc2 = W4[8], wc3 = W4[12];
            v4u t;
            t[0] = cvtpk_bf(S[0][0], S[0][1]); t[1] = cvtpk_bf(S[0][2], S[0][3]); t[2] = cvtpk_bf(S[1][0], S[1][1]); t[3] = cvtpk_bf(S[1][2], S[1][3]);
            const sbf16x8 bs0 = __builtin_bit_cast(sbf16x8, t);
            t[0] = cvtpk_bf(S[2][0], S[2][1]); t[1] = cvtpk_bf(S[2][2], S[2][3]); t[2] = cvtpk_bf(S[3][0], S[3][1]); t[3] = cvtpk_bf(S[3][2], S[3][3]);
            const sbf16x8 bs1 = __builtin_bit_cast(sbf16x8, t);
            t[0] = vq[0]; t[1] = vq[1]; t[2] = 0u; t[3] = 0u; const sbf16x8 vz = __builtin_bit_cast(sbf16x8, t);
            t[0] = qt[0]; t[1] = qt[1]; t[2] = 0u; t[3] = 0u; const sbf16x8 qz = __builtin_bit_cast(sbf16x8, t);
            f32x4 D = (f32x4){0.f, 0.f, 0.f, 0.f};
            D = __builtin_amdgcn_mfma_f32_16x16x32_bf16(XT0, bs0, D, 0, 0, 0);
            D = __builtin_amdgcn_mfma_f32_16x16x32_bf16(XT1, bs1, D, 0, 0, 0);
            D = __builtin_amdgcn_mfma_f32_16x16x32_bf16(qz, vz, D, 0, 0, 0);
            f32x4 Yv = (f32x4){0.f, 0.f, 0.f, 0.f};
            Yv = __builtin_amdgcn_mfma_f32_16x16x32_bf16(RT0, bs0, Yv, 0, 0, 0);
            Yv = __builtin_amdgcn_mfma_f32_16x16x32_bf16(RT1, bs1, Yv, 0, 0, 0);
            t[0] = cvtpk_bf(D[0], D[1]); t[1] = cvtpk_bf(D[2], D[3]); t[2] = vq[0]; t[3] = vq[1]; const sbf16x8 dv = __builtin_bit_cast(sbf16x8, t);
            Yv = __builtin_amdgcn_mfma_f32_16x16x32_bf16(MT, dv, Yv, 0, 0, 0);
            S[0] = __builtin_amdgcn_mfma_f32_16x16x32_bf16(BK0, dv, S[0] * wc0, 0, 0, 0);
            S[1] = __builtin_amdgcn_mfma_f32_16x16x32_bf16(BK1, dv, S[1] * wc1, 0, 0, 0);
            S[2] = __builtin_amdgcn_mfma_f32_16x16x32_bf16(BK2, dv, S[2] * wc2, 0, 0, 0);
            S[3] = __builtin_amdgcn_mfma_f32_16x16x32_bf16(BK3, dv, S[3] * wc3, 0, 0, 0);
#pragma unroll
            for (int i = 0; i < 4; ++i) yo[(size_t)scan_pos(c * 16 + 4 * q + i, d) * 512] = Yv[i];
        }
        if (c + 1 < NCHUNK) SCL_WRITE(buf ^ 1);
        __syncthreads();
    }
#undef SCL_LOAD
#undef SCL_WRITE
}

__device__ __forceinline__ void transpose_item(const float* __restrict__ W, int K, int N, bf16* __restrict__ WT, int out_row0, int k0, int n0, LAS float* scr, int lane) {
#pragma unroll 8
    for (int i = 0; i < 32; ++i) { const int kk = 2 * i + (lane >> 5); scr[kk * 33 + (lane & 31)] = W[(size_t)(k0 + kk) * N + n0 + (lane & 31)]; }
    LDS_WAIT(); asm volatile("" ::: "memory");
    const int c = lane & 7;
#pragma unroll
    for (int j = 0; j < 4; ++j) { const int n = (lane >> 3) + 8 * j; const LAS float* s = scr + (8 * c) * 33 + n;
        v4u o; o.x = pk2(s[0 * 33], s[1 * 33]); o.y = pk2(s[2 * 33], s[3 * 33]); o.z = pk2(s[4 * 33], s[5 * 33]); o.w = pk2(s[6 * 33], s[7 * 33]);
        *(v4u*)(WT + (size_t)(out_row0 + n) * K + k0 + 8 * c) = o; }
    LDS_WAIT(); asm volatile("" ::: "memory");
}
__device__ __forceinline__ void transpose_matrix_item(const float* W, int K, int N, bf16* WT, int item, int il_half  , LAS float* scr, int lane) {
    const int nblk = N / 32, kb = item / nblk, nb = item - kb * nblk, n0 = 32 * nb;
    const int orow = (il_half < 0) ? n0 : ((n0 >> 7) * 256 + il_half * 128 + (n0 & 127));
    transpose_item(W, K, N, WT, orow, 64 * kb, n0, scr, lane);
}

struct Ptrs {
    const float* in[34]; float* out; unsigned char* ws;
};
#define IN_X 0
#define IN_C 1
#define IN_CTX 2
#define IN_CCTX 3
#define IN_ADAW 4
#define IN_ADAB 5
#define IN_N1G 6
#define IN_N2G 7
#define IN_WIN 8
#define IN_WOUT 9
#define IN_DLAM 10
#define IN_SUBG 11
#define IN_MU 12
#define IN_W0 13
#define IN_W2 14
#define IN_A0 15
#define IN_A2 16
#define IN_V0 17
#define IN_V1 18
#define IN_V2 19
#define IN_G2 20
#define IN_KK 21
#define IN_KA 22
#define IN_RK 23
#define IN_LNW 24
#define IN_LNB 25
#define IN_FW1 26
#define IN_FW3 27
#define IN_FW2 28
#define IN_ROUTER 29
#define IN_EW1 30
#define IN_EW3 31
#define IN_EW2 32
#define IN_FINALG 33

__device__ __forceinline__ void phase_prologue(const Args& a, LAS unsigned char* lds, int vcu, int G) {
    const int tid = opaque_tid(), lane = tid & 63, wave = __builtin_amdgcn_readfirstlane(tid >> 6);
    unsigned char* ws = opaque_ptr(a.ws);
    LAS float* scr = (LAS float*)(lds + wave * 8704);
    LAS float* sl = (LAS float*)(lds + 73728);
    for (int i = tid; i < 3072; i += NTHR) { const float v = (i < 2048) ? a.in[IN_C][i] : a.in[IN_CCTX][i - 2048]; sl[i] = v * sigmoid_f(v); }
    __syncthreads();
    const int gw = vcu * NWAVES + wave, NGW = G * NWAVES;
    constexpr int T_MOD = 4 * 96;
    constexpr int I_WIN = 16 * (NIN / 32), I_WOUT = 16 * 32, I_F13 = 16 * (DFF / 32), I_F2 = (DFF / 64) * 32;
    constexpr int T_WIN = 4 * I_WIN, T_WOUT = 4 * I_WOUT, T_F1 = 2 * I_F13, T_F3 = 2 * I_F13, T_F2 = 2 * I_F2;
    constexpr int T_PAD = 4 * 32, T_ROPE = 64, T_LAM = 4;
    constexpr int NT = T_MOD + T_WIN + T_WOUT + T_F1 + T_F3 + T_F2 + T_PAD + T_ROPE + T_LAM;
    float* MOD = (float*)(ws + WS_MOD);
    for (int it = gw; it < NT; it += NGW) {
        int r = it;
        if (r < T_MOD) {
            const int l = r / 96, jg = r - l * 96; const float* aw = a.in[IN_ADAW] + (size_t)l * 1024 * 6144 + jg * 64 + lane;
            float a0 = 0.f, a1 = 0.f, a2 = 0.f;
#pragma unroll 8
            for (int i = 0; i < 1024; ++i) { const float w = aw[(size_t)i * 6144]; a0 += sl[i] * w; a1 += sl[1024 + i] * w; a2 += sl[2048 + i] * w; }
            const float bb = a.in[IN_ADAB][l * 6144 + jg * 64 + lane];
            MOD[(l * 3 + 0) * 6144 + jg * 64 + lane] = a0 + bb; MOD[(l * 3 + 1) * 6144 + jg * 64 + lane] = a1 + bb; MOD[(l * 3 + 2) * 6144 + jg * 64 + lane] = a2 + bb;
            continue; }
        r -= T_MOD;
        if (r < T_WIN) { const int l = r / I_WIN; transpose_matrix_item(a.in[IN_WIN] + (size_t)l * DM * NIN, DM, NIN, (bf16*)(ws + WS_WINT) + (size_t)l * NINP * DM, r - l * I_WIN, -1, scr, lane); continue; }
        r -= T_WIN;
        if (r < T_WOUT) { const int l = r / I_WOUT; transpose_matrix_item(a.in[IN_WOUT] + (size_t)l * DM * DM, DM, DM, (bf16*)(ws + WS_WOUTT) + (size_t)l * DM * DM, r - l * I_WOUT, -1, scr, lane); continue; }
        r -= T_WOUT;
        if (r < T_F1) { const int l = r / I_F13; transpose_matrix_item(a.in[IN_FW1] + (size_t)l * DM * DFF, DM, DFF, (bf16*)(ws + WS_W13T) + (size_t)l * 2 * DFF * DM, r - l * I_F13, 0, scr, lane); continue; }
        r -= T_F1;
        if (r < T_F3) { const int l = r / I_F13; transpose_matrix_item(a.in[IN_FW3] + (size_t)l * DM * DFF, DM, DFF, (bf16*)(ws + WS_W13T) + (size_t)l * 2 * DFF * DM, r - l * I_F13, 1, scr, lane); continue; }
        r -= T_F3;
        if (r < T_F2) { const int l = r / I_F2; transpose_matrix_item(a.in[IN_FW2] + (size_t)l * DFF * DM, DFF, DM, (bf16*)(ws + WS_W2T) + (size_t)l * DM * DFF, r - l * I_F2, -1, scr, lane); continue; }
        r -= T_F2;
        if (r < T_PAD) { const int l = r >> 5, row = NIN + (r & 31); v4u z = {0u, 0u, 0u, 0u}; v4u* o = (v4u*)((bf16*)(ws + WS_WINT) + ((size_t)l * NINP + row) * DM) + lane * 2; o[0] = z; o[1] = z; continue; }
        r -= T_PAD;
        if (r < T_ROPE) { const int e = r * 64 + lane, pos = e >> 4, j = e & 15;
            const float inv = __builtin_amdgcn_exp2f(-(float)(2 * j) * (13.287712379549449f / 32.0f)); const float ang = (float)pos * inv;
            float2* T = (float2*)(ws + WS_ROPE); T[e] = make_float2(cosf(ang), sinf(ang)); continue; }
        r -= T_ROPE;
        { const int l = r; const float* lp = a.in[IN_DLAM] + l * 256;
          const float s0 = wave_sum(lp[lane] * lp[64 + lane]), s1 = wave_sum(lp[128 + lane] * lp[192 + lane]);
          const float li = 0.8f - 0.6f * expf(-0.3f * (float)l);
          if (lane == 0) { float* L = (float*)(ws + WS_LAM); L[l * 2] = expf(s0) - expf(s1) + li; L[l * 2 + 1] = 1.0f - li; } }
    }
    { float* LT = (float*)(ws + WS_LORA);
      for (int o = (vcu * NTHR + tid); o < LO_TOTAL; o += G * NTHR) {
          float v;
          if (o < LO_A2) { const int m = o >> 14, r = o & 16383, chn = r >> 5, j = r & 31; v = a.in[IN_W2][((size_t)m * 32 + j) * 512 + chn]; }
          else if (o < LO_V2) { const int q = o - LO_A2; const int m = q >> 14, r = q & 16383, chn = r >> 5, j = r & 31; v = a.in[IN_A2][((size_t)m * 32 + j) * 512 + chn]; }
          else if (o < LO_G2) { const int q = o - LO_V2; const int m = q >> 14, r = q & 16383, chn = r >> 5, j = r & 31; v = a.in[IN_V2][((size_t)m * 32 + j) * 512 + chn]; }
          else { const int q = o - LO_G2; const int m = q / 49152, r = q - m * 49152, chn = r / 96, j = r - chn * 96; v = a.in[IN_G2][((size_t)m * 96 + j) * 512 + chn]; }
          LT[o] = v; } }
}

__device__ __forceinline__ void phase_norm(const Args& a, LAS unsigned char* lds, int vcu, int G, int l, int which_norm, bool moe) {
    const int tid = opaque_tid(), lane = tid & 63, wave = __builtin_amdgcn_readfirstlane(tid >> 6);
    unsigned char* ws = opaque_ptr(a.ws);
    LAS float* tabA = (LAS float*)lds; LAS float* tabB = tabA + 3072; LAS float* rwT = tabB + 3072;
    const float* MOD = (const float*)(ws + WS_MOD) + (size_t)l * 3 * 6144;
    const float* ng = a.in[which_norm ? IN_N2G : IN_N1G] + l * 1024;
    const int off_sh = which_norm ? 3072 : 0, off_sc = off_sh + 1024;
    for (int i = tid; i < 3072; i += NTHR) { const int w = i >> 10, c = i & 1023; tabA[i] = ng[c] * (1.0f + MOD[w * 6144 + off_sc + c]); tabB[i] = MOD[w * 6144 + off_sh + c]; }
    if (moe) { const float* rw = a.in[IN_ROUTER] + (size_t)(l >> 1) * 1024 * 8; for (int i = tid; i < 8192; i += NTHR) { const int c = i >> 3, e = i & 7; rwT[e * 1024 + c] = rw[i]; } }
    __syncthreads();
    const float* srcLat = (l == 0 && which_norm == 0) ? a.in[IN_X] : a.out;
    const float* srcCtx = (l == 0 && which_norm == 0) ? a.in[IN_CTX] : (const float*)(ws + WS_XC);
    bf16* HN = (bf16*)(ws + WS_HN);
    const int gw = vcu * NWAVES + wave, NGW = G * NWAVES;
    for (int R = gw; R < NR; R += NGW) {
        const int b = R / NPB, p = R - b * NPB; const int w = (p < CL) ? 2 : b;
        const float* xr = (p < CL) ? srcCtx + (size_t)(b * CL + p) * 1024 : srcLat + ((size_t)b * SEQ + (p - CL)) * 1024;
        const f32x4* x4 = (const f32x4*)xr + lane;
        f32x4 v[4]; float ss = 0.f;
#pragma unroll
        for (int j = 0; j < 4; ++j) { v[j] = x4[64 * j]; ss += (v[j][0] * v[j][0] + v[j][1] * v[j][1]) + (v[j][2] * v[j][2] + v[j][3] * v[j][3]); }
        const float rstd = 1.0f / sqrtf(wave_sum(ss) * (1.0f / 1024.0f) + 1e-6f);
        const LAS f32x4* A4 = (const LAS f32x4*)(tabA + w * 1024) + lane; const LAS f32x4* B4 = (const LAS f32x4*)(tabB + w * 1024) + lane;
        unsigned long long* o8 = (unsigned long long*)(HN + (size_t)R * 1024) + lane;
#pragma unroll
        for (int j = 0; j < 4; ++j) { v[j] = (v[j] * rstd) * A4[64 * j] + B4[64 * j];
            o8[64 * j] = (unsigned long long)pk2(v[j][0], v[j][1]) | ((unsigned long long)pk2(v[j][2], v[j][3]) << 32); }
        if (moe) {
            float lg[8];
#pragma unroll
            for (int e = 0; e < 8; ++e) { const LAS f32x4* r4 = (const LAS f32x4*)(rwT + e * 1024) + lane; float s = 0.f;
#pragma unroll
                for (int j = 0; j < 4; ++j) { const f32x4 rr = r4[64 * j]; s += (v[j][0] * rr[0] + v[j][1] * rr[1]) + (v[j][2] * rr[2] + v[j][3] * rr[3]); }
                lg[e] = wave_sum(s); }
            int e1 = 0; float v1 = lg[0];
#pragma unroll
            for (int e = 1; e < 8; ++e) if (lg[e] > v1) { v1 = lg[e]; e1 = e; }
            int e2 = -1; float v2 = -3.0e38f;
#pragma unroll
            for (int e = 0; e < 8; ++e) if (e != e1 && lg[e] > v2) { v2 = lg[e]; e2 = e; }
            if (lane == 0) {
                const float g1 = 1.0f / (1.0f + __expf(v2 - v1)), g2 = 1.0f - g1;
                unsigned* cnt = (unsigned*)(ws + WS_CTL) + CW_CNT + (((l >> 1) * 2 + b) * 8) * 64;
                const unsigned p1 = atomicAdd(cnt + 64 * e1, 1u), p2 = atomicAdd(cnt + 64 * e2, 1u);
                unsigned* ro = (unsigned*)(ws + WS_ROUTE) + (size_t)R * 8;
                ro[0] = (unsigned)e1; ro[1] = (unsigned)e2; ro[2] = p1; ro[3] = p2; ro[4] = __float_as_uint(g1); ro[5] = __float_as_uint(g2);
            }
        }
    }
    if (moe) {
        LAS float* scr = (LAS float*)(lds + 57344 + wave * 8704);
        const int li = l >> 1;
        constexpr int I_13 = 16 * (DFE / 32), I_2 = (DFE / 64) * 32;
        constexpr int NTK = 8 * (2 * I_13 + I_2);
        for (int it = gw; it < NTK; it += NGW) {
            const int e = it / (2 * I_13 + I_2); int r = it - e * (2 * I_13 + I_2);
            if (r < I_13) { transpose_matrix_item(a.in[IN_EW1] + ((size_t)li * 8 + e) * DM * DFE, DM, DFE, (bf16*)(ws + WS_W13E) + (size_t)e * 2 * DFE * DM, r, 0, scr, lane); continue; }
            r -= I_13;
            if (r < I_13) { transpose_matrix_item(a.in[IN_EW3] + ((size_t)li * 8 + e) * DM * DFE, DM, DFE, (bf16*)(ws + WS_W13E) + (size_t)e * 2 * DFE * DM, r, 1, scr, lane); continue; }
            r -= I_13;
            transpose_matrix_item(a.in[IN_EW2] + ((size_t)li * 8 + e) * DFE * DM, DFE, DM, (bf16*)(ws + WS_W2E) + (size_t)e * DM * DFE, r, -1, scr, lane);
        }
    }
}
__device__ __forceinline__ void phase_prep(const Args& a, LAS unsigned char* lds, int G, int l, bool do_rope = true) {
    const int tid = opaque_tid(), lane = tid & 63, wave = __builtin_amdgcn_readfirstlane(tid >> 6);
    unsigned char* ws = opaque_ptr(a.ws);
    const bf16* P = (const bf16*)(ws + WS_PR); bf16* PA = (bf16*)(ws + WS_PA);
    _Float16* SPK = (_Float16*)(ws + WS_SPK); _Float16* DPK = (_Float16*)(ws + WS_DPK); _Float16* VF = (_Float16*)(ws + WS_VFIRST); _Float16* GG = (_Float16*)(ws + WS_G);
    float* BON = (float*)(ws + WS_BONUS); const float* LT = (const float*)(ws + WS_LORA);
    LAS float* wdT = (LAS float*)lds;
    LAS float* adS = wdT + 32 * 64;
    LAS float* gdS = adS + 32 * 64;
    LAS float* vlS = gdS + 32 * 96;
    LAS float* vS  = vlS + 32 * 32;
    const int ch = tid, h = wave, c = lane;
    const float* mu = a.in[IN_MU] + (size_t)l * 3 * 2 * 512;
    const float mur0 = mu[0 * 512 + ch], mur1 = mu[1 * 512 + ch], muk0 = mu[2 * 512 + ch], muk1 = mu[3 * 512 + ch], muv0 = mu[4 * 512 + ch], muv1 = mu[5 * 512 + ch];
    const float k_k = a.in[IN_KK][l * 512 + ch], k_a = a.in[IN_KA][l * 512 + ch], r_k = a.in[IN_RK][l * 512 + ch];
    const float v0c = (l > 0) ? a.in[IN_V0][(l - 1) * 512 + ch] : 0.f;
    for (int tile = blockIdx.x; tile < NB * 520; tile += G) {
        const int b = tile / 520, tt = tile - b * 520, p0 = tt * 32;
        const int seg_lo = (tt < 8) ? 0 : CL, seg_hi = (tt < 8) ? CL : NPB;
        const size_t R0 = (size_t)b * NPB + p0;
        for (int idx = tid; idx < 32 * 224; idx += NTHR) { const int i = idx / 224, cc = idx - i * 224; const float val = bf2f(P[(R0 + i) * LDPR + PC_LORA + cc]);
            if (cc < 64) wdT[i * 64 + cc] = tanh_f(val); else if (cc < 128) adS[i * 64 + cc - 64] = val; else gdS[i * 96 + cc - 128] = sigmoid_f(val); }
        { const bf16* vc = P + R0 * LDPR + PC_RV + ch;
          float prev = (p0 > seg_lo) ? bf2f(*(vc - LDPR)) : 0.f, cur = bf2f(vc[0]);
#pragma unroll 1
          for (int i = 0; i < 32; ++i) { const float nxt = (p0 + i + 1 < seg_hi) ? bf2f(vc[(size_t)(i + 1) * LDPR]) : 0.f;
              vS[i * 512 + ch] = cur + muv0 * (prev - cur) + muv1 * (nxt - cur); prev = cur; cur = nxt; } }
        __syncthreads();
        if (l > 0) { const int j = tid & 31, i0 = tid >> 5; const float* v1p = a.in[IN_V1] + (size_t)(l - 1) * 512 * 32 + j; float acc0 = 0.f, acc1 = 0.f;
#pragma unroll 8
            for (int cc = 0; cc < 512; ++cc) { const float w = v1p[cc * 32]; acc0 += vS[i0 * 512 + cc] * w; acc1 += vS[(i0 + 16) * 512 + cc] * w; }
            vlS[i0 * 32 + j] = acc0; vlS[(i0 + 16) * 32 + j] = acc1; }
        __syncthreads();
        if (l > 0) { float v2c[32];
            { const f32x4* w4 = (const f32x4*)(LT + LO_V2 + ((size_t)(l - 1) * 512 + ch) * 32);
#pragma unroll
              for (int j = 0; j < 8; ++j) { const f32x4 t = w4[j]; v2c[4 * j] = t[0]; v2c[4 * j + 1] = t[1]; v2c[4 * j + 2] = t[2]; v2c[4 * j + 3] = t[3]; } }
#pragma unroll 1
            for (int i = 0; i < 32; ++i) { float z = v0c;
#pragma unroll
                for (int j = 0; j < 32; ++j) z += vlS[i * 32 + j] * v2c[j];
                const float vp = vS[i * 512 + ch], vf = (float)VF[(R0 + i) * 512 + ch]; vS[i * 512 + ch] = vp + (vf - vp) * sigmoid_f(z); } }
        else {
#pragma unroll 1
            for (int i = 0; i < 32; ++i) VF[(R0 + i) * 512 + ch] = (_Float16)vS[i * 512 + ch]; }
        asm volatile("" ::: "memory");
        { float g2c[96];
          { const f32x4* w4 = (const f32x4*)(LT + LO_G2 + ((size_t)l * 512 + ch) * 96);
#pragma unroll
            for (int j = 0; j < 24; ++j) { const f32x4 t = w4[j]; g2c[4 * j] = t[0]; g2c[4 * j + 1] = t[1]; g2c[4 * j + 2] = t[2]; g2c[4 * j + 3] = t[3]; } }
#pragma unroll 1
          for (int i = 0; i < 32; ++i) { float g = 0.f;
#pragma unroll
              for (int jc = 0; jc < 3; ++jc) {
#pragma unroll
                  for (int j = 0; j < 32; ++j) g += gdS[i * 96 + jc * 32 + j] * g2c[jc * 32 + j];
                  __builtin_amdgcn_sched_barrier(0); }
              GG[(R0 + i) * 512 + ch] = (_Float16)g; } }
        asm volatile("" ::: "memory");
#pragma unroll 1
        for (int d = 0; d < 2; ++d) {
          float w2c[32], a2c[32];
          { const f32x4* w4 = (const f32x4*)(LT + LO_W2 + (((size_t)l * 2 + d) * 512 + ch) * 32); const f32x4* a4 = (const f32x4*)(LT + LO_A2 + (((size_t)l * 2 + d) * 512 + ch) * 32);
#pragma unroll
            for (int j = 0; j < 8; ++j) { const f32x4 t = w4[j], u = a4[j]; w2c[4 * j] = t[0]; w2c[4 * j + 1] = t[1]; w2c[4 * j + 2] = t[2]; w2c[4 * j + 3] = t[3];
                a2c[4 * j] = u[0]; a2c[4 * j + 1] = u[1]; a2c[4 * j + 2] = u[2]; a2c[4 * j + 3] = u[3]; } }
          const float w0d = a.in[IN_W0][(l * 2 + d) * 512 + ch], a0d = a.in[IN_A0][(l * 2 + d) * 512 + ch];
          const bf16* rc = P + R0 * LDPR + PC_R + ch; const bf16* kc = P + R0 * LDPR + PC_RK + ch;
          float rprev = (p0 > seg_lo) ? bf2f(*(rc - LDPR)) : 0.f, rcur = bf2f(rc[0]);
          float kprev = (p0 > seg_lo) ? bf2f(*(kc - LDPR)) : 0.f, kcur = bf2f(kc[0]);
#pragma unroll 1
          for (int i = 0; i < 32; ++i) {
              const bool hn = (p0 + i + 1 < seg_hi);
              const float rnxt = hn ? bf2f(rc[(size_t)(i + 1) * LDPR]) : 0.f, knxt = hn ? bf2f(kc[(size_t)(i + 1) * LDPR]) : 0.f;
              const float rs = rcur + mur0 * (rprev - rcur) + mur1 * (rnxt - rcur);
              const float ks = kcur + muk0 * (kprev - kcur) + muk1 * (knxt - kcur);
              rprev = rcur; rcur = rnxt; kprev = kcur; kcur = knxt;
              const float t = ks * k_k; const float ssq = wave_sum(t * t); const float kk = t * (1.0f / sqrtf(fmaxf(ssq, 1e-24f)));
              const int p = p0 + i;
              float wl = w0d, al = a0d;
#pragma unroll
              for (int j = 0; j < 32; ++j) { wl += wdT[i * 64 + d * 32 + j] * w2c[j]; al += adS[i * 64 + d * 32 + j] * a2c[j]; }
              const float e = 0.6065306597126334f * sigmoid_f(wl);
              const float av = sigmoid_f(al);
              const float bb = kk * av, kd = ks * (1.0f + (av - 1.0f) * k_a);
              _Float16* dpk = DPK + ((size_t)(((d * 2 + b) * 8 + h) * NPB) + p) * 192 + c;
              dpk[0] = (_Float16)e; dpk[64] = (_Float16)bb; dpk[128] = (_Float16)kd;
              const float bs = wave_sum(rs * kd * r_k);
              if (d == 0) { _Float16* spk = SPK + ((size_t)((b * 8 + h) * NPB) + p) * 192 + c;
                  spk[0] = (_Float16)rs; spk[64] = (_Float16)kk; spk[128] = (_Float16)vS[i * 512 + ch];
                  if (c == 0) BON[(R0 + i) * 8 + h] = bs; }
              else if (c == 0) BON[(R0 + i) * 8 + h] += bs;
          }
          asm volatile("" ::: "memory");
        }
        __syncthreads();
    }
    if (do_rope) { const float2* RT = (const float2*)(ws + WS_ROPE);
      const int gw = blockIdx.x * NWAVES + wave, NGW = G * NWAVES; const int g = lane & 31, sub = lane >> 5;
      for (int rp = gw; rp < NR / 2; rp += NGW) {
          const int R = rp * 2 + sub; const int b = R / NPB, p = R - b * NPB;
          v4u* pp = (v4u*)(PA + (size_t)R * LDPA + g * 32);
          v4u x[4];
#pragma unroll
          for (int j = 0; j < 4; ++j) x[j] = pp[j];
          if (p < CL && g >= 16) continue;
          float e[32];
#pragma unroll
          for (int j = 0; j < 4; ++j)
#pragma unroll
              for (int k = 0; k < 4; ++k) { e[j * 8 + 2 * k] = bflo(x[j][k]); e[j * 8 + 2 * k + 1] = bfhi(x[j][k]); }
          if (p >= CL) { const int t = p - CL; const int pos = (g & 1) ? (t & 63) : (t >> 6);
#pragma unroll
              for (int j = 0; j < 16; ++j) { const float2 cs = RT[pos * 16 + j]; const float x1 = e[j], x2 = e[16 + j]; e[j] = x1 * cs.x - x2 * cs.y; e[16 + j] = x1 * cs.y + x2 * cs.x; } }
          const float sc = (g < 16) ? QSCALE : 1.0f;
#pragma unroll
          for (int j = 0; j < 4; ++j) { v4u o;
#pragma unroll
              for (int k = 0; k < 4; ++k) o[k] = pk2(e[j * 8 + 2 * k] * sc, e[j * 8 + 2 * k + 1] * sc);
              pp[j] = o; }
      } }
}

__device__ __forceinline__ void phase_prep2(const Args& a, LAS unsigned char* lds, int vcu, int G) {
    const int tid = opaque_tid(), lane = tid & 63, wave = __builtin_amdgcn_readfirstlane(tid >> 6), t15 = lane & 15, q = lane >> 4;
    unsigned char* ws = opaque_ptr(a.ws);
    const _Float16* SPK = (const _Float16*)(ws + WS_SPK); const _Float16* DPK = (const _Float16*)(ws + WS_DPK);
    LAS unsigned char* wl = lds + wave * 16384;
    LAS bf16* sAt = (LAS bf16*)wl; LAS bf16* sBh = sAt + 1024; LAS bf16* sKh = sBh + 1024; LAS bf16* sRt = sKh + 1024; LAS bf16* sXT = sRt + 1024;
    LAS bf16* sBbT = sXT + 1024; LAS bf16* sKbT = sBbT + 1024;
    LAS float* sM = (LAS float*)(sKbT + 1024); LAS float* sQ = sM + 256;
    const int gw = vcu * NWAVES + wave, NGW = G * NWAVES;
    for (int task = gw; task < 32 * NCHUNK; task += NGW) {
        const int chain = task / NCHUNK, c = task - chain * NCHUNK; const int d = chain >> 4, b = (chain >> 3) & 1, h = chain & 7;
        const _Float16* sp = SPK + (size_t)((b * 8 + h) * NPB) * 192; const _Float16* dp = DPK + (size_t)(((d * 2 + b) * 8 + h) * NPB) * 192;
        unsigned char* rec = ws + WS_OPS + ((size_t)chain * NCHUNK + c) * OPS_REC;
        float xa[16], bhv[16], khv[16]; float L = 0.f; unsigned vtp[8];
#pragma unroll
        for (int t = 0; t < 16; ++t) {
            const int p = scan_pos(c * 16 + t, d);
            const float e = (float)dp[(size_t)p * 192 + lane], bb = (float)dp[(size_t)p * 192 + 64 + lane], kd = (float)dp[(size_t)p * 192 + 128 + lane];
            const float r = (float)sp[(size_t)p * 192 + lane], kk = (float)sp[(size_t)p * 192 + 64 + lane], vv = (float)sp[(size_t)p * 192 + 128 + lane];
            const float ep = __expf(L); L -= e; const float en = __expf(-L), ec = __expf(L);
            xa[t] = -kk * ep; bhv[t] = bb * en; khv[t] = kd * en;
            sAt[t * 64 + lane] = (bf16)f2bf(xa[t]); sBh[t * 64 + lane] = (bf16)f2bf(bhv[t]); sKh[t * 64 + lane] = (bf16)f2bf(khv[t]); sRt[t * 64 + lane] = (bf16)f2bf(r * ec);
            if (t & 1) vtp[t >> 1] |= f2bf(vv) << 16; else vtp[t >> 1] = f2bf(vv);
        }
        { const float wc = __expf(L); ((float*)(rec + OR_WC))[lane] = wc;
          v4u o0, o1;
#pragma unroll
          for (int j = 0; j < 4; ++j) { o0[j] = pk2(bhv[2 * j] * wc, bhv[2 * j + 1] * wc); o1[j] = pk2(bhv[8 + 2 * j] * wc, bhv[9 + 2 * j] * wc); }
          ((LAS v4u*)(sBbT + lane * 16))[0] = o0; ((LAS v4u*)(sBbT + lane * 16))[1] = o1;
#pragma unroll
          for (int j = 0; j < 4; ++j) { o0[j] = pk2(khv[2 * j] * wc, khv[2 * j + 1] * wc); o1[j] = pk2(khv[8 + 2 * j] * wc, khv[9 + 2 * j] * wc); }
          ((LAS v4u*)(sKbT + lane * 16))[0] = o0; ((LAS v4u*)(sKbT + lane * 16))[1] = o1;
          v4u* vo = (v4u*)(rec + OR_VT) + lane * 2; vo[0] = (v4u){vtp[0], vtp[1], vtp[2], vtp[3]}; vo[1] = (v4u){vtp[4], vtp[5], vtp[6], vtp[7]}; }
        LDS_WAIT(); asm volatile("" ::: "memory");
        f32x4 mab = {0.f, 0.f, 0.f, 0.f}, mak = mab, mbr = mab, mkr = mab;
#pragma unroll
        for (int s2 = 0; s2 < 2; ++s2) {
            const sbf16x8 fa = *(const LAS sbf16x8*)(sAt + t15 * 64 + 32 * s2 + 8 * q), fb = *(const LAS sbf16x8*)(sBh + t15 * 64 + 32 * s2 + 8 * q);
            const sbf16x8 fk = *(const LAS sbf16x8*)(sKh + t15 * 64 + 32 * s2 + 8 * q), fr = *(const LAS sbf16x8*)(sRt + t15 * 64 + 32 * s2 + 8 * q);
            mab = __builtin_amdgcn_mfma_f32_16x16x32_bf16(fb, fa, mab, 0, 0, 0); mak = __builtin_amdgcn_mfma_f32_16x16x32_bf16(fk, fa, mak, 0, 0, 0);
            mbr = __builtin_amdgcn_mfma_f32_16x16x32_bf16(fb, fr, mbr, 0, 0, 0); mkr = __builtin_amdgcn_mfma_f32_16x16x32_bf16(fk, fr, mkr, 0, 0, 0);
        }
#pragma unroll
        for (int i = 0; i < 4; ++i) { const int j = 4 * q + i; if (j >= t15) { mab[i] = 0.f; mak[i] = 0.f; } if (j > t15) { mbr[i] = 0.f; mkr[i] = 0.f; } }
        *(LAS f32x4*)(sM + t15 * 16 + 4 * q) = mab;
        *(LAS f32x4*)(sQ + t15 * 16 + 4 * q) = mak;
        { v4u mt; mt[0] = pk2(mbr[0], mbr[1]); mt[1] = pk2(mbr[2], mbr[3]); mt[2] = pk2(mkr[0], mkr[1]); mt[3] = pk2(mkr[2], mkr[3]); ((v4u*)rec)[4 * 64 + lane] = mt; }
        LDS_WAIT(); asm volatile("" ::: "memory");
        float qv[16];
#pragma unroll
        for (int t = 0; t < 16; ++t) qv[t] = sQ[t * 16 + t15];
#pragma unroll
        for (int t = 1; t < 16; ++t) {
            float m[16];
#pragma unroll
            for (int j4 = 0; j4 < (t + 3) / 4; ++j4) { const f32x4 mm = *(const LAS f32x4*)(sM + t * 16 + 4 * j4); m[4 * j4] = mm[0]; m[4 * j4 + 1] = mm[1]; m[4 * j4 + 2] = mm[2]; m[4 * j4 + 3] = mm[3]; }
#pragma unroll
            for (int j = 0; j < t; ++j) { xa[t] += m[j] * xa[j]; qv[t] += m[j] * qv[j]; }
        }
        asm volatile("" ::: "memory");
#pragma unroll
        for (int t = 0; t < 16; ++t) { sXT[t * 64 + lane] = (bf16)f2bf(xa[t]); if (q == 0) sQ[t * 16 + t15] = qv[t]; }
        LDS_WAIT(); asm volatile("" ::: "memory");
        { v4u* R4 = (v4u*)rec;
#pragma unroll
          for (int s2 = 0; s2 < 2; ++s2) {
              const v2u x0 = *(const LAS v2u*)(sXT + t15 * 64 + 32 * s2 + 4 * q), x1 = *(const LAS v2u*)(sXT + t15 * 64 + 32 * s2 + 16 + 4 * q);
              R4[s2 * 64 + lane] = (v4u){x0[0], x0[1], x1[0], x1[1]};
              const v2u r0 = *(const LAS v2u*)(sRt + t15 * 64 + 32 * s2 + 4 * q), r1 = *(const LAS v2u*)(sRt + t15 * 64 + 32 * s2 + 16 + 4 * q);
              R4[(2 + s2) * 64 + lane] = (v4u){r0[0], r0[1], r1[0], r1[1]}; }
#pragma unroll
          for (int rt = 0; rt < 4; ++rt) {
              const v2u b0 = *(const LAS v2u*)(sBbT + (16 * rt + t15) * 16 + 4 * q), k0 = *(const LAS v2u*)(sKbT + (16 * rt + t15) * 16 + 4 * q);
              R4[(5 + rt) * 64 + lane] = (v4u){b0[0], b0[1], k0[0], k0[1]}; }
          const f32x4 qq = *(const LAS f32x4*)(sQ + t15 * 16 + 4 * q);
          ((v2u*)(rec + OR_QT))[lane] = (v2u){pk2(qq[0], qq[1]), pk2(qq[2], qq[3])}; }
        LDS_WAIT(); asm volatile("" ::: "memory");
    }
}

__device__ __forceinline__ void phase_mix(const Args& a, LAS unsigned char* lds, volatile LAS unsigned* MISC, int l, int ql, unsigned xcc, bool do_scan = true, bool do_attn = true) {
    const int tid = opaque_tid();
    unsigned char* ws = opaque_ptr(a.ws);
    unsigned* ctl = (unsigned*)(ws + WS_CTL);
    const bf16* P = (const bf16*)(ws + WS_PA);
    if (do_scan) { int xq = (int)(xcc & 7u), tried = 0;
      while (tried < 8) {
          if (tid == 0) MISC[16] = atomicAdd(ctl + CW_QS + (ql * 8 + xq) * 64, 1u);
          __syncthreads(); const unsigned idx = MISC[16]; __syncthreads();
          if (idx >= 4u) { xq = (xq + 1) & 7; ++tried; continue; }
#ifndef NO_SCAN
          scan_chain(xq * 4 + (int)idx, (const unsigned char*)(ws + WS_OPS), (float*)(ws + WS_Y), lds);
#endif
      } }
    if (do_attn) { const float* L = (const float*)(ws + WS_LAM); const float lam = L[l * 2], oml = L[l * 2 + 1];
      const float* subg = a.in[IN_SUBG] + l * 128; bf16* AO = (bf16*)(ws + WS_HN);
      int xq = (int)(xcc & 7u), tried = 0;
      while (tried < 8) {
          if (tid == 0) MISC[16] = atomicAdd(ctl + CW_QA + (ql * 8 + xq) * 64, 1u);
          __syncthreads(); const unsigned idx = MISC[16]; __syncthreads();
          if (idx >= 130u) { xq = (xq + 1) & 7; ++tried; continue; }
          const int b = xq >> 2, h = xq & 3;
#ifndef NO_ATTN
          if (idx < 128u) att::attn_unit(P, b * NPB + CL + (int)idx * 128, b * NPB, NPB / 64, h, lam, oml, subg, AO, (char*)lds);
          else att::attn_unit(P, b * NPB + ((int)idx - 128) * 128, b * NPB, CL / 64, h, lam, oml, subg, AO, (char*)lds);
#endif
      } }
}

__device__ __forceinline__ void phase_finish(const Args& a, int G, int l) {
    const int tid = opaque_tid(), lane = tid & 63, wave = __builtin_amdgcn_readfirstlane(tid >> 6);
    unsigned char* ws = opaque_ptr(a.ws);
    const float* Y = (const float*)(ws + WS_Y); const _Float16* SPK = (const _Float16*)(ws + WS_SPK); const _Float16* GG = (const _Float16*)(ws + WS_G); const float* BON = (const float*)(ws + WS_BONUS);
    bf16* AO = (bf16*)(ws + WS_HN);
    const int ch = tid, h = wave, c = lane;
    const float lw = a.in[IN_LNW][l * 512 + ch], lb = a.in[IN_LNB][l * 512 + ch];
    for (int R = blockIdx.x; R < NR; R += G) {
        const int b = R / NPB, p = R - b * NPB;
        const float y = Y[(size_t)R * 512 + ch] + Y[((size_t)NR + R) * 512 + ch];
        const float mean = wave_sum(y) * (1.0f / 64.0f); const float dv = y - mean; const float var = wave_sum(dv * dv) * (1.0f / 64.0f);
        float o = dv * (1.0f / sqrtf(var + 64e-5f)) * lw + lb;
        const float vv = (float)SPK[((size_t)((b * 8 + h) * NPB) + p) * 192 + 128 + c];
        o += BON[(size_t)R * 8 + h] * vv;
        o *= (float)GG[(size_t)R * 512 + ch];
        AO[(size_t)R * 1024 + 512 + ch] = (bf16)f2bf(o);
    }
}

__device__ __forceinline__ void phase_gather(const Args& a, int vcu, int G, int l, int half) {
    const int tid = opaque_tid(), lane = tid & 63, wave = __builtin_amdgcn_readfirstlane(tid >> 6);
    unsigned char* ws = opaque_ptr(a.ws);
    const unsigned* cnt = (const unsigned*)(ws + WS_CTL) + CW_CNT + (((l >> 1) * 2 + half) * 8) * 64;
    int off[8]; { int r = 0;
#pragma unroll
        for (int e = 0; e < 8; ++e) { off[e] = r; const int n = (int)__hip_atomic_load(cnt + 64 * e, __ATOMIC_RELAXED, __HIP_MEMORY_SCOPE_AGENT); r += ((n + 255) >> 8) << 8; } }
    const bf16* HN = (const bf16*)(ws + WS_HN); bf16* AG = (bf16*)(ws + WS_AG);
    const int gw = vcu * NWAVES + wave, NGW = G * NWAVES;
    for (int rr = gw; rr < NPB; rr += NGW) {
        const int R = half * NPB + rr;
        unsigned* ro = (unsigned*)(ws + WS_ROUTE) + (size_t)R * 8;
        const int e1 = (int)ro[0], e2 = (int)ro[1]; const int p1 = (int)ro[2], p2 = (int)ro[3];
        int o1 = 0, o2 = 0;
#pragma unroll
        for (int e = 0; e < 8; ++e) { if (e == e1) o1 = off[e]; if (e == e2) o2 = off[e]; }
        const int s1 = o1 + p1, s2 = o2 + p2;
        const v4u* src = (const v4u*)(HN + (size_t)R * 1024) + lane * 2; const v4u x0 = src[0], x1 = src[1];
        v4u* d1 = (v4u*)(AG + (size_t)s1 * 1024) + lane * 2; v4u* d2 = (v4u*)(AG + (size_t)s2 * 1024) + lane * 2;
        d1[0] = x0; d1[1] = x1; d2[0] = x0; d2[1] = x1;
        if (lane == 0) { ro[6] = (unsigned)s1; ro[7] = (unsigned)s2; }
    }
}
__device__ __forceinline__ void phase_combine(const Args& a, int vcu, int G, int l, int half) {
    const int tid = opaque_tid(), lane = tid & 63, wave = __builtin_amdgcn_readfirstlane(tid >> 6);
    unsigned char* ws = opaque_ptr(a.ws);
    const bf16* YE = (const bf16*)(ws + WS_YEXP);
    const float* MOD = (const float*)(ws + WS_MOD) + (size_t)l * 3 * 6144 + 5120;
    const int gw = vcu * NWAVES + wave, NGW = G * NWAVES;
    for (int rr = gw; rr < NPB; rr += NGW) {
        const int R = half * NPB + rr; const int b = half, p = rr; const int w = (p < CL) ? 2 : b;
        const unsigned* ro = (const unsigned*)(ws + WS_ROUTE) + (size_t)R * 8;
        const float g1 = __uint_as_float(ro[4]), g2 = __uint_as_float(ro[5]); const int s1 = (int)ro[6], s2 = (int)ro[7];
        float* xr = (p < CL) ? (float*)(ws + WS_XC) + (size_t)(b * CL + p) * 1024 : a.out + ((size_t)b * SEQ + (p - CL)) * 1024;
        const f32x4* gt = (const f32x4*)(MOD + (size_t)w * 6144);
        const v4u* y1 = (const v4u*)(YE + (size_t)s1 * 1024); const v4u* y2 = (const v4u*)(YE + (size_t)s2 * 1024);
#pragma unroll
        for (int j = 0; j < 2; ++j) { const int c8 = lane + 64 * j;
            const v4u u1 = y1[c8], u2 = y2[c8]; f32x4* xp = (f32x4*)xr + c8 * 2; f32x4 x0 = xp[0], x1 = xp[1]; const f32x4 t0 = gt[c8 * 2], t1 = gt[c8 * 2 + 1];
            x0[0] += t0[0] * (g1 * bflo(u1[0]) + g2 * bflo(u2[0])); x0[1] += t0[1] * (g1 * bfhi(u1[0]) + g2 * bfhi(u2[0]));
            x0[2] += t0[2] * (g1 * bflo(u1[1]) + g2 * bflo(u2[1])); x0[3] += t0[3] * (g1 * bfhi(u1[1]) + g2 * bfhi(u2[1]));
            x1[0] += t1[0] * (g1 * bflo(u1[2]) + g2 * bflo(u2[2])); x1[1] += t1[1] * (g1 * bfhi(u1[2]) + g2 * bfhi(u2[2]));
            x1[2] += t1[2] * (g1 * bflo(u1[3]) + g2 * bflo(u2[3])); x1[3] += t1[3] * (g1 * bfhi(u1[3]) + g2 * bfhi(u2[3]));
            xp[0] = x0; xp[1] = x1; }
    }
}
__device__ __forceinline__ void phase_final(const Args& a, int vcu, int G) {
    const int tid = opaque_tid(), lane = tid & 63, wave = __builtin_amdgcn_readfirstlane(tid >> 6);
    const int gw = vcu * NWAVES + wave, NGW = G * NWAVES;
    const f32x4* g4 = (const f32x4*)a.in[IN_FINALG] + lane;
    for (int r = gw; r < NB * SEQ; r += NGW) {
        f32x4* x4 = (f32x4*)(a.out + (size_t)r * 1024) + lane; f32x4 v[4]; float ss = 0.f;
#pragma unroll
        for (int j = 0; j < 4; ++j) { v[j] = x4[64 * j]; ss += (v[j][0] * v[j][0] + v[j][1] * v[j][1]) + (v[j][2] * v[j][2] + v[j][3] * v[j][3]); }
        const float rstd = 1.0f / sqrtf(wave_sum(ss) * (1.0f / 1024.0f) + 1e-6f);
#pragma unroll
        for (int j = 0; j < 4; ++j) x4[64 * j] = (v[j] * rstd) * g4[64 * j];
    }
}
#ifndef MK_MULTI
#define MK_MULTI 0
#endif
constexpr int N_PHASES = 1 + 2 * 10 + 2 * 16 + 1;

__global__ void __launch_bounds__(NTHR, 2) mk_fwd(Args args) {
    extern __shared__ __attribute__((aligned(16))) unsigned char lds_raw[];
    LAS unsigned char* lds = (LAS unsigned char*)lds_raw;
    volatile LAS unsigned* MISC = (volatile LAS unsigned*)(lds + MISC_OFF);
    const int tid = threadIdx.x;
    const int G = gridDim.x; const int bx = blockIdx.x; const int vcu = (G % 8 == 0) ? (bx % 8) * (G / 8) + bx / 8 : bx;
    unsigned char* ws = args.ws;
    unsigned* ctl = (unsigned*)(ws + WS_CTL);
    for (int u = tid; u < (LDS_BYTES - LDSCTL_OFF) / 4; u += NTHR) ((LAS unsigned*)(lds + LDSCTL_OFF))[u] = 0u;
    __syncthreads();
    const int lo = args.ph_lo, hi = args.ph_hi;
    XcdBarrier bar; bar.bar = ctl + CW_BAR; bar.x = xb_xcc_id(); bar.st = MISC + 8;
    if (hi - lo > 1) bar = xcd_barrier_post(ctl + CW_BAR, MISC + 8);
    const unsigned xcc = bar.x;
    int seq = 0;
#ifndef PH_MASK
#define PH_MASK 0xFFFFFFFFu
#endif
#define PH_ON(b) ((PH_MASK >> (b)) & 1u)
#ifndef DUP_SCAN
#define DUP_SCAN true
#endif
#ifndef DUP_ATTN
#define DUP_ATTN true
#endif
#ifndef DUP_MASK
#define DUP_MASK 0u
#endif
#define DUP_ON(b) ((DUP_MASK >> (b)) & 1u)
#define REP(b, stmt) do { if (PH_ON(b)) { stmt; if (DUP_ON(b)) { xcd_barrier(bar); stmt; } } } while (0)
#define PH_BEGIN if (lo <= seq && seq < hi) { unsigned char* ws = opaque_ptr(args.ws); (void)ws;
#define PH_END   if (seq + 1 < hi) xcd_barrier(bar); } ++seq;

    PH_BEGIN REP(0, phase_prologue(args, lds, vcu, G)); PH_END

    for (int l = 0; l < DEPTH; ++l) {
        const bool moe = (l & 1) != 0;
        const float* MODl = (const float*)(ws + WS_MOD) + (size_t)l * 3 * 6144;
        PH_BEGIN if (PH_ON(1)) phase_norm(args, lds, vcu, G, l, 0, false); PH_END
        PH_BEGIN {
            pg8::Gemm g{(const pg8::bf16_t*)(ws + WS_HN), (const pg8::bf16_t*)(ws + WS_WINT) + (size_t)l * NINP * DM, NR, NINP, DM};
            pg8::StaticOrder S; S.init(NR, NINP, G, bx);
            pg8::EpiStoreSplit E{(pg8::bf16_t*)(ws + WS_PA), LDPA, (pg8::bf16_t*)(ws + WS_PR), LDPR, LDPA / 256};
            REP(2, (pg8::gemm_phase<pg8::EpiStoreSplit, pg8::StaticOrder, true, true>(lds, g, S, E)));
        } PH_END
        PH_BEGIN if (PH_ON(3)) { phase_prep(args, lds, G, l); if (DUP_ON(3)) { xcd_barrier(bar); phase_prep(args, lds, G, l, false); } } PH_END
        PH_BEGIN REP(15, phase_prep2(args, lds, vcu, G)); PH_END
        PH_BEGIN if (PH_ON(4)) { phase_mix(args, lds, MISC, l, l, xcc); if (DUP_ON(4)) { xcd_barrier(bar); phase_mix(args, lds, MISC, l, l + 4, xcc, DUP_SCAN, DUP_ATTN); } } PH_END
        PH_BEGIN REP(5, phase_finish(args, G, l)); PH_END
        PH_BEGIN {
            pg8::Gemm g{(const pg8::bf16_t*)(ws + WS_HN), (const pg8::bf16_t*)(ws + WS_WOUTT) + (size_t)l * DM * DM, NR, DM, DM};
            pg8::StaticOrder S; S.init(NR, DM, G, bx);
            pg8::EpiResid E{(l == 0) ? args.in[IN_X] : args.out, (l == 0) ? args.in[IN_CTX] : (const float*)(ws + WS_XC), args.out, (float*)(ws + WS_XC), MODl + 2048};
            if (PH_ON(6)) pg8::gemm_phase<pg8::EpiResid, pg8::StaticOrder, true, true>(lds, g, S, E);
        } PH_END
        PH_BEGIN if (PH_ON(7)) phase_norm(args, lds, vcu, G, l, 1, moe); PH_END
        if (!moe) {
            PH_BEGIN {
                pg8::Gemm g{(const pg8::bf16_t*)(ws + WS_HN), (const pg8::bf16_t*)(ws + WS_W13T) + (size_t)(l >> 1) * 2 * DFF * DM, NR, 2 * DFF, DM};
                pg8::StaticOrder S; S.init(NR, 2 * DFF, G, bx);
                pg8::EpiSwiGLU E{(pg8::bf16_t*)(ws + WS_HF), DFF, 0};
                REP(8, (pg8::gemm_phase<pg8::EpiSwiGLU, pg8::StaticOrder, true, true>(lds, g, S, E)));
            } PH_END
            PH_BEGIN {
                pg8::Gemm g{(const pg8::bf16_t*)(ws + WS_HF), (const pg8::bf16_t*)(ws + WS_W2T) + (size_t)(l >> 1) * DM * DFF, NR, DM, DFF};
                pg8::StaticOrder S; S.init(NR, DM, G, bx);
                pg8::EpiResid E{args.out, (const float*)(ws + WS_XC), args.out, (float*)(ws + WS_XC), MODl + 5120};
                if (PH_ON(9)) pg8::gemm_phase<pg8::EpiResid, pg8::StaticOrder, true, true>(lds, g, S, E);
            } PH_END
        } else {
            for (int half = 0; half < 2; ++half) {
                const unsigned* cnt = (const unsigned*)ctl + CW_CNT + (((l >> 1) * 2 + half) * 8) * 64;
                PH_BEGIN if (PH_ON(10)) phase_gather(args, vcu, G, l, half); PH_END
                PH_BEGIN {
                    pg8::Gemm g{(const pg8::bf16_t*)(ws + WS_AG), (const pg8::bf16_t*)(ws + WS_W13E), 35328, 8 * 2 * DFE, DM};
                    pg8::MoeOrder S; S.init(cnt, (2 * DFE) / 256, G, bx);
                    pg8::EpiSwiGLU E{(pg8::bf16_t*)(ws + WS_HMOE), DFE, (2 * DFE) / 256};
                    REP(11, (pg8::gemm_phase<pg8::EpiSwiGLU, pg8::MoeOrder, true, true>(lds, g, S, E)));
                } PH_END
                PH_BEGIN {
                    pg8::Gemm g{(const pg8::bf16_t*)(ws + WS_HMOE), (const pg8::bf16_t*)(ws + WS_W2E), 35328, 8 * DM, DFE};
                    pg8::MoeOrder S; S.init(cnt, DM / 256, G, bx);
                    pg8::EpiStoreBf16 E{(pg8::bf16_t*)(ws + WS_YEXP), DM, DM / 256};
                    REP(12, (pg8::gemm_phase<pg8::EpiStoreBf16, pg8::MoeOrder, true, true>(lds, g, S, E)));
                } PH_END
                PH_BEGIN if (PH_ON(13)) phase_combine(args, vcu, G, l, half); PH_END
            }
        }
    }
    PH_BEGIN if (PH_ON(14)) phase_final(args, vcu, G); PH_END
#undef PH_BEGIN
#undef PH_END
}

extern "C" void kernel_launch(void* const* d_in, const int* in_sizes, int n_in, void* d_out, int out_size, void* d_ws, size_t ws_size, hipStream_t stream) {
    static int grid = 0;
    if (grid == 0) {
        if (n_in != 34 || out_size != NB * SEQ * DM || ws_size < WS_END) { fprintf(stderr, "kernel_launch: unexpected shapes (n_in %d out %d ws %zu, need %zu)\n", n_in, out_size, ws_size, (size_t)WS_END); grid = -1; return; }
        int dev = 0, cus = 0, per_cu = 0;
        if (hipGetDevice(&dev) != hipSuccess || hipDeviceGetAttribute(&cus, hipDeviceAttributeMultiprocessorCount, dev) != hipSuccess) { grid = -1; return; }
        if (hipFuncSetAttribute((const void*)mk_fwd, hipFuncAttributeMaxDynamicSharedMemorySize, LDS_BYTES) != hipSuccess) { fprintf(stderr, "kernel_launch: hipFuncSetAttribute failed\n"); grid = -1; return; }
        if (hipOccupancyMaxActiveBlocksPerMultiprocessor(&per_cu, (const void*)mk_fwd, NTHR, LDS_BYTES) != hipSuccess || per_cu < 1) fprintf(stderr, "kernel_launch: occupancy query reports %d blocks per CU\n", per_cu);
        (void)hipGetLastError();
        grid = cus;
    }
    if (grid < 0) return;
    if (hipMemsetAsync((char*)d_ws + WS_CTL, 0, CTL_ZERO_BYTES, stream) != hipSuccess) return;
    Args a{};
    for (int i = 0; i < 34; ++i) a.in[i] = (const float*)d_in[i];
    a.out = (float*)d_out; a.ws = (unsigned char*)d_ws;
#if MK_MULTI
    for (int s = 0; s < N_PHASES; ++s) { a.ph_lo = s; a.ph_hi = s + 1; hipLaunchKernelGGL(mk_fwd, dim3(grid), dim3(NTHR), LDS_BYTES, stream, a); }
#else
    a.ph_lo = 0; a.ph_hi = N_PHASES;
    hipLaunchKernelGGL(mk_fwd, dim3(grid), dim3(NTHR), LDS_BYTES, stream, a);
#endif
    const hipError_t le = hipPeekAtLastError();
    if (le != hipSuccess) fprintf(stderr, "kernel_launch: launch failed: %s\n", hipGetErrorName(le));
}
```

```cpp
#include <hip/hip_runtime.h>
#include <cstdio>
#include <cstdint>
__device__ __forceinline__ int opaque_tid() { int t = (int)threadIdx.x; asm volatile("" : "+v"(t)); return t; }
template <class T> __device__ __forceinline__ T* opaque_ptr(T* p) { asm volatile("" : "+s"(p)); return p; }
namespace pg8 {
#define PG8_LAS __attribute__((address_space(3)))
typedef unsigned short bf16_t;
typedef short bf16x8 __attribute__((ext_vector_type(8)));
typedef float f32x4 __attribute__((ext_vector_type(4)));
typedef unsigned u32x4 __attribute__((ext_vector_type(4)));
constexpr int BM = 256, BK = 64, HALF = 128, HTB = HALF * BK * 2  , STAGE_BYTES = 8 * HTB, NXCD = 8, WGM = 8;

__host__ __device__ __forceinline__ int lds_byte(int r, int c) { const int st = (r >> 4) * 2 + (c >> 5), rr = r & 15, cc = c & 31, ob = rr * 64 + cc * 2; return st * 1024 + (ob ^ (((ob >> 9) & 1) << 5)); }
__host__ __device__ __forceinline__ void stage_rc(int b, int& R, int& C) { const int st = b / 1024, sb = b % 1024, swz = sb ^ (((sb >> 9) & 1) << 5); R = (st >> 1) * 16 + swz / 64; C = (st & 1) * 32 + (swz % 64) / 2; }
__host__ __device__ __forceinline__ int perm32(int rho) { const int n = rho >> 4, i = rho & 15; return 8 * (i >> 2) + 4 * n + (i & 3); }

struct Unit { int pm, pn; };
struct Gemm { const bf16_t* A; const bf16_t* Bt; int M, N, K; };

struct StaticOrder {
    int nM, nN, nwg, G, c;
    __host__ __device__ void init(int M, int N, int G_, int c_) { nM = M / BM; nN = N / BM; nwg = nM * nN; G = G_; c = c_; }
    __host__ __device__ bool next(int i, Unit& u) const {
        const long L = (long)i * G + c; if (L >= nwg) return false;
        int wgid = (int)L; { const int q = nwg / NXCD, r = nwg % NXCD, xcd = wgid % NXCD, off = wgid / NXCD; wgid = (xcd < r ? xcd * (q + 1) : r * (q + 1) + (xcd - r) * q) + off; }
        const int nig = WGM * nN, gid = wgid / nig, fm = gid * WGM, gsz = (nM - fm) < WGM ? (nM - fm) : WGM;
        u.pm = fm + ((wgid % nig) % gsz); u.pn = (wgid % nig) / gsz; return true;
    }
    __device__ __forceinline__ void a_ready(const Unit&) const {}
    __device__ __forceinline__ void done(const Unit&) const {}
};

__device__ __forceinline__ unsigned cvt_pk_bf16(float lo, float hi) { unsigned r; asm volatile("v_cvt_pk_bf16_f32 %0, %1, %2" : "=v"(r) : "v"(lo), "v"(hi)); return r; }
typedef float f32x2 __attribute__((ext_vector_type(2)));
__device__ __forceinline__ float silu_acc(float a) { return a * __builtin_amdgcn_rcpf(1.0f + __builtin_amdgcn_exp2f(-1.4426950408889634f * a)); }
struct EpiStoreBf16 {
    static constexpr bool PERM = true, AFTER_DRAIN = false;
    bf16_t* O; int ldc; int ncolt;
    __device__ __forceinline__ void operator()(const f32x4 (&acc)[2][2][4][2], const Unit& u, int wr, int wc, int fr, int fq) const {
        const int row0 = u.pm * BM + wr * 64 + fr; const int pnl = ncolt ? (u.pn % ncolt) : u.pn;
        const int col0 = pnl * BM + wc * 32 + 8 * fq;
#pragma unroll
        for (int ai = 0; ai < 2; ++ai)
#pragma unroll
            for (int m = 0; m < 4; ++m) { bf16_t* rowp = O + (size_t)(row0 + ai * HALF + m * 16) * ldc + col0;
#pragma unroll
                for (int bj = 0; bj < 2; ++bj) { const f32x4 v0 = acc[ai][bj][m][0], v1 = acc[ai][bj][m][1];
                    u32x4 w; w.x = cvt_pk_bf16(v0[0], v0[1]); w.y = cvt_pk_bf16(v0[2], v0[3]); w.z = cvt_pk_bf16(v1[0], v1[1]); w.w = cvt_pk_bf16(v1[2], v1[3]);
                    *(u32x4*)(rowp + bj * HALF) = w; } }
    }
};
struct EpiStoreSplit {
    static constexpr bool PERM = true, AFTER_DRAIN = false;
    bf16_t* O0; int ld0; bf16_t* O1; int ld1; int nt0;
    __device__ __forceinline__ void operator()(const f32x4 (&acc)[2][2][4][2], const Unit& u, int wr, int wc, int fr, int fq) const {
        const int row0 = u.pm * BM + wr * 64 + fr; const bool first = u.pn < nt0; const int pnl = first ? u.pn : u.pn - nt0; const int ldc = first ? ld0 : ld1; bf16_t* O = first ? O0 : O1;
        const int col0 = pnl * BM + wc * 32 + 8 * fq;
#pragma unroll
        for (int ai = 0; ai < 2; ++ai)
#pragma unroll
            for (int m = 0; m < 4; ++m) { bf16_t* rowp = O + (size_t)(row0 + ai * HALF + m * 16) * ldc + col0;
#pragma unroll
                for (int bj = 0; bj < 2; ++bj) { const f32x4 v0 = acc[ai][bj][m][0], v1 = acc[ai][bj][m][1];
                    u32x4 w; w.x = cvt_pk_bf16(v0[0], v0[1]); w.y = cvt_pk_bf16(v0[2], v0[3]); w.z = cvt_pk_bf16(v1[0], v1[1]); w.w = cvt_pk_bf16(v1[2], v1[3]);
                    *(u32x4*)(rowp + bj * HALF) = w; } }
    }
};
struct EpiSwiGLU {
    static constexpr bool PERM = true, AFTER_DRAIN = false;
    bf16_t* O; int ldc; int ncolt;
    __device__ __forceinline__ void operator()(const f32x4 (&acc)[2][2][4][2], const Unit& u, int wr, int wc, int fr, int fq) const {
        const int row0 = u.pm * BM + wr * 64 + fr; const int pnl = ncolt ? (u.pn % ncolt) : u.pn;
        const int col0 = pnl * HALF + wc * 32 + 8 * fq;
#pragma unroll
        for (int ai = 0; ai < 2; ++ai)
#pragma unroll
            for (int m = 0; m < 4; ++m) { bf16_t* rowp = O + (size_t)(row0 + ai * HALF + m * 16) * ldc + col0;
                const f32x4 a0 = acc[ai][0][m][0], a1 = acc[ai][0][m][1], b0 = acc[ai][1][m][0], b1 = acc[ai][1][m][1];
                u32x4 w;
                w.x = cvt_pk_bf16(silu_acc(a0[0]) * b0[0], silu_acc(a0[1]) * b0[1]); w.y = cvt_pk_bf16(silu_acc(a0[2]) * b0[2], silu_acc(a0[3]) * b0[3]);
                w.z = cvt_pk_bf16(silu_acc(a1[0]) * b1[0], silu_acc(a1[1]) * b1[1]); w.w = cvt_pk_bf16(silu_acc(a1[2]) * b1[2], silu_acc(a1[3]) * b1[3]);
                *(u32x4*)rowp = w; }
    }
};
struct EpiResid {
    static constexpr bool PERM = false, AFTER_DRAIN = false;
    const float* srcLat; const float* srcCtx; float* dstLat; float* dstCtx; const float* gate3;
    __device__ __forceinline__ void operator()(const f32x4 (&acc)[2][2][4][2], const Unit& u, int wr, int wc, int fr, int fq) const {
        const int b = u.pm / 65, j = u.pm - b * 65; const int which = (j == 0) ? 2 : b;
        const float* src = (j == 0) ? srcCtx + (size_t)b * 256 * 1024 : srcLat + ((size_t)b * 16384 + (size_t)(j - 1) * 256) * 1024;
        float* dst = (j == 0) ? dstCtx + (size_t)b * 256 * 1024 : dstLat + ((size_t)b * 16384 + (size_t)(j - 1) * 256) * 1024;
        const float* gp = gate3 + (size_t)which * 6144;
        const int col0 = u.pn * BM + wc * 32 + 4 * fq;
        f32x4 gv[2][2];
#pragma unroll
        for (int bj = 0; bj < 2; ++bj)
#pragma unroll
            for (int n = 0; n < 2; ++n) gv[bj][n] = *(const f32x4*)(gp + col0 + bj * HALF + n * 16);
#pragma unroll
        for (int ai = 0; ai < 2; ++ai)
#pragma unroll
            for (int m = 0; m < 4; ++m) { const size_t off = (size_t)(ai * HALF + wr * 64 + m * 16 + fr) * 1024 + col0;
#pragma unroll
                for (int bj = 0; bj < 2; ++bj)
#pragma unroll
                    for (int n = 0; n < 2; ++n) { const f32x4 x = *(const f32x4*)(src + off + bj * HALF + n * 16);
                        *(f32x4*)(dst + off + bj * HALF + n * 16) = x + gv[bj][n] * acc[ai][bj][m][n]; }
                if (m & 1) asm volatile("" ::: "memory"); }
    }
};
struct MoeOrder {
    int t0, t1, t2, t3, t4, t5, t6, t7; int ncol, G, c;
    __device__ __forceinline__ void init(const unsigned* cnt  , int ncol_, int G_, int c_) {
        ncol = ncol_; G = G_; c = c_;
#define MO_T(e) (((int)__hip_atomic_load(cnt + 64 * (e), __ATOMIC_RELAXED, __HIP_MEMORY_SCOPE_AGENT) + 255) >> 8)
        t0 = MO_T(0); t1 = MO_T(1); t2 = MO_T(2); t3 = MO_T(3); t4 = MO_T(4); t5 = MO_T(5); t6 = MO_T(6); t7 = MO_T(7);
#undef MO_T
    }
    __device__ __forceinline__ bool next(int i, Unit& u) const {
        int L = i * G + c; int e = 0, r0 = 0, te = t0; bool found = false;
#define MO_STEP(k, tk) if (!found) { if (L < (tk) * ncol) { e = (k); te = (tk); found = true; } else { L -= (tk) * ncol; r0 += (tk); } }
        MO_STEP(0, t0) MO_STEP(1, t1) MO_STEP(2, t2) MO_STEP(3, t3) MO_STEP(4, t4) MO_STEP(5, t5) MO_STEP(6, t6) MO_STEP(7, t7)
#undef MO_STEP
        if (!found) return false;
        u.pm = r0 + L % te; u.pn = e * ncol + L / te; return true;
    }
    __device__ __forceinline__ void a_ready(const Unit&) const {}
    __device__ __forceinline__ void done(const Unit&) const {}
};
template <class Epi, class Sched, bool ALIGN_EPI = false, bool SP2 = false>
__device__ __forceinline__ void gemm_phase(PG8_LAS unsigned char* lds, const Gemm g, const Sched& S, const Epi& E) {
    const int tid = opaque_tid(), wid = __builtin_amdgcn_readfirstlane(tid >> 6), lane = tid & 63, wr = wid >> 2, wc = wid & 3, fr = lane & 15, fq = lane >> 4;
    const int K = g.K, nt = K / BK;
    unsigned voffA[2], voffB[2];
#pragma unroll
    for (int i = 0; i < 2; ++i) { int R, C; stage_rc(tid * 16 + i * 8192, R, C); const int Rb = Epi::PERM ? ((R & ~31) + perm32(R & 31)) : R;
        voffA[i] = (unsigned)(R * K + C) * 2u; voffB[i] = (unsigned)(Rb * K + C) * 2u; }
    const size_t kstep = (size_t)(BK * 2);
    const size_t hstep = (size_t)HALF * K * 2;
    const size_t tstep = 2 * hstep;
    const unsigned ldsw = (unsigned)wid * 1024u;
    const int aoff = lds_byte(wr * 64 + fr, fq * 8), boff = lds_byte(wc * 32 + fr, fq * 8);
#define PG8_SA(b, h) (((b) * 2 + (h)) * HTB)
#define PG8_SB(b, h) ((4 + (b) * 2 + (h)) * HTB)
#define PG8_STAGE(bufoff, gbase, voff) do { _Pragma("unroll") for (int _i = 0; _i < 2; ++_i) \
        __builtin_amdgcn_global_load_lds((const unsigned*)((const char*)(gbase) + (voff)[_i]), (PG8_LAS unsigned*)(lds + (bufoff) + ldsw + _i * 8192), 16, 0, 0); } while (0)
#define PG8_LDA(dst, b, h) do { _Pragma("unroll") for (int m = 0; m < 4; ++m) _Pragma("unroll") for (int k = 0; k < 2; ++k) dst[m][k] = *(const PG8_LAS bf16x8*)(lds + PG8_SA(b, h) + aoff + m * 2048 + k * 1024); } while (0)
#define PG8_LDB(dst, b, h) do { _Pragma("unroll") for (int n = 0; n < 2; ++n) _Pragma("unroll") for (int k = 0; k < 2; ++k) dst[n][k] = *(const PG8_LAS bf16x8*)(lds + PG8_SB(b, h) + boff + n * 2048 + k * 1024); } while (0)
#define PG8_MMA(ai, bj, At, Bt) do { __builtin_amdgcn_s_setprio(1); _Pragma("unroll") for (int m = 0; m < 4; ++m) _Pragma("unroll") for (int n = 0; n < 2; ++n) _Pragma("unroll") for (int k = 0; k < 2; ++k) \
        acc[ai][bj][m][n] = __builtin_amdgcn_mfma_f32_16x16x32_bf16(Bt[n][k], At[m][k], acc[ai][bj][m][n], 0, 0, 0); __builtin_amdgcn_s_setprio(0); } while (0)
#define PG8_WAIT_V(n) asm volatile("s_waitcnt vmcnt(" #n ")" ::: "memory")
#define PG8_WAIT_L(n) asm volatile("s_waitcnt lgkmcnt(" #n ")" ::: "memory")
#define PG8_BAR __builtin_amdgcn_s_barrier()
#define PG8_SCHED __builtin_amdgcn_sched_barrier(0)
    Unit cur, nxt; int ui = 0;
    if (!S.next(0, cur)) return;
    f32x4 acc[2][2][4][2];
#pragma unroll
    for (int a = 0; a < 2; ++a)
#pragma unroll
        for (int b = 0; b < 2; ++b)
#pragma unroll
            for (int m = 0; m < 4; ++m)
#pragma unroll
                for (int n = 0; n < 2; ++n) acc[a][b][m][n] = (f32x4){0.f, 0.f, 0.f, 0.f};
    bf16x8 At[4][2], B0[2][2], B1[2][2];
    const char* cA = (const char*)g.A + (size_t)cur.pm * tstep; const char* cB = (const char*)g.Bt + (size_t)cur.pn * tstep;
    S.a_ready(cur);
    if constexpr (SP2) {
        PG8_STAGE(PG8_SB(0, 0), cB, voffB); PG8_STAGE(PG8_SB(0, 1), cB + hstep, voffB); PG8_STAGE(PG8_SA(0, 0), cA, voffA); PG8_STAGE(PG8_SA(0, 1), cA + hstep, voffA);
        if (wr == 1) PG8_BAR;
        PG8_WAIT_V(2); PG8_BAR;
        PG8_STAGE(PG8_SB(1, 0), cB + kstep, voffB); PG8_STAGE(PG8_SA(1, 0), cA + kstep, voffA); PG8_STAGE(PG8_SB(1, 1), cB + hstep + kstep, voffB);
        PG8_WAIT_V(6); PG8_BAR;
    } else {
        PG8_STAGE(PG8_SB(0, 0), cB, voffB); PG8_STAGE(PG8_SA(0, 0), cA, voffA); PG8_STAGE(PG8_SB(0, 1), cB + hstep, voffB); PG8_STAGE(PG8_SA(0, 1), cA + hstep, voffA);
        if (wr == 1) PG8_BAR;
        PG8_WAIT_V(4); PG8_BAR;
        PG8_STAGE(PG8_SB(1, 0), cB + kstep, voffB); PG8_STAGE(PG8_SA(1, 0), cA + kstep, voffA); PG8_STAGE(PG8_SB(1, 1), cB + hstep + kstep, voffB);
        PG8_WAIT_V(6); PG8_BAR;
    }
    for (;;) {
        const bool has_next = S.next(ui + 1, nxt);
        const char* nA = has_next ? (const char*)g.A + (size_t)nxt.pm * tstep : cA; const char* nB = has_next ? (const char*)g.Bt + (size_t)nxt.pn * tstep : cB;
        for (int t = 0; t < nt; t += 2) {
            const bool last = (t == nt - 2);
            const char* a1 = cA + (size_t)(t + 1) * kstep;
            const char* a2 = last ? nA : cA + (size_t)(t + 2) * kstep; const char* b2 = last ? nB : cB + (size_t)(t + 2) * kstep;
            const char* a3 = a2 + kstep; const char* b3 = b2 + kstep;
            if (last && has_next) S.a_ready(nxt);
            if constexpr (SP2) {
            PG8_LDB(B0, 0, 0); PG8_LDB(B1, 0, 1); PG8_SCHED; PG8_LDA(At, 0, 0); PG8_STAGE(PG8_SA(1, 1), a1 + hstep, voffA);
            PG8_WAIT_V(8); PG8_WAIT_L(0); PG8_BAR; PG8_MMA(0, 0, At, B0); PG8_MMA(0, 1, At, B1); PG8_BAR; PG8_SCHED;
            PG8_LDA(At, 0, 1); PG8_STAGE(PG8_SB(0, 0), b2, voffB); PG8_STAGE(PG8_SB(0, 1), b2 + hstep, voffB); PG8_STAGE(PG8_SA(0, 0), a2, voffA);
            PG8_WAIT_V(8); PG8_WAIT_L(0); PG8_BAR; PG8_MMA(1, 0, At, B0); PG8_MMA(1, 1, At, B1); PG8_BAR; PG8_SCHED;
            PG8_LDB(B0, 1, 0); PG8_LDB(B1, 1, 1); PG8_SCHED; PG8_LDA(At, 1, 0); PG8_STAGE(PG8_SA(0, 1), a2 + hstep, voffA);
            PG8_WAIT_V(8); PG8_WAIT_L(0); PG8_BAR; PG8_MMA(0, 0, At, B0); PG8_MMA(0, 1, At, B1); PG8_BAR; PG8_SCHED;
            PG8_LDA(At, 1, 1); PG8_STAGE(PG8_SB(1, 0), b3, voffB); PG8_STAGE(PG8_SB(1, 1), b3 + hstep, voffB); PG8_STAGE(PG8_SA(1, 0), a3, voffA);
            PG8_WAIT_V(8); PG8_WAIT_L(0); PG8_BAR; PG8_MMA(1, 0, At, B0); PG8_MMA(1, 1, At, B1); PG8_BAR; PG8_SCHED;
            } else {
            PG8_LDB(B0, 0, 0); PG8_SCHED; PG8_LDA(At, 0, 0); PG8_STAGE(PG8_SA(1, 1), a1 + hstep, voffA);
            PG8_WAIT_L(8); PG8_BAR; PG8_WAIT_L(0); PG8_MMA(0, 0, At, B0); PG8_BAR; PG8_SCHED;
            PG8_LDB(B1, 0, 1); PG8_STAGE(PG8_SB(0, 0), b2, voffB);
            PG8_BAR; PG8_WAIT_L(0); PG8_MMA(0, 1, At, B1); PG8_BAR;
            PG8_LDA(At, 0, 1); PG8_STAGE(PG8_SA(0, 0), a2, voffA);
            PG8_BAR; PG8_WAIT_L(0); PG8_MMA(1, 0, At, B0); PG8_BAR; PG8_SCHED;
            PG8_STAGE(PG8_SB(0, 1), b2 + hstep, voffB);
            PG8_WAIT_V(6); PG8_BAR; PG8_MMA(1, 1, At, B1); PG8_BAR;
            PG8_LDB(B0, 1, 0); PG8_SCHED; PG8_LDA(At, 1, 0); PG8_STAGE(PG8_SA(0, 1), a2 + hstep, voffA);
            PG8_WAIT_L(8); PG8_BAR; PG8_WAIT_L(0); PG8_MMA(0, 0, At, B0); PG8_BAR; PG8_SCHED;
            PG8_LDB(B1, 1, 1); PG8_STAGE(PG8_SB(1, 0), b3, voffB);
            PG8_BAR; PG8_WAIT_L(0); PG8_MMA(0, 1, At, B1); PG8_BAR;
            PG8_LDA(At, 1, 1); PG8_STAGE(PG8_SA(1, 0), a3, voffA);
            PG8_BAR; PG8_WAIT_L(0); PG8_MMA(1, 0, At, B0); PG8_BAR; PG8_SCHED;
            PG8_STAGE(PG8_SB(1, 1), b3 + hstep, voffB);
            PG8_WAIT_V(6); PG8_BAR; PG8_MMA(1, 1, At, B1); PG8_BAR;
            }
        }
        if constexpr (ALIGN_EPI) { if (wr == 0) PG8_BAR; }
        if constexpr (!Epi::AFTER_DRAIN) { E(acc, cur, wr, wc, fr, fq); S.done(cur); }
        if (!has_next) break;
#pragma unroll
        for (int a = 0; a < 2; ++a)
#pragma unroll
            for (int b = 0; b < 2; ++b)
#pragma unroll
                for (int m = 0; m < 4; ++m)
#pragma unroll
                    for (int n = 0; n < 2; ++n) acc[a][b][m][n] = (f32x4){0.f, 0.f, 0.f, 0.f};
        cur = nxt; cA = nA; cB = nB; ++ui;
        if constexpr (ALIGN_EPI) { if (wr == 1) PG8_BAR; }
    }
    PG8_WAIT_V(0);
    if constexpr (!ALIGN_EPI) { if (wr == 0) PG8_BAR; }
    PG8_BAR;
    if constexpr (Epi::AFTER_DRAIN) { E.fused(acc, cur, wr, wc, fr, fq, lds, wid, lane); S.done(cur); }
#undef PG8_SA
#undef PG8_SB
#undef PG8_STAGE
#undef PG8_LDA
#undef PG8_LDB
#undef PG8_MMA
#undef PG8_WAIT_V
#undef PG8_WAIT_L
#undef PG8_BAR
#undef PG8_SCHED
}
}
constexpr int NB = 2, SEQ = 16384, CL = 256, DM = 1024, NPB = SEQ + CL  , NR = NB * NPB  , DEPTH = 4;
constexpr int NIN = 3296, NINP = 3328, DFF = 2816, NEXP = 8, DFE = 3584;
constexpr int NWAVES = 8, NTHR = 512;
constexpr float QSCALE = 0.125f * 1.4426950408889634f;
constexpr int PC_Q = 0, PC_K = 512, PC_V = 1024, PC_R = 0, PC_RK = 512, PC_RV = 1024, PC_LORA = 1536;

constexpr size_t MiB = 1u << 20;
constexpr size_t WS_CTL = 0, CTL_ZERO_BYTES = 1 * MiB;
constexpr size_t WS_MOD = 1 * MiB;
constexpr size_t WS_ROPE = 2 * MiB;
constexpr size_t WS_LAM = 2 * MiB + 65536;
constexpr size_t WS_XC = 3 * MiB;
constexpr size_t WS_ROUTE = 5 * MiB;
constexpr size_t WS_WINT = 8 * MiB;
constexpr size_t WS_WOUTT = 34 * MiB;
constexpr size_t WS_W13T = 42 * MiB;
constexpr size_t WS_W2T = 64 * MiB;
constexpr size_t WS_VFIRST = 76 * MiB;
constexpr size_t WS_HN = 110 * MiB;
constexpr size_t WS_PA = 175 * MiB;
constexpr size_t WS_G = 273 * MiB;
constexpr size_t WS_BONUS = 306 * MiB;
constexpr size_t WS_OPS = 308 * MiB;
constexpr size_t WS_PR = 308 * MiB;
constexpr size_t WS_SPK = 715 * MiB;
constexpr size_t WS_DPK = 813 * MiB;
constexpr size_t WS_Y = 813 * MiB;
constexpr size_t WS_LORA = 1008 * MiB;
constexpr size_t WS_END = 1010 * MiB;
constexpr int LO_W2 = 0, LO_A2 = 131072, LO_V2 = 262144, LO_G2 = 262144 + 49152, LO_V1 = 262144 + 49152 + 196608, LO_TOTAL = LO_V1 + 49152;
constexpr int LDPA = 1536, LDPR = 1792;
constexpr int OPS_REC = 12288, NCHUNK = NPB / 16;
constexpr int OR_QT = 9216, OR_VT = 9728, OR_WC = 11776;
constexpr size_t WS_HF = 175 * MiB;
constexpr size_t WS_W13E = 175 * MiB;
constexpr size_t WS_W2E = 287 * MiB;
constexpr size_t WS_AG = 343 * MiB;
constexpr size_t WS_HMOE = 412 * MiB;
constexpr size_t WS_YEXP = 654 * MiB;
static_assert(WS_WINT + (size_t)4 * NINP * DM * 2 <= WS_WOUTT && WS_WOUTT + (size_t)4 * DM * DM * 2 <= WS_W13T && WS_W13T + (size_t)2 * 2 * DFF * DM * 2 <= WS_W2T && WS_W2T + (size_t)2 * DM * DFF * 2 <= WS_VFIRST, "ws map 1");
static_assert(WS_VFIRST + (size_t)NR * 512 * 2 <= WS_HN && WS_HN + (size_t)NR * DM * 2 <= WS_PA && WS_PA + (size_t)NR * LDPA * 2 <= WS_G && WS_G + (size_t)NR * 512 * 2 <= WS_BONUS && WS_BONUS + (size_t)NR * 8 * 4 <= WS_OPS, "ws map 2");
static_assert(WS_OPS + (size_t)32 * NCHUNK * OPS_REC <= WS_SPK && WS_PR + (size_t)NR * LDPR * 2 <= WS_SPK && WS_SPK + (size_t)NB * 8 * NPB * 192 * 2 <= WS_DPK && WS_DPK + (size_t)2 * NB * 8 * NPB * 192 * 2 <= WS_LORA && WS_Y + (size_t)2 * NR * 512 * 4 <= WS_LORA && WS_LORA + (size_t)LO_TOTAL * 2 <= WS_END, "ws map 3");
static_assert(WS_HF + (size_t)NR * DFF * 2 <= WS_LORA && WS_W13E + (size_t)8 * 2 * DFE * DM * 2 <= WS_W2E && WS_W2E + (size_t)8 * DM * DFE * 2 <= WS_AG && WS_AG + (size_t)35328 * DM * 2 <= WS_HMOE && WS_HMOE + (size_t)35328 * DFE * 2 <= WS_YEXP && WS_YEXP + (size_t)35328 * DM * 2 <= WS_LORA, "ws map 4");
constexpr int CW_TMO = 0;
constexpr int CW_BAR = 4096;
constexpr int CW_QS = 16384;
constexpr int CW_QA = 20480;
constexpr int CW_CNT = 24576;

constexpr int RING_BYTES = 131072;
constexpr int LDSCTL_OFF = RING_BYTES, MISC_OFF = LDSCTL_OFF + 320;
constexpr int LDS_BYTES = 147456;

#define GAS __attribute__((address_space(1)))
#define LAS __attribute__((address_space(3)))
typedef unsigned short bf16;
typedef unsigned v4u __attribute__((ext_vector_type(4)));
typedef unsigned v2u __attribute__((ext_vector_type(2)));
typedef float f32x4 __attribute__((ext_vector_type(4)));
typedef _Float16 h4 __attribute__((ext_vector_type(4)));
#define LDS_WAIT() asm volatile("s_waitcnt lgkmcnt(0)" ::: "memory")
__device__ __forceinline__ unsigned f2bf(float f) { unsigned u = __builtin_bit_cast(unsigned, f); return (u + 0x7fffu + ((u >> 16) & 1u)) >> 16; }
__device__ __forceinline__ unsigned pk2(float lo, float hi) { return f2bf(lo) | (f2bf(hi) << 16); }
__device__ __forceinline__ float bf2f(bf16 h) { return __builtin_bit_cast(float, (unsigned)h << 16); }
__device__ __forceinline__ float bflo(unsigned w) { return __builtin_bit_cast(float, w << 16); }
__device__ __forceinline__ float bfhi(unsigned w) { return __builtin_bit_cast(float, w & 0xffff0000u); }
__device__ __forceinline__ float sigmoid_f(float x) { return 1.0f / (1.0f + __expf(-x)); }
__device__ __forceinline__ float tanh_f(float x) { return 1.0f - 2.0f / (__expf(2.0f * x) + 1.0f); }
__device__ __forceinline__ float wave_sum(float v) {
#pragma unroll
    for (int o = 1; o < 64; o <<= 1) v += __shfl_xor(v, o);
    return v;
}
#define XB_TMO      128
#define XB_XCNT(j)  (256  + 64 * (j))
#define XB_XSUB(j)  (1280 + 64 * (j))
#define XB_XGEN(j)  (2304 + 64 * (j))
#define XB_TOP      3328
#define XB_TOPGEN   3392
#define XCD_BAR_WORDS 3456
#define XB_SPIN_CAP (1u << 18)

__device__ __forceinline__ unsigned xb_ld(unsigned* p)              { return __hip_atomic_load(p, __ATOMIC_RELAXED, __HIP_MEMORY_SCOPE_AGENT); }
__device__ __forceinline__ unsigned xb_add(unsigned* p, unsigned v) { return __hip_atomic_fetch_add(p, v, __ATOMIC_RELAXED, __HIP_MEMORY_SCOPE_AGENT); }
__device__ __forceinline__ unsigned xb_xcc_id() { return (unsigned)__builtin_amdgcn_s_getreg((3 << 11) | 20) & 0xFu; }
#define XB_SPIN(cond, bar) do { unsigned _sp = 0; while (cond) { __builtin_amdgcn_s_sleep(1); \
    if ((++_sp & 255u) == 0u) { if (xb_ld(&(bar)[XB_TMO])) break; if (_sp > XB_SPIN_CAP) { atomicAdd(&(bar)[XB_TMO], 1u); break; } } } } while (0)

struct XcdBarrier {
    unsigned* bar; unsigned x;
    volatile LAS unsigned* st;
};

__device__ __forceinline__ XcdBarrier xcd_barrier_post(unsigned* bar, volatile LAS unsigned* st) {
    XcdBarrier b; b.bar = bar; b.x = xb_xcc_id(); b.st = st;
    if (threadIdx.x == 0) (void)xb_add(&bar[XB_XCNT(b.x)], 1u);
    return b;
}
__device__ __forceinline__ void xcd_barrier_complete(unsigned* bar, unsigned x, unsigned& nloc, unsigned& nx) {
    const unsigned G = gridDim.x * gridDim.y * gridDim.z;
    unsigned sum, cnt, mine, sp = 0u;
    for (;;) {
        sum = 0u; cnt = 0u; mine = 0u;
#pragma unroll
        for (unsigned j = 0; j < 16; ++j) { const unsigned c = xb_ld(&bar[XB_XCNT(j)]); sum += c; cnt += (c > 0u) ? 1u : 0u; mine = (j == x) ? c : mine; }
        if (sum == G) break;
        __builtin_amdgcn_s_sleep(1);
        if ((++sp & 255u) == 0u) { if (xb_ld(&bar[XB_TMO])) break; if (sp > XB_SPIN_CAP) { atomicAdd(&bar[XB_TMO], 1u); break; } }
    }
    nloc = mine > 0u ? mine : 1u; nx = cnt > 0u ? cnt : 1u;
}

__device__ __forceinline__ void xcd_barrier(const XcdBarrier& b) {
    asm volatile("s_waitcnt vmcnt(0)" ::: "memory");
    __syncthreads();
    if (threadIdx.x == 0) {
        unsigned* bar = b.bar;
        __builtin_amdgcn_s_waitcnt(0);
        unsigned nloc = b.st[0], nx = b.st[1];
        if (nloc == 0u) { xcd_barrier_complete(bar, b.x, nloc, nx); b.st[0] = nloc; b.st[1] = nx; }
        const unsigned old = xb_add(&bar[XB_XSUB(b.x)], 1u);
        const unsigned gen = old / nloc;
        if (old + 1u == (gen + 1u) * nloc) {
            __builtin_amdgcn_fence(__ATOMIC_RELEASE, "agent");
            asm volatile("s_waitcnt vmcnt(0)" ::: "memory");
            const unsigned og = xb_add(&bar[XB_TOP], 1u);
            const unsigned tg = og / nx;
            if (og + 1u == (tg + 1u) * nx) xb_add(&bar[XB_TOPGEN], 1u);
            else XB_SPIN(xb_ld(&bar[XB_TOPGEN]) == tg, bar);
            __builtin_amdgcn_fence(__ATOMIC_ACQUIRE, "agent");
            xb_add(&bar[XB_XGEN(b.x)], 1u);
            asm volatile("s_waitcnt vmcnt(0)" ::: "memory");
        } else {
            XB_SPIN(xb_ld(&bar[XB_XGEN(b.x)]) == gen, bar);
            __builtin_amdgcn_fence(__ATOMIC_ACQUIRE, "agent");
            asm volatile("s_waitcnt vmcnt(0)" ::: "memory");
        }
    }
    __syncthreads();
}
struct Args { const float* in[34]; float* out; unsigned char* ws; int ph_lo, ph_hi; };
namespace att {
using bf16x8 = __attribute__((ext_vector_type(8))) short;
using s16x4  = __attribute__((ext_vector_type(4))) short;
using f32x16 = __attribute__((ext_vector_type(16))) float;
using u32x4  = __attribute__((ext_vector_type(4))) unsigned;
constexpr int KVBLK = 64;
constexpr size_t SHM_V = KVBLK * 128 * 2, SHM_K = KVBLK * 128 * 2;
constexpr float THR2 = 11.5f;
#define KSWZ(row, colB) ((row) * 256 + ((colB) ^ (((row) & 7) << 4)))
#define SBAR() __builtin_amdgcn_sched_barrier(0)
__device__ __forceinline__ int crow(int r, int hi) { return (r & 3) + 8 * (r >> 2) + 4 * hi; }
__device__ __forceinline__ unsigned cvtpk(float lo, float hi) { unsigned r; asm volatile("v_cvt_pk_bf16_f32 %0, %1, %2" : "=v"(r) : "v"(lo), "v"(hi)); return r; }
__device__ __forceinline__ bf16x8 ld8(const bf16* p) { return *reinterpret_cast<const bf16x8*>(p); }

__device__ __forceinline__ void partialSM(f32x16& p0, f32x16& p1, float& m_reg, float& mn, float& alpha) {
  float pmax = p0[0];
#pragma unroll
  for (int r = 1; r < 16; ++r) pmax = fmaxf(pmax, p0[r]);
#pragma unroll
  for (int r = 0; r < 16; ++r) pmax = fmaxf(pmax, p1[r]);
  { auto rr = __builtin_amdgcn_permlane32_swap(__float_as_uint(pmax), __float_as_uint(pmax), false, false);
    pmax = fmaxf(__uint_as_float(rr[0]), __uint_as_float(rr[1])); }
  if (__builtin_expect(__all(pmax - m_reg <= THR2), 1)) { mn = m_reg; alpha = 1.f; }
  else { mn = fmaxf(m_reg, pmax); alpha = __builtin_amdgcn_exp2f(m_reg - mn); m_reg = mn; }
#pragma unroll
  for (int r = 0; r < 16; ++r) p0[r] = p0[r] - mn;
#pragma unroll
  for (int r = 0; r < 16; ++r) p1[r] = p1[r] - mn;
#pragma unroll
  for (int r = 0; r < 16; ++r) p0[r] = __builtin_amdgcn_exp2f(p0[r]);
}
__device__ __forceinline__ void finishSM(f32x16& p0, f32x16& p1, float alpha, float& l_reg, bf16x8& pa0, bf16x8& pa1, bf16x8& pa2, bf16x8& pa3) {
#pragma unroll
  for (int r = 0; r < 16; ++r) p1[r] = __builtin_amdgcn_exp2f(p1[r]);
  float ps = 0;
#pragma unroll
  for (int r = 0; r < 16; ++r) ps += p0[r];
#pragma unroll
  for (int r = 0; r < 16; ++r) ps += p1[r];
  { auto rr = __builtin_amdgcn_permlane32_swap(__float_as_uint(ps), __float_as_uint(ps), false, false);
    ps = __uint_as_float(rr[0]) + __uint_as_float(rr[1]); }
  l_reg = l_reg * alpha + ps;
#define PK4(P, BASE, OUT) do { unsigned a0 = cvtpk(P[BASE + 0], P[BASE + 1]), a1 = cvtpk(P[BASE + 2], P[BASE + 3]);   \
    unsigned b0 = cvtpk(P[BASE + 4], P[BASE + 5]), b1 = cvtpk(P[BASE + 6], P[BASE + 7]);                              \
    auto r0 = __builtin_amdgcn_permlane32_swap(a0, b0, false, false); auto r1 = __builtin_amdgcn_permlane32_swap(a1, b1, false, false); \
    u32x4 w = {r0[0], r1[0], r0[1], r1[1]}; OUT = *reinterpret_cast<bf16x8*>(&w); } while (0)
  PK4(p0, 0, pa0); PK4(p0, 8, pa1); PK4(p1, 0, pa2); PK4(p1, 8, pa3);
#undef PK4
}
__device__ __forceinline__ void qkt(f32x16& p0, f32x16& p1, const bf16* Ks, const bf16x8* qr, int r32, int hi, int cbase) {
  p0 = f32x16{}; p1 = f32x16{};
#pragma unroll
  for (int d0 = 0; d0 < 4; ++d0) { int cb = (cbase + d0 * 16 + hi * 8) * 2;
    bf16x8 b0 = *reinterpret_cast<const bf16x8*>((const char*)Ks + KSWZ(r32, cb));
    bf16x8 b1 = *reinterpret_cast<const bf16x8*>((const char*)Ks + KSWZ(32 + r32, cb));
    p0 = __builtin_amdgcn_mfma_f32_32x32x16_bf16(b0, qr[d0], p0, 0, 0, 0);
    p1 = __builtin_amdgcn_mfma_f32_32x32x16_bf16(b1, qr[d0], p1, 0, 0, 0); }
}
__device__ __forceinline__ int v_st(int k, int c) { const int kk = (k & ~0xC) | ((k & 4) << 1) | ((k & 8) >> 1); return ((kk >> 3) * 4 + (c >> 5)) * 512 + ((kk & 7) * 32 + (c & 31)) * 2; }
__device__ __forceinline__ int v_rd_base(int lane) { return ((lane & 3) << 3) | (((lane >> 2) & 3) << 6) | (((lane >> 4) & 1) << 5) | (((lane >> 5) & 1) << 8); }
constexpr int v_rd_off(int d0, int ks, int half) { return d0 * 512 + ks * 4096 + half * 2048; }
template <int OFF> __device__ __forceinline__ s16x4 tr_read(int vb) {
  s16x4 r; asm volatile("ds_read_b64_tr_b16 %0, %1 offset:%2" : "=&v"(r) : "v"(vb), "i"(OFF) : "memory"); return r;
}
template <int D0> __device__ __forceinline__ void pv_one(f32x16& od, int vb, bf16x8 pa0, bf16x8 pa1, bf16x8 pa2, bf16x8 pa3) {
  const s16x4 l0 = tr_read<v_rd_off(D0, 0, 0)>(vb), h0 = tr_read<v_rd_off(D0, 0, 1)>(vb), l1 = tr_read<v_rd_off(D0, 1, 0)>(vb), h1 = tr_read<v_rd_off(D0, 1, 1)>(vb);
  const s16x4 l2 = tr_read<v_rd_off(D0, 2, 0)>(vb), h2 = tr_read<v_rd_off(D0, 2, 1)>(vb), l3 = tr_read<v_rd_off(D0, 3, 0)>(vb), h3 = tr_read<v_rd_off(D0, 3, 1)>(vb);
  asm volatile("s_waitcnt lgkmcnt(0)" ::: "memory"); SBAR();
#define PK(L, H) (bf16x8){L[0], L[1], L[2], L[3], H[0], H[1], H[2], H[3]}
  od = __builtin_amdgcn_mfma_f32_32x32x16_bf16(pa0, PK(l0, h0), od, 0, 0, 0);
  od = __builtin_amdgcn_mfma_f32_32x32x16_bf16(pa1, PK(l1, h1), od, 0, 0, 0);
  od = __builtin_amdgcn_mfma_f32_32x32x16_bf16(pa2, PK(l2, h2), od, 0, 0, 0);
  od = __builtin_amdgcn_mfma_f32_32x32x16_bf16(pa3, PK(l3, h3), od, 0, 0, 0);
#undef PK
}
__device__ __forceinline__ void pv_d0(f32x16* o, int vb, bf16x8 pa0, bf16x8 pa1, bf16x8 pa2, bf16x8 pa3) {
  pv_one<0>(o[0], vb, pa0, pa1, pa2, pa3); pv_one<1>(o[1], vb, pa0, pa1, pa2, pa3); pv_one<2>(o[2], vb, pa0, pa1, pa2, pa3); pv_one<3>(o[3], vb, pa0, pa1, pa2, pa3);
}

__device__ __forceinline__ void attn_unit(const bf16* __restrict__ P, int qrow0, int krow0, int NT, int h, float lam, float oml, const float* __restrict__ subg, bf16* __restrict__ AO, char* lds) {
  constexpr int LDK = LDPA;
  const int tid = opaque_tid(), wid = __builtin_amdgcn_readfirstlane(tid >> 6), lane = tid & 63, r32 = lane & 31, hi = lane >> 5;
  const int mp = wid >> 2, wq = wid & 3;
  bf16* V_lds = (bf16*)lds; bf16* K_lds = (bf16*)(lds + 2 * SHM_V);
  float* ws = (float*)(lds + 2 * SHM_V + 2 * SHM_K) + wid * 64; float* li_l = ws; float* al_l = ws + 32;
  float m_reg = -1e30f, l_reg = 0; f32x16 o[4] = {}; bf16x8 qr[4];
  const bf16* Qw = P + (size_t)(qrow0 + wq * 32 + r32) * LDK + PC_Q + h * 128 + mp * 64 + hi * 8;
#pragma unroll
  for (int d0 = 0; d0 < 4; ++d0) qr[d0] = ld8(Qw + d0 * 16);
  const bf16* Kh = P + (size_t)krow0 * LDK + PC_K + h * 128; const bf16* Vh = P + (size_t)krow0 * LDK + PC_V + h * 128;
  const int cbase = mp * 64;
  const int sr = tid >> 4, sc = (tid & 15) * 8, vst0 = v_st(sr, sc), vst1 = v_st(32 + sr, sc);
  const int vb0 = (int)(uintptr_t)V_lds + v_rd_base(lane);
  struct { bf16x8 vs0, vs1, ks0, ks1; } sr_[2];
#define SLOAD(i, k0) do { sr_[i].vs0 = ld8(&Vh[(size_t)((k0) + sr) * LDK + sc]); sr_[i].vs1 = ld8(&Vh[(size_t)((k0) + 32 + sr) * LDK + sc]); \
    sr_[i].ks0 = ld8(&Kh[(size_t)((k0) + sr) * LDK + sc]); sr_[i].ks1 = ld8(&Kh[(size_t)((k0) + 32 + sr) * LDK + sc]); } while (0)
#define SWRITE(b, i) do { *(bf16x8*)((char*)V_lds + (b) * SHM_V + vst0) = sr_[i].vs0;          \
    *(bf16x8*)((char*)V_lds + (b) * SHM_V + vst1) = sr_[i].vs1; int kc = sc * 2;               \
    *(bf16x8*)((char*)K_lds + (b) * SHM_K + KSWZ(sr, kc)) = sr_[i].ks0;                       \
    *(bf16x8*)((char*)K_lds + (b) * SHM_K + KSWZ(32 + sr, kc)) = sr_[i].ks1; } while (0)
#define SWAIT() asm volatile("s_waitcnt vmcnt(4)" ::: "memory")
#define RESC(a) do { if (__any((a) < 1.f)) { if (hi == 0) al_l[r32] = (a); asm volatile("s_waitcnt lgkmcnt(0)" ::: "memory"); \
    _Pragma("unroll") for (int d = 0; d < 4; ++d) _Pragma("unroll") for (int r = 0; r < 16; ++r) o[d][r] *= al_l[crow(r, hi)]; } } while (0)
  f32x16 pA0, pA1, pB0, pB1; float mnA, mnB, alA, alB; bf16x8 pa0, pa1, pa2, pa3;
  constexpr int SE = 0, SO = 1;
  SLOAD(SE, 0); asm volatile("s_waitcnt vmcnt(0)" ::: "memory"); SWRITE(0, SE); __syncthreads();
  qkt(pA0, pA1, K_lds, qr, r32, hi, cbase); partialSM(pA0, pA1, m_reg, mnA, alA);
  SLOAD(SO, KVBLK); if (2 < NT) SLOAD(SE, 2 * KVBLK);
  SWAIT(); SWRITE(1, SO); __syncthreads();
  for (int j = 1; j + 1 < NT; j += 2) {
    SBAR(); qkt(pB0, pB1, (bf16*)((char*)K_lds + SHM_K), qr, r32, hi, cbase);
    finishSM(pA0, pA1, alA, l_reg, pa0, pa1, pa2, pa3); SBAR();
    SLOAD(SO, (j + 2) * KVBLK); SBAR();
    pv_d0(o, vb0, pa0, pa1, pa2, pa3); partialSM(pB0, pB1, m_reg, mnB, alB);
    __syncthreads(); SWAIT(); SWRITE(0, SE);
    RESC(alB); __syncthreads();
    SBAR(); qkt(pA0, pA1, K_lds, qr, r32, hi, cbase);
    finishSM(pB0, pB1, alB, l_reg, pa0, pa1, pa2, pa3); SBAR();
    if (j + 3 < NT) SLOAD(SE, (j + 3) * KVBLK); SBAR();
    pv_d0(o, vb0 + (int)SHM_V, pa0, pa1, pa2, pa3); partialSM(pA0, pA1, m_reg, mnA, alA);
    __syncthreads(); SWAIT(); SWRITE(1, SO);
    RESC(alA); __syncthreads();
  }
  SBAR(); qkt(pB0, pB1, (bf16*)((char*)K_lds + SHM_K), qr, r32, hi, cbase);
  finishSM(pA0, pA1, alA, l_reg, pa0, pa1, pa2, pa3); SBAR();
  pv_d0(o, vb0, pa0, pa1, pa2, pa3); partialSM(pB0, pB1, m_reg, mnB, alB);
  __syncthreads(); RESC(alB);
  finishSM(pB0, pB1, alB, l_reg, pa0, pa1, pa2, pa3); SBAR();
  pv_d0(o, vb0 + (int)SHM_V, pa0, pa1, pa2, pa3);
  if (hi == 0) li_l[r32] = l_reg; asm volatile("s_waitcnt lgkmcnt(0)" ::: "memory");
  float rli[16];
#pragma unroll
  for (int r = 0; r < 16; ++r) rli[r] = __builtin_amdgcn_rcpf(li_l[crow(r, hi)]);
  __syncthreads();
  { float* OB = (float*)lds + mp * (128 * 128) + (wq * 32) * 128;
#pragma unroll
    for (int r = 0; r < 16; ++r) { const int orow = crow(r, hi);
#pragma unroll
      for (int d0 = 0; d0 < 4; ++d0) OB[orow * 128 + d0 * 32 + r32] = o[d0][r] * rli[r]; } }
  __syncthreads();
  { const int row = tid >> 2, qd = tid & 3;
    const f32x4* A4 = (const f32x4*)((const float*)lds + row * 128 + qd * 32); const f32x4* B4 = A4 + (128 * 128) / 4;
    f32x4 dv[8]; float ss = 0.f;
#pragma unroll
    for (int j = 0; j < 8; ++j) { dv[j] = A4[j] - lam * B4[j]; ss += (dv[j][0] * dv[j][0] + dv[j][1] * dv[j][1]) + (dv[j][2] * dv[j][2] + dv[j][3] * dv[j][3]); }
    ss += __shfl_xor(ss, 1); ss += __shfl_xor(ss, 2);
    const float rstd = __builtin_amdgcn_rsqf(ss * (1.0f / 128.0f) + 1e-5f) ;
    const f32x4* g4 = (const f32x4*)(subg + qd * 32);
    bf16* op = AO + (size_t)(qrow0 + row) * DM + h * 128 + qd * 32;
#pragma unroll
    for (int j = 0; j < 4; ++j) { const f32x4 g0 = g4[2 * j], g1 = g4[2 * j + 1]; const f32x4 a = dv[2 * j] * rstd, b = dv[2 * j + 1] * rstd;
      u32x4 w; w.x = cvtpk(a[0] * g0[0] * oml, a[1] * g0[1] * oml); w.y = cvtpk(a[2] * g0[2] * oml, a[3] * g0[3] * oml);
      w.z = cvtpk(b[0] * g1[0] * oml, b[1] * g1[1] * oml); w.w = cvtpk(b[2] * g1[2] * oml, b[3] * g1[3] * oml);
      *(u32x4*)(op + j * 8) = w; } }
  __syncthreads();
#undef SLOAD
#undef SWRITE
#undef SWAIT
#undef RESC
}
#undef SBAR
}
__device__ __forceinline__ int scan_pos(int n, int d) { return d == 0 ? n : (n < CL ? (CL - 1) - n : (NPB + CL - 1) - n); }
typedef short sbf16x8 __attribute__((ext_vector_type(8)));
typedef float f32x2_t __attribute__((ext_vector_type(2))); typedef __bf16 bf16x2_t __attribute__((ext_vector_type(2)));
__device__ __forceinline__ unsigned cvtpk_bf(float lo, float hi) { f32x2_t v = {lo, hi}; bf16x2_t b = __builtin_convertvector(v, bf16x2_t); return __builtin_bit_cast(unsigned, b); }
__device__ __forceinline__ void scan_chain(int chain, const unsigned char* __restrict__ OPS, float* __restrict__ Y, LAS unsigned char* lds) {
    const int tid = opaque_tid(), wid = __builtin_amdgcn_readfirstlane(tid >> 6), lane = tid & 63, v15 = lane & 15, q = lane >> 4;
    const int d = chain >> 4, b = (chain >> 3) & 1, h = chain & 7;
    const unsigned char* rec = OPS + (size_t)chain * NCHUNK * OPS_REC;
    v4u g0, g1;
#define SCL_LOAD(c) do { const v4u* r_ = (const v4u*)(rec + (size_t)(c) * OPS_REC); g0 = r_[tid]; if (tid < 256) g1 = r_[512 + tid]; } while (0)
#define SCL_WRITE(buf) do { LAS v4u* o_ = (LAS v4u*)(lds + (buf) * OPS_REC); o_[tid] = g0; if (tid < 256) o_[512 + tid] = g1; } while (0)
    f32x4 S[4];
#pragma unroll
    for (int rt = 0; rt < 4; ++rt) S[rt] = (f32x4){0.f, 0.f, 0.f, 0.f};
    float* yo = Y + ((size_t)d * NR + (size_t)b * NPB) * 512 + h * 64 + wid * 16 + v15;
    SCL_LOAD(0); SCL_WRITE(0); __syncthreads();
    for (int c = 0; c < NCHUNK; ++c) {
        const int buf = c & 1;
        if (c + 1 < NCHUNK) SCL_LOAD(c + 1);
        if (wid < 4) {
            const LAS unsigned char* rb = lds + buf * OPS_REC;
            const LAS sbf16x8* T8 = (const LAS sbf16x8*)rb + lane;
            const sbf16x8 XT0 = T8[0], XT1 = T8[64], RT0 = T8[128], RT1 = T8[192], MT = T8[256], BK0 = T8[320], BK1 = T8[384], BK2 = T8[448], BK3 = T8[512];
            const v2u qt = *(const LAS v2u*)(rb + OR_QT + lane * 8);
            const v2u vq = *(const LAS v2u*)(rb + OR_VT + ((wid * 16 + v15) * 16 + 4 * q) * 2);
            const LAS f32x4* W4 = (const LAS f32x4*)(rb + OR_WC) + q;
            const f32x4 wc0 = W4[0], wc1 = W4[4], wc2 = W4[8], wc3 = W4[12];
            v4u t;
            t[0] = cvtpk_bf(S[0][0], S[0][1]); t[1] = cvtpk_bf(S[0][2], S[0][3]); t[2] = cvtpk_bf(S[1][0], S[1][1]); t[3] = cvtpk_bf(S[1][2], S[1][3]);
            const sbf16x8 bs0 = __builtin_bit_cast(sbf16x8, t);
            t[0] = cvtpk_bf(S[2][0], S[2][1]); t[1] = cvtpk_bf(S[2][2], S[2][3]); t[2] = cvtpk_bf(S[3][0], S[3][1]); t[3] = cvtpk_bf(S[3][2], S[3][3]);
            const sbf16x8 bs1 = __builtin_bit_cast(sbf16x8, t);
            t[0] = vq[0]; t[1] = vq[1]; t[2] = 0u; t[3] = 0u; const sbf16x8 vz = __builtin_bit_cast(sbf16x8, t);
            t[0] = qt[0]; t[1] = qt[1]; t[2] = 0u; t[3] = 0u; const sbf16x8 qz = __builtin_bit_cast(sbf16x8, t);
            f32x4 D = (f32x4){0.f, 0.f, 0.f, 0.f};
            D = __builtin_amdgcn_mfma_f32_16x16x32_bf16(XT0, bs0, D, 0, 0, 0);
            D = __builtin_amdgcn_mfma_f32_16x16x32_bf16(XT1, bs1, D, 0, 0, 0);
            D = __builtin_amdgcn_mfma_f32_16x16x32_bf16(qz, vz, D, 0, 0, 0);
            f32x4 Yv = (f32x4){0.f, 0.f, 0.f, 0.f};
            Yv = __builtin_amdgcn_mfma_f32_16x16x32_bf16(RT0, bs0, Yv, 0, 0, 0);
            Yv = __builtin_amdgcn_mfma_f32_16x16x32_bf16(RT1, bs1, Yv, 0, 0, 0);
            t[0] = cvtpk_bf(D[0], D[1]); t[1] = cvtpk_bf(D[2], D[3]); t[2] = vq[0]; t[3] = vq[1]; const sbf16x8 dv = __builtin_bit_cast(sbf16x8, t);
            Yv = __builtin_amdgcn_mfma_f32_16x16x32_bf16(MT, dv, Yv, 0, 0, 0);
            S[0] = __builtin_amdgcn_mfma_f32_16x16x32_bf16(BK0, dv, S[0] * wc0, 0, 0, 0);
            S[1] = __builtin_amdgcn_mfma_f32_16x16x32_bf16(BK1, dv, S[1] * wc1, 0, 0, 0);
            S[2] = __builtin_amdgcn_mfma_f32_16x16x32_bf16(BK2, dv, S[2] * wc2, 0, 0, 0);
            S[3] = __builtin_amdgcn_mfma_f32_16x16x32_bf16(BK3, dv, S[3] * wc3, 0, 0, 0);
#pragma unroll
            for (int i = 0; i < 4; ++i) yo[(size_t)scan_pos(c * 16 + 4 * q + i, d) * 512] = Yv[i];
        }
        if (c + 1 < NCHUNK) SCL_WRITE(buf ^ 1);
        __syncthreads();
    }
#undef SCL_LOAD
#undef SCL_WRITE
}

__device__ __forceinline__ void transpose_item(const float* __restrict__ W, int K, int N, bf16* __restrict__ WT, int out_row0, int k0, int n0, LAS float* scr, int lane) {
#pragma unroll 8
    for (int i = 0; i < 32; ++i) { const int kk = 2 * i + (lane >> 5); scr[kk * 33 + (lane & 31)] = W[(size_t)(k0 + kk) * N + n0 + (lane & 31)]; }
    LDS_WAIT(); asm volatile("" ::: "memory");
    const int c = lane & 7;
#pragma unroll
    for (int j = 0; j < 4; ++j) { const int n = (lane >> 3) + 8 * j; const LAS float* s = scr + (8 * c) * 33 + n;
        v4u o; o.x = pk2(s[0 * 33], s[1 * 33]); o.y = pk2(s[2 * 33], s[3 * 33]); o.z = pk2(s[4 * 33], s[5 * 33]); o.w = pk2(s[6 * 33], s[7 * 33]);
        *(v4u*)(WT + (size_t)(out_row0 + n) * K + k0 + 8 * c) = o; }
    LDS_WAIT(); asm volatile("" ::: "memory");
}
__device__ __forceinline__ void transpose_matrix_item(const float* W, int K, int N, bf16* WT, int item, int il_half  , LAS float* scr, int lane) {
    const int nblk = N / 32, kb = item / nblk, nb = item - kb * nblk, n0 = 32 * nb;
    const int orow = (il_half < 0) ? n0 : ((n0 >> 7) * 256 + il_half * 128 + (n0 & 127));
    transpose_item(W, K, N, WT, orow, 64 * kb, n0, scr, lane);
}

struct Ptrs {
    const float* in[34]; float* out; unsigned char* ws;
};
#define IN_X 0
#define IN_C 1
#define IN_CTX 2
#define IN_CCTX 3
#define IN_ADAW 4
#define IN_ADAB 5
#define IN_N1G 6
#define IN_N2G 7
#define IN_WIN 8
#define IN_WOUT 9
#define IN_DLAM 10
#define IN_SUBG 11
#define IN_MU 12
#define IN_W0 13
#define IN_W2 14
#define IN_A0 15
#define IN_A2 16
#define IN_V0 17
#define IN_V1 18
#define IN_V2 19
#define IN_G2 20
#define IN_KK 21
#define IN_KA 22
#define IN_RK 23
#define IN_LNW 24
#define IN_LNB 25
#define IN_FW1 26
#define IN_FW3 27
#define IN_FW2 28
#define IN_ROUTER 29
#define IN_EW1 30
#define IN_EW3 31
#define IN_EW2 32
#define IN_FINALG 33

__device__ __forceinline__ void phase_prologue(const Args& a, LAS unsigned char* lds, int vcu, int G) {
    const int tid = opaque_tid(), lane = tid & 63, wave = __builtin_amdgcn_readfirstlane(tid >> 6);
    unsigned char* ws = opaque_ptr(a.ws);
    LAS float* scr = (LAS float*)(lds + wave * 8704);
    LAS float* sl = (LAS float*)(lds + 73728);
    for (int i = tid; i < 3072; i += NTHR) { const float v = (i < 2048) ? a.in[IN_C][i] : a.in[IN_CCTX][i - 2048]; sl[i] = v * sigmoid_f(v); }
    __syncthreads();
    const int gw = vcu * NWAVES + wave, NGW = G * NWAVES;
    constexpr int T_MOD = 4 * 96;
    constexpr int I_WIN = 16 * (NIN / 32), I_WOUT = 16 * 32, I_F13 = 16 * (DFF / 32), I_F2 = (DFF / 64) * 32;
    constexpr int T_WIN = 4 * I_WIN, T_WOUT = 4 * I_WOUT, T_F1 = 2 * I_F13, T_F3 = 2 * I_F13, T_F2 = 2 * I_F2;
    constexpr int T_PAD = 4 * 32, T_ROPE = 64, T_LAM = 4;
    constexpr int NT = T_MOD + T_WIN + T_WOUT + T_F1 + T_F3 + T_F2 + T_PAD + T_ROPE + T_LAM;
    float* MOD = (float*)(ws + WS_MOD);
    for (int it = gw; it < NT; it += NGW) {
        int r = it;
        if (r < T_MOD) {
            const int l = r / 96, jg = r - l * 96; const float* aw = a.in[IN_ADAW] + (size_t)l * 1024 * 6144 + jg * 64 + lane;
            float a0 = 0.f, a1 = 0.f, a2 = 0.f;
#pragma unroll 8
            for (int i = 0; i < 1024; ++i) { const float w = aw[(size_t)i * 6144]; a0 += sl[i] * w; a1 += sl[1024 + i] * w; a2 += sl[2048 + i] * w; }
            const float bb = a.in[IN_ADAB][l * 6144 + jg * 64 + lane];
            MOD[(l * 3 + 0) * 6144 + jg * 64 + lane] = a0 + bb; MOD[(l * 3 + 1) * 6144 + jg * 64 + lane] = a1 + bb; MOD[(l * 3 + 2) * 6144 + jg * 64 + lane] = a2 + bb;
            continue; }
        r -= T_MOD;
        if (r < T_WIN) { const int l = r / I_WIN; transpose_matrix_item(a.in[IN_WIN] + (size_t)l * DM * NIN, DM, NIN, (bf16*)(ws + WS_WINT) + (size_t)l * NINP * DM, r - l * I_WIN, -1, scr, lane); continue; }
        r -= T_WIN;
        if (r < T_WOUT) { const int l = r / I_WOUT; transpose_matrix_item(a.in[IN_WOUT] + (size_t)l * DM * DM, DM, DM, (bf16*)(ws + WS_WOUTT) + (size_t)l * DM * DM, r - l * I_WOUT, -1, scr, lane); continue; }
        r -= T_WOUT;
        if (r < T_F1) { const int l = r / I_F13; transpose_matrix_item(a.in[IN_FW1] + (size_t)l * DM * DFF, DM, DFF, (bf16*)(ws + WS_W13T) + (size_t)l * 2 * DFF * DM, r - l * I_F13, 0, scr, lane); continue; }
        r -= T_F1;
        if (r < T_F3) { const int l = r / I_F13; transpose_matrix_item(a.in[IN_FW3] + (size_t)l * DM * DFF, DM, DFF, (bf16*)(ws + WS_W13T) + (size_t)l * 2 * DFF * DM, r - l * I_F13, 1, scr, lane); continue; }
        r -= T_F3;
        if (r < T_F2) { const int l = r / I_F2; transpose_matrix_item(a.in[IN_FW2] + (size_t)l * DFF * DM, DFF, DM, (bf16*)(ws + WS_W2T) + (size_t)l * DM * DFF, r - l * I_F2, -1, scr, lane); continue; }
        r -= T_F2;
        if (r < T_PAD) { const int l = r >> 5, row = NIN + (r & 31); v4u z = {0u, 0u, 0u, 0u}; v4u* o = (v4u*)((bf16*)(ws + WS_WINT) + ((size_t)l * NINP + row) * DM) + lane * 2; o[0] = z; o[1] = z; continue; }
        r -= T_PAD;
        if (r < T_ROPE) { const int e = r * 64 + lane, pos = e >> 4, j = e & 15;
            const float inv = __builtin_amdgcn_exp2f(-(float)(2 * j) * (13.287712379549449f / 32.0f)); const float ang = (float)pos * inv;
            float2* T = (float2*)(ws + WS_ROPE); T[e] = make_float2(cosf(ang), sinf(ang)); continue; }
        r -= T_ROPE;
        { const int l = r; const float* lp = a.in[IN_DLAM] + l * 256;
          const float s0 = wave_sum(lp[lane] * lp[64 + lane]), s1 = wave_sum(lp[128 + lane] * lp[192 + lane]);
          const float li = 0.8f - 0.6f * expf(-0.3f * (float)l);
          if (lane == 0) { float* L = (float*)(ws + WS_LAM); L[l * 2] = expf(s0) - expf(s1) + li; L[l * 2 + 1] = 1.0f - li; } }
    }
    { bf16* LB = (bf16*)(ws + WS_LORA);
      for (int o = (vcu * NTHR + tid); o < LO_TOTAL; o += G * NTHR) {
          float v;
          if (o < LO_A2) { const int m = o >> 14, r = o & 16383, chn = r >> 5, j = r & 31; v = a.in[IN_W2][((size_t)m * 32 + j) * 512 + chn]; }
          else if (o < LO_V2) { const int q = o - LO_A2; const int m = q >> 14, r = q & 16383, chn = r >> 5, j = r & 31; v = a.in[IN_A2][((size_t)m * 32 + j) * 512 + chn]; }
          else if (o < LO_G2) { const int q = o - LO_V2; const int m = q >> 14, r = q & 16383, chn = r >> 5, j = r & 31; v = a.in[IN_V2][((size_t)m * 32 + j) * 512 + chn]; }
          else if (o < LO_V1) { const int q = o - LO_G2; const int m = q / 49152, r = q - m * 49152, chn = r / 96, j = r - chn * 96; v = a.in[IN_G2][((size_t)m * 96 + j) * 512 + chn]; }
          else { const int q = o - LO_V1; const int m = q >> 14, r = q & 16383, j = r >> 9, chn = r & 511; v = a.in[IN_V1][((size_t)m * 512 + chn) * 32 + j]; }
          LB[o] = (bf16)f2bf(v); } }
}

__device__ __forceinline__ void phase_norm(const Args& a, LAS unsigned char* lds, int vcu, int G, int l, int which_norm, bool moe) {
    const int tid = opaque_tid(), lane = tid & 63, wave = __builtin_amdgcn_readfirstlane(tid >> 6);
    unsigned char* ws = opaque_ptr(a.ws);
    LAS float* tabA = (LAS float*)lds; LAS float* tabB = tabA + 3072; LAS float* rwT = tabB + 3072;
    const float* MOD = (const float*)(ws + WS_MOD) + (size_t)l * 3 * 6144;
    const float* ng = a.in[which_norm ? IN_N2G : IN_N1G] + l * 1024;
    const int off_sh = which_norm ? 3072 : 0, off_sc = off_sh + 1024;
    for (int i = tid; i < 3072; i += NTHR) { const int w = i >> 10, c = i & 1023; tabA[i] = ng[c] * (1.0f + MOD[w * 6144 + off_sc + c]); tabB[i] = MOD[w * 6144 + off_sh + c]; }
    if (moe) { const float* rw = a.in[IN_ROUTER] + (size_t)(l >> 1) * 1024 * 8; for (int i = tid; i < 8192; i += NTHR) { const int c = i >> 3, e = i & 7; rwT[e * 1024 + c] = rw[i]; } }
    __syncthreads();
    const float* srcLat = (l == 0 && which_norm == 0) ? a.in[IN_X] : a.out;
    const float* srcCtx = (l == 0 && which_norm == 0) ? a.in[IN_CTX] : (const float*)(ws + WS_XC);
    bf16* HN = (bf16*)(ws + WS_HN);
    const int gw = vcu * NWAVES + wave, NGW = G * NWAVES;
    for (int R = gw; R < NR; R += NGW) {
        const int b = R / NPB, p = R - b * NPB; const int w = (p < CL) ? 2 : b;
        const float* xr = (p < CL) ? srcCtx + (size_t)(b * CL + p) * 1024 : srcLat + ((size_t)b * SEQ + (p - CL)) * 1024;
        const f32x4* x4 = (const f32x4*)xr + lane;
        f32x4 v[4]; float ss = 0.f;
#pragma unroll
        for (int j = 0; j < 4; ++j) { v[j] = x4[64 * j]; ss += (v[j][0] * v[j][0] + v[j][1] * v[j][1]) + (v[j][2] * v[j][2] + v[j][3] * v[j][3]); }
        const float rstd = 1.0f / sqrtf(wave_sum(ss) * (1.0f / 1024.0f) + 1e-6f);
        const LAS f32x4* A4 = (const LAS f32x4*)(tabA + w * 1024) + lane; const LAS f32x4* B4 = (const LAS f32x4*)(tabB + w * 1024) + lane;
        unsigned long long* o8 = (unsigned long long*)(HN + (size_t)R * 1024) + lane;
#pragma unroll
        for (int j = 0; j < 4; ++j) { v[j] = (v[j] * rstd) * A4[64 * j] + B4[64 * j];
            o8[64 * j] = (unsigned long long)pk2(v[j][0], v[j][1]) | ((unsigned long long)pk2(v[j][2], v[j][3]) << 32); }
        if (moe) {
            float lg[8];
#pragma unroll
            for (int e = 0; e < 8; ++e) { const LAS f32x4* r4 = (const LAS f32x4*)(rwT + e * 1024) + lane; float s = 0.f;
#pragma unroll
                for (int j = 0; j < 4; ++j) { const f32x4 rr = r4[64 * j]; s += (v[j][0] * rr[0] + v[j][1] * rr[1]) + (v[j][2] * rr[2] + v[j][3] * rr[3]); }
                lg[e] = wave_sum(s); }
            int e1 = 0; float v1 = lg[0];
#pragma unroll
            for (int e = 1; e < 8; ++e) if (lg[e] > v1) { v1 = lg[e]; e1 = e; }
            int e2 = -1; float v2 = -3.0e38f;
#pragma unroll
            for (int e = 0; e < 8; ++e) if (e != e1 && lg[e] > v2) { v2 = lg[e]; e2 = e; }
            if (lane == 0) {
                const float g1 = 1.0f / (1.0f + __expf(v2 - v1)), g2 = 1.0f - g1;
                unsigned* cnt = (unsigned*)(ws + WS_CTL) + CW_CNT + (((l >> 1) * 2 + b) * 8) * 64;
                const unsigned p1 = atomicAdd(cnt + 64 * e1, 1u), p2 = atomicAdd(cnt + 64 * e2, 1u);
                unsigned* ro = (unsigned*)(ws + WS_ROUTE) + (size_t)R * 8;
                ro[0] = (unsigned)e1; ro[1] = (unsigned)e2; ro[2] = p1; ro[3] = p2; ro[4] = __float_as_uint(g1); ro[5] = __float_as_uint(g2);
            }
        }
    }
    if (moe) {
        LAS float* scr = (LAS float*)(lds + 57344 + wave * 8704);
        const int li = l >> 1;
        constexpr int I_13 = 16 * (DFE / 32), I_2 = (DFE / 64) * 32;
        constexpr int NTK = 8 * (2 * I_13 + I_2);
        for (int it = gw; it < NTK; it += NGW) {
            const int e = it / (2 * I_13 + I_2); int r = it - e * (2 * I_13 + I_2);
            if (r < I_13) { transpose_matrix_item(a.in[IN_EW1] + ((size_t)li * 8 + e) * DM * DFE, DM, DFE, (bf16*)(ws + WS_W13E) + (size_t)e * 2 * DFE * DM, r, 0, scr, lane); continue; }
            r -= I_13;
            if (r < I_13) { transpose_matrix_item(a.in[IN_EW3] + ((size_t)li * 8 + e) * DM * DFE, DM, DFE, (bf16*)(ws + WS_W13E) + (size_t)e * 2 * DFE * DM, r, 1, scr, lane); continue; }
            r -= I_13;
            transpose_matrix_item(a.in[IN_EW2] + ((size_t)li * 8 + e) * DFE * DM, DFE, DM, (bf16*)(ws + WS_W2E) + (size_t)e * DM * DFE, r, -1, scr, lane);
        }
    }
}
__device__ __forceinline__ float dpp_rowsum16(float x) {
    x += __builtin_bit_cast(float, __builtin_amdgcn_update_dpp(0, __builtin_bit_cast(int, x), 0xB1, 0xF, 0xF, true));
    x += __builtin_bit_cast(float, __builtin_amdgcn_update_dpp(0, __builtin_bit_cast(int, x), 0x4E, 0xF, 0xF, true));
    x += __builtin_bit_cast(float, __builtin_amdgcn_update_dpp(0, __builtin_bit_cast(int, x), 0x141, 0xF, 0xF, true));
    x += __builtin_bit_cast(float, __builtin_amdgcn_update_dpp(0, __builtin_bit_cast(int, x), 0x140, 0xF, 0xF, true));
    return x;
}
__device__ __forceinline__ void phase_prep(const Args& a, LAS unsigned char* lds, int G, int l, bool do_rope = true) {
    const int tid = opaque_tid(), lane = tid & 63, wave = __builtin_amdgcn_readfirstlane(tid >> 6), c16 = lane & 15, q = lane >> 4;
    unsigned char* ws = opaque_ptr(a.ws);
    const bf16* P = (const bf16*)(ws + WS_PR); bf16* PA = (bf16*)(ws + WS_PA);
    _Float16* SPK = (_Float16*)(ws + WS_SPK); _Float16* DPK = (_Float16*)(ws + WS_DPK); _Float16* VF = (_Float16*)(ws + WS_VFIRST); _Float16* GG = (_Float16*)(ws + WS_G);
    float* BON = (float*)(ws + WS_BONUS); const bf16* LB = (const bf16*)(ws + WS_LORA);
    LAS bf16* sP = (LAS bf16*)lds;
    LAS bf16* sWD = sP + 18 * 1536;
    LAS bf16* sAD = sWD + 16 * 64;
    LAS bf16* sGD = sAD + 16 * 64;
    LAS bf16* sVA = sGD + 16 * 96;
    LAS bf16* sVL = sVA + 16 * 512;
    LAS float* sPart = (LAS float*)(sVL + 16 * 32);
    const int h = wave, ch4 = h * 64 + 4 * c16;
    for (int tile = blockIdx.x; tile < NB * NCHUNK; tile += G) {
        const int b = tile / NCHUNK, tt = tile - b * NCHUNK, p0 = tt * 16;
        const int seg_lo = (tt < 16) ? 0 : CL, seg_hi = (tt < 16) ? CL : NPB;
        const size_t R0 = (size_t)b * NPB + p0;
        for (int pc = tid; pc < 18 * 192; pc += NTHR) { const int rr = pc / 192, cc = pc - rr * 192; const int p = p0 - 1 + rr;
            v4u x = {0u, 0u, 0u, 0u}; if (p >= seg_lo && p < seg_hi) x = *(const v4u*)(P + ((size_t)b * NPB + p) * LDPR + cc * 8);
            *(LAS v4u*)(sP + rr * 1536 + cc * 8) = x; }
        for (int idx = tid; idx < 16 * 224; idx += NTHR) { const int i = idx / 224, cc = idx - i * 224; const float val = bf2f(P[(R0 + i) * LDPR + PC_LORA + cc]);
            if (cc < 64) sWD[i * 64 + cc] = (bf16)f2bf(tanh_f(val)); else if (cc < 128) sAD[i * 64 + cc - 64] = (bf16)f2bf(val); else sGD[i * 96 + cc - 128] = (bf16)f2bf(sigmoid_f(val)); }
        __syncthreads();
        f32x4 rs[4], ks[4], vs[4];
        { f32x4 rw[6], kw[6], vw[6]; const float* mu = a.in[IN_MU] + (size_t)l * 3 * 2 * 512 + ch4;
          const f32x4 mur0 = *(const f32x4*)(mu), mur1 = *(const f32x4*)(mu + 512), muk0 = *(const f32x4*)(mu + 1024), muk1 = *(const f32x4*)(mu + 1536), muv0 = *(const f32x4*)(mu + 2048), muv1 = *(const f32x4*)(mu + 2560);
#pragma unroll
          for (int j = 0; j < 6; ++j) { const LAS bf16* rp = sP + (4 * q + j) * 1536 + ch4;
              const v2u xr = *(const LAS v2u*)(rp), xk = *(const LAS v2u*)(rp + 512), xv = *(const LAS v2u*)(rp + 1024);
              rw[j] = (f32x4){bflo(xr[0]), bfhi(xr[0]), bflo(xr[1]), bfhi(xr[1])}; kw[j] = (f32x4){bflo(xk[0]), bfhi(xk[0]), bflo(xk[1]), bfhi(xk[1])}; vw[j] = (f32x4){bflo(xv[0]), bfhi(xv[0]), bflo(xv[1]), bfhi(xv[1])}; }
#pragma unroll
          for (int i = 0; i < 4; ++i) { rs[i] = rw[i + 1] + mur0 * (rw[i] - rw[i + 1]) + mur1 * (rw[i + 2] - rw[i + 1]);
              ks[i] = kw[i + 1] + muk0 * (kw[i] - kw[i + 1]) + muk1 * (kw[i + 2] - kw[i + 1]);
              vs[i] = vw[i + 1] + muv0 * (vw[i] - vw[i + 1]) + muv1 * (vw[i + 2] - vw[i + 1]); } }
        f32x4 accV[4];
        if (l > 0) {
#pragma unroll
            for (int i = 0; i < 4; ++i) *(LAS v2u*)(sVA + (4 * q + i) * 512 + ch4) = (v2u){pk2(vs[i][0], vs[i][1]), pk2(vs[i][2], vs[i][3])};
            __syncthreads();
            { f32x4 pv0 = {0.f, 0.f, 0.f, 0.f}, pv1 = pv0; const bf16* v1b = LB + LO_V1 + (size_t)(l - 1) * 16384;
#pragma unroll
              for (int s2 = 0; s2 < 2; ++s2) { const sbf16x8 fa = *(const LAS sbf16x8*)(sVA + c16 * 512 + h * 64 + 32 * s2 + 8 * q);
                  const sbf16x8 fb0 = *(const sbf16x8*)(v1b + (size_t)c16 * 512 + h * 64 + 32 * s2 + 8 * q), fb1 = *(const sbf16x8*)(v1b + (size_t)(16 + c16) * 512 + h * 64 + 32 * s2 + 8 * q);
                  pv0 = __builtin_amdgcn_mfma_f32_16x16x32_bf16(fa, fb0, pv0, 0, 0, 0); pv1 = __builtin_amdgcn_mfma_f32_16x16x32_bf16(fa, fb1, pv1, 0, 0, 0); }
#pragma unroll
              for (int i = 0; i < 4; ++i) { sPart[(h * 16 + 4 * q + i) * 32 + c16] = pv0[i]; sPart[(h * 16 + 4 * q + i) * 32 + 16 + c16] = pv1[i]; } }
            __syncthreads();
            { float sacc = 0.f;
#pragma unroll
              for (int hh = 0; hh < 8; ++hh) sacc += sPart[hh * 512 + tid];
              sVL[tid] = (bf16)f2bf(sacc); }
            __syncthreads();
            { const sbf16x8 fa = *(const LAS sbf16x8*)(sVL + c16 * 32 + 8 * q); const bf16* v2b = LB + LO_V2 + ((size_t)(l - 1) * 512 + ch4) * 32 + 8 * q;
#pragma unroll
              for (int ct = 0; ct < 4; ++ct) { const sbf16x8 fb = *(const sbf16x8*)(v2b + ct * 32); accV[ct] = __builtin_amdgcn_mfma_f32_16x16x32_bf16(fa, fb, (f32x4){0.f, 0.f, 0.f, 0.f}, 0, 0, 0); } }
        }
        f32x4 vfin[4];
#pragma unroll
        for (int i = 0; i < 4; ++i) { const size_t R = R0 + 4 * q + i;
            if (l > 0) { const h4 vf = *(const h4*)(VF + R * 512 + ch4); const f32x4 v0p = *(const f32x4*)(a.in[IN_V0] + (l - 1) * 512 + ch4);
#pragma unroll
                for (int cc = 0; cc < 4; ++cc) { const float vp = vs[i][cc]; vfin[i][cc] = vp + ((float)vf[cc] - vp) * sigmoid_f(v0p[cc] + accV[cc][i]); } }
            else { vfin[i] = vs[i]; *(h4*)(VF + R * 512 + ch4) = (h4){(_Float16)vs[i][0], (_Float16)vs[i][1], (_Float16)vs[i][2], (_Float16)vs[i][3]}; } }
        { f32x4 accG[4];
#pragma unroll
          for (int ct = 0; ct < 4; ++ct) accG[ct] = (f32x4){0.f, 0.f, 0.f, 0.f};
#pragma unroll
          for (int s3 = 0; s3 < 3; ++s3) { const sbf16x8 fa = *(const LAS sbf16x8*)(sGD + c16 * 96 + 32 * s3 + 8 * q); const bf16* g2b = LB + LO_G2 + ((size_t)l * 512 + ch4) * 96 + 32 * s3 + 8 * q;
#pragma unroll
              for (int ct = 0; ct < 4; ++ct) { const sbf16x8 fb = *(const sbf16x8*)(g2b + ct * 96); accG[ct] = __builtin_amdgcn_mfma_f32_16x16x32_bf16(fa, fb, accG[ct], 0, 0, 0); } }
#pragma unroll
          for (int i = 0; i < 4; ++i) *(h4*)(GG + (R0 + 4 * q + i) * 512 + ch4) = (h4){(_Float16)accG[0][i], (_Float16)accG[1][i], (_Float16)accG[2][i], (_Float16)accG[3][i]}; }
        f32x4 kkv[4]; const f32x4 kkp = *(const f32x4*)(a.in[IN_KK] + l * 512 + ch4);
#pragma unroll
        for (int i = 0; i < 4; ++i) { const f32x4 t = ks[i] * kkp; float ss = (t[0] * t[0] + t[1] * t[1]) + (t[2] * t[2] + t[3] * t[3]); ss = dpp_rowsum16(ss);
            kkv[i] = t * (1.0f / sqrtf(fmaxf(ss, 1e-24f))); }
        float bon[4] = {0.f, 0.f, 0.f, 0.f};
#pragma unroll 1
        for (int d = 0; d < 2; ++d) {
            f32x4 accW[4], accA[4]; const f32x4 w0d = *(const f32x4*)(a.in[IN_W0] + (l * 2 + d) * 512 + ch4), a0d = *(const f32x4*)(a.in[IN_A0] + (l * 2 + d) * 512 + ch4);
            const f32x4 kap = *(const f32x4*)(a.in[IN_KA] + l * 512 + ch4), rkp = *(const f32x4*)(a.in[IN_RK] + l * 512 + ch4);
            { const sbf16x8 fw = *(const LAS sbf16x8*)(sWD + c16 * 64 + 32 * d + 8 * q), fad = *(const LAS sbf16x8*)(sAD + c16 * 64 + 32 * d + 8 * q);
              const bf16* w2b = LB + LO_W2 + (((size_t)l * 2 + d) * 512 + ch4) * 32 + 8 * q; const bf16* a2b = LB + LO_A2 + (((size_t)l * 2 + d) * 512 + ch4) * 32 + 8 * q;
#pragma unroll
              for (int ct = 0; ct < 4; ++ct) { accW[ct] = __builtin_amdgcn_mfma_f32_16x16x32_bf16(fw, *(const sbf16x8*)(w2b + ct * 32), (f32x4){0.f, 0.f, 0.f, 0.f}, 0, 0, 0);
                  accA[ct] = __builtin_amdgcn_mfma_f32_16x16x32_bf16(fad, *(const sbf16x8*)(a2b + ct * 32), (f32x4){0.f, 0.f, 0.f, 0.f}, 0, 0, 0); } }
#pragma unroll
            for (int i = 0; i < 4; ++i) { const int p = p0 + 4 * q + i; h4 oe, ob, ok;
#pragma unroll
                for (int cc = 0; cc < 4; ++cc) { const float e = 0.6065306597126334f * sigmoid_f(w0d[cc] + accW[cc][i]);
                    const float av = sigmoid_f(a0d[cc] + accA[cc][i]); const float kd = ks[i][cc] * (1.0f + (av - 1.0f) * kap[cc]);
                    oe[cc] = (_Float16)e; ob[cc] = (_Float16)(kkv[i][cc] * av); ok[cc] = (_Float16)kd; bon[i] += rs[i][cc] * kd * rkp[cc]; }
                _Float16* dpk = DPK + ((size_t)(((d * 2 + b) * 8 + h) * NPB) + p) * 192 + 4 * c16;
                *(h4*)dpk = oe; *(h4*)(dpk + 64) = ob; *(h4*)(dpk + 128) = ok; }
        }
#pragma unroll
        for (int i = 0; i < 4; ++i) { const int p = p0 + 4 * q + i;
            _Float16* spk = SPK + ((size_t)((b * 8 + h) * NPB) + p) * 192 + 4 * c16;
            *(h4*)spk = (h4){(_Float16)rs[i][0], (_Float16)rs[i][1], (_Float16)rs[i][2], (_Float16)rs[i][3]};
            *(h4*)(spk + 64) = (h4){(_Float16)kkv[i][0], (_Float16)kkv[i][1], (_Float16)kkv[i][2], (_Float16)kkv[i][3]};
            *(h4*)(spk + 128) = (h4){(_Float16)vfin[i][0], (_Float16)vfin[i][1], (_Float16)vfin[i][2], (_Float16)vfin[i][3]};
            const float bs = dpp_rowsum16(bon[i]);
            if (c16 == 0) BON[(R0 + 4 * q + i) * 8 + h] = bs; }
        __syncthreads();
    }
    if (do_rope) { const float2* RT = (const float2*)(ws + WS_ROPE);
      const int gw = blockIdx.x * NWAVES + wave, NGW = G * NWAVES; const int g = lane & 31, sub = lane >> 5;
      for (int rp = gw; rp < NR / 2; rp += NGW) {
          const int R = rp * 2 + sub; const int b = R / NPB, p = R - b * NPB;
          v4u* pp = (v4u*)(PA + (size_t)R * LDPA + g * 32);
          v4u x[4];
#pragma unroll
          for (int j = 0; j < 4; ++j) x[j] = pp[j];
          if (p < CL && g >= 16) continue;
          float e[32];
#pragma unroll
          for (int j = 0; j < 4; ++j)
#pragma unroll
              for (int k = 0; k < 4; ++k) { e[j * 8 + 2 * k] = bflo(x[j][k]); e[j * 8 + 2 * k + 1] = bfhi(x[j][k]); }
          if (p >= CL) { const int t = p - CL; const int pos = (g & 1) ? (t & 63) : (t >> 6);
#pragma unroll
              for (int j = 0; j < 16; ++j) { const float2 cs = RT[pos * 16 + j]; const float x1 = e[j], x2 = e[16 + j]; e[j] = x1 * cs.x - x2 * cs.y; e[16 + j] = x1 * cs.y + x2 * cs.x; } }
          const float sc = (g < 16) ? QSCALE : 1.0f;
#pragma unroll
          for (int j = 0; j < 4; ++j) { v4u o;
#pragma unroll
              for (int k = 0; k < 4; ++k) o[k] = pk2(e[j * 8 + 2 * k] * sc, e[j * 8 + 2 * k + 1] * sc);
              pp[j] = o; }
      } }
}

__device__ __forceinline__ void phase_prep2(const Args& a, LAS unsigned char* lds, int vcu, int G) {
    const int tid = opaque_tid(), lane = tid & 63, wave = __builtin_amdgcn_readfirstlane(tid >> 6), t15 = lane & 15, q = lane >> 4;
    unsigned char* ws = opaque_ptr(a.ws);
    const _Float16* SPK = (const _Float16*)(ws + WS_SPK); const _Float16* DPK = (const _Float16*)(ws + WS_DPK);
    LAS unsigned char* wl = lds + wave * 16384;
    LAS bf16* sAt = (LAS bf16*)wl; LAS bf16* sBh = sAt + 1024; LAS bf16* sKh = sBh + 1024; LAS bf16* sRt = sKh + 1024; LAS bf16* sXT = sRt + 1024;
    LAS bf16* sBbT = sXT + 1024; LAS bf16* sKbT = sBbT + 1024;
    LAS float* sM = (LAS float*)(sKbT + 1024); LAS float* sQ = sM + 256;
    const int gw = vcu * NWAVES + wave, NGW = G * NWAVES;
    for (int task = gw; task < 32 * NCHUNK; task += NGW) {
        const int chain = task / NCHUNK, c = task - chain * NCHUNK; const int d = chain >> 4, b = (chain >> 3) & 1, h = chain & 7;
        const _Float16* sp = SPK + (size_t)((b * 8 + h) * NPB) * 192; const _Float16* dp = DPK + (size_t)(((d * 2 + b) * 8 + h) * NPB) * 192;
        unsigned char* rec = ws + WS_OPS + ((size_t)chain * NCHUNK + c) * OPS_REC;
        float xa[16], bhv[16], khv[16]; float L = 0.f; unsigned vtp[8];
#pragma unroll
        for (int t = 0; t < 16; ++t) {
            const int p = scan_pos(c * 16 + t, d);
            const float e = (float)dp[(size_t)p * 192 + lane], bb = (float)dp[(size_t)p * 192 + 64 + lane], kd = (float)dp[(size_t)p * 192 + 128 + lane];
            const float r = (float)sp[(size_t)p * 192 + lane], kk = (float)sp[(size_t)p * 192 + 64 + lane], vv = (float)sp[(size_t)p * 192 + 128 + lane];
            const float ep = __expf(L); L -= e; const float en = __expf(-L), ec = __expf(L);
            xa[t] = -kk * ep; bhv[t] = bb * en; khv[t] = kd * en;
            sAt[t * 64 + lane] = (bf16)f2bf(xa[t]); sBh[t * 64 + lane] = (bf16)f2bf(bhv[t]); sKh[t * 64 + lane] = (bf16)f2bf(khv[t]); sRt[t * 64 + lane] = (bf16)f2bf(r * ec);
            if (t & 1) vtp[t >> 1] |= f2bf(vv) << 16; else vtp[t >> 1] = f2bf(vv);
        }
        { const float wc = __expf(L); ((float*)(rec + OR_WC))[lane] = wc;
          v4u o0, o1;
#pragma unroll
          for (int j = 0; j < 4; ++j) { o0[j] = pk2(bhv[2 * j] * wc, bhv[2 * j + 1] * wc); o1[j] = pk2(bhv[8 + 2 * j] * wc, bhv[9 + 2 * j] * wc); }
          ((LAS v4u*)(sBbT + lane * 16))[0] = o0; ((LAS v4u*)(sBbT + lane * 16))[1] = o1;
#pragma unroll
          for (int j = 0; j < 4; ++j) { o0[j] = pk2(khv[2 * j] * wc, khv[2 * j + 1] * wc); o1[j] = pk2(khv[8 + 2 * j] * wc, khv[9 + 2 * j] * wc); }
          ((LAS v4u*)(sKbT + lane * 16))[0] = o0; ((LAS v4u*)(sKbT + lane * 16))[1] = o1;
          v4u* vo = (v4u*)(rec + OR_VT) + lane * 2; vo[0] = (v4u){vtp[0], vtp[1], vtp[2], vtp[3]}; vo[1] = (v4u){vtp[4], vtp[5], vtp[6], vtp[7]}; }
        LDS_WAIT(); asm volatile("" ::: "memory");
        f32x4 mab = {0.f, 0.f, 0.f, 0.f}, mak = mab, mbr = mab, mkr = mab;
#pragma unroll
        for (int s2 = 0; s2 < 2; ++s2) {
            const sbf16x8 fa = *(const LAS sbf16x8*)(sAt + t15 * 64 + 32 * s2 + 8 * q), fb = *(const LAS sbf16x8*)(sBh + t15 * 64 + 32 * s2 + 8 * q);
            const sbf16x8 fk = *(const LAS sbf16x8*)(sKh + t15 * 64 + 32 * s2 + 8 * q), fr = *(const LAS sbf16x8*)(sRt + t15 * 64 + 32 * s2 + 8 * q);
            mab = __builtin_amdgcn_mfma_f32_16x16x32_bf16(fb, fa, mab, 0, 0, 0); mak = __builtin_amdgcn_mfma_f32_16x16x32_bf16(fk, fa, mak, 0, 0, 0);
            mbr = __builtin_amdgcn_mfma_f32_16x16x32_bf16(fb, fr, mbr, 0, 0, 0); mkr = __builtin_amdgcn_mfma_f32_16x16x32_bf16(fk, fr, mkr, 0, 0, 0);
        }
#pragma unroll
        for (int i = 0; i < 4; ++i) { const int j = 4 * q + i; if (j >= t15) { mab[i] = 0.f; mak[i] = 0.f; } if (j > t15) { mbr[i] = 0.f; mkr[i] = 0.f; } }
        *(LAS f32x4*)(sM + t15 * 16 + 4 * q) = mab;
        *(LAS f32x4*)(sQ + t15 * 16 + 4 * q) = mak;
        { v4u mt; mt[0] = pk2(mbr[0], mbr[1]); mt[1] = pk2(mbr[2], mbr[3]); mt[2] = pk2(mkr[0], mkr[1]); mt[3] = pk2(mkr[2], mkr[3]); ((v4u*)rec)[4 * 64 + lane] = mt; }
        LDS_WAIT(); asm volatile("" ::: "memory");
        float qv[16];
#pragma unroll
        for (int t = 0; t < 16; ++t) qv[t] = sQ[t * 16 + t15];
#pragma unroll
        for (int t = 1; t < 16; ++t) {
            float m[16];
#pragma unroll
            for (int j4 = 0; j4 < (t + 3) / 4; ++j4) { const f32x4 mm = *(const LAS f32x4*)(sM + t * 16 + 4 * j4); m[4 * j4] = mm[0]; m[4 * j4 + 1] = mm[1]; m[4 * j4 + 2] = mm[2]; m[4 * j4 + 3] = mm[3]; }
#pragma unroll
            for (int j = 0; j < t; ++j) { xa[t] += m[j] * xa[j]; qv[t] += m[j] * qv[j]; }
        }
        asm volatile("" ::: "memory");
#pragma unroll
        for (int t = 0; t < 16; ++t) { sXT[t * 64 + lane] = (bf16)f2bf(xa[t]); if (q == 0) sQ[t * 16 + t15] = qv[t]; }
        LDS_WAIT(); asm volatile("" ::: "memory");
        { v4u* R4 = (v4u*)rec;
#pragma unroll
          for (int s2 = 0; s2 < 2; ++s2) {
              const v2u x0 = *(const LAS v2u*)(sXT + t15 * 64 + 32 * s2 + 4 * q), x1 = *(const LAS v2u*)(sXT + t15 * 64 + 32 * s2 + 16 + 4 * q);
              R4[s2 * 64 + lane] = (v4u){x0[0], x0[1], x1[0], x1[1]};
              const v2u r0 = *(const LAS v2u*)(sRt + t15 * 64 + 32 * s2 + 4 * q), r1 = *(const LAS v2u*)(sRt + t15 * 64 + 32 * s2 + 16 + 4 * q);
              R4[(2 + s2) * 64 + lane] = (v4u){r0[0], r0[1], r1[0], r1[1]}; }
#pragma unroll
          for (int rt = 0; rt < 4; ++rt) {
              const v2u b0 = *(const LAS v2u*)(sBbT + (16 * rt + t15) * 16 + 4 * q), k0 = *(const LAS v2u*)(sKbT + (16 * rt + t15) * 16 + 4 * q);
              R4[(5 + rt) * 64 + lane] = (v4u){b0[0], b0[1], k0[0], k0[1]}; }
          const f32x4 qq = *(const LAS f32x4*)(sQ + t15 * 16 + 4 * q);
          ((v2u*)(rec + OR_QT))[lane] = (v2u){pk2(qq[0], qq[1]), pk2(qq[2], qq[3])}; }
        LDS_WAIT(); asm volatile("" ::: "memory");
    }
}

__device__ __forceinline__ void phase_mix(const Args& a, LAS unsigned char* lds, volatile LAS unsigned* MISC, int l, int ql, unsigned xcc, bool do_scan = true, bool do_attn = true) {
    const int tid = opaque_tid();
    unsigned char* ws = opaque_ptr(a.ws);
    unsigned* ctl = (unsigned*)(ws + WS_CTL);
    const bf16* P = (const bf16*)(ws + WS_PA);
    if (do_scan) { int xq = (int)(xcc & 7u), tried = 0;
      while (tried < 8) {
          if (tid == 0) MISC[16] = atomicAdd(ctl + CW_QS + (ql * 8 + xq) * 64, 1u);
          __syncthreads(); const unsigned idx = MISC[16]; __syncthreads();
          if (idx >= 4u) { xq = (xq + 1) & 7; ++tried; continue; }
#ifndef NO_SCAN
          scan_chain(xq * 4 + (int)idx, (const unsigned char*)(ws + WS_OPS), (float*)(ws + WS_Y), lds);
#endif
      } }
    if (do_attn) { const float* L = (const float*)(ws + WS_LAM); const float lam = L[l * 2], oml = L[l * 2 + 1];
      const float* subg = a.in[IN_SUBG] + l * 128; bf16* AO = (bf16*)(ws + WS_HN);
      int xq = (int)(xcc & 7u), tried = 0;
      while (tried < 8) {
          if (tid == 0) MISC[16] = atomicAdd(ctl + CW_QA + (ql * 8 + xq) * 64, 1u);
          __syncthreads(); const unsigned idx = MISC[16]; __syncthreads();
          if (idx >= 130u) { xq = (xq + 1) & 7; ++tried; continue; }
          const int b = xq >> 2, h = xq & 3;
#ifndef NO_ATTN
          if (idx < 128u) att::attn_unit(P, b * NPB + CL + (int)idx * 128, b * NPB, NPB / 64, h, lam, oml, subg, AO, (char*)lds);
          else att::attn_unit(P, b * NPB + ((int)idx - 128) * 128, b * NPB, CL / 64, h, lam, oml, subg, AO, (char*)lds);
#endif
      } }
}

__device__ __forceinline__ void phase_finish(const Args& a, int G, int l) {
    const int tid = opaque_tid(), lane = tid & 63, wave = __builtin_amdgcn_readfirstlane(tid >> 6);
    unsigned char* ws = opaque_ptr(a.ws);
    const float* Y = (const float*)(ws + WS_Y); const _Float16* SPK = (const _Float16*)(ws + WS_SPK); const _Float16* GG = (const _Float16*)(ws + WS_G); const float* BON = (const float*)(ws + WS_BONUS);
    bf16* AO = (bf16*)(ws + WS_HN);
    const int ch = tid, h = wave, c = lane;
    const float lw = a.in[IN_LNW][l * 512 + ch], lb = a.in[IN_LNB][l * 512 + ch];
    for (int R = blockIdx.x; R < NR; R += G) {
        const int b = R / NPB, p = R - b * NPB;
        const float y = Y[(size_t)R * 512 + ch] + Y[((size_t)NR + R) * 512 + ch];
        const float mean = wave_sum(y) * (1.0f / 64.0f); const float dv = y - mean; const float var = wave_sum(dv * dv) * (1.0f / 64.0f);
        float o = dv * (1.0f / sqrtf(var + 64e-5f)) * lw + lb;
        const float vv = (float)SPK[((size_t)((b * 8 + h) * NPB) + p) * 192 + 128 + c];
        o += BON[(size_t)R * 8 + h] * vv;
        o *= (float)GG[(size_t)R * 512 + ch];
        AO[(size_t)R * 1024 + 512 + ch] = (bf16)f2bf(o);
    }
}

__device__ __forceinline__ void phase_gather(const Args& a, int vcu, int G, int l, int half) {
    const int tid = opaque_tid(), lane = tid & 63, wave = __builtin_amdgcn_readfirstlane(tid >> 6);
    unsigned char* ws = opaque_ptr(a.ws);
    const unsigned* cnt = (const unsigned*)(ws + WS_CTL) + CW_CNT + (((l >> 1) * 2 + half) * 8) * 64;
    int off[8]; { int r = 0;
#pragma unroll
        for (int e = 0; e < 8; ++e) { off[e] = r; const int n = (int)__hip_atomic_load(cnt + 64 * e, __ATOMIC_RELAXED, __HIP_MEMORY_SCOPE_AGENT); r += ((n + 255) >> 8) << 8; } }
    const bf16* HN = (const bf16*)(ws + WS_HN); bf16* AG = (bf16*)(ws + WS_AG);
    const int gw = vcu * NWAVES + wave, NGW = G * NWAVES;
    for (int rr = gw; rr < NPB; rr += NGW) {
        const int R = half * NPB + rr;
        unsigned* ro = (unsigned*)(ws + WS_ROUTE) + (size_t)R * 8;
        const int e1 = (int)ro[0], e2 = (int)ro[1]; const int p1 = (int)ro[2], p2 = (int)ro[3];
        int o1 = 0, o2 = 0;
#pragma unroll
        for (int e = 0; e < 8; ++e) { if (e == e1) o1 = off[e]; if (e == e2) o2 = off[e]; }
        const int s1 = o1 + p1, s2 = o2 + p2;
        const v4u* src = (const v4u*)(HN + (size_t)R * 1024) + lane * 2; const v4u x0 = src[0], x1 = src[1];
        v4u* d1 = (v4u*)(AG + (size_t)s1 * 1024) + lane * 2; v4u* d2 = (v4u*)(AG + (size_t)s2 * 1024) + lane * 2;
        d1[0] = x0; d1[1] = x1; d2[0] = x0; d2[1] = x1;
        if (lane == 0) { ro[6] = (unsigned)s1; ro[7] = (unsigned)s2; }
    }
}
__device__ __forceinline__ void phase_combine(const Args& a, int vcu, int G, int l, int half) {
    const int tid = opaque_tid(), lane = tid & 63, wave = __builtin_amdgcn_readfirstlane(tid >> 6);
    unsigned char* ws = opaque_ptr(a.ws);
    const bf16* YE = (const bf16*)(ws + WS_YEXP);
    const float* MOD = (const float*)(ws + WS_MOD) + (size_t)l * 3 * 6144 + 5120;
    const int gw = vcu * NWAVES + wave, NGW = G * NWAVES;
    for (int rr = gw; rr < NPB; rr += NGW) {
        const int R = half * NPB + rr; const int b = half, p = rr; const int w = (p < CL) ? 2 : b;
        const unsigned* ro = (const unsigned*)(ws + WS_ROUTE) + (size_t)R * 8;
        const float g1 = __uint_as_float(ro[4]), g2 = __uint_as_float(ro[5]); const int s1 = (int)ro[6], s2 = (int)ro[7];
        float* xr = (p < CL) ? (float*)(ws + WS_XC) + (size_t)(b * CL + p) * 1024 : a.out + ((size_t)b * SEQ + (p - CL)) * 1024;
        const f32x4* gt = (const f32x4*)(MOD + (size_t)w * 6144);
        const v4u* y1 = (const v4u*)(YE + (size_t)s1 * 1024); const v4u* y2 = (const v4u*)(YE + (size_t)s2 * 1024);
#pragma unroll
        for (int j = 0; j < 2; ++j) { const int c8 = lane + 64 * j;
            const v4u u1 = y1[c8], u2 = y2[c8]; f32x4* xp = (f32x4*)xr + c8 * 2; f32x4 x0 = xp[0], x1 = xp[1]; const f32x4 t0 = gt[c8 * 2], t1 = gt[c8 * 2 + 1];
            x0[0] += t0[0] * (g1 * bflo(u1[0]) + g2 * bflo(u2[0])); x0[1] += t0[1] * (g1 * bfhi(u1[0]) + g2 * bfhi(u2[0]));
            x0[2] += t0[2] * (g1 * bflo(u1[1]) + g2 * bflo(u2[1])); x0[3] += t0[3] * (g1 * bfhi(u1[1]) + g2 * bfhi(u2[1]));
            x1[0] += t1[0] * (g1 * bflo(u1[2]) + g2 * bflo(u2[2])); x1[1] += t1[1] * (g1 * bfhi(u1[2]) + g2 * bfhi(u2[2]));
            x1[2] += t1[2] * (g1 * bflo(u1[3]) + g2 * bflo(u2[3])); x1[3] += t1[3] * (g1 * bfhi(u1[3]) + g2 * bfhi(u2[3]));
            xp[0] = x0; xp[1] = x1; }
    }
}
__device__ __forceinline__ void phase_final(const Args& a, int vcu, int G) {
    const int tid = opaque_tid(), lane = tid & 63, wave = __builtin_amdgcn_readfirstlane(tid >> 6);
    const int gw = vcu * NWAVES + wave, NGW = G * NWAVES;
    const f32x4* g4 = (const f32x4*)a.in[IN_FINALG] + lane;
    for (int r = gw; r < NB * SEQ; r += NGW) {
        f32x4* x4 = (f32x4*)(a.out + (size_t)r * 1024) + lane; f32x4 v[4]; float ss = 0.f;
#pragma unroll
        for (int j = 0; j < 4; ++j) { v[j] = x4[64 * j]; ss += (v[j][0] * v[j][0] + v[j][1] * v[j][1]) + (v[j][2] * v[j][2] + v[j][3] * v[j][3]); }
        const float rstd = 1.0f / sqrtf(wave_sum(ss) * (1.0f / 1024.0f) + 1e-6f);
#pragma unroll
        for (int j = 0; j < 4; ++j) x4[64 * j] = (v[j] * rstd) * g4[64 * j];
    }
}
#ifndef MK_MULTI
#define MK_MULTI 0
#endif
constexpr int N_PHASES = 1 + 2 * 10 + 2 * 16 + 1;

__global__ void __launch_bounds__(NTHR, 2) mk_fwd(Args args) {
    extern __shared__ __attribute__((aligned(16))) unsigned char lds_raw[];
    LAS unsigned char* lds = (LAS unsigned char*)lds_raw;
    volatile LAS unsigned* MISC = (volatile LAS unsigned*)(lds + MISC_OFF);
    const int tid = threadIdx.x;
    const int G = gridDim.x; const int bx = blockIdx.x; const int vcu = (G % 8 == 0) ? (bx % 8) * (G / 8) + bx / 8 : bx;
    unsigned char* ws = args.ws;
    unsigned* ctl = (unsigned*)(ws + WS_CTL);
    for (int u = tid; u < (LDS_BYTES - LDSCTL_OFF) / 4; u += NTHR) ((LAS unsigned*)(lds + LDSCTL_OFF))[u] = 0u;
    __syncthreads();
    const int lo = args.ph_lo, hi = args.ph_hi;
    XcdBarrier bar; bar.bar = ctl + CW_BAR; bar.x = xb_xcc_id(); bar.st = MISC + 8;
    if (hi - lo > 1) bar = xcd_barrier_post(ctl + CW_BAR, MISC + 8);
    const unsigned xcc = bar.x;
    int seq = 0;
#ifndef PH_MASK
#define PH_MASK 0xFFFFFFFFu
#endif
#define PH_ON(b) ((PH_MASK >> (b)) & 1u)
#ifndef DUP_SCAN
#define DUP_SCAN true
#endif
#ifndef DUP_ATTN
#define DUP_ATTN true
#endif
#ifndef DUP_MASK
#define DUP_MASK 0u
#endif
#define DUP_ON(b) ((DUP_MASK >> (b)) & 1u)
#define REP(b, stmt) do { if (PH_ON(b)) { stmt; if (DUP_ON(b)) { xcd_barrier(bar); stmt; } } } while (0)
#define PH_BEGIN if (lo <= seq && seq < hi) { unsigned char* ws = opaque_ptr(args.ws); (void)ws;
#define PH_END   if (seq + 1 < hi) xcd_barrier(bar); } ++seq;

    PH_BEGIN REP(0, phase_prologue(args, lds, vcu, G)); PH_END

    for (int l = 0; l < DEPTH; ++l) {
        const bool moe = (l & 1) != 0;
        const float* MODl = (const float*)(ws + WS_MOD) + (size_t)l * 3 * 6144;
        PH_BEGIN if (PH_ON(1)) phase_norm(args, lds, vcu, G, l, 0, false); PH_END
        PH_BEGIN {
            pg8::Gemm g{(const pg8::bf16_t*)(ws + WS_HN), (const pg8::bf16_t*)(ws + WS_WINT) + (size_t)l * NINP * DM, NR, NINP, DM};
            pg8::StaticOrder S; S.init(NR, NINP, G, bx);
            pg8::EpiStoreSplit E{(pg8::bf16_t*)(ws + WS_PA), LDPA, (pg8::bf16_t*)(ws + WS_PR), LDPR, LDPA / 256};
            REP(2, (pg8::gemm_phase<pg8::EpiStoreSplit, pg8::StaticOrder, true, true>(lds, g, S, E)));
        } PH_END
        PH_BEGIN if (PH_ON(3)) { phase_prep(args, lds, G, l); if (DUP_ON(3)) { xcd_barrier(bar); phase_prep(args, lds, G, l, false); } } PH_END
        PH_BEGIN REP(15, phase_prep2(args, lds, vcu, G)); PH_END
        PH_BEGIN if (PH_ON(4)) { phase_mix(args, lds, MISC, l, l, xcc); if (DUP_ON(4)) { xcd_barrier(bar); phase_mix(args, lds, MISC, l, l + 4, xcc, DUP_SCAN, DUP_ATTN); } } PH_END
        PH_BEGIN REP(5, phase_finish(args, G, l)); PH_END
        PH_BEGIN {
            pg8::Gemm g{(const pg8::bf16_t*)(ws + WS_HN), (const pg8::bf16_t*)(ws + WS_WOUTT) + (size_t)l * DM * DM, NR, DM, DM};
            pg8::StaticOrder S; S.init(NR, DM, G, bx);
            pg8::EpiResid E{(l == 0) ? args.in[IN_X] : args.out, (l == 0) ? args.in[IN_CTX] : (const float*)(ws + WS_XC), args.out, (float*)(ws + WS_XC), MODl + 2048};
            if (PH_ON(6)) pg8::gemm_phase<pg8::EpiResid, pg8::StaticOrder, true, true>(lds, g, S, E);
        } PH_END
        PH_BEGIN if (PH_ON(7)) phase_norm(args, lds, vcu, G, l, 1, moe); PH_END
        if (!moe) {
            PH_BEGIN {
                pg8::Gemm g{(const pg8::bf16_t*)(ws + WS_HN), (const pg8::bf16_t*)(ws + WS_W13T) + (size_t)(l >> 1) * 2 * DFF * DM, NR, 2 * DFF, DM};
                pg8::StaticOrder S; S.init(NR, 2 * DFF, G, bx);
                pg8::EpiSwiGLU E{(pg8::bf16_t*)(ws + WS_HF), DFF, 0};
                REP(8, (pg8::gemm_phase<pg8::EpiSwiGLU, pg8::StaticOrder, true, true>(lds, g, S, E)));
            } PH_END
            PH_BEGIN {
                pg8::Gemm g{(const pg8::bf16_t*)(ws + WS_HF), (const pg8::bf16_t*)(ws + WS_W2T) + (size_t)(l >> 1) * DM * DFF, NR, DM, DFF};
                pg8::StaticOrder S; S.init(NR, DM, G, bx);
                pg8::EpiResid E{args.out, (const float*)(ws + WS_XC), args.out, (float*)(ws + WS_XC), MODl + 5120};
                if (PH_ON(9)) pg8::gemm_phase<pg8::EpiResid, pg8::StaticOrder, true, true>(lds, g, S, E);
            } PH_END
        } else {
            for (int half = 0; half < 2; ++half) {
                const unsigned* cnt = (const unsigned*)ctl + CW_CNT + (((l >> 1) * 2 + half) * 8) * 64;
                PH_BEGIN if (PH_ON(10)) phase_gather(args, vcu, G, l, half); PH_END
                PH_BEGIN {
                    pg8::Gemm g{(const pg8::bf16_t*)(ws + WS_AG), (const pg8::bf16_t*)(ws + WS_W13E), 35328, 8 * 2 * DFE, DM};
                    pg8::MoeOrder S; S.init(cnt, (2 * DFE) / 256, G, bx);
                    pg8::EpiSwiGLU E{(pg8::bf16_t*)(ws + WS_HMOE), DFE, (2 * DFE) / 256};
                    REP(11, (pg8::gemm_phase<pg8::EpiSwiGLU, pg8::MoeOrder, true, true>(lds, g, S, E)));
                } PH_END
                PH_BEGIN {
                    pg8::Gemm g{(const pg8::bf16_t*)(ws + WS_HMOE), (const pg8::bf16_t*)(ws + WS_W2E), 35328, 8 * DM, DFE};
                    pg8::MoeOrder S; S.init(cnt, DM / 256, G, bx);
                    pg8::EpiStoreBf16 E{(pg8::bf16_t*)(ws + WS_YEXP), DM, DM / 256};
                    REP(12, (pg8::gemm_phase<pg8::EpiStoreBf16, pg8::MoeOrder, true, true>(lds, g, S, E)));
                } PH_END
                PH_BEGIN if (PH_ON(13)) phase_combine(args, vcu, G, l, half); PH_END
            }
        }
    }
    PH_BEGIN if (PH_ON(14)) phase_final(args, vcu, G); PH_END
#undef PH_BEGIN
#undef PH_END
}

extern "C" void kernel_launch(void* const* d_in, const int* in_sizes, int n_in, void* d_out, int out_size, void* d_ws, size_t ws_size, hipStream_t stream) {
    static int grid = 0;
    if (grid == 0) {
        if (n_in != 34 || out_size != NB * SEQ * DM || ws_size < WS_END) { fprintf(stderr, "kernel_launch: unexpected shapes (n_in %d out %d ws %zu, need %zu)\n", n_in, out_size, ws_size, (size_t)WS_END); grid = -1; return; }
        int dev = 0, cus = 0, per_cu = 0;
        if (hipGetDevice(&dev) != hipSuccess || hipDeviceGetAttribute(&cus, hipDeviceAttributeMultiprocessorCount, dev) != hipSuccess) { grid = -1; return; }
        if (hipFuncSetAttribute((const void*)mk_fwd, hipFuncAttributeMaxDynamicSharedMemorySize, LDS_BYTES) != hipSuccess) { fprintf(stderr, "kernel_launch: hipFuncSetAttribute failed\n"); grid = -1; return; }
        if (hipOccupancyMaxActiveBlocksPerMultiprocessor(&per_cu, (const void*)mk_fwd, NTHR, LDS_BYTES) != hipSuccess || per_cu < 1) fprintf(stderr, "kernel_launch: occupancy query reports %d blocks per CU\n", per_cu);
        (void)hipGetLastError();
        grid = cus;
    }
    if (grid < 0) return;
    if (hipMemsetAsync((char*)d_ws + WS_CTL, 0, CTL_ZERO_BYTES, stream) != hipSuccess) return;
    Args a{};
    for (int i = 0; i < 34; ++i) a.in[i] = (const float*)d_in[i];
    a.out = (float*)d_out; a.ws = (unsigned char*)d_ws;
#if MK_MULTI
    for (int s = 0; s < N_PHASES; ++s) { a.ph_lo = s; a.ph_hi = s + 1; hipLaunchKernelGGL(mk_fwd, dim3(grid), dim3(NTHR), LDS_BYTES, stream, a); }
#else
    a.ph_lo = 0; a.ph_hi = N_PHASES;
    hipLaunchKernelGGL(mk_fwd, dim3(grid), dim3(NTHR), LDS_BYTES, stream, a);
#endif
    const hipError_t le = hipPeekAtLastError();
    if (le != hipSuccess) fprintf(stderr, "kernel_launch: launch failed: %s\n", hipGetErrorName(le));
}
```

```cpp
#include <hip/hip_runtime.h>
#include <cstdio>
#include <cstdint>
__device__ __forceinline__ int opaque_tid() { int t = (int)threadIdx.x; asm volatile("" : "+v"(t)); return t; }
template <class T> __device__ __forceinline__ T* opaque_ptr(T* p) { asm volatile("" : "+s"(p)); return p; }
namespace pg8 {
#define PG8_LAS __attribute__((address_space(3)))
typedef unsigned short bf16_t;
typedef short bf16x8 __attribute__((ext_vector_type(8)));
typedef float f32x4 __attribute__((ext_vector_type(4)));
typedef unsigned u32x4 __attribute__((ext_vector_type(4)));
constexpr int BM = 256, BK = 64, HALF = 128, HTB = HALF * BK * 2  , STAGE_BYTES = 8 * HTB, NXCD = 8, WGM = 8;

__host__ __device__ __forceinline__ int lds_byte(int r, int c) { const int st = (r >> 4) * 2 + (c >> 5), rr = r & 15, cc = c & 31, ob = rr * 64 + cc * 2; return st * 1024 + (ob ^ (((ob >> 9) & 1) << 5)); }
__host__ __device__ __forceinline__ void stage_rc(int b, int& R, int& C) { const int st = b / 1024, sb = b % 1024, swz = sb ^ (((sb >> 9) & 1) << 5); R = (st >> 1) * 16 + swz / 64; C = (st & 1) * 32 + (swz % 64) / 2; }
__host__ __device__ __forceinline__ int perm32(int rho) { const int n = rho >> 4, i = rho & 15; return 8 * (i >> 2) + 4 * n + (i & 3); }

struct Unit { int pm, pn; };
struct Gemm { const bf16_t* A; const bf16_t* Bt; int M, N, K; };

struct StaticOrder {
    int nM, nN, nwg, G, c;
    __host__ __device__ void init(int M, int N, int G_, int c_) { nM = M / BM; nN = N / BM; nwg = nM * nN; G = G_; c = c_; }
    __host__ __device__ bool next(int i, Unit& u) const {
        const long L = (long)i * G + c; if (L >= nwg) return false;
        int wgid = (int)L; { const int q = nwg / NXCD, r = nwg % NXCD, xcd = wgid % NXCD, off = wgid / NXCD; wgid = (xcd < r ? xcd * (q + 1) : r * (q + 1) + (xcd - r) * q) + off; }
        const int nig = WGM * nN, gid = wgid / nig, fm = gid * WGM, gsz = (nM - fm) < WGM ? (nM - fm) : WGM;
        u.pm = fm + ((wgid % nig) % gsz); u.pn = (wgid % nig) / gsz; return true;
    }
    __device__ __forceinline__ void a_ready(const Unit&) const {}
    __device__ __forceinline__ void done(const Unit&) const {}
};

__device__ __forceinline__ unsigned cvt_pk_bf16(float lo, float hi) { unsigned r; asm volatile("v_cvt_pk_bf16_f32 %0, %1, %2" : "=v"(r) : "v"(lo), "v"(hi)); return r; }
typedef float f32x2 __attribute__((ext_vector_type(2)));
__device__ __forceinline__ float silu_acc(float a) { return a * __builtin_amdgcn_rcpf(1.0f + __builtin_amdgcn_exp2f(-1.4426950408889634f * a)); }
struct EpiStoreBf16 {
    static constexpr bool PERM = true, AFTER_DRAIN = false;
    bf16_t* O; int ldc; int ncolt;
    __device__ __forceinline__ void operator()(const f32x4 (&acc)[2][2][4][2], const Unit& u, int wr, int wc, int fr, int fq) const {
        const int row0 = u.pm * BM + wr * 64 + fr; const int pnl = ncolt ? (u.pn % ncolt) : u.pn;
        const int col0 = pnl * BM + wc * 32 + 8 * fq;
#pragma unroll
        for (int ai = 0; ai < 2; ++ai)
#pragma unroll
            for (int m = 0; m < 4; ++m) { bf16_t* rowp = O + (size_t)(row0 + ai * HALF + m * 16) * ldc + col0;
#pragma unroll
                for (int bj = 0; bj < 2; ++bj) { const f32x4 v0 = acc[ai][bj][m][0], v1 = acc[ai][bj][m][1];
                    u32x4 w; w.x = cvt_pk_bf16(v0[0], v0[1]); w.y = cvt_pk_bf16(v0[2], v0[3]); w.z = cvt_pk_bf16(v1[0], v1[1]); w.w = cvt_pk_bf16(v1[2], v1[3]);
                    *(u32x4*)(rowp + bj * HALF) = w; } }
    }
};
struct EpiStoreSplit {
    static constexpr bool PERM = true, AFTER_DRAIN = false;
    bf16_t* O0; int ld0; bf16_t* O1; int ld1; int nt0;
    __device__ __forceinline__ void operator()(const f32x4 (&acc)[2][2][4][2], const Unit& u, int wr, int wc, int fr, int fq) const {
        const int row0 = u.pm * BM + wr * 64 + fr; const bool first = u.pn < nt0; const int pnl = first ? u.pn : u.pn - nt0; const int ldc = first ? ld0 : ld1; bf16_t* O = first ? O0 : O1;
        const int col0 = pnl * BM + wc * 32 + 8 * fq;
#pragma unroll
        for (int ai = 0; ai < 2; ++ai)
#pragma unroll
            for (int m = 0; m < 4; ++m) { bf16_t* rowp = O + (size_t)(row0 + ai * HALF + m * 16) * ldc + col0;
#pragma unroll
                for (int bj = 0; bj < 2; ++bj) { const f32x4 v0 = acc[ai][bj][m][0], v1 = acc[ai][bj][m][1];
                    u32x4 w; w.x = cvt_pk_bf16(v0[0], v0[1]); w.y = cvt_pk_bf16(v0[2], v0[3]); w.z = cvt_pk_bf16(v1[0], v1[1]); w.w = cvt_pk_bf16(v1[2], v1[3]);
                    *(u32x4*)(rowp + bj * HALF) = w; } }
    }
};
struct EpiSwiGLU {
    static constexpr bool PERM = true, AFTER_DRAIN = false;
    bf16_t* O; int ldc; int ncolt;
    __device__ __forceinline__ void operator()(const f32x4 (&acc)[2][2][4][2], const Unit& u, int wr, int wc, int fr, int fq) const {
        const int row0 = u.pm * BM + wr * 64 + fr; const int pnl = ncolt ? (u.pn % ncolt) : u.pn;
        const int col0 = pnl * HALF + wc * 32 + 8 * fq;
#pragma unroll
        for (int ai = 0; ai < 2; ++ai)
#pragma unroll
            for (int m = 0; m < 4; ++m) { bf16_t* rowp = O + (size_t)(row0 + ai * HALF + m * 16) * ldc + col0;
                const f32x4 a0 = acc[ai][0][m][0], a1 = acc[ai][0][m][1], b0 = acc[ai][1][m][0], b1 = acc[ai][1][m][1];
                u32x4 w;
                w.x = cvt_pk_bf16(silu_acc(a0[0]) * b0[0], silu_acc(a0[1]) * b0[1]); w.y = cvt_pk_bf16(silu_acc(a0[2]) * b0[2], silu_acc(a0[3]) * b0[3]);
                w.z = cvt_pk_bf16(silu_acc(a1[0]) * b1[0], silu_acc(a1[1]) * b1[1]); w.w = cvt_pk_bf16(silu_acc(a1[2]) * b1[2], silu_acc(a1[3]) * b1[3]);
                *(u32x4*)rowp = w; }
    }
};
struct EpiResid {
    static constexpr bool PERM = false, AFTER_DRAIN = false;
    const float* srcLat; const float* srcCtx; float* dstLat; float* dstCtx; const float* gate3;
    __device__ __forceinline__ void operator()(const f32x4 (&acc)[2][2][4][2], const Unit& u, int wr, int wc, int fr, int fq) const {
        const int b = u.pm / 65, j = u.pm - b * 65; const int which = (j == 0) ? 2 : b;
        const float* src = (j == 0) ? srcCtx + (size_t)b * 256 * 1024 : srcLat + ((size_t)b * 16384 + (size_t)(j - 1) * 256) * 1024;
        float* dst = (j == 0) ? dstCtx + (size_t)b * 256 * 1024 : dstLat + ((size_t)b * 16384 + (size_t)(j - 1) * 256) * 1024;
        const float* gp = gate3 + (size_t)which * 6144;
        const int col0 = u.pn * BM + wc * 32 + 4 * fq;
        f32x4 gv[2][2];
#pragma unroll
        for (int bj = 0; bj < 2; ++bj)
#pragma unroll
            for (int n = 0; n < 2; ++n) gv[bj][n] = *(const f32x4*)(gp + col0 + bj * HALF + n * 16);
#pragma unroll
        for (int ai = 0; ai < 2; ++ai)
#pragma unroll
            for (int m = 0; m < 4; ++m) { const size_t off = (size_t)(ai * HALF + wr * 64 + m * 16 + fr) * 1024 + col0;
#pragma unroll
                for (int bj = 0; bj < 2; ++bj)
#pragma unroll
                    for (int n = 0; n < 2; ++n) { const f32x4 x = *(const f32x4*)(src + off + bj * HALF + n * 16);
                        *(f32x4*)(dst + off + bj * HALF + n * 16) = x + gv[bj][n] * acc[ai][bj][m][n]; }
                if (m & 1) asm volatile("" ::: "memory"); }
    }
};
struct MoeOrder {
    int t0, t1, t2, t3, t4, t5, t6, t7; int ncol, G, c;
    __device__ __forceinline__ void init(const unsigned* cnt  , int ncol_, int G_, int c_) {
        ncol = ncol_; G = G_; c = c_;
#define MO_T(e) (((int)__hip_atomic_load(cnt + 64 * (e), __ATOMIC_RELAXED, __HIP_MEMORY_SCOPE_AGENT) + 255) >> 8)
        t0 = MO_T(0); t1 = MO_T(1); t2 = MO_T(2); t3 = MO_T(3); t4 = MO_T(4); t5 = MO_T(5); t6 = MO_T(6); t7 = MO_T(7);
#undef MO_T
    }
    __device__ __forceinline__ bool next(int i, Unit& u) const {
        int L = i * G + c; int e = 0, r0 = 0, te = t0; bool found = false;
#define MO_STEP(k, tk) if (!found) { if (L < (tk) * ncol) { e = (k); te = (tk); found = true; } else { L -= (tk) * ncol; r0 += (tk); } }
        MO_STEP(0, t0) MO_STEP(1, t1) MO_STEP(2, t2) MO_STEP(3, t3) MO_STEP(4, t4) MO_STEP(5, t5) MO_STEP(6, t6) MO_STEP(7, t7)
#undef MO_STEP
        if (!found) return false;
        u.pm = r0 + L % te; u.pn = e * ncol + L / te; return true;
    }
    __device__ __forceinline__ void a_ready(const Unit&) const {}
    __device__ __forceinline__ void done(const Unit&) const {}
};
template <class Epi, class Sched, bool ALIGN_EPI = false, bool SP2 = false>
__device__ __forceinline__ void gemm_phase(PG8_LAS unsigned char* lds, const Gemm g, const Sched& S, const Epi& E) {
    const int tid = opaque_tid(), wid = __builtin_amdgcn_readfirstlane(tid >> 6), lane = tid & 63, wr = wid >> 2, wc = wid & 3, fr = lane & 15, fq = lane >> 4;
    const int K = g.K, nt = K / BK;
    unsigned voffA[2], voffB[2];
#pragma unroll
    for (int i = 0; i < 2; ++i) { int R, C; stage_rc(tid * 16 + i * 8192, R, C); const int Rb = Epi::PERM ? ((R & ~31) + perm32(R & 31)) : R;
        voffA[i] = (unsigned)(R * K + C) * 2u; voffB[i] = (unsigned)(Rb * K + C) * 2u; }
    const size_t kstep = (size_t)(BK * 2);
    const size_t hstep = (size_t)HALF * K * 2;
    const size_t tstep = 2 * hstep;
    const unsigned ldsw = (unsigned)wid * 1024u;
    const int aoff = lds_byte(wr * 64 + fr, fq * 8), boff = lds_byte(wc * 32 + fr, fq * 8);
#define PG8_SA(b, h) (((b) * 2 + (h)) * HTB)
#define PG8_SB(b, h) ((4 + (b) * 2 + (h)) * HTB)
#define PG8_STAGE(bufoff, gbase, voff) do { _Pragma("unroll") for (int _i = 0; _i < 2; ++_i) \
        __builtin_amdgcn_global_load_lds((const unsigned*)((const char*)(gbase) + (voff)[_i]), (PG8_LAS unsigned*)(lds + (bufoff) + ldsw + _i * 8192), 16, 0, 0); } while (0)
#define PG8_LDA(dst, b, h) do { _Pragma("unroll") for (int m = 0; m < 4; ++m) _Pragma("unroll") for (int k = 0; k < 2; ++k) dst[m][k] = *(const PG8_LAS bf16x8*)(lds + PG8_SA(b, h) + aoff + m * 2048 + k * 1024); } while (0)
#define PG8_LDB(dst, b, h) do { _Pragma("unroll") for (int n = 0; n < 2; ++n) _Pragma("unroll") for (int k = 0; k < 2; ++k) dst[n][k] = *(const PG8_LAS bf16x8*)(lds + PG8_SB(b, h) + boff + n * 2048 + k * 1024); } while (0)
#define PG8_MMA(ai, bj, At, Bt) do { __builtin_amdgcn_s_setprio(1); _Pragma("unroll") for (int m = 0; m < 4; ++m) _Pragma("unroll") for (int n = 0; n < 2; ++n) _Pragma("unroll") for (int k = 0; k < 2; ++k) \
        acc[ai][bj][m][n] = __builtin_amdgcn_mfma_f32_16x16x32_bf16(Bt[n][k], At[m][k], acc[ai][bj][m][n], 0, 0, 0); __builtin_amdgcn_s_setprio(0); } while (0)
#define PG8_WAIT_V(n) asm volatile("s_waitcnt vmcnt(" #n ")" ::: "memory")
#define PG8_WAIT_L(n) asm volatile("s_waitcnt lgkmcnt(" #n ")" ::: "memory")
#define PG8_BAR __builtin_amdgcn_s_barrier()
#define PG8_SCHED __builtin_amdgcn_sched_barrier(0)
    Unit cur, nxt; int ui = 0;
    if (!S.next(0, cur)) return;
    f32x4 acc[2][2][4][2];
#pragma unroll
    for (int a = 0; a < 2; ++a)
#pragma unroll
        for (int b = 0; b < 2; ++b)
#pragma unroll
            for (int m = 0; m < 4; ++m)
#pragma unroll
                for (int n = 0; n < 2; ++n) acc[a][b][m][n] = (f32x4){0.f, 0.f, 0.f, 0.f};
    bf16x8 At[4][2], B0[2][2], B1[2][2];
    const char* cA = (const char*)g.A + (size_t)cur.pm * tstep; const char* cB = (const char*)g.Bt + (size_t)cur.pn * tstep;
    S.a_ready(cur);
    if constexpr (SP2) {
        PG8_STAGE(PG8_SB(0, 0), cB, voffB); PG8_STAGE(PG8_SB(0, 1), cB + hstep, voffB); PG8_STAGE(PG8_SA(0, 0), cA, voffA); PG8_STAGE(PG8_SA(0, 1), cA + hstep, voffA);
        if (wr == 1) PG8_BAR;
        PG8_WAIT_V(2); PG8_BAR;
        PG8_STAGE(PG8_SB(1, 0), cB + kstep, voffB); PG8_STAGE(PG8_SA(1, 0), cA + kstep, voffA); PG8_STAGE(PG8_SB(1, 1), cB + hstep + kstep, voffB);
        PG8_WAIT_V(6); PG8_BAR;
    } else {
        PG8_STAGE(PG8_SB(0, 0), cB, voffB); PG8_STAGE(PG8_SA(0, 0), cA, voffA); PG8_STAGE(PG8_SB(0, 1), cB + hstep, voffB); PG8_STAGE(PG8_SA(0, 1), cA + hstep, voffA);
        if (wr == 1) PG8_BAR;
        PG8_WAIT_V(4); PG8_BAR;
        PG8_STAGE(PG8_SB(1, 0), cB + kstep, voffB); PG8_STAGE(PG8_SA(1, 0), cA + kstep, voffA); PG8_STAGE(PG8_SB(1, 1), cB + hstep + kstep, voffB);
        PG8_WAIT_V(6); PG8_BAR;
    }
    for (;;) {
        const bool has_next = S.next(ui + 1, nxt);
        const char* nA = has_next ? (const char*)g.A + (size_t)nxt.pm * tstep : cA; const char* nB = has_next ? (const char*)g.Bt + (size_t)nxt.pn * tstep : cB;
        for (int t = 0; t < nt; t += 2) {
            const bool last = (t == nt - 2);
            const char* a1 = cA + (size_t)(t + 1) * kstep;
            const char* a2 = last ? nA : cA + (size_t)(t + 2) * kstep; const char* b2 = last ? nB : cB + (size_t)(t + 2) * kstep;
            const char* a3 = a2 + kstep; const char* b3 = b2 + kstep;
            if (last && has_next) S.a_ready(nxt);
            if constexpr (SP2) {
            PG8_LDB(B0, 0, 0); PG8_LDB(B1, 0, 1); PG8_SCHED; PG8_LDA(At, 0, 0); PG8_STAGE(PG8_SA(1, 1), a1 + hstep, voffA);
            PG8_WAIT_V(8); PG8_WAIT_L(0); PG8_BAR; PG8_MMA(0, 0, At, B0); PG8_MMA(0, 1, At, B1); PG8_BAR; PG8_SCHED;
            PG8_LDA(At, 0, 1); PG8_STAGE(PG8_SB(0, 0), b2, voffB); PG8_STAGE(PG8_SB(0, 1), b2 + hstep, voffB); PG8_STAGE(PG8_SA(0, 0), a2, voffA);
            PG8_WAIT_V(8); PG8_WAIT_L(0); PG8_BAR; PG8_MMA(1, 0, At, B0); PG8_MMA(1, 1, At, B1); PG8_BAR; PG8_SCHED;
            PG8_LDB(B0, 1, 0); PG8_LDB(B1, 1, 1); PG8_SCHED; PG8_LDA(At, 1, 0); PG8_STAGE(PG8_SA(0, 1), a2 + hstep, voffA);
            PG8_WAIT_V(8); PG8_WAIT_L(0); PG8_BAR; PG8_MMA(0, 0, At, B0); PG8_MMA(0, 1, At, B1); PG8_BAR; PG8_SCHED;
            PG8_LDA(At, 1, 1); PG8_STAGE(PG8_SB(1, 0), b3, voffB); PG8_STAGE(PG8_SB(1, 1), b3 + hstep, voffB); PG8_STAGE(PG8_SA(1, 0), a3, voffA);
            PG8_WAIT_V(8); PG8_WAIT_L(0); PG8_BAR; PG8_MMA(1, 0, At, B0); PG8_MMA(1, 1, At, B1); PG8_BAR; PG8_SCHED;
            } else {
            PG8_LDB(B0, 0, 0); PG8_SCHED; PG8_LDA(At, 0, 0); PG8_STAGE(PG8_SA(1, 1), a1 + hstep, voffA);
            PG8_WAIT_L(8); PG8_BAR; PG8_WAIT_L(0); PG8_MMA(0, 0, At, B0); PG8_BAR; PG8_SCHED;
            PG8_LDB(B1, 0, 1); PG8_STAGE(PG8_SB(0, 0), b2, voffB);
            PG8_BAR; PG8_WAIT_L(0); PG8_MMA(0, 1, At, B1); PG8_BAR;
            PG8_LDA(At, 0, 1); PG8_STAGE(PG8_SA(0, 0), a2, voffA);
            PG8_BAR; PG8_WAIT_L(0); PG8_MMA(1, 0, At, B0); PG8_BAR; PG8_SCHED;
            PG8_STAGE(PG8_SB(0, 1), b2 + hstep, voffB);
            PG8_WAIT_V(6); PG8_BAR; PG8_MMA(1, 1, At, B1); PG8_BAR;
            PG8_LDB(B0, 1, 0); PG8_SCHED; PG8_LDA(At, 1, 0); PG8_STAGE(PG8_SA(0, 1), a2 + hstep, voffA);
            PG8_WAIT_L(8); PG8_BAR; PG8_WAIT_L(0); PG8_MMA(0, 0, At, B0); PG8_BAR; PG8_SCHED;
            PG8_LDB(B1, 1, 1); PG8_STAGE(PG8_SB(1, 0), b3, voffB);
            PG8_BAR; PG8_WAIT_L(0); PG8_MMA(0, 1, At, B1); PG8_BAR;
            PG8_LDA(At, 1, 1); PG8_STAGE(PG8_SA(1, 0), a3, voffA);
            PG8_BAR; PG8_WAIT_L(0); PG8_MMA(1, 0, At, B0); PG8_BAR; PG8_SCHED;
            PG8_STAGE(PG8_SB(1, 1), b3 + hstep, voffB);
            PG8_WAIT_V(6); PG8_BAR; PG8_MMA(1, 1, At, B1); PG8_BAR;
            }
        }
        if constexpr (ALIGN_EPI) { if (wr == 0) PG8_BAR; }
        if constexpr (!Epi::AFTER_DRAIN) { E(acc, cur, wr, wc, fr, fq); S.done(cur); }
        if (!has_next) break;
#pragma unroll
        for (int a = 0; a < 2; ++a)
#pragma unroll
            for (int b = 0; b < 2; ++b)
#pragma unroll
                for (int m = 0; m < 4; ++m)
#pragma unroll
                    for (int n = 0; n < 2; ++n) acc[a][b][m][n] = (f32x4){0.f, 0.f, 0.f, 0.f};
        cur = nxt; cA = nA; cB = nB; ++ui;
        if constexpr (ALIGN_EPI) { if (wr == 1) PG8_BAR; }
    }
    PG8_WAIT_V(0);
    if constexpr (!ALIGN_EPI) { if (wr == 0) PG8_BAR; }
    PG8_BAR;
    if constexpr (Epi::AFTER_DRAIN) { E.fused(acc, cur, wr, wc, fr, fq, lds, wid, lane); S.done(cur); }
#undef PG8_SA
#undef PG8_SB
#undef PG8_STAGE
#undef PG8_LDA
#undef PG8_LDB
#undef PG8_MMA
#undef PG8_WAIT_V
#undef PG8_WAIT_L
#undef PG8_BAR
#undef PG8_SCHED
}
}
constexpr int NB = 2, SEQ = 16384, CL = 256, DM = 1024, NPB = SEQ + CL  , NR = NB * NPB  , DEPTH = 4;
constexpr int NIN = 3296, NINP = 3328, DFF = 2816, NEXP = 8, DFE = 3584;
constexpr int NWAVES = 8, NTHR = 512;
constexpr float QSCALE = 0.125f * 1.4426950408889634f;
constexpr int PC_Q = 0, PC_K = 512, PC_V = 1024, PC_R = 0, PC_RK = 512, PC_RV = 1024, PC_LORA = 1536;

constexpr size_t MiB = 1u << 20;
constexpr size_t WS_CTL = 0, CTL_ZERO_BYTES = 1 * MiB;
constexpr size_t WS_MOD = 1 * MiB;
constexpr size_t WS_ROPE = 2 * MiB;
constexpr size_t WS_LAM = 2 * MiB + 65536;
constexpr size_t WS_XC = 3 * MiB;
constexpr size_t WS_ROUTE = 5 * MiB;
constexpr size_t WS_WINT = 8 * MiB;
constexpr size_t WS_WOUTT = 34 * MiB;
constexpr size_t WS_W13T = 42 * MiB;
constexpr size_t WS_W2T = 64 * MiB;
constexpr size_t WS_VFIRST = 76 * MiB;
constexpr size_t WS_HN = 110 * MiB;
constexpr size_t WS_PA = 175 * MiB;
constexpr size_t WS_G = 273 * MiB;
constexpr size_t WS_BONUS = 306 * MiB;
constexpr size_t WS_OPS = 308 * MiB;
constexpr size_t WS_PR = 308 * MiB;
constexpr size_t WS_SPK = 715 * MiB;
constexpr size_t WS_DPK = 813 * MiB;
constexpr size_t WS_Y = 813 * MiB;
constexpr size_t WS_LORA = 1008 * MiB;
constexpr size_t WS_END = 1010 * MiB;
constexpr int LO_W2 = 0, LO_A2 = 131072, LO_V2 = 262144, LO_G2 = 262144 + 49152, LO_V1 = 262144 + 49152 + 196608, LO_TOTAL = LO_V1 + 49152;
constexpr int LDPA = 1536, LDPR = 1792;
constexpr int OPS_REC = 12288, NCHUNK = NPB / 16;
constexpr int OR_QT = 9216, OR_VT = 9728, OR_WC = 11776;
constexpr size_t WS_HF = 175 * MiB;
constexpr size_t WS_W13E = 175 * MiB;
constexpr size_t WS_W2E = 287 * MiB;
constexpr size_t WS_AG = 343 * MiB;
constexpr size_t WS_HMOE = 412 * MiB;
constexpr size_t WS_YEXP = 654 * MiB;
static_assert(WS_WINT + (size_t)4 * NINP * DM * 2 <= WS_WOUTT && WS_WOUTT + (size_t)4 * DM * DM * 2 <= WS_W13T && WS_W13T + (size_t)2 * 2 * DFF * DM * 2 <= WS_W2T && WS_W2T + (size_t)2 * DM * DFF * 2 <= WS_VFIRST, "ws map 1");
static_assert(WS_VFIRST + (size_t)NR * 512 * 2 <= WS_HN && WS_HN + (size_t)NR * DM * 2 <= WS_PA && WS_PA + (size_t)NR * LDPA * 2 <= WS_G && WS_G + (size_t)NR * 512 * 2 <= WS_BONUS && WS_BONUS + (size_t)NR * 8 * 4 <= WS_OPS, "ws map 2");
static_assert(WS_OPS + (size_t)32 * NCHUNK * OPS_REC <= WS_SPK && WS_PR + (size_t)NR * LDPR * 2 <= WS_SPK && WS_SPK + (size_t)NB * 8 * NPB * 192 * 2 <= WS_DPK && WS_DPK + (size_t)2 * NB * 8 * NPB * 192 * 2 <= WS_LORA && WS_Y + (size_t)2 * NR * 512 * 4 <= WS_LORA && WS_LORA + (size_t)LO_TOTAL * 2 <= WS_END, "ws map 3");
static_assert(WS_HF + (size_t)NR * DFF * 2 <= WS_LORA && WS_W13E + (size_t)8 * 2 * DFE * DM * 2 <= WS_W2E && WS_W2E + (size_t)8 * DM * DFE * 2 <= WS_AG && WS_AG + (size_t)35328 * DM * 2 <= WS_HMOE && WS_HMOE + (size_t)35328 * DFE * 2 <= WS_YEXP && WS_YEXP + (size_t)35328 * DM * 2 <= WS_LORA, "ws map 4");
constexpr int CW_TMO = 0;
constexpr int CW_BAR = 4096;
constexpr int CW_QS = 16384;
constexpr int CW_QA = 20480;
constexpr int CW_CNT = 24576;

constexpr int RING_BYTES = 131072;
constexpr int LDSCTL_OFF = RING_BYTES, MISC_OFF = LDSCTL_OFF + 320;
constexpr int LDS_BYTES = 147456;

#define GAS __attribute__((address_space(1)))
#define LAS __attribute__((address_space(3)))
typedef unsigned short bf16;
typedef unsigned v4u __attribute__((ext_vector_type(4)));
typedef unsigned v2u __attribute__((ext_vector_type(2)));
typedef float f32x4 __attribute__((ext_vector_type(4)));
typedef _Float16 h4 __attribute__((ext_vector_type(4)));
#define LDS_WAIT() asm volatile("s_waitcnt lgkmcnt(0)" ::: "memory")
__device__ __forceinline__ unsigned f2bf(float f) { unsigned u = __builtin_bit_cast(unsigned, f); return (u + 0x7fffu + ((u >> 16) & 1u)) >> 16; }
__device__ __forceinline__ unsigned pk2(float lo, float hi) { return f2bf(lo) | (f2bf(hi) << 16); }
__device__ __forceinline__ float bf2f(bf16 h) { return __builtin_bit_cast(float, (unsigned)h << 16); }
__device__ __forceinline__ float bflo(unsigned w) { return __builtin_bit_cast(float, w << 16); }
__device__ __forceinline__ float bfhi(unsigned w) { return __builtin_bit_cast(float, w & 0xffff0000u); }
__device__ __forceinline__ float sigmoid_f(float x) { return 1.0f / (1.0f + __expf(-x)); }
__device__ __forceinline__ float tanh_f(float x) { return 1.0f - 2.0f / (__expf(2.0f * x) + 1.0f); }
__device__ __forceinline__ float wave_sum(float v) {
#pragma unroll
    for (int o = 1; o < 64; o <<= 1) v += __shfl_xor(v, o);
    return v;
}
#define XB_TMO      128
#define XB_XCNT(j)  (256  + 64 * (j))
#define XB_XSUB(j)  (1280 + 64 * (j))
#define XB_XGEN(j)  (2304 + 64 * (j))
#define XB_TOP      3328
#define XB_TOPGEN   3392
#define XCD_BAR_WORDS 3456
#define XB_SPIN_CAP (1u << 18)

__device__ __forceinline__ unsigned xb_ld(unsigned* p)              { return __hip_atomic_load(p, __ATOMIC_RELAXED, __HIP_MEMORY_SCOPE_AGENT); }
__device__ __forceinline__ unsigned xb_add(unsigned* p, unsigned v) { return __hip_atomic_fetch_add(p, v, __ATOMIC_RELAXED, __HIP_MEMORY_SCOPE_AGENT); }
__device__ __forceinline__ unsigned xb_xcc_id() { return (unsigned)__builtin_amdgcn_s_getreg((3 << 11) | 20) & 0xFu; }
#define XB_SPIN(cond, bar) do { unsigned _sp = 0; while (cond) { __builtin_amdgcn_s_sleep(1); \
    if ((++_sp & 255u) == 0u) { if (xb_ld(&(bar)[XB_TMO])) break; if (_sp > XB_SPIN_CAP) { atomicAdd(&(bar)[XB_TMO], 1u); break; } } } } while (0)

struct XcdBarrier {
    unsigned* bar; unsigned x;
    volatile LAS unsigned* st;
};

__device__ __forceinline__ XcdBarrier xcd_barrier_post(unsigned* bar, volatile LAS unsigned* st) {
    XcdBarrier b; b.bar = bar; b.x = xb_xcc_id(); b.st = st;
    if (threadIdx.x == 0) (void)xb_add(&bar[XB_XCNT(b.x)], 1u);
    return b;
}
__device__ __forceinline__ void xcd_barrier_complete(unsigned* bar, unsigned x, unsigned& nloc, unsigned& nx) {
    const unsigned G = gridDim.x * gridDim.y * gridDim.z;
    unsigned sum, cnt, mine, sp = 0u;
    for (;;) {
        sum = 0u; cnt = 0u; mine = 0u;
#pragma unroll
        for (unsigned j = 0; j < 16; ++j) { const unsigned c = xb_ld(&bar[XB_XCNT(j)]); sum += c; cnt += (c > 0u) ? 1u : 0u; mine = (j == x) ? c : mine; }
        if (sum == G) break;
        __builtin_amdgcn_s_sleep(1);
        if ((++sp & 255u) == 0u) { if (xb_ld(&bar[XB_TMO])) break; if (sp > XB_SPIN_CAP) { atomicAdd(&bar[XB_TMO], 1u); break; } }
    }
    nloc = mine > 0u ? mine : 1u; nx = cnt > 0u ? cnt : 1u;
}

__device__ __forceinline__ void xcd_barrier(const XcdBarrier& b) {
    asm volatile("s_waitcnt vmcnt(0)" ::: "memory");
    __syncthreads();
    if (threadIdx.x == 0) {
        unsigned* bar = b.bar;
        __builtin_amdgcn_s_waitcnt(0);
        unsigned nloc = b.st[0], nx = b.st[1];
        if (nloc == 0u) { xcd_barrier_complete(bar, b.x, nloc, nx); b.st[0] = nloc; b.st[1] = nx; }
        const unsigned old = xb_add(&bar[XB_XSUB(b.x)], 1u);
        const unsigned gen = old / nloc;
        if (old + 1u == (gen + 1u) * nloc) {
            __builtin_amdgcn_fence(__ATOMIC_RELEASE, "agent");
            asm volatile("s_waitcnt vmcnt(0)" ::: "memory");
            const unsigned og = xb_add(&bar[XB_TOP], 1u);
            const unsigned tg = og / nx;
            if (og + 1u == (tg + 1u) * nx) xb_add(&bar[XB_TOPGEN], 1u);
            else XB_SPIN(xb_ld(&bar[XB_TOPGEN]) == tg, bar);
            __builtin_amdgcn_fence(__ATOMIC_ACQUIRE, "agent");
            xb_add(&bar[XB_XGEN(b.x)], 1u);
            asm volatile("s_waitcnt vmcnt(0)" ::: "memory");
        } else {
            XB_SPIN(xb_ld(&bar[XB_XGEN(b.x)]) == gen, bar);
            __builtin_amdgcn_fence(__ATOMIC_ACQUIRE, "agent");
            asm volatile("s_waitcnt vmcnt(0)" ::: "memory");
        }
    }
    __syncthreads();
}
struct Args { const float* in[34]; float* out; unsigned char* ws; int ph_lo, ph_hi; };
namespace att {
using bf16x8 = __attribute__((ext_vector_type(8))) short;
using s16x4  = __attribute__((ext_vector_type(4))) short;
using f32x16 = __attribute__((ext_vector_type(16))) float;
using u32x4  = __attribute__((ext_vector_type(4))) unsigned;
constexpr int KVBLK = 64;
constexpr size_t SHM_V = KVBLK * 128 * 2, SHM_K = KVBLK * 128 * 2;
constexpr float THR2 = 11.5f;
#define KSWZ(row, colB) ((row) * 256 + ((colB) ^ (((row) & 7) << 4)))
#define SBAR() __builtin_amdgcn_sched_barrier(0)
__device__ __forceinline__ int crow(int r, int hi) { return (r & 3) + 8 * (r >> 2) + 4 * hi; }
__device__ __forceinline__ unsigned cvtpk(float lo, float hi) { unsigned r; asm volatile("v_cvt_pk_bf16_f32 %0, %1, %2" : "=v"(r) : "v"(lo), "v"(hi)); return r; }
__device__ __forceinline__ bf16x8 ld8(const bf16* p) { return *reinterpret_cast<const bf16x8*>(p); }

#define MX3(a, b, c) __builtin_fmaxf(__builtin_fmaxf((a), (b)), (c))
__device__ __forceinline__ float rowmax32(const f32x16& p0, const f32x16& p1) {
  float a = MX3(p0[0], p0[1], p1[0]), b = MX3(p0[2], p0[3], p1[1]); a = MX3(a, p1[2], p1[3]);
#pragma unroll
  for (int r = 4; r < 16; r += 4) { a = MX3(a, p0[r], p0[r + 1]); b = MX3(b, p0[r + 2], p0[r + 3]); a = MX3(a, p1[r], p1[r + 1]); b = MX3(b, p1[r + 2], p1[r + 3]); }
  float m = __builtin_fmaxf(a, b);
  auto rr = __builtin_amdgcn_permlane32_swap(__float_as_uint(m), __float_as_uint(m), false, false);
  return __builtin_fmaxf(__uint_as_float(rr[0]), __uint_as_float(rr[1]));
}
__device__ __forceinline__ void firstSM(f32x16& p0, f32x16& p1, float& m_reg, f32x16& negm, float& alpha) {
  const float dl = rowmax32(p0, p1); m_reg = dl; alpha = 1.f;
#pragma unroll
  for (int r = 0; r < 16; ++r) { p0[r] = p0[r] - dl; p1[r] = p1[r] - dl; negm[r] = -dl; }
  asm volatile("" : "+v"(negm));
#pragma unroll
  for (int r = 0; r < 16; ++r) p0[r] = __builtin_amdgcn_exp2f(p0[r]);
}
__device__ __forceinline__ void finishSM(f32x16& p0, f32x16& p1, float alpha, float& l_reg, bf16x8& pa0, bf16x8& pa1, bf16x8& pa2, bf16x8& pa3) {
#pragma unroll
  for (int r = 0; r < 16; ++r) p1[r] = __builtin_amdgcn_exp2f(p1[r]);
  float ps = 0;
#pragma unroll
  for (int r = 0; r < 16; ++r) ps += p0[r];
#pragma unroll
  for (int r = 0; r < 16; ++r) ps += p1[r];
  { auto rr = __builtin_amdgcn_permlane32_swap(__float_as_uint(ps), __float_as_uint(ps), false, false);
    ps = __uint_as_float(rr[0]) + __uint_as_float(rr[1]); }
  l_reg = l_reg * alpha + ps;
#define PK4(P, BASE, OUT) do { unsigned a0 = cvtpk(P[BASE + 0], P[BASE + 1]), a1 = cvtpk(P[BASE + 2], P[BASE + 3]);   \
    unsigned b0 = cvtpk(P[BASE + 4], P[BASE + 5]), b1 = cvtpk(P[BASE + 6], P[BASE + 7]);                              \
    auto r0 = __builtin_amdgcn_permlane32_swap(a0, b0, false, false); auto r1 = __builtin_amdgcn_permlane32_swap(a1, b1, false, false); \
    u32x4 w = {r0[0], r1[0], r0[1], r1[1]}; OUT = *reinterpret_cast<bf16x8*>(&w); } while (0)
  PK4(p0, 0, pa0); PK4(p0, 8, pa1); PK4(p1, 0, pa2); PK4(p1, 8, pa3);
#undef PK4
}
__device__ __forceinline__ void qkt(f32x16& p0, f32x16& p1, const bf16* Ks, const bf16x8* qr, int r32, int hi, int cbase, const f32x16& negm) {
#pragma unroll
  for (int d0 = 0; d0 < 4; ++d0) { int cb = (cbase + d0 * 16 + hi * 8) * 2;
    bf16x8 b0 = *reinterpret_cast<const bf16x8*>((const char*)Ks + KSWZ(r32, cb));
    bf16x8 b1 = *reinterpret_cast<const bf16x8*>((const char*)Ks + KSWZ(32 + r32, cb));
    if (d0 == 0) { p0 = __builtin_amdgcn_mfma_f32_32x32x16_bf16(b0, qr[0], negm, 0, 0, 0); p1 = __builtin_amdgcn_mfma_f32_32x32x16_bf16(b1, qr[0], negm, 0, 0, 0); }
    else { p0 = __builtin_amdgcn_mfma_f32_32x32x16_bf16(b0, qr[d0], p0, 0, 0, 0); p1 = __builtin_amdgcn_mfma_f32_32x32x16_bf16(b1, qr[d0], p1, 0, 0, 0); } }
}
__device__ __forceinline__ int v_st(int k, int c) { const int kk = (k & ~0xC) | ((k & 4) << 1) | ((k & 8) >> 1); return ((kk >> 3) * 4 + (c >> 5)) * 512 + ((kk & 7) * 32 + (c & 31)) * 2; }
__device__ __forceinline__ int v_rd_base(int lane) { return ((lane & 3) << 3) | (((lane >> 2) & 3) << 6) | (((lane >> 4) & 1) << 5) | (((lane >> 5) & 1) << 8); }
constexpr int v_rd_off(int d0, int ks, int half) { return d0 * 512 + ks * 4096 + half * 2048; }
template <int OFF> __device__ __forceinline__ s16x4 tr_read(int vb) {
  s16x4 r; asm volatile("ds_read_b64_tr_b16 %0, %1 offset:%2" : "=&v"(r) : "v"(vb), "i"(OFF) : "memory"); return r;
}
template <int D0> __device__ __forceinline__ void pv_one(f32x16& od, int vb, bf16x8 pa0, bf16x8 pa1, bf16x8 pa2, bf16x8 pa3) {
  const s16x4 l0 = tr_read<v_rd_off(D0, 0, 0)>(vb), h0 = tr_read<v_rd_off(D0, 0, 1)>(vb), l1 = tr_read<v_rd_off(D0, 1, 0)>(vb), h1 = tr_read<v_rd_off(D0, 1, 1)>(vb);
  const s16x4 l2 = tr_read<v_rd_off(D0, 2, 0)>(vb), h2 = tr_read<v_rd_off(D0, 2, 1)>(vb), l3 = tr_read<v_rd_off(D0, 3, 0)>(vb), h3 = tr_read<v_rd_off(D0, 3, 1)>(vb);
  asm volatile("s_waitcnt lgkmcnt(0)" ::: "memory"); SBAR();
#define PK(L, H) (bf16x8){L[0], L[1], L[2], L[3], H[0], H[1], H[2], H[3]}
  od = __builtin_amdgcn_mfma_f32_32x32x16_bf16(pa0, PK(l0, h0), od, 0, 0, 0);
  od = __builtin_amdgcn_mfma_f32_32x32x16_bf16(pa1, PK(l1, h1), od, 0, 0, 0);
  od = __builtin_amdgcn_mfma_f32_32x32x16_bf16(pa2, PK(l2, h2), od, 0, 0, 0);
  od = __builtin_amdgcn_mfma_f32_32x32x16_bf16(pa3, PK(l3, h3), od, 0, 0, 0);
#undef PK
}
__device__ __forceinline__ void pv_d0(f32x16* o, int vb, bf16x8 pa0, bf16x8 pa1, bf16x8 pa2, bf16x8 pa3) {
  pv_one<0>(o[0], vb, pa0, pa1, pa2, pa3); pv_one<1>(o[1], vb, pa0, pa1, pa2, pa3); pv_one<2>(o[2], vb, pa0, pa1, pa2, pa3); pv_one<3>(o[3], vb, pa0, pa1, pa2, pa3);
}

__device__ __forceinline__ void pv_softmax(f32x16* o, int vb, bf16x8 pa0, bf16x8 pa1, bf16x8 pa2, bf16x8 pa3, f32x16& p0, f32x16& p1, float& m_reg, f32x16& negm, float& alpha) {
  pv_one<0>(o[0], vb, pa0, pa1, pa2, pa3);
  const float pmax = rowmax32(p0, p1);
  pv_one<1>(o[1], vb, pa0, pa1, pa2, pa3);
  alpha = 1.f;
  if (__builtin_expect(__any(pmax > THR2), 0)) { const float dl = __builtin_fmaxf(pmax, 0.f); m_reg += dl; alpha = __builtin_amdgcn_exp2f(-dl);
#pragma unroll
    for (int r = 0; r < 16; ++r) { p0[r] = p0[r] - dl; p1[r] = p1[r] - dl; negm[r] = -m_reg; }
    asm volatile("" : "+v"(negm)); }
#pragma unroll
  for (int r = 0; r < 4; ++r) p0[r] = __builtin_amdgcn_exp2f(p0[r]);
  pv_one<2>(o[2], vb, pa0, pa1, pa2, pa3);
#pragma unroll
  for (int r = 4; r < 10; ++r) p0[r] = __builtin_amdgcn_exp2f(p0[r]);
  pv_one<3>(o[3], vb, pa0, pa1, pa2, pa3);
#pragma unroll
  for (int r = 10; r < 16; ++r) p0[r] = __builtin_amdgcn_exp2f(p0[r]);
}

__device__ __forceinline__ void attn_unit(const bf16* __restrict__ P, int qrow0, int krow0, int NT, int h, float lam, float oml, const float* __restrict__ subg, bf16* __restrict__ AO, char* lds) {
  constexpr int LDK = LDPA;
  const int tid = opaque_tid(), wid = __builtin_amdgcn_readfirstlane(tid >> 6), lane = tid & 63, r32 = lane & 31, hi = lane >> 5;
  const int mp = wid >> 2, wq = wid & 3;
  bf16* V_lds = (bf16*)lds; bf16* K_lds = (bf16*)(lds + 2 * SHM_V);
  float* ws = (float*)(lds + 2 * SHM_V + 2 * SHM_K) + wid * 64; float* li_l = ws; float* al_l = ws + 32;
  float m_reg = 0.f, l_reg = 0; f32x16 o[4] = {}; bf16x8 qr[4]; f32x16 negm = f32x16{}; asm volatile("" : "+v"(negm));
  const bf16* Qw = P + (size_t)(qrow0 + wq * 32 + r32) * LDK + PC_Q + h * 128 + mp * 64 + hi * 8;
#pragma unroll
  for (int d0 = 0; d0 < 4; ++d0) qr[d0] = ld8(Qw + d0 * 16);
  const bf16* Kh = P + (size_t)krow0 * LDK + PC_K + h * 128; const bf16* Vh = P + (size_t)krow0 * LDK + PC_V + h * 128;
  const int cbase = mp * 64;
  const int sr = tid >> 4, sc = (tid & 15) * 8, vst0 = v_st(sr, sc), vst1 = v_st(32 + sr, sc);
  const int vb0 = (int)(uintptr_t)V_lds + v_rd_base(lane);
  struct { bf16x8 vs0, vs1, ks0, ks1; } sr_[2];
#define SLOAD(i, k0) do { sr_[i].vs0 = ld8(&Vh[(size_t)((k0) + sr) * LDK + sc]); sr_[i].vs1 = ld8(&Vh[(size_t)((k0) + 32 + sr) * LDK + sc]); \
    sr_[i].ks0 = ld8(&Kh[(size_t)((k0) + sr) * LDK + sc]); sr_[i].ks1 = ld8(&Kh[(size_t)((k0) + 32 + sr) * LDK + sc]); } while (0)
#define SWRITE(b, i) do { *(bf16x8*)((char*)V_lds + (b) * SHM_V + vst0) = sr_[i].vs0;          \
    *(bf16x8*)((char*)V_lds + (b) * SHM_V + vst1) = sr_[i].vs1; int kc = sc * 2;               \
    *(bf16x8*)((char*)K_lds + (b) * SHM_K + KSWZ(sr, kc)) = sr_[i].ks0;                       \
    *(bf16x8*)((char*)K_lds + (b) * SHM_K + KSWZ(32 + sr, kc)) = sr_[i].ks1; } while (0)
#define SWAIT() asm volatile("s_waitcnt vmcnt(4)" ::: "memory")
#define RESC(a) do { if (__any((a) < 1.f)) { if (hi == 0) al_l[r32] = (a); asm volatile("s_waitcnt lgkmcnt(0)" ::: "memory"); \
    _Pragma("unroll") for (int d = 0; d < 4; ++d) _Pragma("unroll") for (int r = 0; r < 16; ++r) o[d][r] *= al_l[crow(r, hi)]; } } while (0)
  f32x16 pA0, pA1, pB0, pB1; float alA, alB; bf16x8 pa0, pa1, pa2, pa3;
  constexpr int SE = 0, SO = 1;
  SLOAD(SE, 0); asm volatile("s_waitcnt vmcnt(0)" ::: "memory"); SWRITE(0, SE); __syncthreads();
  qkt(pA0, pA1, K_lds, qr, r32, hi, cbase, negm); firstSM(pA0, pA1, m_reg, negm, alA);
  SLOAD(SO, KVBLK); if (2 < NT) SLOAD(SE, 2 * KVBLK);
  SWAIT(); SWRITE(1, SO); __syncthreads();
  for (int j = 1; j + 1 < NT; j += 2) {
    SBAR(); qkt(pB0, pB1, (bf16*)((char*)K_lds + SHM_K), qr, r32, hi, cbase, negm);
    finishSM(pA0, pA1, alA, l_reg, pa0, pa1, pa2, pa3); SBAR();
    SLOAD(SO, (j + 2) * KVBLK); SBAR();
    pv_softmax(o, vb0, pa0, pa1, pa2, pa3, pB0, pB1, m_reg, negm, alB);
    __syncthreads(); SWAIT(); SWRITE(0, SE);
    RESC(alB); __syncthreads();
    SBAR(); qkt(pA0, pA1, K_lds, qr, r32, hi, cbase, negm);
    finishSM(pB0, pB1, alB, l_reg, pa0, pa1, pa2, pa3); SBAR();
    if (j + 3 < NT) SLOAD(SE, (j + 3) * KVBLK); SBAR();
    pv_softmax(o, vb0 + (int)SHM_V, pa0, pa1, pa2, pa3, pA0, pA1, m_reg, negm, alA);
    __syncthreads(); SWAIT(); SWRITE(1, SO);
    RESC(alA); __syncthreads();
  }
  SBAR(); qkt(pB0, pB1, (bf16*)((char*)K_lds + SHM_K), qr, r32, hi, cbase, negm);
  finishSM(pA0, pA1, alA, l_reg, pa0, pa1, pa2, pa3); SBAR();
  pv_softmax(o, vb0, pa0, pa1, pa2, pa3, pB0, pB1, m_reg, negm, alB);
  __syncthreads(); RESC(alB);
  finishSM(pB0, pB1, alB, l_reg, pa0, pa1, pa2, pa3); SBAR();
  pv_d0(o, vb0 + (int)SHM_V, pa0, pa1, pa2, pa3);
  if (hi == 0) li_l[r32] = l_reg; asm volatile("s_waitcnt lgkmcnt(0)" ::: "memory");
  float rli[16];
#pragma unroll
  for (int r = 0; r < 16; ++r) rli[r] = __builtin_amdgcn_rcpf(li_l[crow(r, hi)]);
  __syncthreads();
  { float* OB = (float*)lds + mp * (128 * 128) + (wq * 32) * 128;
#pragma unroll
    for (int r = 0; r < 16; ++r) { const int orow = crow(r, hi);
#pragma unroll
      for (int d0 = 0; d0 < 4; ++d0) OB[orow * 128 + d0 * 32 + r32] = o[d0][r] * rli[r]; } }
  __syncthreads();
  { const int row = tid >> 2, qd = tid & 3;
    const f32x4* A4 = (const f32x4*)((const float*)lds + row * 128 + qd * 32); const f32x4* B4 = A4 + (128 * 128) / 4;
    f32x4 dv[8]; float ss = 0.f;
#pragma unroll
    for (int j = 0; j < 8; ++j) { dv[j] = A4[j] - lam * B4[j]; ss += (dv[j][0] * dv[j][0] + dv[j][1] * dv[j][1]) + (dv[j][2] * dv[j][2] + dv[j][3] * dv[j][3]); }
    ss += __shfl_xor(ss, 1); ss += __shfl_xor(ss, 2);
    const float rstd = __builtin_amdgcn_rsqf(ss * (1.0f / 128.0f) + 1e-5f) ;
    const f32x4* g4 = (const f32x4*)(subg + qd * 32);
    bf16* op = AO + (size_t)(qrow0 + row) * DM + h * 128 + qd * 32;
#pragma unroll
    for (int j = 0; j < 4; ++j) { const f32x4 g0 = g4[2 * j], g1 = g4[2 * j + 1]; const f32x4 a = dv[2 * j] * rstd, b = dv[2 * j + 1] * rstd;
      u32x4 w; w.x = cvtpk(a[0] * g0[0] * oml, a[1] * g0[1] * oml); w.y = cvtpk(a[2] * g0[2] * oml, a[3] * g0[3] * oml);
      w.z = cvtpk(b[0] * g1[0] * oml, b[1] * g1[1] * oml); w.w = cvtpk(b[2] * g1[2] * oml, b[3] * g1[3] * oml);
      *(u32x4*)(op + j * 8) = w; } }
  __syncthreads();
#undef SLOAD
#undef SWRITE
#undef SWAIT
#undef RESC
}
#undef SBAR
}
__device__ __forceinline__ int scan_pos(int n, int d) { return d == 0 ? n : (n < CL ? (CL - 1) - n : (NPB + CL - 1) - n); }
typedef short sbf16x8 __attribute__((ext_vector_type(8)));
typedef float f32x2_t __attribute__((ext_vector_type(2))); typedef __bf16 bf16x2_t __attribute__((ext_vector_type(2)));
__device__ __forceinline__ unsigned cvtpk_bf(float lo, float hi) { f32x2_t v = {lo, hi}; bf16x2_t b = __builtin_convertvector(v, bf16x2_t); return __builtin_bit_cast(unsigned, b); }
__device__ __forceinline__ void scan_chain(int chain, const unsigned char* __restrict__ OPS, float* __restrict__ Y, LAS unsigned char* lds) {
    const int tid = opaque_tid(), wid = __builtin_amdgcn_readfirstlane(tid >> 6), lane = tid & 63, v15 = lane & 15, q = lane >> 4;
    const int d = chain >> 4, b = (chain >> 3) & 1, h = chain & 7;
    const unsigned char* rec = OPS + (size_t)chain * NCHUNK * OPS_REC;
    v4u g0, g1;
#define SCL_LOAD(c) do { const v4u* r_ = (const v4u*)(rec + (size_t)(c) * OPS_REC); g0 = r_[tid]; if (tid < 256) g1 = r_[512 + tid]; } while (0)
#define SCL_WRITE(buf) do { LAS v4u* o_ = (LAS v4u*)(lds + (buf) * OPS_REC); o_[tid] = g0; if (tid < 256) o_[512 + tid] = g1; } while (0)
    f32x4 S[4];
#pragma unroll
    for (int rt = 0; rt < 4; ++rt) S[rt] = (f32x4){0.f, 0.f, 0.f, 0.f};
    float* yo = Y + ((size_t)d * NR + (size_t)b * NPB) * 512 + h * 64 + wid * 16 + v15;
    SCL_LOAD(0); SCL_WRITE(0); __syncthreads();
    for (int c = 0; c < NCHUNK; ++c) {
        const int buf = c & 1;
        if (c + 1 < NCHUNK) SCL_LOAD(c + 1);
        if (wid < 4) {
            const LAS unsigned char* rb = lds + buf * OPS_REC;
            const LAS sbf16x8* T8 = (const LAS sbf16x8*)rb + lane;
            const sbf16x8 XT0 = T8[0], XT1 = T8[64], RT0 = T8[128], RT1 = T8[192], MT = T8[256], BK0 = T8[320], BK1 = T8[384], BK2 = T8[448], BK3 = T8[512];
            const v2u qt = *(const LAS v2u*)(rb + OR_QT + lane * 8);
            const v2u vq = *(const LAS v2u*)(rb + OR_VT + ((wid * 16 + v15) * 16 + 4 * q) * 2);
            const LAS f32x4* W4 = (const LAS f32x4*)(rb + OR_WC) + q;
            const f32x4 wc0 = W4[0], wc1 = W4[4], wc2 = W4[8], wc3 = W4[12];
            v4u t;
            t[0] = cvtpk_bf(S[0][0], S[0][1]); t[1] = cvtpk_bf(S[0][2], S[0][3]); t[2] = cvtpk_bf(S[1][0], S[1][1]); t[3] = cvtpk_bf(S[1][2], S[1][3]);
            const sbf16x8 bs0 = __builtin_bit_cast(sbf16x8, t);
            t[0] = cvtpk_bf(S[2][0], S[2][1]); t[1] = cvtpk_bf(S[2][2], S[2][3]); t[2] = cvtpk_bf(S[3][0], S[3][1]); t[3] = cvtpk_bf(S[3][2], S[3][3]);
            const sbf16x8 bs1 = __builtin_bit_cast(sbf16x8, t);
            t[0] = vq[0]; t[1] = vq[1]; t[2] = 0u; t[3] = 0u; const sbf16x8 vz = __builtin_bit_cast(sbf16x8, t);
            t[0] = qt[0]; t[1] = qt[1]; t[2] = 0u; t[3] = 0u; const sbf16x8 qz = __builtin_bit_cast(sbf16x8, t);
            f32x4 D = (f32x4){0.f, 0.f, 0.f, 0.f};
            D = __builtin_amdgcn_mfma_f32_16x16x32_bf16(XT0, bs0, D, 0, 0, 0);
            D = __builtin_amdgcn_mfma_f32_16x16x32_bf16(XT1, bs1, D, 0, 0, 0);
            D = __builtin_amdgcn_mfma_f32_16x16x32_bf16(qz, vz, D, 0, 0, 0);
            f32x4 Yv = (f32x4){0.f, 0.f, 0.f, 0.f};
            Yv = __builtin_amdgcn_mfma_f32_16x16x32_bf16(RT0, bs0, Yv, 0, 0, 0);
            Yv = __builtin_amdgcn_mfma_f32_16x16x32_bf16(RT1, bs1, Yv, 0, 0, 0);
            t[0] = cvtpk_bf(D[0], D[1]); t[1] = cvtpk_bf(D[2], D[3]); t[2] = vq[0]; t[3] = vq[1]; const sbf16x8 dv = __builtin_bit_cast(sbf16x8, t);
            Yv = __builtin_amdgcn_mfma_f32_16x16x32_bf16(MT, dv, Yv, 0, 0, 0);
            S[0] = __builtin_amdgcn_mfma_f32_16x16x32_bf16(BK0, dv, S[0] * wc0, 0, 0, 0);
            S[1] = __builtin_amdgcn_mfma_f32_16x16x32_bf16(BK1, dv, S[1] * wc1, 0, 0, 0);
            S[2] = __builtin_amdgcn_mfma_f32_16x16x32_bf16(BK2, dv, S[2] * wc2, 0, 0, 0);
            S[3] = __builtin_amdgcn_mfma_f32_16x16x32_bf16(BK3, dv, S[3] * wc3, 0, 0, 0);
#pragma unroll
            for (int i = 0; i < 4; ++i) yo[(size_t)scan_pos(c * 16 + 4 * q + i, d) * 512] = Yv[i];
        }
        if (c + 1 < NCHUNK) SCL_WRITE(buf ^ 1);
        __syncthreads();
    }
#undef SCL_LOAD
#undef SCL_WRITE
}

__device__ __forceinline__ void transpose_item(const float* __restrict__ W, int K, int N, bf16* __restrict__ WT, int out_row0, int k0, int n0, LAS float* scr, int lane) {
#pragma unroll 8
    for (int i = 0; i < 32; ++i) { const int kk = 2 * i + (lane >> 5); scr[kk * 33 + (lane & 31)] = W[(size_t)(k0 + kk) * N + n0 + (lane & 31)]; }
    LDS_WAIT(); asm volatile("" ::: "memory");
    const int c = lane & 7;
#pragma unroll
    for (int j = 0; j < 4; ++j) { const int n = (lane >> 3) + 8 * j; const LAS float* s = scr + (8 * c) * 33 + n;
        v4u o; o.x = pk2(s[0 * 33], s[1 * 33]); o.y = pk2(s[2 * 33], s[3 * 33]); o.z = pk2(s[4 * 33], s[5 * 33]); o.w = pk2(s[6 * 33], s[7 * 33]);
        *(v4u*)(WT + (size_t)(out_row0 + n) * K + k0 + 8 * c) = o; }
    LDS_WAIT(); asm volatile("" ::: "memory");
}
__device__ __forceinline__ void transpose_matrix_item(const float* W, int K, int N, bf16* WT, int item, int il_half  , LAS float* scr, int lane) {
    const int nblk = N / 32, kb = item / nblk, nb = item - kb * nblk, n0 = 32 * nb;
    const int orow = (il_half < 0) ? n0 : ((n0 >> 7) * 256 + il_half * 128 + (n0 & 127));
    transpose_item(W, K, N, WT, orow, 64 * kb, n0, scr, lane);
}

struct Ptrs {
    const float* in[34]; float* out; unsigned char* ws;
};
#define IN_X 0
#define IN_C 1
#define IN_CTX 2
#define IN_CCTX 3
#define IN_ADAW 4
#define IN_ADAB 5
#define IN_N1G 6
#define IN_N2G 7
#define IN_WIN 8
#define IN_WOUT 9
#define IN_DLAM 10
#define IN_SUBG 11
#define IN_MU 12
#define IN_W0 13
#define IN_W2 14
#define IN_A0 15
#define IN_A2 16
#define IN_V0 17
#define IN_V1 18
#define IN_V2 19
#define IN_G2 20
#define IN_KK 21
#define IN_KA 22
#define IN_RK 23
#define IN_LNW 24
#define IN_LNB 25
#define IN_FW1 26
#define IN_FW3 27
#define IN_FW2 28
#define IN_ROUTER 29
#define IN_EW1 30
#define IN_EW3 31
#define IN_EW2 32
#define IN_FINALG 33

__device__ __forceinline__ void phase_prologue(const Args& a, LAS unsigned char* lds, int vcu, int G) {
    const int tid = opaque_tid(), lane = tid & 63, wave = __builtin_amdgcn_readfirstlane(tid >> 6);
    unsigned char* ws = opaque_ptr(a.ws);
    LAS float* scr = (LAS float*)(lds + wave * 8704);
    LAS float* sl = (LAS float*)(lds + 73728);
    for (int i = tid; i < 3072; i += NTHR) { const float v = (i < 2048) ? a.in[IN_C][i] : a.in[IN_CCTX][i - 2048]; sl[i] = v * sigmoid_f(v); }
    __syncthreads();
    const int gw = vcu * NWAVES + wave, NGW = G * NWAVES;
    constexpr int T_MOD = 4 * 96;
    constexpr int I_WIN = 16 * (NIN / 32), I_WOUT = 16 * 32, I_F13 = 16 * (DFF / 32), I_F2 = (DFF / 64) * 32;
    constexpr int T_WIN = 4 * I_WIN, T_WOUT = 4 * I_WOUT, T_F1 = 2 * I_F13, T_F3 = 2 * I_F13, T_F2 = 2 * I_F2;
    constexpr int T_PAD = 4 * 32, T_ROPE = 64, T_LAM = 4;
    constexpr int NT = T_MOD + T_WIN + T_WOUT + T_F1 + T_F3 + T_F2 + T_PAD + T_ROPE + T_LAM;
    float* MOD = (float*)(ws + WS_MOD);
    for (int it = gw; it < NT; it += NGW) {
        int r = it;
        if (r < T_MOD) {
            const int l = r / 96, jg = r - l * 96; const float* aw = a.in[IN_ADAW] + (size_t)l * 1024 * 6144 + jg * 64 + lane;
            float a0 = 0.f, a1 = 0.f, a2 = 0.f;
#pragma unroll 8
            for (int i = 0; i < 1024; ++i) { const float w = aw[(size_t)i * 6144]; a0 += sl[i] * w; a1 += sl[1024 + i] * w; a2 += sl[2048 + i] * w; }
            const float bb = a.in[IN_ADAB][l * 6144 + jg * 64 + lane];
            MOD[(l * 3 + 0) * 6144 + jg * 64 + lane] = a0 + bb; MOD[(l * 3 + 1) * 6144 + jg * 64 + lane] = a1 + bb; MOD[(l * 3 + 2) * 6144 + jg * 64 + lane] = a2 + bb;
            continue; }
        r -= T_MOD;
        if (r < T_WIN) { const int l = r / I_WIN; transpose_matrix_item(a.in[IN_WIN] + (size_t)l * DM * NIN, DM, NIN, (bf16*)(ws + WS_WINT) + (size_t)l * NINP * DM, r - l * I_WIN, -1, scr, lane); continue; }
        r -= T_WIN;
        if (r < T_WOUT) { const int l = r / I_WOUT; transpose_matrix_item(a.in[IN_WOUT] + (size_t)l * DM * DM, DM, DM, (bf16*)(ws + WS_WOUTT) + (size_t)l * DM * DM, r - l * I_WOUT, -1, scr, lane); continue; }
        r -= T_WOUT;
        if (r < T_F1) { const int l = r / I_F13; transpose_matrix_item(a.in[IN_FW1] + (size_t)l * DM * DFF, DM, DFF, (bf16*)(ws + WS_W13T) + (size_t)l * 2 * DFF * DM, r - l * I_F13, 0, scr, lane); continue; }
        r -= T_F1;
        if (r < T_F3) { const int l = r / I_F13; transpose_matrix_item(a.in[IN_FW3] + (size_t)l * DM * DFF, DM, DFF, (bf16*)(ws + WS_W13T) + (size_t)l * 2 * DFF * DM, r - l * I_F13, 1, scr, lane); continue; }
        r -= T_F3;
        if (r < T_F2) { const int l = r / I_F2; transpose_matrix_item(a.in[IN_FW2] + (size_t)l * DFF * DM, DFF, DM, (bf16*)(ws + WS_W2T) + (size_t)l * DM * DFF, r - l * I_F2, -1, scr, lane); continue; }
        r -= T_F2;
        if (r < T_PAD) { const int l = r >> 5, row = NIN + (r & 31); v4u z = {0u, 0u, 0u, 0u}; v4u* o = (v4u*)((bf16*)(ws + WS_WINT) + ((size_t)l * NINP + row) * DM) + lane * 2; o[0] = z; o[1] = z; continue; }
        r -= T_PAD;
        if (r < T_ROPE) { const int e = r * 64 + lane, pos = e >> 4, j = e & 15;
            const float inv = __builtin_amdgcn_exp2f(-(float)(2 * j) * (13.287712379549449f / 32.0f)); const float ang = (float)pos * inv;
            float2* T = (float2*)(ws + WS_ROPE); T[e] = make_float2(cosf(ang), sinf(ang)); continue; }
        r -= T_ROPE;
        { const int l = r; const float* lp = a.in[IN_DLAM] + l * 256;
          const float s0 = wave_sum(lp[lane] * lp[64 + lane]), s1 = wave_sum(lp[128 + lane] * lp[192 + lane]);
          const float li = 0.8f - 0.6f * expf(-0.3f * (float)l);
          if (lane == 0) { float* L = (float*)(ws + WS_LAM); L[l * 2] = expf(s0) - expf(s1) + li; L[l * 2 + 1] = 1.0f - li; } }
    }
    { bf16* LB = (bf16*)(ws + WS_LORA);
      for (int o = (vcu * NTHR + tid); o < LO_TOTAL; o += G * NTHR) {
          float v;
          if (o < LO_A2) { const int m = o >> 14, r = o & 16383, chn = r >> 5, j = r & 31; v = a.in[IN_W2][((size_t)m * 32 + j) * 512 + chn]; }
          else if (o < LO_V2) { const int q = o - LO_A2; const int m = q >> 14, r = q & 16383, chn = r >> 5, j = r & 31; v = a.in[IN_A2][((size_t)m * 32 + j) * 512 + chn]; }
          else if (o < LO_G2) { const int q = o - LO_V2; const int m = q >> 14, r = q & 16383, chn = r >> 5, j = r & 31; v = a.in[IN_V2][((size_t)m * 32 + j) * 512 + chn]; }
          else if (o < LO_V1) { const int q = o - LO_G2; const int m = q / 49152, r = q - m * 49152, chn = r / 96, j = r - chn * 96; v = a.in[IN_G2][((size_t)m * 96 + j) * 512 + chn]; }
          else { const int q = o - LO_V1; const int m = q >> 14, r = q & 16383, j = r >> 9, chn = r & 511; v = a.in[IN_V1][((size_t)m * 512 + chn) * 32 + j]; }
          LB[o] = (bf16)f2bf(v); } }
}

__device__ __forceinline__ void phase_norm(const Args& a, LAS unsigned char* lds, int vcu, int G, int l, int which_norm, bool moe) {
    const int tid = opaque_tid(), lane = tid & 63, wave = __builtin_amdgcn_readfirstlane(tid >> 6);
    unsigned char* ws = opaque_ptr(a.ws);
    LAS float* tabA = (LAS float*)lds; LAS float* tabB = tabA + 3072; LAS float* rwT = tabB + 3072;
    const float* MOD = (const float*)(ws + WS_MOD) + (size_t)l * 3 * 6144;
    const float* ng = a.in[which_norm ? IN_N2G : IN_N1G] + l * 1024;
    const int off_sh = which_norm ? 3072 : 0, off_sc = off_sh + 1024;
    for (int i = tid; i < 3072; i += NTHR) { const int w = i >> 10, c = i & 1023; tabA[i] = ng[c] * (1.0f + MOD[w * 6144 + off_sc + c]); tabB[i] = MOD[w * 6144 + off_sh + c]; }
    if (moe) { const float* rw = a.in[IN_ROUTER] + (size_t)(l >> 1) * 1024 * 8; for (int i = tid; i < 8192; i += NTHR) { const int c = i >> 3, e = i & 7; rwT[e * 1024 + c] = rw[i]; } }
    __syncthreads();
    const float* srcLat = (l == 0 && which_norm == 0) ? a.in[IN_X] : a.out;
    const float* srcCtx = (l == 0 && which_norm == 0) ? a.in[IN_CTX] : (const float*)(ws + WS_XC);
    bf16* HN = (bf16*)(ws + WS_HN);
    const int gw = vcu * NWAVES + wave, NGW = G * NWAVES;
    for (int R = gw; R < NR; R += NGW) {
        const int b = R / NPB, p = R - b * NPB; const int w = (p < CL) ? 2 : b;
        const float* xr = (p < CL) ? srcCtx + (size_t)(b * CL + p) * 1024 : srcLat + ((size_t)b * SEQ + (p - CL)) * 1024;
        const f32x4* x4 = (const f32x4*)xr + lane;
        f32x4 v[4]; float ss = 0.f;
#pragma unroll
        for (int j = 0; j < 4; ++j) { v[j] = x4[64 * j]; ss += (v[j][0] * v[j][0] + v[j][1] * v[j][1]) + (v[j][2] * v[j][2] + v[j][3] * v[j][3]); }
        const float rstd = 1.0f / sqrtf(wave_sum(ss) * (1.0f / 1024.0f) + 1e-6f);
        const LAS f32x4* A4 = (const LAS f32x4*)(tabA + w * 1024) + lane; const LAS f32x4* B4 = (const LAS f32x4*)(tabB + w * 1024) + lane;
        unsigned long long* o8 = (unsigned long long*)(HN + (size_t)R * 1024) + lane;
#pragma unroll
        for (int j = 0; j < 4; ++j) { v[j] = (v[j] * rstd) * A4[64 * j] + B4[64 * j];
            o8[64 * j] = (unsigned long long)pk2(v[j][0], v[j][1]) | ((unsigned long long)pk2(v[j][2], v[j][3]) << 32); }
        if (moe) {
            float lg[8];
#pragma unroll
            for (int e = 0; e < 8; ++e) { const LAS f32x4* r4 = (const LAS f32x4*)(rwT + e * 1024) + lane; float s = 0.f;
#pragma unroll
                for (int j = 0; j < 4; ++j) { const f32x4 rr = r4[64 * j]; s += (v[j][0] * rr[0] + v[j][1] * rr[1]) + (v[j][2] * rr[2] + v[j][3] * rr[3]); }
                lg[e] = wave_sum(s); }
            int e1 = 0; float v1 = lg[0];
#pragma unroll
            for (int e = 1; e < 8; ++e) if (lg[e] > v1) { v1 = lg[e]; e1 = e; }
            int e2 = -1; float v2 = -3.0e38f;
#pragma unroll
            for (int e = 0; e < 8; ++e) if (e != e1 && lg[e] > v2) { v2 = lg[e]; e2 = e; }
            if (lane == 0) {
                const float g1 = 1.0f / (1.0f + __expf(v2 - v1)), g2 = 1.0f - g1;
                unsigned* cnt = (unsigned*)(ws + WS_CTL) + CW_CNT + (((l >> 1) * 2 + b) * 8) * 64;
                const unsigned p1 = atomicAdd(cnt + 64 * e1, 1u), p2 = atomicAdd(cnt + 64 * e2, 1u);
                unsigned* ro = (unsigned*)(ws + WS_ROUTE) + (size_t)R * 8;
                ro[0] = (unsigned)e1; ro[1] = (unsigned)e2; ro[2] = p1; ro[3] = p2; ro[4] = __float_as_uint(g1); ro[5] = __float_as_uint(g2);
            }
        }
    }
    if (moe) {
        LAS float* scr = (LAS float*)(lds + 57344 + wave * 8704);
        const int li = l >> 1;
        constexpr int I_13 = 16 * (DFE / 32), I_2 = (DFE / 64) * 32;
        constexpr int NTK = 8 * (2 * I_13 + I_2);
        for (int it = gw; it < NTK; it += NGW) {
            const int e = it / (2 * I_13 + I_2); int r = it - e * (2 * I_13 + I_2);
            if (r < I_13) { transpose_matrix_item(a.in[IN_EW1] + ((size_t)li * 8 + e) * DM * DFE, DM, DFE, (bf16*)(ws + WS_W13E) + (size_t)e * 2 * DFE * DM, r, 0, scr, lane); continue; }
            r -= I_13;
            if (r < I_13) { transpose_matrix_item(a.in[IN_EW3] + ((size_t)li * 8 + e) * DM * DFE, DM, DFE, (bf16*)(ws + WS_W13E) + (size_t)e * 2 * DFE * DM, r, 1, scr, lane); continue; }
            r -= I_13;
            transpose_matrix_item(a.in[IN_EW2] + ((size_t)li * 8 + e) * DFE * DM, DFE, DM, (bf16*)(ws + WS_W2E) + (size_t)e * DM * DFE, r, -1, scr, lane);
        }
    }
}
__device__ __forceinline__ float dpp_rowsum16(float x) {
    x += __builtin_bit_cast(float, __builtin_amdgcn_update_dpp(0, __builtin_bit_cast(int, x), 0xB1, 0xF, 0xF, true));
    x += __builtin_bit_cast(float, __builtin_amdgcn_update_dpp(0, __builtin_bit_cast(int, x), 0x4E, 0xF, 0xF, true));
    x += __builtin_bit_cast(float, __builtin_amdgcn_update_dpp(0, __builtin_bit_cast(int, x), 0x141, 0xF, 0xF, true));
    x += __builtin_bit_cast(float, __builtin_amdgcn_update_dpp(0, __builtin_bit_cast(int, x), 0x140, 0xF, 0xF, true));
    return x;
}
__device__ __forceinline__ void phase_prep(const Args& a, LAS unsigned char* lds, int G, int l, bool do_rope = true) {
    const int tid = opaque_tid(), lane = tid & 63, wave = __builtin_amdgcn_readfirstlane(tid >> 6), c16 = lane & 15, q = lane >> 4;
    unsigned char* ws = opaque_ptr(a.ws);
    const bf16* P = (const bf16*)(ws + WS_PR); bf16* PA = (bf16*)(ws + WS_PA);
    _Float16* SPK = (_Float16*)(ws + WS_SPK); _Float16* DPK = (_Float16*)(ws + WS_DPK); _Float16* VF = (_Float16*)(ws + WS_VFIRST); _Float16* GG = (_Float16*)(ws + WS_G);
    float* BON = (float*)(ws + WS_BONUS); const bf16* LB = (const bf16*)(ws + WS_LORA);
    LAS bf16* sP = (LAS bf16*)lds;
    LAS bf16* sWD = sP + 18 * 1536;
    LAS bf16* sAD = sWD + 16 * 64;
    LAS bf16* sGD = sAD + 16 * 64;
    LAS bf16* sVA = sGD + 16 * 96;
    LAS bf16* sVL = sVA + 16 * 512;
    LAS float* sPart = (LAS float*)(sVL + 16 * 32);
    const int h = wave, ch4 = h * 64 + 4 * c16;
    for (int tile = blockIdx.x; tile < NB * NCHUNK; tile += G) {
        const int b = tile / NCHUNK, tt = tile - b * NCHUNK, p0 = tt * 16;
        const int seg_lo = (tt < 16) ? 0 : CL, seg_hi = (tt < 16) ? CL : NPB;
        const size_t R0 = (size_t)b * NPB + p0;
        for (int pc = tid; pc < 18 * 192; pc += NTHR) { const int rr = pc / 192, cc = pc - rr * 192; const int p = p0 - 1 + rr;
            v4u x = {0u, 0u, 0u, 0u}; if (p >= seg_lo && p < seg_hi) x = *(const v4u*)(P + ((size_t)b * NPB + p) * LDPR + cc * 8);
            *(LAS v4u*)(sP + rr * 1536 + cc * 8) = x; }
        for (int idx = tid; idx < 16 * 224; idx += NTHR) { const int i = idx / 224, cc = idx - i * 224; const float val = bf2f(P[(R0 + i) * LDPR + PC_LORA + cc]);
            if (cc < 64) sWD[i * 64 + cc] = (bf16)f2bf(tanh_f(val)); else if (cc < 128) sAD[i * 64 + cc - 64] = (bf16)f2bf(val); else sGD[i * 96 + cc - 128] = (bf16)f2bf(sigmoid_f(val)); }
        __syncthreads();
        f32x4 rs[4], ks[4], vs[4];
        { f32x4 rw[6], kw[6], vw[6]; const float* mu = a.in[IN_MU] + (size_t)l * 3 * 2 * 512 + ch4;
          const f32x4 mur0 = *(const f32x4*)(mu), mur1 = *(const f32x4*)(mu + 512), muk0 = *(const f32x4*)(mu + 1024), muk1 = *(const f32x4*)(mu + 1536), muv0 = *(const f32x4*)(mu + 2048), muv1 = *(const f32x4*)(mu + 2560);
#pragma unroll
          for (int j = 0; j < 6; ++j) { const LAS bf16* rp = sP + (4 * q + j) * 1536 + ch4;
              const v2u xr = *(const LAS v2u*)(rp), xk = *(const LAS v2u*)(rp + 512), xv = *(const LAS v2u*)(rp + 1024);
              rw[j] = (f32x4){bflo(xr[0]), bfhi(xr[0]), bflo(xr[1]), bfhi(xr[1])}; kw[j] = (f32x4){bflo(xk[0]), bfhi(xk[0]), bflo(xk[1]), bfhi(xk[1])}; vw[j] = (f32x4){bflo(xv[0]), bfhi(xv[0]), bflo(xv[1]), bfhi(xv[1])}; }
#pragma unroll
          for (int i = 0; i < 4; ++i) { rs[i] = rw[i + 1] + mur0 * (rw[i] - rw[i + 1]) + mur1 * (rw[i + 2] - rw[i + 1]);
              ks[i] = kw[i + 1] + muk0 * (kw[i] - kw[i + 1]) + muk1 * (kw[i + 2] - kw[i + 1]);
              vs[i] = vw[i + 1] + muv0 * (vw[i] - vw[i + 1]) + muv1 * (vw[i + 2] - vw[i + 1]); } }
        f32x4 accV[4];
        if (l > 0) {
#pragma unroll
            for (int i = 0; i < 4; ++i) *(LAS v2u*)(sVA + (4 * q + i) * 512 + ch4) = (v2u){pk2(vs[i][0], vs[i][1]), pk2(vs[i][2], vs[i][3])};
            __syncthreads();
            { f32x4 pv0 = {0.f, 0.f, 0.f, 0.f}, pv1 = pv0; const bf16* v1b = LB + LO_V1 + (size_t)(l - 1) * 16384;
#pragma unroll
              for (int s2 = 0; s2 < 2; ++s2) { const sbf16x8 fa = *(const LAS sbf16x8*)(sVA + c16 * 512 + h * 64 + 32 * s2 + 8 * q);
                  const sbf16x8 fb0 = *(const sbf16x8*)(v1b + (size_t)c16 * 512 + h * 64 + 32 * s2 + 8 * q), fb1 = *(const sbf16x8*)(v1b + (size_t)(16 + c16) * 512 + h * 64 + 32 * s2 + 8 * q);
                  pv0 = __builtin_amdgcn_mfma_f32_16x16x32_bf16(fa, fb0, pv0, 0, 0, 0); pv1 = __builtin_amdgcn_mfma_f32_16x16x32_bf16(fa, fb1, pv1, 0, 0, 0); }
#pragma unroll
              for (int i = 0; i < 4; ++i) { sPart[(h * 16 + 4 * q + i) * 32 + c16] = pv0[i]; sPart[(h * 16 + 4 * q + i) * 32 + 16 + c16] = pv1[i]; } }
            __syncthreads();
            { float sacc = 0.f;
#pragma unroll
              for (int hh = 0; hh < 8; ++hh) sacc += sPart[hh * 512 + tid];
              sVL[tid] = (bf16)f2bf(sacc); }
            __syncthreads();
            { const sbf16x8 fa = *(const LAS sbf16x8*)(sVL + c16 * 32 + 8 * q); const bf16* v2b = LB + LO_V2 + ((size_t)(l - 1) * 512 + ch4) * 32 + 8 * q;
#pragma unroll
              for (int ct = 0; ct < 4; ++ct) { const sbf16x8 fb = *(const sbf16x8*)(v2b + ct * 32); accV[ct] = __builtin_amdgcn_mfma_f32_16x16x32_bf16(fa, fb, (f32x4){0.f, 0.f, 0.f, 0.f}, 0, 0, 0); } }
        }
        f32x4 vfin[4];
#pragma unroll
        for (int i = 0; i < 4; ++i) { const size_t R = R0 + 4 * q + i;
            if (l > 0) { const h4 vf = *(const h4*)(VF + R * 512 + ch4); const f32x4 v0p = *(const f32x4*)(a.in[IN_V0] + (l - 1) * 512 + ch4);
#pragma unroll
                for (int cc = 0; cc < 4; ++cc) { const float vp = vs[i][cc]; vfin[i][cc] = vp + ((float)vf[cc] - vp) * sigmoid_f(v0p[cc] + accV[cc][i]); } }
            else { vfin[i] = vs[i]; *(h4*)(VF + R * 512 + ch4) = (h4){(_Float16)vs[i][0], (_Float16)vs[i][1], (_Float16)vs[i][2], (_Float16)vs[i][3]}; } }
        { f32x4 accG[4];
#pragma unroll
          for (int ct = 0; ct < 4; ++ct) accG[ct] = (f32x4){0.f, 0.f, 0.f, 0.f};
#pragma unroll
          for (int s3 = 0; s3 < 3; ++s3) { const sbf16x8 fa = *(const LAS sbf16x8*)(sGD + c16 * 96 + 32 * s3 + 8 * q); const bf16* g2b = LB + LO_G2 + ((size_t)l * 512 + ch4) * 96 + 32 * s3 + 8 * q;
#pragma unroll
              for (int ct = 0; ct < 4; ++ct) { const sbf16x8 fb = *(const sbf16x8*)(g2b + ct * 96); accG[ct] = __builtin_amdgcn_mfma_f32_16x16x32_bf16(fa, fb, accG[ct], 0, 0, 0); } }
#pragma unroll
          for (int i = 0; i < 4; ++i) *(h4*)(GG + (R0 + 4 * q + i) * 512 + ch4) = (h4){(_Float16)accG[0][i], (_Float16)accG[1][i], (_Float16)accG[2][i], (_Float16)accG[3][i]}; }
        f32x4 kkv[4]; const f32x4 kkp = *(const f32x4*)(a.in[IN_KK] + l * 512 + ch4);
#pragma unroll
        for (int i = 0; i < 4; ++i) { const f32x4 t = ks[i] * kkp; float ss = (t[0] * t[0] + t[1] * t[1]) + (t[2] * t[2] + t[3] * t[3]); ss = dpp_rowsum16(ss);
            kkv[i] = t * (1.0f / sqrtf(fmaxf(ss, 1e-24f))); }
        float bon[4] = {0.f, 0.f, 0.f, 0.f};
#pragma unroll 1
        for (int d = 0; d < 2; ++d) {
            f32x4 accW[4], accA[4]; const f32x4 w0d = *(const f32x4*)(a.in[IN_W0] + (l * 2 + d) * 512 + ch4), a0d = *(const f32x4*)(a.in[IN_A0] + (l * 2 + d) * 512 + ch4);
            const f32x4 kap = *(const f32x4*)(a.in[IN_KA] + l * 512 + ch4), rkp = *(const f32x4*)(a.in[IN_RK] + l * 512 + ch4);
            { const sbf16x8 fw = *(const LAS sbf16x8*)(sWD + c16 * 64 + 32 * d + 8 * q), fad = *(const LAS sbf16x8*)(sAD + c16 * 64 + 32 * d + 8 * q);
              const bf16* w2b = LB + LO_W2 + (((size_t)l * 2 + d) * 512 + ch4) * 32 + 8 * q; const bf16* a2b = LB + LO_A2 + (((size_t)l * 2 + d) * 512 + ch4) * 32 + 8 * q;
#pragma unroll
              for (int ct = 0; ct < 4; ++ct) { accW[ct] = __builtin_amdgcn_mfma_f32_16x16x32_bf16(fw, *(const sbf16x8*)(w2b + ct * 32), (f32x4){0.f, 0.f, 0.f, 0.f}, 0, 0, 0);
                  accA[ct] = __builtin_amdgcn_mfma_f32_16x16x32_bf16(fad, *(const sbf16x8*)(a2b + ct * 32), (f32x4){0.f, 0.f, 0.f, 0.f}, 0, 0, 0); } }
#pragma unroll
            for (int i = 0; i < 4; ++i) { const int p = p0 + 4 * q + i; h4 oe, ob, ok;
#pragma unroll
                for (int cc = 0; cc < 4; ++cc) { const float e = 0.6065306597126334f * sigmoid_f(w0d[cc] + accW[cc][i]);
                    const float av = sigmoid_f(a0d[cc] + accA[cc][i]); const float kd = ks[i][cc] * (1.0f + (av - 1.0f) * kap[cc]);
                    oe[cc] = (_Float16)e; ob[cc] = (_Float16)(kkv[i][cc] * av); ok[cc] = (_Float16)kd; bon[i] += rs[i][cc] * kd * rkp[cc]; }
                _Float16* dpk = DPK + ((size_t)(((d * 2 + b) * 8 + h) * NPB) + p) * 192 + 4 * c16;
                *(h4*)dpk = oe; *(h4*)(dpk + 64) = ob; *(h4*)(dpk + 128) = ok; }
        }
#pragma unroll
        for (int i = 0; i < 4; ++i) { const int p = p0 + 4 * q + i;
            _Float16* spk = SPK + ((size_t)((b * 8 + h) * NPB) + p) * 192 + 4 * c16;
            *(h4*)spk = (h4){(_Float16)rs[i][0], (_Float16)rs[i][1], (_Float16)rs[i][2], (_Float16)rs[i][3]};
            *(h4*)(spk + 64) = (h4){(_Float16)kkv[i][0], (_Float16)kkv[i][1], (_Float16)kkv[i][2], (_Float16)kkv[i][3]};
            *(h4*)(spk + 128) = (h4){(_Float16)vfin[i][0], (_Float16)vfin[i][1], (_Float16)vfin[i][2], (_Float16)vfin[i][3]};
            const float bs = dpp_rowsum16(bon[i]);
            if (c16 == 0) BON[(R0 + 4 * q + i) * 8 + h] = bs; }
        __syncthreads();
    }
    if (do_rope) { const float2* RT = (const float2*)(ws + WS_ROPE);
      const int gw = blockIdx.x * NWAVES + wave, NGW = G * NWAVES; const int g = lane & 31, sub = lane >> 5;
      for (int rp = gw; rp < NR / 2; rp += NGW) {
          const int R = rp * 2 + sub; const int b = R / NPB, p = R - b * NPB;
          v4u* pp = (v4u*)(PA + (size_t)R * LDPA + g * 32);
          v4u x[4];
#pragma unroll
          for (int j = 0; j < 4; ++j) x[j] = pp[j];
          if (p < CL && g >= 16) continue;
          float e[32];
#pragma unroll
          for (int j = 0; j < 4; ++j)
#pragma unroll
              for (int k = 0; k < 4; ++k) { e[j * 8 + 2 * k] = bflo(x[j][k]); e[j * 8 + 2 * k + 1] = bfhi(x[j][k]); }
          if (p >= CL) { const int t = p - CL; const int pos = (g & 1) ? (t & 63) : (t >> 6);
#pragma unroll
              for (int j = 0; j < 16; ++j) { const float2 cs = RT[pos * 16 + j]; const float x1 = e[j], x2 = e[16 + j]; e[j] = x1 * cs.x - x2 * cs.y; e[16 + j] = x1 * cs.y + x2 * cs.x; } }
          const float sc = (g < 16) ? QSCALE : 1.0f;
#pragma unroll
          for (int j = 0; j < 4; ++j) { v4u o;
#pragma unroll
              for (int k = 0; k < 4; ++k) o[k] = pk2(e[j * 8 + 2 * k] * sc, e[j * 8 + 2 * k + 1] * sc);
              pp[j] = o; }
      } }
}

__device__ __forceinline__ void phase_prep2(const Args& a, LAS unsigned char* lds, int vcu, int G) {
    const int tid = opaque_tid(), lane = tid & 63, wave = __builtin_amdgcn_readfirstlane(tid >> 6), t15 = lane & 15, q = lane >> 4;
    unsigned char* ws = opaque_ptr(a.ws);
    const _Float16* SPK = (const _Float16*)(ws + WS_SPK); const _Float16* DPK = (const _Float16*)(ws + WS_DPK);
    LAS unsigned char* wl = lds + wave * 16384;
    LAS bf16* sAt = (LAS bf16*)wl; LAS bf16* sBh = sAt + 1024; LAS bf16* sKh = sBh + 1024; LAS bf16* sRt = sKh + 1024; LAS bf16* sXT = sRt + 1024;
    LAS bf16* sBbT = sXT + 1024; LAS bf16* sKbT = sBbT + 1024;
    LAS float* sM = (LAS float*)(sKbT + 1024); LAS float* sQ = sM + 256;
    const int gw = vcu * NWAVES + wave, NGW = G * NWAVES;
    for (int task = gw; task < 32 * NCHUNK; task += NGW) {
        const int chain = task / NCHUNK, c = task - chain * NCHUNK; const int d = chain >> 4, b = (chain >> 3) & 1, h = chain & 7;
        const _Float16* sp = SPK + (size_t)((b * 8 + h) * NPB) * 192; const _Float16* dp = DPK + (size_t)(((d * 2 + b) * 8 + h) * NPB) * 192;
        unsigned char* rec = ws + WS_OPS + ((size_t)chain * NCHUNK + c) * OPS_REC;
        float xa[16], bhv[16], khv[16]; float L = 0.f; unsigned vtp[8];
#pragma unroll
        for (int t = 0; t < 16; ++t) {
            const int p = scan_pos(c * 16 + t, d);
            const float e = (float)dp[(size_t)p * 192 + lane], bb = (float)dp[(size_t)p * 192 + 64 + lane], kd = (float)dp[(size_t)p * 192 + 128 + lane];
            const float r = (float)sp[(size_t)p * 192 + lane], kk = (float)sp[(size_t)p * 192 + 64 + lane], vv = (float)sp[(size_t)p * 192 + 128 + lane];
            const float ep = __expf(L); L -= e; const float en = __expf(-L), ec = __expf(L);
            xa[t] = -kk * ep; bhv[t] = bb * en; khv[t] = kd * en;
            sAt[t * 64 + lane] = (bf16)f2bf(xa[t]); sBh[t * 64 + lane] = (bf16)f2bf(bhv[t]); sKh[t * 64 + lane] = (bf16)f2bf(khv[t]); sRt[t * 64 + lane] = (bf16)f2bf(r * ec);
            if (t & 1) vtp[t >> 1] |= f2bf(vv) << 16; else vtp[t >> 1] = f2bf(vv);
        }
        { const float wc = __expf(L); ((float*)(rec + OR_WC))[lane] = wc;
          v4u o0, o1;
#pragma unroll
          for (int j = 0; j < 4; ++j) { o0[j] = pk2(bhv[2 * j] * wc, bhv[2 * j + 1] * wc); o1[j] = pk2(bhv[8 + 2 * j] * wc, bhv[9 + 2 * j] * wc); }
          ((LAS v4u*)(sBbT + lane * 16))[0] = o0; ((LAS v4u*)(sBbT + lane * 16))[1] = o1;
#pragma unroll
          for (int j = 0; j < 4; ++j) { o0[j] = pk2(khv[2 * j] * wc, khv[2 * j + 1] * wc); o1[j] = pk2(khv[8 + 2 * j] * wc, khv[9 + 2 * j] * wc); }
          ((LAS v4u*)(sKbT + lane * 16))[0] = o0; ((LAS v4u*)(sKbT + lane * 16))[1] = o1;
          v4u* vo = (v4u*)(rec + OR_VT) + lane * 2; vo[0] = (v4u){vtp[0], vtp[1], vtp[2], vtp[3]}; vo[1] = (v4u){vtp[4], vtp[5], vtp[6], vtp[7]}; }
        LDS_WAIT(); asm volatile("" ::: "memory");
        f32x4 mab = {0.f, 0.f, 0.f, 0.f}, mak = mab, mbr = mab, mkr = mab;
#pragma unroll
        for (int s2 = 0; s2 < 2; ++s2) {
            const sbf16x8 fa = *(const LAS sbf16x8*)(sAt + t15 * 64 + 32 * s2 + 8 * q), fb = *(const LAS sbf16x8*)(sBh + t15 * 64 + 32 * s2 + 8 * q);
            const sbf16x8 fk = *(const LAS sbf16x8*)(sKh + t15 * 64 + 32 * s2 + 8 * q), fr = *(const LAS sbf16x8*)(sRt + t15 * 64 + 32 * s2 + 8 * q);
            mab = __builtin_amdgcn_mfma_f32_16x16x32_bf16(fb, fa, mab, 0, 0, 0); mak = __builtin_amdgcn_mfma_f32_16x16x32_bf16(fk, fa, mak, 0, 0, 0);
            mbr = __builtin_amdgcn_mfma_f32_16x16x32_bf16(fb, fr, mbr, 0, 0, 0); mkr = __builtin_amdgcn_mfma_f32_16x16x32_bf16(fk, fr, mkr, 0, 0, 0);
        }
#pragma unroll
        for (int i = 0; i < 4; ++i) { const int j = 4 * q + i; if (j >= t15) { mab[i] = 0.f; mak[i] = 0.f; } if (j > t15) { mbr[i] = 0.f; mkr[i] = 0.f; } }
        *(LAS f32x4*)(sM + t15 * 16 + 4 * q) = mab;
        *(LAS f32x4*)(sQ + t15 * 16 + 4 * q) = mak;
        { v4u mt; mt[0] = pk2(mbr[0], mbr[1]); mt[1] = pk2(mbr[2], mbr[3]); mt[2] = pk2(mkr[0], mkr[1]); mt[3] = pk2(mkr[2], mkr[3]); ((v4u*)rec)[4 * 64 + lane] = mt; }
        LDS_WAIT(); asm volatile("" ::: "memory");
        float qv[16];
#pragma unroll
        for (int t = 0; t < 16; ++t) qv[t] = sQ[t * 16 + t15];
#pragma unroll
        for (int t = 1; t < 16; ++t) {
            float m[16];
#pragma unroll
            for (int j4 = 0; j4 < (t + 3) / 4; ++j4) { const f32x4 mm = *(const LAS f32x4*)(sM + t * 16 + 4 * j4); m[4 * j4] = mm[0]; m[4 * j4 + 1] = mm[1]; m[4 * j4 + 2] = mm[2]; m[4 * j4 + 3] = mm[3]; }
#pragma unroll
            for (int j = 0; j < t; ++j) { xa[t] += m[j] * xa[j]; qv[t] += m[j] * qv[j]; }
        }
        asm volatile("" ::: "memory");
#pragma unroll
        for (int t = 0; t < 16; ++t) { sXT[t * 64 + lane] = (bf16)f2bf(xa[t]); if (q == 0) sQ[t * 16 + t15] = qv[t]; }
        LDS_WAIT(); asm volatile("" ::: "memory");
        { v4u* R4 = (v4u*)rec;
#pragma unroll
          for (int s2 = 0; s2 < 2; ++s2) {
              const v2u x0 = *(const LAS v2u*)(sXT + t15 * 64 + 32 * s2 + 4 * q), x1 = *(const LAS v2u*)(sXT + t15 * 64 + 32 * s2 + 16 + 4 * q);
              R4[s2 * 64 + lane] = (v4u){x0[0], x0[1], x1[0], x1[1]};
              const v2u r0 = *(const LAS v2u*)(sRt + t15 * 64 + 32 * s2 + 4 * q), r1 = *(const LAS v2u*)(sRt + t15 * 64 + 32 * s2 + 16 + 4 * q);
              R4[(2 + s2) * 64 + lane] = (v4u){r0[0], r0[1], r1[0], r1[1]}; }
#pragma unroll
          for (int rt = 0; rt < 4; ++rt) {
              const v2u b0 = *(const LAS v2u*)(sBbT + (16 * rt + t15) * 16 + 4 * q), k0 = *(const LAS v2u*)(sKbT + (16 * rt + t15) * 16 + 4 * q);
              R4[(5 + rt) * 64 + lane] = (v4u){b0[0], b0[1], k0[0], k0[1]}; }
          const f32x4 qq = *(const LAS f32x4*)(sQ + t15 * 16 + 4 * q);
          ((v2u*)(rec + OR_QT))[lane] = (v2u){pk2(qq[0], qq[1]), pk2(qq[2], qq[3])}; }
        LDS_WAIT(); asm volatile("" ::: "memory");
    }
}

__device__ __forceinline__ void phase_mix(const Args& a, LAS unsigned char* lds, volatile LAS unsigned* MISC, int l, int ql, unsigned xcc, bool do_scan = true, bool do_attn = true) {
    const int tid = opaque_tid();
    unsigned char* ws = opaque_ptr(a.ws);
    unsigned* ctl = (unsigned*)(ws + WS_CTL);
    const bf16* P = (const bf16*)(ws + WS_PA);
    if (do_scan) { int xq = (int)(xcc & 7u), tried = 0;
      while (tried < 8) {
          if (tid == 0) MISC[16] = atomicAdd(ctl + CW_QS + (ql * 8 + xq) * 64, 1u);
          __syncthreads(); const unsigned idx = MISC[16]; __syncthreads();
          if (idx >= 4u) { xq = (xq + 1) & 7; ++tried; continue; }
#ifndef NO_SCAN
          scan_chain(xq * 4 + (int)idx, (const unsigned char*)(ws + WS_OPS), (float*)(ws + WS_Y), lds);
#endif
      } }
    if (do_attn) { const float* L = (const float*)(ws + WS_LAM); const float lam = L[l * 2], oml = L[l * 2 + 1];
      const float* subg = a.in[IN_SUBG] + l * 128; bf16* AO = (bf16*)(ws + WS_HN);
      int xq = (int)(xcc & 7u), tried = 0;
      while (tried < 8) {
          if (tid == 0) MISC[16] = atomicAdd(ctl + CW_QA + (ql * 8 + xq) * 64, 1u);
          __syncthreads(); const unsigned idx = MISC[16]; __syncthreads();
          if (idx >= 130u) { xq = (xq + 1) & 7; ++tried; continue; }
          const int b = xq >> 2, h = xq & 3;
#ifndef NO_ATTN
          if (idx < 128u) att::attn_unit(P, b * NPB + CL + (int)idx * 128, b * NPB, NPB / 64, h, lam, oml, subg, AO, (char*)lds);
          else att::attn_unit(P, b * NPB + ((int)idx - 128) * 128, b * NPB, CL / 64, h, lam, oml, subg, AO, (char*)lds);
#endif
      } }
}

__device__ __forceinline__ void phase_finish(const Args& a, int G, int l) {
    const int tid = opaque_tid(), lane = tid & 63, wave = __builtin_amdgcn_readfirstlane(tid >> 6);
    unsigned char* ws = opaque_ptr(a.ws);
    const float* Y = (const float*)(ws + WS_Y); const _Float16* SPK = (const _Float16*)(ws + WS_SPK); const _Float16* GG = (const _Float16*)(ws + WS_G); const float* BON = (const float*)(ws + WS_BONUS);
    bf16* AO = (bf16*)(ws + WS_HN);
    const int ch = tid, h = wave, c = lane;
    const float lw = a.in[IN_LNW][l * 512 + ch], lb = a.in[IN_LNB][l * 512 + ch];
    for (int R = blockIdx.x; R < NR; R += G) {
        const int b = R / NPB, p = R - b * NPB;
        const float y = Y[(size_t)R * 512 + ch] + Y[((size_t)NR + R) * 512 + ch];
        const float mean = wave_sum(y) * (1.0f / 64.0f); const float dv = y - mean; const float var = wave_sum(dv * dv) * (1.0f / 64.0f);
        float o = dv * (1.0f / sqrtf(var + 64e-5f)) * lw + lb;
        const float vv = (float)SPK[((size_t)((b * 8 + h) * NPB) + p) * 192 + 128 + c];
        o += BON[(size_t)R * 8 + h] * vv;
        o *= (float)GG[(size_t)R * 512 + ch];
        AO[(size_t)R * 1024 + 512 + ch] = (bf16)f2bf(o);
    }
}

__device__ __forceinline__ void phase_gather(const Args& a, int vcu, int G, int l, int half) {
    const int tid = opaque_tid(), lane = tid & 63, wave = __builtin_amdgcn_readfirstlane(tid >> 6);
    unsigned char* ws = opaque_ptr(a.ws);
    const unsigned* cnt = (const unsigned*)(ws + WS_CTL) + CW_CNT + (((l >> 1) * 2 + half) * 8) * 64;
    int off[8]; { int r = 0;
#pragma unroll
        for (int e = 0; e < 8; ++e) { off[e] = r; const int n = (int)__hip_atomic_load(cnt + 64 * e, __ATOMIC_RELAXED, __HIP_MEMORY_SCOPE_AGENT); r += ((n + 255) >> 8) << 8; } }
    const bf16* HN = (const bf16*)(ws + WS_HN); bf16* AG = (bf16*)(ws + WS_AG);
    const int gw = vcu * NWAVES + wave, NGW = G * NWAVES;
    for (int rr = gw; rr < NPB; rr += NGW) {
        const int R = half * NPB + rr;
        unsigned* ro = (unsigned*)(ws + WS_ROUTE) + (size_t)R * 8;
        const int e1 = (int)ro[0], e2 = (int)ro[1]; const int p1 = (int)ro[2], p2 = (int)ro[3];
        int o1 = 0, o2 = 0;
#pragma unroll
        for (int e = 0; e < 8; ++e) { if (e == e1) o1 = off[e]; if (e == e2) o2 = off[e]; }
        const int s1 = o1 + p1, s2 = o2 + p2;
        const v4u* src = (const v4u*)(HN + (size_t)R * 1024) + lane * 2; const v4u x0 = src[0], x1 = src[1];
        v4u* d1 = (v4u*)(AG + (size_t)s1 * 1024) + lane * 2; v4u* d2 = (v4u*)(AG + (size_t)s2 * 1024) + lane * 2;
        d1[0] = x0; d1[1] = x1; d2[0] = x0; d2[1] = x1;
        if (lane == 0) { ro[6] = (unsigned)s1; ro[7] = (unsigned)s2; }
    }
}
__device__ __forceinline__ void phase_combine(const Args& a, int vcu, int G, int l, int half) {
    const int tid = opaque_tid(), lane = tid & 63, wave = __builtin_amdgcn_readfirstlane(tid >> 6);
    unsigned char* ws = opaque_ptr(a.ws);
    const bf16* YE = (const bf16*)(ws + WS_YEXP);
    const float* MOD = (const float*)(ws + WS_MOD) + (size_t)l * 3 * 6144 + 5120;
    const int gw = vcu * NWAVES + wave, NGW = G * NWAVES;
    for (int rr = gw; rr < NPB; rr += NGW) {
        const int R = half * NPB + rr; const int b = half, p = rr; const int w = (p < CL) ? 2 : b;
        const unsigned* ro = (const unsigned*)(ws + WS_ROUTE) + (size_t)R * 8;
        const float g1 = __uint_as_float(ro[4]), g2 = __uint_as_float(ro[5]); const int s1 = (int)ro[6], s2 = (int)ro[7];
        float* xr = (p < CL) ? (float*)(ws + WS_XC) + (size_t)(b * CL + p) * 1024 : a.out + ((size_t)b * SEQ + (p - CL)) * 1024;
        const f32x4* gt = (const f32x4*)(MOD + (size_t)w * 6144);
        const v4u* y1 = (const v4u*)(YE + (size_t)s1 * 1024); const v4u* y2 = (const v4u*)(YE + (size_t)s2 * 1024);
#pragma unroll
        for (int j = 0; j < 2; ++j) { const int c8 = lane + 64 * j;
            const v4u u1 = y1[c8], u2 = y2[c8]; f32x4* xp = (f32x4*)xr + c8 * 2; f32x4 x0 = xp[0], x1 = xp[1]; const f32x4 t0 = gt[c8 * 2], t1 = gt[c8 * 2 + 1];
            x0[0] += t0[0] * (g1 * bflo(u1[0]) + g2 * bflo(u2[0])); x0[1] += t0[1] * (g1 * bfhi(u1[0]) + g2 * bfhi(u2[0]));
            x0[2] += t0[2] * (g1 * bflo(u1[1]) + g2 * bflo(u2[1])); x0[3] += t0[3] * (g1 * bfhi(u1[1]) + g2 * bfhi(u2[1]));
            x1[0] += t1[0] * (g1 * bflo(u1[2]) + g2 * bflo(u2[2])); x1[1] += t1[1] * (g1 * bfhi(u1[2]) + g2 * bfhi(u2[2]));
            x1[2] += t1[2] * (g1 * bflo(u1[3]) + g2 * bflo(u2[3])); x1[3] += t1[3] * (g1 * bfhi(u1[3]) + g2 * bfhi(u2[3]));
            xp[0] = x0; xp[1] = x1; }
    }
}
__device__ __forceinline__ void phase_final(const Args& a, int vcu, int G) {
    const int tid = opaque_tid(), lane = tid & 63, wave = __builtin_amdgcn_readfirstlane(tid >> 6);
    const int gw = vcu * NWAVES + wave, NGW = G * NWAVES;
    const f32x4* g4 = (const f32x4*)a.in[IN_FINALG] + lane;
    for (int r = gw; r < NB * SEQ; r += NGW) {
        f32x4* x4 = (f32x4*)(a.out + (size_t)r * 1024) + lane; f32x4 v[4]; float ss = 0.f;
#pragma unroll
        for (int j = 0; j < 4; ++j) { v[j] = x4[64 * j]; ss += (v[j][0] * v[j][0] + v[j][1] * v[j][1]) + (v[j][2] * v[j][2] + v[j][3] * v[j][3]); }
        const float rstd = 1.0f / sqrtf(wave_sum(ss) * (1.0f / 1024.0f) + 1e-6f);
#pragma unroll
        for (int j = 0; j < 4; ++j) x4[64 * j] = (v[j] * rstd) * g4[64 * j];
    }
}
#ifndef MK_MULTI
#define MK_MULTI 0
#endif
constexpr int N_PHASES = 1 + 2 * 10 + 2 * 16 + 1;

__global__ void __launch_bounds__(NTHR, 2) mk_fwd(Args args) {
    extern __shared__ __attribute__((aligned(16))) unsigned char lds_raw[];
    LAS unsigned char* lds = (LAS unsigned char*)lds_raw;
    volatile LAS unsigned* MISC = (volatile LAS unsigned*)(lds + MISC_OFF);
    const int tid = threadIdx.x;
    const int G = gridDim.x; const int bx = blockIdx.x; const int vcu = (G % 8 == 0) ? (bx % 8) * (G / 8) + bx / 8 : bx;
    unsigned char* ws = args.ws;
    unsigned* ctl = (unsigned*)(ws + WS_CTL);
    for (int u = tid; u < (LDS_BYTES - LDSCTL_OFF) / 4; u += NTHR) ((LAS unsigned*)(lds + LDSCTL_OFF))[u] = 0u;
    __syncthreads();
    const int lo = args.ph_lo, hi = args.ph_hi;
    XcdBarrier bar; bar.bar = ctl + CW_BAR; bar.x = xb_xcc_id(); bar.st = MISC + 8;
    if (hi - lo > 1) bar = xcd_barrier_post(ctl + CW_BAR, MISC + 8);
    const unsigned xcc = bar.x;
    int seq = 0;
#ifndef PH_MASK
#define PH_MASK 0xFFFFFFFFu
#endif
#define PH_ON(b) ((PH_MASK >> (b)) & 1u)
#ifndef DUP_SCAN
#define DUP_SCAN true
#endif
#ifndef DUP_ATTN
#define DUP_ATTN true
#endif
#ifndef DUP_MASK
#define DUP_MASK 0u
#endif
#define DUP_ON(b) ((DUP_MASK >> (b)) & 1u)
#define REP(b, stmt) do { if (PH_ON(b)) { stmt; if (DUP_ON(b)) { xcd_barrier(bar); stmt; } } } while (0)
#define PH_BEGIN if (lo <= seq && seq < hi) { unsigned char* ws = opaque_ptr(args.ws); (void)ws;
#define PH_END   if (seq + 1 < hi) xcd_barrier(bar); } ++seq;

    PH_BEGIN REP(0, phase_prologue(args, lds, vcu, G)); PH_END

    for (int l = 0; l < DEPTH; ++l) {
        const bool moe = (l & 1) != 0;
        const float* MODl = (const float*)(ws + WS_MOD) + (size_t)l * 3 * 6144;
        PH_BEGIN if (PH_ON(1)) phase_norm(args, lds, vcu, G, l, 0, false); PH_END
        PH_BEGIN {
            pg8::Gemm g{(const pg8::bf16_t*)(ws + WS_HN), (const pg8::bf16_t*)(ws + WS_WINT) + (size_t)l * NINP * DM, NR, NINP, DM};
            pg8::StaticOrder S; S.init(NR, NINP, G, bx);
            pg8::EpiStoreSplit E{(pg8::bf16_t*)(ws + WS_PA), LDPA, (pg8::bf16_t*)(ws + WS_PR), LDPR, LDPA / 256};
            REP(2, (pg8::gemm_phase<pg8::EpiStoreSplit, pg8::StaticOrder, true, true>(lds, g, S, E)));
        } PH_END
        PH_BEGIN if (PH_ON(3)) { phase_prep(args, lds, G, l); if (DUP_ON(3)) { xcd_barrier(bar); phase_prep(args, lds, G, l, false); } } PH_END
        PH_BEGIN REP(15, phase_prep2(args, lds, vcu, G)); PH_END
        PH_BEGIN if (PH_ON(4)) { phase_mix(args, lds, MISC, l, l, xcc); if (DUP_ON(4)) { xcd_barrier(bar); phase_mix(args, lds, MISC, l, l + 4, xcc, DUP_SCAN, DUP_ATTN); } } PH_END
        PH_BEGIN REP(5, phase_finish(args, G, l)); PH_END
        PH_BEGIN {
            pg8::Gemm g{(const pg8::bf16_t*)(ws + WS_HN), (const pg8::bf16_t*)(ws + WS_WOUTT) + (size_t)l * DM * DM, NR, DM, DM};
            pg8::StaticOrder S; S.init(NR, DM, G, bx);
            pg8::EpiResid E{(l == 0) ? args.in[IN_X] : args.out, (l == 0) ? args.in[IN_CTX] : (const float*)(ws + WS_XC), args.out, (float*)(ws + WS_XC), MODl + 2048};
            if (PH_ON(6)) pg8::gemm_phase<pg8::EpiResid, pg8::StaticOrder, true, true>(lds, g, S, E);
        } PH_END
        PH_BEGIN if (PH_ON(7)) phase_norm(args, lds, vcu, G, l, 1, moe); PH_END
        if (!moe) {
            PH_BEGIN {
                pg8::Gemm g{(const pg8::bf16_t*)(ws + WS_HN), (const pg8::bf16_t*)(ws + WS_W13T) + (size_t)(l >> 1) * 2 * DFF * DM, NR, 2 * DFF, DM};
                pg8::StaticOrder S; S.init(NR, 2 * DFF, G, bx);
                pg8::EpiSwiGLU E{(pg8::bf16_t*)(ws + WS_HF), DFF, 0};
                REP(8, (pg8::gemm_phase<pg8::EpiSwiGLU, pg8::StaticOrder, true, true>(lds, g, S, E)));
            } PH_END
            PH_BEGIN {
                pg8::Gemm g{(const pg8::bf16_t*)(ws + WS_HF), (const pg8::bf16_t*)(ws + WS_W2T) + (size_t)(l >> 1) * DM * DFF, NR, DM, DFF};
                pg8::StaticOrder S; S.init(NR, DM, G, bx);
                pg8::EpiResid E{args.out, (const float*)(ws + WS_XC), args.out, (float*)(ws + WS_XC), MODl + 5120};
                if (PH_ON(9)) pg8::gemm_phase<pg8::EpiResid, pg8::StaticOrder, true, true>(lds, g, S, E);
            } PH_END
        } else {
            for (int half = 0; half < 2; ++half) {
                const unsigned* cnt = (const unsigned*)ctl + CW_CNT + (((l >> 1) * 2 + half) * 8) * 64;
                PH_BEGIN if (PH_ON(10)) phase_gather(args, vcu, G, l, half); PH_END
                PH_BEGIN {
                    pg8::Gemm g{(const pg8::bf16_t*)(ws + WS_AG), (const pg8::bf16_t*)(ws + WS_W13E), 35328, 8 * 2 * DFE, DM};
                    pg8::MoeOrder S; S.init(cnt, (2 * DFE) / 256, G, bx);
                    pg8::EpiSwiGLU E{(pg8::bf16_t*)(ws + WS_HMOE), DFE, (2 * DFE) / 256};
                    REP(11, (pg8::gemm_phase<pg8::EpiSwiGLU, pg8::MoeOrder, true, true>(lds, g, S, E)));
                } PH_END
                PH_BEGIN {
                    pg8::Gemm g{(const pg8::bf16_t*)(ws + WS_HMOE), (const pg8::bf16_t*)(ws + WS_W2E), 35328, 8 * DM, DFE};
                    pg8::MoeOrder S; S.init(cnt, DM / 256, G, bx);
                    pg8::EpiStoreBf16 E{(pg8::bf16_t*)(ws + WS_YEXP), DM, DM / 256};
                    REP(12, (pg8::gemm_phase<pg8::EpiStoreBf16, pg8::MoeOrder, true, true>(lds, g, S, E)));
                } PH_END
                PH_BEGIN if (PH_ON(13)) phase_combine(args, vcu, G, l, half); PH_END
            }
        }
    }
    PH_BEGIN if (PH_ON(14)) phase_final(args, vcu, G); PH_END
#undef PH_BEGIN
#undef PH_END
}

extern "C" void kernel_launch(void* const* d_in, const int* in_sizes, int n_in, void* d_out, int out_size, void* d_ws, size_t ws_size, hipStream_t stream) {
    static int grid = 0;
    if (grid == 0) {
        if (n_in != 34 || out_size != NB * SEQ * DM || ws_size < WS_END) { fprintf(stderr, "kernel_launch: unexpected shapes (n_in %d out %d ws %zu, need %zu)\n", n_in, out_size, ws_size, (size_t)WS_END); grid = -1; return; }
        int dev = 0, cus = 0, per_cu = 0;
        if (hipGetDevice(&dev) != hipSuccess || hipDeviceGetAttribute(&cus, hipDeviceAttributeMultiprocessorCount, dev) != hipSuccess) { grid = -1; return; }
        if (hipFuncSetAttribute((const void*)mk_fwd, hipFuncAttributeMaxDynamicSharedMemorySize, LDS_BYTES) != hipSuccess) { fprintf(stderr, "kernel_launch: hipFuncSetAttribute failed\n"); grid = -1; return; }
        if (hipOccupancyMaxActiveBlocksPerMultiprocessor(&per_cu, (const void*)mk_fwd, NTHR, LDS_BYTES) != hipSuccess || per_cu < 1) fprintf(stderr, "kernel_launch: occupancy query reports %d blocks per CU\n", per_cu);
        (void)hipGetLastError();
        grid = cus;
    }
    if (grid < 0) return;
    if (hipMemsetAsync((char*)d_ws + WS_CTL, 0, CTL_ZERO_BYTES, stream) != hipSuccess) return;
    Args a{};
    for (int i = 0; i < 34; ++i) a.in[i] = (const float*)d_in[i];
    a.out = (float*)d_out; a.ws = (unsigned char*)d_ws;
#if MK_MULTI
    for (int s = 0; s < N_PHASES; ++s) { a.ph_lo = s; a.ph_hi = s + 1; hipLaunchKernelGGL(mk_fwd, dim3(grid), dim3(NTHR), LDS_BYTES, stream, a); }
#else
    a.ph_lo = 0; a.ph_hi = N_PHASES;
    hipLaunchKernelGGL(mk_fwd, dim3(grid), dim3(NTHR), LDS_BYTES, stream, a);
#endif
    const hipError_t le = hipPeekAtLastError();
    if (le != hipSuccess) fprintf(stderr, "kernel_launch: launch failed: %s\n", hipGetErrorName(le));
}
```

```cpp
#include <hip/hip_runtime.h>
#include <cstdio>
#include <cstdint>
__device__ __forceinline__ int opaque_tid() { int t = (int)threadIdx.x; asm volatile("" : "+v"(t)); return t; }
template <class T> __device__ __forceinline__ T* opaque_ptr(T* p) { __attribute__((address_space(1))) T* g = (__attribute__((address_space(1))) T*)p; asm volatile("" : "+s"(g)); return (T*)g; }
template <class T> __device__ __forceinline__ const T* gptr(const T* p) { return (const T*)(const __attribute__((address_space(1))) T*)p; }
namespace pg8 {
#define PG8_LAS __attribute__((address_space(3)))
typedef unsigned short bf16_t;
typedef short bf16x8 __attribute__((ext_vector_type(8)));
typedef float f32x4 __attribute__((ext_vector_type(4)));
typedef unsigned u32x4 __attribute__((ext_vector_type(4)));
constexpr int BM = 256, BK = 64, HALF = 128, HTB = HALF * BK * 2  , STAGE_BYTES = 8 * HTB, NXCD = 8, WGM = 8;

__host__ __device__ __forceinline__ int lds_byte(int r, int c) { const int st = (r >> 4) * 2 + (c >> 5), rr = r & 15, cc = c & 31, ob = rr * 64 + cc * 2; return st * 1024 + (ob ^ (((ob >> 9) & 1) << 5)); }
__host__ __device__ __forceinline__ void stage_rc(int b, int& R, int& C) { const int st = b / 1024, sb = b % 1024, swz = sb ^ (((sb >> 9) & 1) << 5); R = (st >> 1) * 16 + swz / 64; C = (st & 1) * 32 + (swz % 64) / 2; }
__host__ __device__ __forceinline__ int perm32(int rho) { const int n = rho >> 4, i = rho & 15; return 8 * (i >> 2) + 4 * n + (i & 3); }

struct Unit { int pm, pn; };
struct Gemm { const bf16_t* A; const bf16_t* Bt; int M, N, K; };

struct StaticOrder {
    int nM, nN, nwg, G, c;
    __host__ __device__ void init(int M, int N, int G_, int c_) { nM = M / BM; nN = N / BM; nwg = nM * nN; G = G_; c = c_; }
    __host__ __device__ bool next(int i, Unit& u) const {
        const long L = (long)i * G + c; if (L >= nwg) return false;
        int wgid = (int)L; { const int q = nwg / NXCD, r = nwg % NXCD, xcd = wgid % NXCD, off = wgid / NXCD; wgid = (xcd < r ? xcd * (q + 1) : r * (q + 1) + (xcd - r) * q) + off; }
        const int nig = WGM * nN, gid = wgid / nig, fm = gid * WGM, gsz = (nM - fm) < WGM ? (nM - fm) : WGM;
        u.pm = fm + ((wgid % nig) % gsz); u.pn = (wgid % nig) / gsz; return true;
    }
    __device__ __forceinline__ void a_ready(const Unit&) const {}
    __device__ __forceinline__ void done(const Unit&) const {}
};

__device__ __forceinline__ unsigned cvt_pk_bf16(float lo, float hi) { unsigned r; asm volatile("v_cvt_pk_bf16_f32 %0, %1, %2" : "=v"(r) : "v"(lo), "v"(hi)); return r; }
typedef float f32x2 __attribute__((ext_vector_type(2)));
__device__ __forceinline__ float silu_acc(float a) { return a * __builtin_amdgcn_rcpf(1.0f + __builtin_amdgcn_exp2f(-1.4426950408889634f * a)); }
struct EpiStoreBf16 {
    static constexpr bool PERM = true, AFTER_DRAIN = false;
    bf16_t* O; int ldc; int ncolt;
    __device__ __forceinline__ void operator()(const f32x4 (&acc)[2][2][4][2], const Unit& u, int wr, int wc, int fr, int fq) const {
        const int row0 = u.pm * BM + wr * 64 + fr; const int pnl = ncolt ? (u.pn % ncolt) : u.pn;
        const int col0 = pnl * BM + wc * 32 + 8 * fq;
#pragma unroll
        for (int ai = 0; ai < 2; ++ai)
#pragma unroll
            for (int m = 0; m < 4; ++m) { bf16_t* rowp = O + (size_t)(row0 + ai * HALF + m * 16) * ldc + col0;
#pragma unroll
                for (int bj = 0; bj < 2; ++bj) { const f32x4 v0 = acc[ai][bj][m][0], v1 = acc[ai][bj][m][1];
                    u32x4 w; w.x = cvt_pk_bf16(v0[0], v0[1]); w.y = cvt_pk_bf16(v0[2], v0[3]); w.z = cvt_pk_bf16(v1[0], v1[1]); w.w = cvt_pk_bf16(v1[2], v1[3]);
                    *(__attribute__((address_space(1))) u32x4*)(rowp + bj * HALF) = w; } }
    }
};
struct EpiStoreSplit {
    static constexpr bool PERM = true, AFTER_DRAIN = false;
    bf16_t* O0; int ld0; bf16_t* O1; int ld1; int nt0; const float* RT  ; float qscale;
    __device__ __forceinline__ void operator()(const f32x4 (&acc)[2][2][4][2], const Unit& u, int wr, int wc, int fr, int fq) const {
        const int row0 = u.pm * BM + wr * 64 + fr; const bool first = u.pn < nt0; const int pnl = first ? u.pn : u.pn - nt0; const int ldc = first ? ld0 : ld1; bf16_t* O = first ? O0 : O1;
        const int col0 = pnl * BM + wc * 32 + 8 * fq;
        const int bb = u.pm / 65, jt = u.pm - bb * 65;
        if (u.pn < 4 && (jt != 0 || u.pn < 2)) {
            const float sc = (u.pn < 2) ? qscale : 1.0f; const bool hi = (fq >> 1) != 0;
#pragma unroll
            for (int ai = 0; ai < 2; ++ai)
#pragma unroll
                for (int m = 0; m < 4; ++m) { bf16_t* rowp = O + (size_t)(row0 + ai * HALF + m * 16) * ldc + col0;
                    f32x4 cs[4];
                    if (jt != 0) { const int t = (jt - 1) * 256 + ai * HALF + wr * 64 + m * 16 + fr; const int pos = (wc & 1) ? (t & 63) : (t >> 6);
                        const f32x4* cp = (const f32x4*)(RT + (size_t)(pos * 16 + 8 * (fq & 1)) * 2);
#pragma unroll
                        for (int k = 0; k < 4; ++k) cs[k] = cp[k]; }
#pragma unroll
                    for (int bj = 0; bj < 2; ++bj) { f32x4 v[2] = {acc[ai][bj][m][0], acc[ai][bj][m][1]};
                        if (jt != 0) {
#pragma unroll
                            for (int n = 0; n < 2; ++n)
#pragma unroll
                                for (int i = 0; i < 4; ++i) { const float xf = v[n][i]; const unsigned xv = __builtin_bit_cast(unsigned, xf);
                                    auto rr = __builtin_amdgcn_permlane32_swap(xv, xv, false, false);
                                    const unsigned r0 = rr[0], r1 = rr[1]; const float x1 = __builtin_bit_cast(float, r0), x2 = __builtin_bit_cast(float, r1);
                                    const int k = 4 * n + i; const float c = cs[k >> 1][(k & 1) * 2], s = cs[k >> 1][(k & 1) * 2 + 1];
                                    v[n][i] = hi ? (x1 * s + x2 * c) : (x1 * c - x2 * s); } }
                        u32x4 w; w.x = cvt_pk_bf16(v[0][0] * sc, v[0][1] * sc); w.y = cvt_pk_bf16(v[0][2] * sc, v[0][3] * sc); w.z = cvt_pk_bf16(v[1][0] * sc, v[1][1] * sc); w.w = cvt_pk_bf16(v[1][2] * sc, v[1][3] * sc);
                        *(__attribute__((address_space(1))) u32x4*)(rowp + bj * HALF) = w; } }
            return;
        }
#pragma unroll
        for (int ai = 0; ai < 2; ++ai)
#pragma unroll
            for (int m = 0; m < 4; ++m) { bf16_t* rowp = O + (size_t)(row0 + ai * HALF + m * 16) * ldc + col0;
#pragma unroll
                for (int bj = 0; bj < 2; ++bj) { const f32x4 v0 = acc[ai][bj][m][0], v1 = acc[ai][bj][m][1];
                    u32x4 w; w.x = cvt_pk_bf16(v0[0], v0[1]); w.y = cvt_pk_bf16(v0[2], v0[3]); w.z = cvt_pk_bf16(v1[0], v1[1]); w.w = cvt_pk_bf16(v1[2], v1[3]);
                    *(__attribute__((address_space(1))) u32x4*)(rowp + bj * HALF) = w; } }
    }
};
struct EpiSwiGLU {
    static constexpr bool PERM = true, AFTER_DRAIN = false;
    bf16_t* O; int ldc; int ncolt;
    __device__ __forceinline__ void operator()(const f32x4 (&acc)[2][2][4][2], const Unit& u, int wr, int wc, int fr, int fq) const {
        const int row0 = u.pm * BM + wr * 64 + fr; const int pnl = ncolt ? (u.pn % ncolt) : u.pn;
        const int col0 = pnl * HALF + wc * 32 + 8 * fq;
#pragma unroll
        for (int ai = 0; ai < 2; ++ai)
#pragma unroll
            for (int m = 0; m < 4; ++m) { bf16_t* rowp = O + (size_t)(row0 + ai * HALF + m * 16) * ldc + col0;
                const f32x4 a0 = acc[ai][0][m][0], a1 = acc[ai][0][m][1], b0 = acc[ai][1][m][0], b1 = acc[ai][1][m][1];
                u32x4 w;
                w.x = cvt_pk_bf16(silu_acc(a0[0]) * b0[0], silu_acc(a0[1]) * b0[1]); w.y = cvt_pk_bf16(silu_acc(a0[2]) * b0[2], silu_acc(a0[3]) * b0[3]);
                w.z = cvt_pk_bf16(silu_acc(a1[0]) * b1[0], silu_acc(a1[1]) * b1[1]); w.w = cvt_pk_bf16(silu_acc(a1[2]) * b1[2], silu_acc(a1[3]) * b1[3]);
                *(__attribute__((address_space(1))) u32x4*)rowp = w; }
    }
};
constexpr int XPITCH = 2048;
struct EpiResid {
    static constexpr bool PERM = true, AFTER_DRAIN = false;
    const float* srcF; bf16_t* X; const float* gate3;
    __device__ __forceinline__ void operator()(const f32x4 (&acc)[2][2][4][2], const Unit& u, int wr, int wc, int fr, int fq) const {
        const int b = u.pm / 65, j = u.pm - b * 65;
        const size_t r0 = (size_t)b * 16384 + (size_t)(j - 1) * 256;
        const float* gp = gate3 + (size_t)b * 6144;
        const int col0 = u.pn * BM + wc * 32 + 8 * fq;
        f32x4 gv[2][2];
#pragma unroll
        for (int bj = 0; bj < 2; ++bj)
#pragma unroll
            for (int n = 0; n < 2; ++n) gv[bj][n] = *(const f32x4*)(gp + col0 + bj * HALF + n * 4);
#pragma unroll
        for (int ai = 0; ai < 2; ++ai)
#pragma unroll
            for (int m = 0; m < 4; ++m) { const size_t row = r0 + (size_t)(ai * HALF + wr * 64 + m * 16 + fr);
#pragma unroll
                for (int bj = 0; bj < 2; ++bj) { const int c = col0 + bj * HALF; f32x4 x0, x1;
                    if (srcF != nullptr) { const __attribute__((address_space(1))) f32x4* sp = (const __attribute__((address_space(1))) f32x4*)(srcF + row * 1024 + c); x0 = sp[0]; x1 = sp[1]; }
                    else { const u32x4 w = *(const __attribute__((address_space(1))) u32x4*)(X + row * XPITCH + c);
                        x0 = (f32x4){__builtin_bit_cast(float, w.x << 16), __builtin_bit_cast(float, w.x & 0xffff0000u), __builtin_bit_cast(float, w.y << 16), __builtin_bit_cast(float, w.y & 0xffff0000u)};
                        x1 = (f32x4){__builtin_bit_cast(float, w.z << 16), __builtin_bit_cast(float, w.z & 0xffff0000u), __builtin_bit_cast(float, w.w << 16), __builtin_bit_cast(float, w.w & 0xffff0000u)}; }
                    const f32x4 y0 = x0 + gv[bj][0] * acc[ai][bj][m][0], y1 = x1 + gv[bj][1] * acc[ai][bj][m][1];
                    u32x4 o; o.x = cvt_pk_bf16(y0[0], y0[1]); o.y = cvt_pk_bf16(y0[2], y0[3]); o.z = cvt_pk_bf16(y1[0], y1[1]); o.w = cvt_pk_bf16(y1[2], y1[3]);
                    *(__attribute__((address_space(1))) u32x4*)(X + row * XPITCH + c) = o; }
                if (m & 1) asm volatile("" ::: "memory"); }
    }
};
struct LatentOrder {
    StaticOrder so;
    __device__ __forceinline__ void init(int N, int G_, int c_) { so.init(128 * BM, N, G_, c_); }
    __device__ __forceinline__ bool next(int i, Unit& u) const { if (!so.next(i, u)) return false; u.pm = u.pm + 1 + (u.pm >= 64 ? 1 : 0); return true; }
    __device__ __forceinline__ void a_ready(const Unit&) const {}
    __device__ __forceinline__ void done(const Unit&) const {}
};
struct EpiNull {
    static constexpr bool PERM = false, AFTER_DRAIN = false;
    float* sink;
    __device__ __forceinline__ void operator()(const f32x4 (&acc)[2][2][4][2], const Unit& u, int wr, int wc, int fr, int fq) const {
        float s = 0.f;
#pragma unroll
        for (int ai = 0; ai < 2; ++ai)
#pragma unroll
            for (int bj = 0; bj < 2; ++bj)
#pragma unroll
                for (int m = 0; m < 4; ++m)
#pragma unroll
                    for (int n = 0; n < 2; ++n) s += acc[ai][bj][m][n][0] + acc[ai][bj][m][n][1] + acc[ai][bj][m][n][2] + acc[ai][bj][m][n][3];
        if (s == 123456.789f) *sink = s;
    }
};
struct MoeOrder {
    int t0, t1, t2, t3, t4, t5, t6, t7; int ncol, G, c;
    __device__ __forceinline__ void init(const unsigned* cnt  , int ncol_, int G_, int c_) {
        ncol = ncol_; G = G_; c = c_;
#define MO_T(e) (((int)__hip_atomic_load(cnt + 64 * (e), __ATOMIC_RELAXED, __HIP_MEMORY_SCOPE_AGENT) + 255) >> 8)
        t0 = MO_T(0); t1 = MO_T(1); t2 = MO_T(2); t3 = MO_T(3); t4 = MO_T(4); t5 = MO_T(5); t6 = MO_T(6); t7 = MO_T(7);
#undef MO_T
    }
    __device__ __forceinline__ bool next(int i, Unit& u) const {
        int L = i * G + c;
        {
          const int U = (t0 + t1 + t2 + t3 + t4 + t5 + t6 + t7) * ncol; if (L >= U) return false;
          const int q = U / NXCD, r = U % NXCD, xcd = L % NXCD, off = L / NXCD; L = (xcd < r ? xcd * (q + 1) : r * (q + 1) + (xcd - r) * q) + off; }
        int e = 0, r0 = 0, te = t0; bool found = false;
#define MO_STEP(k, tk) if (!found) { if (L < (tk) * ncol) { e = (k); te = (tk); found = true; } else { L -= (tk) * ncol; r0 += (tk); } }
        MO_STEP(0, t0) MO_STEP(1, t1) MO_STEP(2, t2) MO_STEP(3, t3) MO_STEP(4, t4) MO_STEP(5, t5) MO_STEP(6, t6) MO_STEP(7, t7)
#undef MO_STEP
        if (!found) return false;
        const int nig = WGM * ncol, gid = L / nig, fm = gid * WGM, gsz = (te - fm) < WGM ? (te - fm) : WGM, rr = L - gid * nig;
        u.pm = r0 + fm + rr % gsz; u.pn = e * ncol + rr / gsz; return true;
    }
    __device__ __forceinline__ void a_ready(const Unit&) const {}
    __device__ __forceinline__ void done(const Unit&) const {}
};
template <class Epi, class Sched, bool ALIGN_EPI = false, bool SP2 = false>
__device__ __forceinline__ void gemm_phase(PG8_LAS unsigned char* lds, const Gemm g, const Sched& S, const Epi& E) {
    const int tid = opaque_tid(), wid = __builtin_amdgcn_readfirstlane(tid >> 6), lane = tid & 63, wr = wid >> 2, wc = wid & 3, fr = lane & 15, fq = lane >> 4;
    const int K = g.K, nt = K / BK;
    unsigned voffA[2], voffB[2];
#pragma unroll
    for (int i = 0; i < 2; ++i) { int R, C; stage_rc(tid * 16 + i * 8192, R, C); const int Rb = Epi::PERM ? ((R & ~31) + perm32(R & 31)) : R;
        voffA[i] = (unsigned)(R * K + C) * 2u; voffB[i] = (unsigned)(Rb * K + C) * 2u; }
    const size_t kstep = (size_t)(BK * 2);
    const size_t hstep = (size_t)HALF * K * 2;
    const size_t tstep = 2 * hstep;
    const unsigned ldsw = (unsigned)wid * 1024u;
    const int aoff = lds_byte(wr * 64 + fr, fq * 8), boff = lds_byte(wc * 32 + fr, fq * 8);
#define PG8_SA(b, h) (((b) * 2 + (h)) * HTB)
#define PG8_SB(b, h) ((4 + (b) * 2 + (h)) * HTB)
#define PG8_STAGE(bufoff, gbase, voff) do { _Pragma("unroll") for (int _i = 0; _i < 2; ++_i) \
        __builtin_amdgcn_global_load_lds((const unsigned*)((const char*)(gbase) + (voff)[_i]), (PG8_LAS unsigned*)(lds + (bufoff) + ldsw + _i * 8192), 16, 0, 0); } while (0)
#define PG8_LDA(dst, b, h) do { _Pragma("unroll") for (int m = 0; m < 4; ++m) _Pragma("unroll") for (int k = 0; k < 2; ++k) dst[m][k] = *(const PG8_LAS bf16x8*)(lds + PG8_SA(b, h) + aoff + m * 2048 + k * 1024); } while (0)
#define PG8_LDB(dst, b, h) do { _Pragma("unroll") for (int n = 0; n < 2; ++n) _Pragma("unroll") for (int k = 0; k < 2; ++k) dst[n][k] = *(const PG8_LAS bf16x8*)(lds + PG8_SB(b, h) + boff + n * 2048 + k * 1024); } while (0)
#define PG8_MMA(ai, bj, At, Bt) do { __builtin_amdgcn_s_setprio(1); _Pragma("unroll") for (int m = 0; m < 4; ++m) _Pragma("unroll") for (int n = 0; n < 2; ++n) _Pragma("unroll") for (int k = 0; k < 2; ++k) \
        acc[ai][bj][m][n] = __builtin_amdgcn_mfma_f32_16x16x32_bf16(Bt[n][k], At[m][k], acc[ai][bj][m][n], 0, 0, 0); __builtin_amdgcn_s_setprio(0); } while (0)
#define PG8_WAIT_V(n) asm volatile("s_waitcnt vmcnt(" #n ")" ::: "memory")
#define PG8_WAIT_L(n) asm volatile("s_waitcnt lgkmcnt(" #n ")" ::: "memory")
#define PG8_BAR __builtin_amdgcn_s_barrier()
#define PG8_SCHED __builtin_amdgcn_sched_barrier(0)
    Unit cur, nxt; int ui = 0;
    if (!S.next(0, cur)) return;
    f32x4 acc[2][2][4][2];
#pragma unroll
    for (int a = 0; a < 2; ++a)
#pragma unroll
        for (int b = 0; b < 2; ++b)
#pragma unroll
            for (int m = 0; m < 4; ++m)
#pragma unroll
                for (int n = 0; n < 2; ++n) acc[a][b][m][n] = (f32x4){0.f, 0.f, 0.f, 0.f};
    bf16x8 At[4][2], B0[2][2], B1[2][2];
    const char* cA = (const char*)g.A + (size_t)cur.pm * tstep; const char* cB = (const char*)g.Bt + (size_t)cur.pn * tstep;
    S.a_ready(cur);
    if constexpr (SP2) {
        PG8_STAGE(PG8_SB(0, 0), cB, voffB); PG8_STAGE(PG8_SB(0, 1), cB + hstep, voffB); PG8_STAGE(PG8_SA(0, 0), cA, voffA); PG8_STAGE(PG8_SA(0, 1), cA + hstep, voffA);
        if (wr == 1) PG8_BAR;
        PG8_WAIT_V(2); PG8_BAR;
        PG8_STAGE(PG8_SB(1, 0), cB + kstep, voffB); PG8_STAGE(PG8_SA(1, 0), cA + kstep, voffA); PG8_STAGE(PG8_SB(1, 1), cB + hstep + kstep, voffB);
        PG8_WAIT_V(6); PG8_BAR;
    } else {
        PG8_STAGE(PG8_SB(0, 0), cB, voffB); PG8_STAGE(PG8_SA(0, 0), cA, voffA); PG8_STAGE(PG8_SB(0, 1), cB + hstep, voffB); PG8_STAGE(PG8_SA(0, 1), cA + hstep, voffA);
        if (wr == 1) PG8_BAR;
        PG8_WAIT_V(4); PG8_BAR;
        PG8_STAGE(PG8_SB(1, 0), cB + kstep, voffB); PG8_STAGE(PG8_SA(1, 0), cA + kstep, voffA); PG8_STAGE(PG8_SB(1, 1), cB + hstep + kstep, voffB);
        PG8_WAIT_V(6); PG8_BAR;
    }
    for (;;) {
        const bool has_next = S.next(ui + 1, nxt);
        const char* nA = has_next ? (const char*)g.A + (size_t)nxt.pm * tstep : cA; const char* nB = has_next ? (const char*)g.Bt + (size_t)nxt.pn * tstep : cB;
        for (int t = 0; t < nt; t += 2) {
            const bool last = (t == nt - 2);
            const char* a1 = cA + (size_t)(t + 1) * kstep;
            const char* a2 = last ? nA : cA + (size_t)(t + 2) * kstep; const char* b2 = last ? nB : cB + (size_t)(t + 2) * kstep;
            const char* a3 = a2 + kstep; const char* b3 = b2 + kstep;
            if (last && has_next) S.a_ready(nxt);
            if constexpr (SP2) {
            PG8_LDB(B0, 0, 0); PG8_LDB(B1, 0, 1); PG8_SCHED; PG8_LDA(At, 0, 0); PG8_STAGE(PG8_SA(1, 1), a1 + hstep, voffA);
            PG8_WAIT_V(8); PG8_WAIT_L(0); PG8_BAR; PG8_MMA(0, 0, At, B0); PG8_MMA(0, 1, At, B1); PG8_BAR; PG8_SCHED;
            PG8_LDA(At, 0, 1); PG8_STAGE(PG8_SB(0, 0), b2, voffB); PG8_STAGE(PG8_SB(0, 1), b2 + hstep, voffB); PG8_STAGE(PG8_SA(0, 0), a2, voffA);
            PG8_WAIT_V(8); PG8_WAIT_L(0); PG8_BAR; PG8_MMA(1, 0, At, B0); PG8_MMA(1, 1, At, B1); PG8_BAR; PG8_SCHED;
            PG8_LDB(B0, 1, 0); PG8_LDB(B1, 1, 1); PG8_SCHED; PG8_LDA(At, 1, 0); PG8_STAGE(PG8_SA(0, 1), a2 + hstep, voffA);
            PG8_WAIT_V(8); PG8_WAIT_L(0); PG8_BAR; PG8_MMA(0, 0, At, B0); PG8_MMA(0, 1, At, B1); PG8_BAR; PG8_SCHED;
            PG8_LDA(At, 1, 1); PG8_STAGE(PG8_SB(1, 0), b3, voffB); PG8_STAGE(PG8_SB(1, 1), b3 + hstep, voffB); PG8_STAGE(PG8_SA(1, 0), a3, voffA);
            PG8_WAIT_V(8); PG8_WAIT_L(0); PG8_BAR; PG8_MMA(1, 0, At, B0); PG8_MMA(1, 1, At, B1); PG8_BAR; PG8_SCHED;
            } else {
            PG8_LDB(B0, 0, 0); PG8_SCHED; PG8_LDA(At, 0, 0); PG8_STAGE(PG8_SA(1, 1), a1 + hstep, voffA);
            PG8_WAIT_L(8); PG8_BAR; PG8_WAIT_L(0); PG8_MMA(0, 0, At, B0); PG8_BAR; PG8_SCHED;
            PG8_LDB(B1, 0, 1); PG8_STAGE(PG8_SB(0, 0), b2, voffB);
            PG8_BAR; PG8_WAIT_L(0); PG8_MMA(0, 1, At, B1); PG8_BAR;
            PG8_LDA(At, 0, 1); PG8_STAGE(PG8_SA(0, 0), a2, voffA);
            PG8_BAR; PG8_WAIT_L(0); PG8_MMA(1, 0, At, B0); PG8_BAR; PG8_SCHED;
            PG8_STAGE(PG8_SB(0, 1), b2 + hstep, voffB);
            PG8_WAIT_V(6); PG8_BAR; PG8_MMA(1, 1, At, B1); PG8_BAR;
            PG8_LDB(B0, 1, 0); PG8_SCHED; PG8_LDA(At, 1, 0); PG8_STAGE(PG8_SA(0, 1), a2 + hstep, voffA);
            PG8_WAIT_L(8); PG8_BAR; PG8_WAIT_L(0); PG8_MMA(0, 0, At, B0); PG8_BAR; PG8_SCHED;
            PG8_LDB(B1, 1, 1); PG8_STAGE(PG8_SB(1, 0), b3, voffB);
            PG8_BAR; PG8_WAIT_L(0); PG8_MMA(0, 1, At, B1); PG8_BAR;
            PG8_LDA(At, 1, 1); PG8_STAGE(PG8_SA(1, 0), a3, voffA);
            PG8_BAR; PG8_WAIT_L(0); PG8_MMA(1, 0, At, B0); PG8_BAR; PG8_SCHED;
            PG8_STAGE(PG8_SB(1, 1), b3 + hstep, voffB);
            PG8_WAIT_V(6); PG8_BAR; PG8_MMA(1, 1, At, B1); PG8_BAR;
            }
        }
        if constexpr (ALIGN_EPI) { if (wr == 0) PG8_BAR; }
        if constexpr (!Epi::AFTER_DRAIN) { E(acc, cur, wr, wc, fr, fq); S.done(cur); }
        if (!has_next) break;
#pragma unroll
        for (int a = 0; a < 2; ++a)
#pragma unroll
            for (int b = 0; b < 2; ++b)
#pragma unroll
                for (int m = 0; m < 4; ++m)
#pragma unroll
                    for (int n = 0; n < 2; ++n) acc[a][b][m][n] = (f32x4){0.f, 0.f, 0.f, 0.f};
        cur = nxt; cA = nA; cB = nB; ++ui;
        if constexpr (ALIGN_EPI) { if (wr == 1) PG8_BAR; }
    }
    PG8_WAIT_V(0);
    if constexpr (!ALIGN_EPI) { if (wr == 0) PG8_BAR; }
    PG8_BAR;
    if constexpr (Epi::AFTER_DRAIN) { E.fused(acc, cur, wr, wc, fr, fq, lds, wid, lane); S.done(cur); }
#undef PG8_SA
#undef PG8_SB
#undef PG8_STAGE
#undef PG8_LDA
#undef PG8_LDB
#undef PG8_MMA
#undef PG8_WAIT_V
#undef PG8_WAIT_L
#undef PG8_BAR
#undef PG8_SCHED
}
}
constexpr int NB = 2, SEQ = 16384, CL = 256, DM = 1024, NPB = SEQ + CL  , NR = NB * NPB  , DEPTH = 4;
constexpr int NIN = 3296, NINP = 3328, DFF = 2816, NEXP = 8, DFE = 3584;
constexpr int NWAVES = 8, NTHR = 512;
constexpr float QSCALE = 0.125f * 1.4426950408889634f;
constexpr int PC_Q = 0, PC_K = 512, PC_V = 1024, PC_R = 0, PC_RK = 512, PC_RV = 1024, PC_LORA = 1536;

constexpr size_t MiB = 1u << 20;
constexpr size_t WS_CTL = 0, CTL_ZERO_BYTES = 1 * MiB;
constexpr size_t WS_MOD = 1 * MiB;
constexpr size_t WS_ROPE = 2 * MiB;
constexpr size_t WS_LAM = 2 * MiB + 65536;
constexpr size_t WS_XC = 3 * MiB;
constexpr size_t WS_ROUTE = 5 * MiB;
constexpr size_t WS_WINT = 8 * MiB;
constexpr size_t WS_WOUTT = 34 * MiB;
constexpr size_t WS_W13T = 42 * MiB;
constexpr size_t WS_W2T = 64 * MiB;
constexpr size_t WS_VFIRST = 76 * MiB;
constexpr size_t WS_HN = 110 * MiB;
constexpr size_t WS_PA = 175 * MiB;
constexpr size_t WS_G = 273 * MiB;
constexpr size_t WS_BONUS = 306 * MiB;
constexpr size_t WS_OPS = 308 * MiB;
constexpr size_t WS_PR = 308 * MiB;
constexpr size_t WS_PRE = 715 * MiB;
constexpr int PRE_REC = 8192;
constexpr size_t WS_VV = 975 * MiB;
constexpr size_t WS_Y = 813 * MiB;
constexpr size_t WS_APART = 943 * MiB;
constexpr size_t WS_ASTAT = 1010 * MiB;
constexpr int ATT_SPLIT = 8, ATT_SLICES = 4;
constexpr size_t WS_LORA = 1008 * MiB;
constexpr size_t WS_WCB = 1012 * MiB;
constexpr size_t WS_END = 1021 * MiB;
constexpr int LO_W2 = 0, LO_A2 = 131072, LO_V2 = 262144, LO_G2 = 262144 + 49152, LO_V1 = 262144 + 49152 + 196608, LO_TOTAL = LO_V1 + 49152;
constexpr int LDPA = 1536, LDPR = 1792;
constexpr int OPS_REC = 12288, NCHUNK = NPB / 16;
constexpr int OR_QT = 9216, OR_VT = 9728, OR_WC = 11776;
constexpr size_t WS_HF = 175 * MiB;
constexpr int MOE_ROWS = 68608;
constexpr size_t WS_W2E = 175 * MiB;
constexpr size_t WS_W13E = 231 * MiB;
constexpr size_t WS_AG = 343 * MiB;
constexpr size_t WS_HMOE = 477 * MiB;
constexpr size_t WS_YEXP = 231 * MiB;
static_assert(WS_WINT + (size_t)4 * NINP * DM * 2 <= WS_WOUTT && WS_WOUTT + (size_t)4 * DM * DM * 2 <= WS_W13T && WS_W13T + (size_t)2 * 2 * DFF * DM * 2 <= WS_W2T && WS_W2T + (size_t)2 * DM * DFF * 2 <= WS_VFIRST, "ws map 1");
static_assert(WS_VFIRST + (size_t)NR * 512 * 2 <= WS_HN && WS_HN + (size_t)NR * DM * 2 <= WS_PA && WS_PA + (size_t)NR * LDPA * 2 <= WS_G && WS_G + (size_t)NR * 512 * 2 <= WS_BONUS && WS_BONUS + (size_t)NR * 8 * 4 <= WS_OPS, "ws map 2");
static_assert(WS_OPS + (size_t)32 * NCHUNK * OPS_REC <= WS_PRE && WS_PR + (size_t)NR * LDPR * 2 <= WS_PRE && WS_PRE + (size_t)32 * NCHUNK * PRE_REC <= WS_VV && WS_VV + (size_t)NR * 512 * 2 <= WS_LORA && WS_Y + (size_t)2 * NR * 512 * 4 <= WS_APART && WS_LORA + (size_t)LO_TOTAL * 2 <= WS_ASTAT, "ws map 3");
static_assert(WS_APART + (size_t)64 * 4 * 2 * 128 * 128 * 4 <= WS_VV && WS_ASTAT + (size_t)64 * 4 * 2 * 128 * 2 * 4 <= WS_WCB && WS_WCB + (size_t)32 * NCHUNK * 256 <= WS_END, "ws map 5");
static_assert(WS_HF + (size_t)NR * DFF * 2 <= WS_LORA && WS_W2E + (size_t)8 * DM * DFE * 2 <= WS_W13E && WS_W13E + (size_t)8 * 2 * DFE * DM * 2 <= WS_AG && WS_AG + (size_t)MOE_ROWS * DM * 2 <= WS_HMOE && WS_HMOE + (size_t)MOE_ROWS * DFE * 2 <= WS_LORA && WS_YEXP + (size_t)MOE_ROWS * DM * 2 <= WS_HMOE, "ws map 4");
constexpr int CW_TMO = 0;
constexpr int CW_BAR = 4096;
constexpr int CW_QS = 16384;
constexpr int CW_QA = 20480;
constexpr int CW_CNT = 24576;

constexpr int RING_BYTES = 131072;
constexpr int LDSCTL_OFF = RING_BYTES, MISC_OFF = LDSCTL_OFF + 320;
constexpr int LDS_BYTES = 147456;

#define GAS __attribute__((address_space(1)))
#define LAS __attribute__((address_space(3)))
typedef unsigned short bf16;
typedef unsigned v4u __attribute__((ext_vector_type(4)));
typedef unsigned v2u __attribute__((ext_vector_type(2)));
typedef float f32x4 __attribute__((ext_vector_type(4)));
typedef _Float16 h4 __attribute__((ext_vector_type(4)));
#define LDS_WAIT() asm volatile("s_waitcnt lgkmcnt(0)" ::: "memory")
__device__ __forceinline__ unsigned f2bf(float f) { unsigned u = __builtin_bit_cast(unsigned, f); return (u + 0x7fffu + ((u >> 16) & 1u)) >> 16; }
__device__ __forceinline__ unsigned pk2(float lo, float hi) { return f2bf(lo) | (f2bf(hi) << 16); }
__device__ __forceinline__ float bf2f(bf16 h) { return __builtin_bit_cast(float, (unsigned)h << 16); }
__device__ __forceinline__ float bflo(unsigned w) { return __builtin_bit_cast(float, w << 16); }
__device__ __forceinline__ float bfhi(unsigned w) { return __builtin_bit_cast(float, w & 0xffff0000u); }
__device__ __forceinline__ float sigmoid_f(float x) { return __builtin_amdgcn_rcpf(1.0f + __expf(-x)); }
__device__ __forceinline__ float tanh_f(float x) { return 1.0f - 2.0f * __builtin_amdgcn_rcpf(__expf(2.0f * x) + 1.0f); }
__device__ __forceinline__ float dpp_rowsum16(float x) {
    x += __builtin_bit_cast(float, __builtin_amdgcn_update_dpp(0, __builtin_bit_cast(int, x), 0xB1, 0xF, 0xF, true));
    x += __builtin_bit_cast(float, __builtin_amdgcn_update_dpp(0, __builtin_bit_cast(int, x), 0x4E, 0xF, 0xF, true));
    x += __builtin_bit_cast(float, __builtin_amdgcn_update_dpp(0, __builtin_bit_cast(int, x), 0x141, 0xF, 0xF, true));
    x += __builtin_bit_cast(float, __builtin_amdgcn_update_dpp(0, __builtin_bit_cast(int, x), 0x140, 0xF, 0xF, true));
    return x;
}
__device__ __forceinline__ float wave_sum(float v) {
    v = dpp_rowsum16(v); v += __shfl_xor(v, 16); v += __shfl_xor(v, 32); return v;
}
#define XB_TMO      128
#define XB_XCNT(j)  (256  + 64 * (j))
#define XB_XSUB(j)  (1280 + 64 * (j))
#define XB_XGEN(j)  (2304 + 64 * (j))
#define XB_TOP      3328
#define XB_TOPGEN   3392
#define XCD_BAR_WORDS 3456
#define XB_SPIN_CAP (1u << 18)

__device__ __forceinline__ unsigned xb_ld(unsigned* p)              { return __hip_atomic_load(p, __ATOMIC_RELAXED, __HIP_MEMORY_SCOPE_AGENT); }
__device__ __forceinline__ unsigned xb_add(unsigned* p, unsigned v) { return __hip_atomic_fetch_add(p, v, __ATOMIC_RELAXED, __HIP_MEMORY_SCOPE_AGENT); }
__device__ __forceinline__ unsigned xb_xcc_id() { return (unsigned)__builtin_amdgcn_s_getreg((3 << 11) | 20) & 0xFu; }
#define XB_SPIN(cond, bar) do { unsigned _sp = 0; while (cond) { __builtin_amdgcn_s_sleep(1); \
    if ((++_sp & 255u) == 0u) { if (xb_ld(&(bar)[XB_TMO])) break; if (_sp > XB_SPIN_CAP) { atomicAdd(&(bar)[XB_TMO], 1u); break; } } } } while (0)

struct XcdBarrier {
    unsigned* bar; unsigned x;
    volatile LAS unsigned* st;
};

__device__ __forceinline__ XcdBarrier xcd_barrier_post(unsigned* bar, volatile LAS unsigned* st) {
    XcdBarrier b; b.bar = bar; b.x = xb_xcc_id(); b.st = st;
    if (threadIdx.x == 0) (void)xb_add(&bar[XB_XCNT(b.x)], 1u);
    return b;
}
__device__ __forceinline__ void xcd_barrier_complete(unsigned* bar, unsigned x, unsigned& nloc, unsigned& nx) {
    const unsigned G = gridDim.x * gridDim.y * gridDim.z;
    unsigned sum, cnt, mine, sp = 0u;
    for (;;) {
        sum = 0u; cnt = 0u; mine = 0u;
#pragma unroll
        for (unsigned j = 0; j < 16; ++j) { const unsigned c = xb_ld(&bar[XB_XCNT(j)]); sum += c; cnt += (c > 0u) ? 1u : 0u; mine = (j == x) ? c : mine; }
        if (sum == G) break;
        __builtin_amdgcn_s_sleep(1);
        if ((++sp & 255u) == 0u) { if (xb_ld(&bar[XB_TMO])) break; if (sp > XB_SPIN_CAP) { atomicAdd(&bar[XB_TMO], 1u); break; } }
    }
    nloc = mine > 0u ? mine : 1u; nx = cnt > 0u ? cnt : 1u;
}

__device__ __forceinline__ void xcd_barrier(const XcdBarrier& b) {
    asm volatile("s_waitcnt vmcnt(0)" ::: "memory");
    __syncthreads();
    if (threadIdx.x == 0) {
        unsigned* bar = b.bar;
        __builtin_amdgcn_s_waitcnt(0);
        unsigned nloc = b.st[0], nx = b.st[1];
        if (nloc == 0u) { xcd_barrier_complete(bar, b.x, nloc, nx); b.st[0] = nloc; b.st[1] = nx; }
        const unsigned old = xb_add(&bar[XB_XSUB(b.x)], 1u);
        const unsigned gen = old / nloc;
        if (old + 1u == (gen + 1u) * nloc) {
            __builtin_amdgcn_fence(__ATOMIC_RELEASE, "agent");
            asm volatile("s_waitcnt vmcnt(0)" ::: "memory");
            const unsigned og = xb_add(&bar[XB_TOP], 1u);
            const unsigned tg = og / nx;
            if (og + 1u == (tg + 1u) * nx) xb_add(&bar[XB_TOPGEN], 1u);
            else XB_SPIN(xb_ld(&bar[XB_TOPGEN]) == tg, bar);
            __builtin_amdgcn_fence(__ATOMIC_ACQUIRE, "agent");
            xb_add(&bar[XB_XGEN(b.x)], 1u);
            asm volatile("s_waitcnt vmcnt(0)" ::: "memory");
        } else {
            XB_SPIN(xb_ld(&bar[XB_XGEN(b.x)]) == gen, bar);
            __builtin_amdgcn_fence(__ATOMIC_ACQUIRE, "agent");
            asm volatile("s_waitcnt vmcnt(0)" ::: "memory");
        }
    }
    __syncthreads();
}
struct Args { const float* in[34]; float* out; unsigned char* ws; int ph_lo, ph_hi; };
namespace att {
using bf16x8 = __attribute__((ext_vector_type(8))) short;
using s16x4  = __attribute__((ext_vector_type(4))) short;
using f32x16 = __attribute__((ext_vector_type(16))) float;
using u32x4  = __attribute__((ext_vector_type(4))) unsigned;
constexpr int KVBLK = 64;
constexpr size_t SHM_V = KVBLK * 128 * 2, SHM_K = KVBLK * 128 * 2;
constexpr float THR2 = 11.5f;
#define KSWZ(row, colB) ((row) * 256 + ((colB) ^ (((row) & 7) << 4)))
#define SBAR() __builtin_amdgcn_sched_barrier(0)
__device__ __forceinline__ int crow(int r, int hi) { return (r & 3) + 8 * (r >> 2) + 4 * hi; }
__device__ __forceinline__ unsigned cvtpk(float lo, float hi) { unsigned r; asm volatile("v_cvt_pk_bf16_f32 %0, %1, %2" : "=v"(r) : "v"(lo), "v"(hi)); return r; }
__device__ __forceinline__ bf16x8 ld8(const bf16* p) { return *reinterpret_cast<const bf16x8*>(p); }

#define MX3(a, b, c) __builtin_fmaxf(__builtin_fmaxf((a), (b)), (c))
__device__ __forceinline__ float rowmax32(const f32x16& p0, const f32x16& p1) {
  float a = MX3(p0[0], p0[1], p1[0]), b = MX3(p0[2], p0[3], p1[1]); a = MX3(a, p1[2], p1[3]);
#pragma unroll
  for (int r = 4; r < 16; r += 4) { a = MX3(a, p0[r], p0[r + 1]); b = MX3(b, p0[r + 2], p0[r + 3]); a = MX3(a, p1[r], p1[r + 1]); b = MX3(b, p1[r + 2], p1[r + 3]); }
  float m = __builtin_fmaxf(a, b);
  auto rr = __builtin_amdgcn_permlane32_swap(__float_as_uint(m), __float_as_uint(m), false, false);
  return __builtin_fmaxf(__uint_as_float(rr[0]), __uint_as_float(rr[1]));
}
__device__ __forceinline__ void firstSM(f32x16& p0, f32x16& p1, float& m_reg, f32x16& negm, float& alpha) {
  const float dl = rowmax32(p0, p1); m_reg = dl; alpha = 1.f;
#pragma unroll
  for (int r = 0; r < 16; ++r) { p0[r] = p0[r] - dl; p1[r] = p1[r] - dl; negm[r] = -dl; }
  asm volatile("" : "+v"(negm));
#pragma unroll
  for (int r = 0; r < 16; ++r) p0[r] = __builtin_amdgcn_exp2f(p0[r]);
}
__device__ __forceinline__ void finishSM(f32x16& p0, f32x16& p1, float alpha, float& l_reg, bf16x8& pa0, bf16x8& pa1, bf16x8& pa2, bf16x8& pa3) {
#pragma unroll
  for (int r = 0; r < 16; ++r) p1[r] = __builtin_amdgcn_exp2f(p1[r]);
  float ps = p0[0], pt = p0[1], pu = p0[2], pv = p0[3];
#pragma unroll
  for (int r = 4; r < 16; r += 4) { ps += p0[r]; pt += p0[r + 1]; pu += p0[r + 2]; pv += p0[r + 3]; }
#pragma unroll
  for (int r = 0; r < 16; r += 4) { ps += p1[r]; pt += p1[r + 1]; pu += p1[r + 2]; pv += p1[r + 3]; }
  ps = (ps + pt) + (pu + pv);
  { auto rr = __builtin_amdgcn_permlane32_swap(__float_as_uint(ps), __float_as_uint(ps), false, false);
    ps = __uint_as_float(rr[0]) + __uint_as_float(rr[1]); }
  l_reg = l_reg * alpha + ps;
#define PK4(P, BASE, OUT) do { u32x4 w = {cvtpk(P[BASE + 0], P[BASE + 1]), cvtpk(P[BASE + 2], P[BASE + 3]), cvtpk(P[BASE + 4], P[BASE + 5]), cvtpk(P[BASE + 6], P[BASE + 7])}; \
    OUT = *reinterpret_cast<bf16x8*>(&w); } while (0)
  PK4(p0, 0, pa0); PK4(p0, 8, pa1); PK4(p1, 0, pa2); PK4(p1, 8, pa3);
#undef PK4
}
__device__ __forceinline__ void qkt(f32x16& p0, f32x16& p1, const bf16* Ks, const bf16x8* qr, int r32, int hi, int cbase, const f32x16& negm) {
#pragma unroll
  for (int d0 = 0; d0 < 4; ++d0) { int cb = (cbase + d0 * 16 + hi * 8) * 2;
    bf16x8 b0 = *reinterpret_cast<const bf16x8*>((const char*)Ks + KSWZ(r32, cb));
    bf16x8 b1 = *reinterpret_cast<const bf16x8*>((const char*)Ks + KSWZ(32 + r32, cb));
    if (d0 == 0) { p0 = __builtin_amdgcn_mfma_f32_32x32x16_bf16(b0, qr[0], negm, 0, 0, 0); p1 = __builtin_amdgcn_mfma_f32_32x32x16_bf16(b1, qr[0], negm, 0, 0, 0); }
    else { p0 = __builtin_amdgcn_mfma_f32_32x32x16_bf16(b0, qr[d0], p0, 0, 0, 0); p1 = __builtin_amdgcn_mfma_f32_32x32x16_bf16(b1, qr[d0], p1, 0, 0, 0); } }
}
__device__ __forceinline__ int v_st(int k, int c) { const int kk = k;     return ((kk >> 3) * 4 + (c >> 5)) * 512 + ((kk & 7) * 32 + (c & 31)) * 2; }
__device__ __forceinline__ int v_rd_base(int lane) { return ((lane & 3) << 3) | (((lane >> 2) & 3) << 6) | (((lane >> 4) & 1) << 5) | (((lane >> 5) & 1) << 8); }
constexpr int v_rd_off(int d0, int ks, int half) { return d0 * 512 + ks * 4096 + half * 2048; }
template <int OFF> __device__ __forceinline__ s16x4 tr_read(int vb) {
  s16x4 r; asm volatile("ds_read_b64_tr_b16 %0, %1 offset:%2" : "=&v"(r) : "v"(vb), "i"(OFF) : "memory"); return r;
}
template <int D0> __device__ __forceinline__ void pv_one(f32x16& od, int vb, bf16x8 pa0, bf16x8 pa1, bf16x8 pa2, bf16x8 pa3) {
  const s16x4 l0 = tr_read<v_rd_off(D0, 0, 0)>(vb), h0 = tr_read<v_rd_off(D0, 0, 1)>(vb), l1 = tr_read<v_rd_off(D0, 1, 0)>(vb), h1 = tr_read<v_rd_off(D0, 1, 1)>(vb);
  const s16x4 l2 = tr_read<v_rd_off(D0, 2, 0)>(vb), h2 = tr_read<v_rd_off(D0, 2, 1)>(vb), l3 = tr_read<v_rd_off(D0, 3, 0)>(vb), h3 = tr_read<v_rd_off(D0, 3, 1)>(vb);
  asm volatile("s_waitcnt lgkmcnt(0)" ::: "memory"); SBAR();
#define PK(L, H) (bf16x8){L[0], L[1], L[2], L[3], H[0], H[1], H[2], H[3]}
  od = __builtin_amdgcn_mfma_f32_32x32x16_bf16(PK(l0, h0), pa0, od, 0, 0, 0);
  od = __builtin_amdgcn_mfma_f32_32x32x16_bf16(PK(l1, h1), pa1, od, 0, 0, 0);
  od = __builtin_amdgcn_mfma_f32_32x32x16_bf16(PK(l2, h2), pa2, od, 0, 0, 0);
  od = __builtin_amdgcn_mfma_f32_32x32x16_bf16(PK(l3, h3), pa3, od, 0, 0, 0);
#undef PK
}
__device__ __forceinline__ void pv_d0(f32x16* o, int vb, bf16x8 pa0, bf16x8 pa1, bf16x8 pa2, bf16x8 pa3) {
  pv_one<0>(o[0], vb, pa0, pa1, pa2, pa3); pv_one<1>(o[1], vb, pa0, pa1, pa2, pa3); pv_one<2>(o[2], vb, pa0, pa1, pa2, pa3); pv_one<3>(o[3], vb, pa0, pa1, pa2, pa3);
}

struct VFrag { s16x4 l0, h0, l1, h1, l2, h2, l3, h3; };
template <int D0> __device__ __forceinline__ void vf_read(VFrag& f, int vb) {
  f.l0 = tr_read<v_rd_off(D0, 0, 0)>(vb); f.h0 = tr_read<v_rd_off(D0, 0, 1)>(vb); f.l1 = tr_read<v_rd_off(D0, 1, 0)>(vb); f.h1 = tr_read<v_rd_off(D0, 1, 1)>(vb);
  f.l2 = tr_read<v_rd_off(D0, 2, 0)>(vb); f.h2 = tr_read<v_rd_off(D0, 2, 1)>(vb); f.l3 = tr_read<v_rd_off(D0, 3, 0)>(vb); f.h3 = tr_read<v_rd_off(D0, 3, 1)>(vb);
}
__device__ __forceinline__ void vf_mma(f32x16& od, const VFrag& f, bf16x8 pa0, bf16x8 pa1, bf16x8 pa2, bf16x8 pa3) {
#define PK(L, H) (bf16x8){L[0], L[1], L[2], L[3], H[0], H[1], H[2], H[3]}
  od = __builtin_amdgcn_mfma_f32_32x32x16_bf16(PK(f.l0, f.h0), pa0, od, 0, 0, 0);
  od = __builtin_amdgcn_mfma_f32_32x32x16_bf16(PK(f.l1, f.h1), pa1, od, 0, 0, 0);
  od = __builtin_amdgcn_mfma_f32_32x32x16_bf16(PK(f.l2, f.h2), pa2, od, 0, 0, 0);
  od = __builtin_amdgcn_mfma_f32_32x32x16_bf16(PK(f.l3, f.h3), pa3, od, 0, 0, 0);
#undef PK
}
#define LGK_WAIT(n) do { asm volatile("s_waitcnt lgkmcnt(" #n ")" ::: "memory"); SBAR(); } while (0)
__device__ __forceinline__ void pv_softmax(f32x16* o, int vb, bf16x8 pa0, bf16x8 pa1, bf16x8 pa2, bf16x8 pa3, f32x16& p0, f32x16& p1, float& m_reg, f32x16& negm, float& alpha) {
  VFrag fa, fb;
  vf_read<0>(fa, vb); vf_read<1>(fb, vb); LGK_WAIT(8);
  vf_mma(o[0], fa, pa0, pa1, pa2, pa3);
  const float pmax = rowmax32(p0, p1);
  vf_read<2>(fa, vb); LGK_WAIT(8);
  vf_mma(o[1], fb, pa0, pa1, pa2, pa3);
  alpha = 1.f;
  if (__builtin_expect(__any(pmax > THR2), 0)) { const float dl = __builtin_fmaxf(pmax, 0.f); m_reg += dl; alpha = __builtin_amdgcn_exp2f(-dl);
#pragma unroll
    for (int r = 0; r < 16; ++r) { p0[r] = p0[r] - dl; p1[r] = p1[r] - dl; negm[r] = -m_reg; }
    asm volatile("" : "+v"(negm)); }
#pragma unroll
  for (int r = 0; r < 4; ++r) p0[r] = __builtin_amdgcn_exp2f(p0[r]);
  vf_read<3>(fb, vb); LGK_WAIT(8);
  vf_mma(o[2], fa, pa0, pa1, pa2, pa3);
#pragma unroll
  for (int r = 4; r < 10; ++r) p0[r] = __builtin_amdgcn_exp2f(p0[r]);
  LGK_WAIT(0);
  vf_mma(o[3], fb, pa0, pa1, pa2, pa3);
#pragma unroll
  for (int r = 10; r < 16; ++r) p0[r] = __builtin_amdgcn_exp2f(p0[r]);
}

__device__ __forceinline__ void pvseg(f32x16* o, int vb, bf16x8 pa0, bf16x8 pa1, bf16x8 pa2, bf16x8 pa3, VFrag& fa, VFrag& fb) {
  vf_mma(o[0], fa, pa0, pa1, pa2, pa3); SBAR();
  vf_read<2>(fa, vb); SBAR();
  vf_mma(o[1], fb, pa0, pa1, pa2, pa3); SBAR();
  vf_read<3>(fb, vb); LGK_WAIT(8);
  vf_mma(o[2], fa, pa0, pa1, pa2, pa3); SBAR();
  LGK_WAIT(0);
  vf_mma(o[3], fb, pa0, pa1, pa2, pa3);
}
template <int OFF> __device__ __forceinline__ bf16x8 k_read(int ad) { bf16x8 r; asm volatile("ds_read_b128 %0, %1 offset:%2" : "=&v"(r) : "v"(ad), "i"(OFF) : "memory"); return r; }
__device__ __forceinline__ void mseg(f32x16& p0, f32x16& p1, f32x16* o, const int* kad, const bf16x8* qr, const f32x16& negm, int vb, bf16x8 pa0, bf16x8 pa1, bf16x8 pa2, bf16x8 pa3, VFrag& fa, VFrag& fb) {
  const bf16x8 ka0 = k_read<0>(kad[0]), kb0 = k_read<8192>(kad[0]), ka1 = k_read<0>(kad[1]), kb1 = k_read<8192>(kad[1]);
  const bf16x8 ka2 = k_read<0>(kad[2]), kb2 = k_read<8192>(kad[2]), ka3 = k_read<0>(kad[3]), kb3 = k_read<8192>(kad[3]);
  SBAR();
  vf_mma(o[0], fa, pa0, pa1, pa2, pa3); SBAR();
  vf_mma(o[1], fb, pa0, pa1, pa2, pa3); SBAR();
  LGK_WAIT(0);
  p0 = __builtin_amdgcn_mfma_f32_32x32x16_bf16(ka0, qr[0], negm, 0, 0, 0); p1 = __builtin_amdgcn_mfma_f32_32x32x16_bf16(kb0, qr[0], negm, 0, 0, 0);
  p0 = __builtin_amdgcn_mfma_f32_32x32x16_bf16(ka1, qr[1], p0, 0, 0, 0); p1 = __builtin_amdgcn_mfma_f32_32x32x16_bf16(kb1, qr[1], p1, 0, 0, 0);
  SBAR();
  vf_read<2>(fa, vb); SBAR();
  p0 = __builtin_amdgcn_mfma_f32_32x32x16_bf16(ka2, qr[2], p0, 0, 0, 0); p1 = __builtin_amdgcn_mfma_f32_32x32x16_bf16(kb2, qr[2], p1, 0, 0, 0);
  p0 = __builtin_amdgcn_mfma_f32_32x32x16_bf16(ka3, qr[3], p0, 0, 0, 0); p1 = __builtin_amdgcn_mfma_f32_32x32x16_bf16(kb3, qr[3], p1, 0, 0, 0);
  SBAR();
  vf_read<3>(fb, vb); LGK_WAIT(8);
  vf_mma(o[2], fa, pa0, pa1, pa2, pa3); SBAR();
  LGK_WAIT(0);
  vf_mma(o[3], fb, pa0, pa1, pa2, pa3);
}

__device__ __forceinline__ void attn_unit(const bf16* __restrict__ P, int qrow0, int krow0, int NT, int h, float lam, float oml, const float* __restrict__ subg, bf16* __restrict__ AO, char* lds, float* __restrict__ part = nullptr, float* __restrict__ pstat = nullptr) {
  constexpr int LDK = LDPA;
  const int tid = opaque_tid(), wid = __builtin_amdgcn_readfirstlane(tid >> 6), lane = tid & 63, r32 = lane & 31, hi = lane >> 5;
  const int mp = wid >> 2, wq = wid & 3;
  bf16* V_lds = (bf16*)lds; bf16* K_lds = (bf16*)(lds + 3 * SHM_V);
  float m_reg = 0.f, l_reg = 0; f32x16 o[4] = {}; bf16x8 qr[4]; f32x16 negm = f32x16{}; asm volatile("" : "+v"(negm));
  const bf16* Qw = P + (size_t)(qrow0 + wq * 32 + r32) * LDK + PC_Q + h * 128 + mp * 64 + hi * 8;
#pragma unroll
  for (int d0 = 0; d0 < 4; ++d0) qr[d0] = ld8(Qw + d0 * 16);
  const bf16* Kh = P + (size_t)krow0 * LDK + PC_K + h * 128; const bf16* Vh = P + (size_t)krow0 * LDK + PC_V + h * 128;
  const int cbase = mp * 64;
  const int u = tid & 255;
  const int kr = u >> 3, kcb = (cbase + (u & 7) * 8) * 2;
  const int vr = mp * 32 + (u >> 4), vc = (u & 15) * 8;
  const int vst0 = v_st(vr, vc), vst1 = v_st(vr + 16, vc), kst0 = KSWZ(kr, kcb), kst1 = KSWZ(kr + 32, kcb);
  const bf16* Kg = Kh + (size_t)kr * LDK + cbase + (u & 7) * 8; const bf16* Vg = Vh + (size_t)vr * LDK + vc;
  const int vb0 = (int)(uintptr_t)V_lds + v_rd_base(lane);
  int kad[4];
#pragma unroll
  for (int d0 = 0; d0 < 4; ++d0) kad[d0] = (int)(uintptr_t)K_lds + KSWZ(r32, (cbase + d0 * 16 + hi * 8) * 2);
  struct { bf16x8 v0, v1, k0, k1; } sA, sB;
#define SLOAD(S, k0_) do { const size_t ko_ = (size_t)(k0_) * LDK; S.v0 = ld8(Vg + ko_); S.v1 = ld8(Vg + ko_ + (size_t)16 * LDK); S.k0 = ld8(Kg + ko_); S.k1 = ld8(Kg + ko_ + (size_t)32 * LDK); } while (0)
#define SWRITE(S, voff) do { *(bf16x8*)((char*)V_lds + (voff) + vst0) = S.v0; *(bf16x8*)((char*)V_lds + (voff) + vst1) = S.v1; \
    *(bf16x8*)((char*)K_lds + kst0) = S.k0; *(bf16x8*)((char*)K_lds + kst1) = S.k1; } while (0)
#ifndef PRIO_M
#define PRIO_M 1
#endif
#define XBAR() asm volatile("s_waitcnt lgkmcnt(0)\n\ts_barrier" ::: "memory")
#define RESC(a) do { if (__any((a) < 1.f)) { \
    _Pragma("unroll") for (int d = 0; d < 4; ++d) _Pragma("unroll") for (int r = 0; r < 16; ++r) o[d][r] *= (a); } } while (0)
  f32x16 p0, p1; float alpha; bf16x8 pa0, pa1, pa2, pa3;
  const int lastk = (NT - 1) * KVBLK;
  SLOAD(sA, 0); SWRITE(sA, 0); SLOAD(sB, min(KVBLK, lastk)); SLOAD(sA, min(2 * KVBLK, lastk));
  XBAR();
  if (mp == 1) XBAR();
  qkt(p0, p1, K_lds, qr, r32, hi, cbase, negm);
  XBAR();
  firstSM(p0, p1, m_reg, negm, alpha);
  finishSM(p0, p1, alpha, l_reg, pa0, pa1, pa2, pa3);
  VFrag fa, fb;
  vf_read<0>(fa, vb0); vf_read<1>(fb, vb0);
  SWRITE(sB, (int)SHM_V); SLOAD(sB, min(3 * KVBLK, lastk));
  XBAR();
  int vsl = 0, wsl = 2 * (int)SHM_V;
#define STEP(S, t_) do { \
    SBAR(); __builtin_amdgcn_s_setprio(PRIO_M); mseg(p0, p1, o, kad, qr, negm, vb0 + vsl, pa0, pa1, pa2, pa3, fa, fb); SBAR(); __builtin_amdgcn_s_setprio(0); SBAR(); \
    XBAR(); \
    { const float pmax = rowmax32(p0, p1); alpha = 1.f; \
      if (__builtin_expect(__any(pmax > THR2), 0)) { const float dl = __builtin_fmaxf(pmax, 0.f); m_reg += dl; alpha = __builtin_amdgcn_exp2f(-dl); \
        _Pragma("unroll") for (int r = 0; r < 16; ++r) { p0[r] = p0[r] - dl; p1[r] = p1[r] - dl; negm[r] = -m_reg; } \
        asm volatile("" : "+v"(negm)); } \
      _Pragma("unroll") for (int r = 0; r < 16; ++r) p0[r] = __builtin_amdgcn_exp2f(p0[r]); \
      finishSM(p0, p1, alpha, l_reg, pa0, pa1, pa2, pa3); \
      RESC(alpha); } \
    vsl = (vsl == 2 * (int)SHM_V) ? 0 : vsl + (int)SHM_V; \
    SBAR(); vf_read<0>(fa, vb0 + vsl); vf_read<1>(fb, vb0 + vsl); SBAR(); \
    SWRITE(S, wsl); SLOAD(S, min(((t_) + 3) * KVBLK, lastk)); \
    XBAR(); \
    wsl = (wsl == 2 * (int)SHM_V) ? 0 : wsl + (int)SHM_V; } while (0)
  int t = 1;
#pragma unroll 1
  for (; t + 1 < NT; t += 2) { STEP(sA, t); STEP(sB, t + 1); }
  if (t < NT) STEP(sA, t);
#undef STEP
  SBAR(); pvseg(o, vb0 + vsl, pa0, pa1, pa2, pa3, fa, fb); SBAR();
  if (mp == 0) XBAR();
  if (part != nullptr) {
    float* pb = part + (size_t)mp * (128 * 128) + wq * 32 + r32;
#pragma unroll
    for (int r = 0; r < 16; ++r) { const int dvr = crow(r, hi);
#pragma unroll
      for (int d0 = 0; d0 < 4; ++d0) pb[(size_t)(d0 * 32 + dvr) * 128] = o[d0][r]; }
    if (hi == 0) { float2* st = (float2*)pstat + mp * 128 + wq * 32 + r32; *st = make_float2(m_reg, l_reg); }
    __syncthreads();
    return;
  }
  const float rl = __builtin_amdgcn_rcpf(l_reg);
  __syncthreads();
  { float* OB = (float*)lds + mp * (128 * 128) + wq * 32 + r32;
#pragma unroll
    for (int r = 0; r < 16; ++r) { const int dvr = crow(r, hi);
#pragma unroll
      for (int d0 = 0; d0 < 4; ++d0) OB[(d0 * 32 + dvr) * 128] = o[d0][r] * rl; } }
  __syncthreads();
  { const int row = tid >> 2, qd = tid & 3;
    const float* A1 = (const float*)lds + (qd * 32) * 128 + row; const float* B1 = A1 + 128 * 128;
    f32x4 dv[8]; float ss = 0.f;
#pragma unroll
    for (int j = 0; j < 8; ++j) {
#pragma unroll
      for (int e = 0; e < 4; ++e) dv[j][e] = A1[(4 * j + e) * 128] - lam * B1[(4 * j + e) * 128];
      ss += (dv[j][0] * dv[j][0] + dv[j][1] * dv[j][1]) + (dv[j][2] * dv[j][2] + dv[j][3] * dv[j][3]); }
    ss += __shfl_xor(ss, 1); ss += __shfl_xor(ss, 2);
    const float rstd = __builtin_amdgcn_rsqf(ss * (1.0f / 128.0f) + 1e-5f) ;
    const f32x4* g4 = (const f32x4*)(subg + qd * 32);
    bf16* op = AO + (size_t)(qrow0 + row) * DM + h * 128 + qd * 32;
#pragma unroll
    for (int j = 0; j < 4; ++j) { const f32x4 g0 = g4[2 * j], g1 = g4[2 * j + 1]; const f32x4 a = dv[2 * j] * rstd, b = dv[2 * j + 1] * rstd;
      u32x4 w; w.x = cvtpk(a[0] * g0[0] * oml, a[1] * g0[1] * oml); w.y = cvtpk(a[2] * g0[2] * oml, a[3] * g0[3] * oml);
      w.z = cvtpk(b[0] * g1[0] * oml, b[1] * g1[1] * oml); w.w = cvtpk(b[2] * g1[2] * oml, b[3] * g1[3] * oml);
      *(u32x4*)(op + j * 8) = w; } }
  __syncthreads();
#undef SLOAD
#undef SWRITE
#undef XBAR
#undef RESC
}
template <int NS> __device__ __forceinline__ void attn_merge(const float* __restrict__ part, const float* __restrict__ pstat, size_t slice_stride, size_t stat_stride, int qrow0, int h, float lam, float oml, const float* __restrict__ subg, bf16* __restrict__ AO) {
  const int tid = opaque_tid(); const int row = tid >> 2, qd = tid & 3;
  f32x4 om[2][8];
#pragma unroll
  for (int mp = 0; mp < 2; ++mp) {
    float mi[NS], li[NS]; float M = -3.0e38f;
#pragma unroll
    for (int i = 0; i < NS; ++i) { const float2 st = *((const float2*)(pstat + i * stat_stride) + mp * 128 + row); mi[i] = st.x; li[i] = st.y; M = fmaxf(M, st.x); }
    float L = 0.f;
#pragma unroll
    for (int j = 0; j < 8; ++j) om[mp][j] = (f32x4){0.f, 0.f, 0.f, 0.f};
#pragma unroll
    for (int i = 0; i < NS; ++i) { const float w = __builtin_amdgcn_exp2f(mi[i] - M); L += w * li[i];
      const float* p1 = part + i * slice_stride + (size_t)mp * (128 * 128) + (size_t)(qd * 32) * 128 + row;
#pragma unroll
      for (int j = 0; j < 8; ++j)
#pragma unroll
        for (int e = 0; e < 4; ++e) om[mp][j][e] += w * p1[(size_t)(4 * j + e) * 128]; }
    const float rl = 1.0f / L;
#pragma unroll
    for (int j = 0; j < 8; ++j) om[mp][j] = om[mp][j] * rl;
  }
  f32x4 dv[8]; float ss = 0.f;
#pragma unroll
  for (int j = 0; j < 8; ++j) { dv[j] = om[0][j] - lam * om[1][j]; ss += (dv[j][0] * dv[j][0] + dv[j][1] * dv[j][1]) + (dv[j][2] * dv[j][2] + dv[j][3] * dv[j][3]); }
  ss += __shfl_xor(ss, 1); ss += __shfl_xor(ss, 2);
  const float rstd = __builtin_amdgcn_rsqf(ss * (1.0f / 128.0f) + 1e-5f);
  const f32x4* g4 = (const f32x4*)(subg + qd * 32);
  bf16* op = AO + (size_t)(qrow0 + row) * DM + h * 128 + qd * 32;
#pragma unroll
  for (int j = 0; j < 4; ++j) { const f32x4 g0 = g4[2 * j], g1 = g4[2 * j + 1]; const f32x4 a = dv[2 * j] * rstd, b = dv[2 * j + 1] * rstd;
    u32x4 w; w.x = cvtpk(a[0] * g0[0] * oml, a[1] * g0[1] * oml); w.y = cvtpk(a[2] * g0[2] * oml, a[3] * g0[3] * oml);
    w.z = cvtpk(b[0] * g1[0] * oml, b[1] * g1[1] * oml); w.w = cvtpk(b[2] * g1[2] * oml, b[3] * g1[3] * oml);
    *(u32x4*)(op + j * 8) = w; }
}
#undef SBAR
}
__device__ __forceinline__ int scan_chunk_of(int tile, int d) { return d == 0 ? tile : (tile < CL / 16 ? (CL / 16 - 1) - tile : (NCHUNK + CL / 16 - 1) - tile); }
__device__ __forceinline__ int scan_pos(int n, int d) { return d == 0 ? n : (n < CL ? (CL - 1) - n : (NPB + CL - 1) - n); }
typedef short sbf16x8 __attribute__((ext_vector_type(8)));
typedef float f32x2_t __attribute__((ext_vector_type(2))); typedef __bf16 bf16x2_t __attribute__((ext_vector_type(2)));
__device__ __forceinline__ unsigned cvtpk_bf(float lo, float hi) { f32x2_t v = {lo, hi}; bf16x2_t b = __builtin_convertvector(v, bf16x2_t); return __builtin_bit_cast(unsigned, b); }
__device__ __forceinline__ void scan_chunk(const LAS unsigned char* rb, f32x4 (&S)[4], float* yo, int c, int d, int wid, int lane, int v15, int q) {
    const LAS sbf16x8* T8 = (const LAS sbf16x8*)rb + lane;
    const sbf16x8 XT0 = T8[0], XT1 = T8[64], RT0 = T8[128], RT1 = T8[192], MT = T8[256], BK0 = T8[320], BK1 = T8[384], BK2 = T8[448], BK3 = T8[512];
    const v2u qt = *(const LAS v2u*)(rb + OR_QT + lane * 8);
    const v2u vq = *(const LAS v2u*)(rb + OR_VT + ((wid * 16 + v15) * 16 + 4 * q) * 2);
    const LAS f32x4* W4 = (const LAS f32x4*)(rb + OR_WC) + q;
    const f32x4 wc0 = W4[0], wc1 = W4[4], wc2 = W4[8], wc3 = W4[12];
    v4u t;
    t[0] = cvtpk_bf(S[0][0], S[0][1]); t[1] = cvtpk_bf(S[0][2], S[0][3]); t[2] = cvtpk_bf(S[1][0], S[1][1]); t[3] = cvtpk_bf(S[1][2], S[1][3]);
    const sbf16x8 bs0 = __builtin_bit_cast(sbf16x8, t);
    t[0] = cvtpk_bf(S[2][0], S[2][1]); t[1] = cvtpk_bf(S[2][2], S[2][3]); t[2] = cvtpk_bf(S[3][0], S[3][1]); t[3] = cvtpk_bf(S[3][2], S[3][3]);
    const sbf16x8 bs1 = __builtin_bit_cast(sbf16x8, t);
    t[0] = vq[0]; t[1] = vq[1]; t[2] = 0u; t[3] = 0u; const sbf16x8 vz = __builtin_bit_cast(sbf16x8, t);
    t[0] = qt[0]; t[1] = qt[1]; t[2] = 0u; t[3] = 0u; const sbf16x8 qz = __builtin_bit_cast(sbf16x8, t);
    f32x4 D = (f32x4){0.f, 0.f, 0.f, 0.f};
    D = __builtin_amdgcn_mfma_f32_16x16x32_bf16(XT0, bs0, D, 0, 0, 0);
    D = __builtin_amdgcn_mfma_f32_16x16x32_bf16(XT1, bs1, D, 0, 0, 0);
    D = __builtin_amdgcn_mfma_f32_16x16x32_bf16(qz, vz, D, 0, 0, 0);
    f32x4 Yv = (f32x4){0.f, 0.f, 0.f, 0.f};
    Yv = __builtin_amdgcn_mfma_f32_16x16x32_bf16(RT0, bs0, Yv, 0, 0, 0);
    Yv = __builtin_amdgcn_mfma_f32_16x16x32_bf16(RT1, bs1, Yv, 0, 0, 0);
    t[0] = cvtpk_bf(D[0], D[1]); t[1] = cvtpk_bf(D[2], D[3]); t[2] = vq[0]; t[3] = vq[1]; const sbf16x8 dv = __builtin_bit_cast(sbf16x8, t);
    Yv = __builtin_amdgcn_mfma_f32_16x16x32_bf16(MT, dv, Yv, 0, 0, 0);
    S[0] = __builtin_amdgcn_mfma_f32_16x16x32_bf16(BK0, dv, S[0] * wc0, 0, 0, 0);
    S[1] = __builtin_amdgcn_mfma_f32_16x16x32_bf16(BK1, dv, S[1] * wc1, 0, 0, 0);
    S[2] = __builtin_amdgcn_mfma_f32_16x16x32_bf16(BK2, dv, S[2] * wc2, 0, 0, 0);
    S[3] = __builtin_amdgcn_mfma_f32_16x16x32_bf16(BK3, dv, S[3] * wc3, 0, 0, 0);
#pragma unroll
    for (int i = 0; i < 4; ++i) yo[(size_t)scan_pos(c * 16 + 4 * q + i, d) * 512] = Yv[i];
}
__device__ __forceinline__ void scan_chain(int chain0, const unsigned char* __restrict__ OPS, float* __restrict__ Y, LAS unsigned char* lds) {
    const int tid = opaque_tid(), wid = __builtin_amdgcn_readfirstlane(tid >> 6), lane = tid & 63, v15 = lane & 15, q = lane >> 4;
    const int grp = wid >> 2, wq = wid & 3; const int chain = chain0 + grp;
    const int d = chain >> 4, b = (chain >> 3) & 1, h = chain & 7;
    const unsigned char* recA = OPS + (size_t)chain0 * NCHUNK * OPS_REC; const unsigned char* recB = recA + (size_t)NCHUNK * OPS_REC;
    constexpr int PF = 4;
    v4u ga[PF], gb[PF], gc[PF];
#define SCL_LOAD(slot, c) do { if ((c) < NCHUNK) { const v4u* ra_ = (const v4u*)(recA + (size_t)(c) * OPS_REC); const v4u* rb_ = (const v4u*)(recB + (size_t)(c) * OPS_REC); \
        ga[slot] = ra_[tid]; gb[slot] = rb_[tid]; gc[slot] = (tid < 256) ? ra_[512 + tid] : rb_[256 + tid]; } } while (0)
#define SCL_WRITE(slot, buf) do { LAS v4u* oa_ = (LAS v4u*)(lds + (buf) * 2 * OPS_REC); LAS v4u* ob_ = oa_ + OPS_REC / 16; \
        oa_[tid] = ga[slot]; ob_[tid] = gb[slot]; if (tid < 256) oa_[512 + tid] = gc[slot]; else ob_[256 + tid] = gc[slot]; } while (0)
    f32x4 S[4];
#pragma unroll
    for (int rt = 0; rt < 4; ++rt) S[rt] = (f32x4){0.f, 0.f, 0.f, 0.f};
    float* yo = Y + ((size_t)d * NR + (size_t)b * NPB) * 512 + h * 64 + wq * 16 + v15;
    SCL_LOAD(0, 0); SCL_LOAD(1, 1); SCL_LOAD(2, 2); SCL_LOAD(3, 3);
    SCL_WRITE(0, 0); __syncthreads();
#define SCL_TRIP(c, slot) do { \
        const int buf = (c) & 1; \
        SCL_LOAD(slot, (c) + PF); \
        scan_chunk(lds + (buf * 2 + grp) * OPS_REC, S, yo, (c), d, wq, lane, v15, q); \
        if ((c) + 1 < NCHUNK) SCL_WRITE(((slot) + 1) & 3, buf ^ 1); \
        __syncthreads(); } while (0)
    for (int c = 0; c < NCHUNK; c += 4) { SCL_TRIP(c, 0); SCL_TRIP(c + 1, 1); SCL_TRIP(c + 2, 2); SCL_TRIP(c + 3, 3); }
#undef SCL_TRIP
#undef SCL_LOAD
#undef SCL_WRITE
}

__device__ __forceinline__ void transpose_item(const float* __restrict__ W, int K, int N, bf16* __restrict__ WT, int out_row0, int k0, int n0, LAS float* scr, int lane) {
    float tv[32];
#pragma unroll
    for (int i = 0; i < 32; ++i) tv[i] = W[(size_t)(k0 + 2 * i + (lane >> 5)) * N + n0 + (lane & 31)];
#pragma unroll
    for (int i = 0; i < 32; ++i) scr[(2 * i + (lane >> 5)) * 33 + (lane & 31)] = tv[i];
    LDS_WAIT(); asm volatile("" ::: "memory");
    const int c = lane & 7;
#pragma unroll
    for (int j = 0; j < 4; ++j) { const int n = (lane >> 3) + 8 * j; const LAS float* s = scr + (8 * c) * 33 + n;
        v4u o; o.x = pk2(s[0 * 33], s[1 * 33]); o.y = pk2(s[2 * 33], s[3 * 33]); o.z = pk2(s[4 * 33], s[5 * 33]); o.w = pk2(s[6 * 33], s[7 * 33]);
        *(v4u*)(WT + (size_t)(out_row0 + n) * K + k0 + 8 * c) = o; }
    LDS_WAIT(); asm volatile("" ::: "memory");
}
__device__ __forceinline__ void transpose_matrix_item(const float* W, int K, int N, bf16* WT, int item, int il_half  , LAS float* scr, int lane) {
    const int nblk = N / 32, kb = item / nblk, nb = item - kb * nblk, n0 = 32 * nb;
    const int orow = (il_half < 0) ? n0 : ((n0 >> 7) * 256 + il_half * 128 + (n0 & 127));
    transpose_item(W, K, N, WT, orow, 64 * kb, n0, scr, lane);
}

struct Ptrs {
    const float* in[34]; float* out; unsigned char* ws;
};
#define IN_X 0
#define IN_C 1
#define IN_CTX 2
#define IN_CCTX 3
#define IN_ADAW 4
#define IN_ADAB 5
#define IN_N1G 6
#define IN_N2G 7
#define IN_WIN 8
#define IN_WOUT 9
#define IN_DLAM 10
#define IN_SUBG 11
#define IN_MU 12
#define IN_W0 13
#define IN_W2 14
#define IN_A0 15
#define IN_A2 16
#define IN_V0 17
#define IN_V1 18
#define IN_V2 19
#define IN_G2 20
#define IN_KK 21
#define IN_KA 22
#define IN_RK 23
#define IN_LNW 24
#define IN_LNB 25
#define IN_FW1 26
#define IN_FW3 27
#define IN_FW2 28
#define IN_ROUTER 29
#define IN_EW1 30
#define IN_EW3 31
#define IN_EW2 32
#define IN_FINALG 33

__device__ __forceinline__ void phase_prologue(const Args& a, LAS unsigned char* lds, int vcu, int G) {
    const int tid = opaque_tid(), lane = tid & 63, wave = __builtin_amdgcn_readfirstlane(tid >> 6);
    unsigned char* ws = opaque_ptr(a.ws);
    LAS float* scr = (LAS float*)(lds + wave * 8704);
    LAS float* sl = (LAS float*)(lds + 73728);
    for (int i = tid; i < 3072; i += NTHR) { const float v = (i < 2048) ? gptr(a.in[IN_C])[i] : gptr(a.in[IN_CCTX])[i - 2048]; sl[i] = v * sigmoid_f(v); }
    __syncthreads();
    const int gw = vcu * NWAVES + wave, NGW = G * NWAVES;
    constexpr int T_MOD = 4 * 96;
    constexpr int I_WIN = 16 * (NIN / 32), I_WOUT = 16 * 32, I_F13 = 16 * (DFF / 32), I_F2 = (DFF / 64) * 32;
    constexpr int T_WIN = 4 * I_WIN, T_WOUT = 4 * I_WOUT, T_F1 = 2 * I_F13, T_F3 = 2 * I_F13, T_F2 = 2 * I_F2;
    constexpr int T_PAD = 4 * 32, T_ROPE = 64, T_LAM = 4;
    constexpr int NT = T_MOD + T_WIN + T_WOUT + T_F1 + T_F3 + T_F2 + T_PAD + T_ROPE + T_LAM;
    float* MOD = (float*)(ws + WS_MOD);
    for (int it = gw; it < NT; it += NGW) {
        int r = it;
        if (r < T_MOD) {
            const int l = r / 96, jg = r - l * 96; const float* aw = gptr(a.in[IN_ADAW]) + (size_t)l * 1024 * 6144 + jg * 64 + lane;
            float a0 = 0.f, a1 = 0.f, a2 = 0.f;
            for (int i0 = 0; i0 < 1024; i0 += 32) { float wv[32];
#pragma unroll
                for (int i = 0; i < 32; ++i) wv[i] = aw[(size_t)(i0 + i) * 6144];
#pragma unroll
                for (int i = 0; i < 32; ++i) { a0 += sl[i0 + i] * wv[i]; a1 += sl[1024 + i0 + i] * wv[i]; a2 += sl[2048 + i0 + i] * wv[i]; } }
            const float bb = gptr(a.in[IN_ADAB])[l * 6144 + jg * 64 + lane];
            MOD[(l * 3 + 0) * 6144 + jg * 64 + lane] = a0 + bb; MOD[(l * 3 + 1) * 6144 + jg * 64 + lane] = a1 + bb; MOD[(l * 3 + 2) * 6144 + jg * 64 + lane] = a2 + bb;
            continue; }
        r -= T_MOD;
        if (r < T_WIN) { const int l = r / I_WIN; transpose_matrix_item(gptr(a.in[IN_WIN]) + (size_t)l * DM * NIN, DM, NIN, (bf16*)(ws + WS_WINT) + (size_t)l * NINP * DM, r - l * I_WIN, -1, scr, lane); continue; }
        r -= T_WIN;
        if (r < T_WOUT) { const int l = r / I_WOUT; transpose_matrix_item(gptr(a.in[IN_WOUT]) + (size_t)l * DM * DM, DM, DM, (bf16*)(ws + WS_WOUTT) + (size_t)l * DM * DM, r - l * I_WOUT, -1, scr, lane); continue; }
        r -= T_WOUT;
        if (r < T_F1) { const int l = r / I_F13; transpose_matrix_item(gptr(a.in[IN_FW1]) + (size_t)l * DM * DFF, DM, DFF, (bf16*)(ws + WS_W13T) + (size_t)l * 2 * DFF * DM, r - l * I_F13, 0, scr, lane); continue; }
        r -= T_F1;
        if (r < T_F3) { const int l = r / I_F13; transpose_matrix_item(gptr(a.in[IN_FW3]) + (size_t)l * DM * DFF, DM, DFF, (bf16*)(ws + WS_W13T) + (size_t)l * 2 * DFF * DM, r - l * I_F13, 1, scr, lane); continue; }
        r -= T_F3;
        if (r < T_F2) { const int l = r / I_F2; transpose_matrix_item(gptr(a.in[IN_FW2]) + (size_t)l * DFF * DM, DFF, DM, (bf16*)(ws + WS_W2T) + (size_t)l * DM * DFF, r - l * I_F2, -1, scr, lane); continue; }
        r -= T_F2;
        if (r < T_PAD) { const int l = r >> 5, row = NIN + (r & 31); v4u z = {0u, 0u, 0u, 0u}; v4u* o = (v4u*)((bf16*)(ws + WS_WINT) + ((size_t)l * NINP + row) * DM) + lane * 2; o[0] = z; o[1] = z; continue; }
        r -= T_PAD;
        if (r < T_ROPE) { const int e = r * 64 + lane, pos = e >> 4, j = e & 15;
            const float inv = __builtin_amdgcn_exp2f(-(float)(2 * j) * (13.287712379549449f / 32.0f)); const float ang = (float)pos * inv;
            float2* T = (float2*)(ws + WS_ROPE); T[e] = make_float2(cosf(ang), sinf(ang)); continue; }
        r -= T_ROPE;
        { const int l = r; const float* lp = gptr(a.in[IN_DLAM]) + l * 256;
          const float s0 = wave_sum(lp[lane] * lp[64 + lane]), s1 = wave_sum(lp[128 + lane] * lp[192 + lane]);
          const float li = 0.8f - 0.6f * expf(-0.3f * (float)l);
          if (lane == 0) { float* L = (float*)(ws + WS_LAM); L[l * 2] = expf(s0) - expf(s1) + li; L[l * 2 + 1] = 1.0f - li; } }
    }
    { bf16* LB = (bf16*)(ws + WS_LORA);
      for (int o = (vcu * NTHR + tid); o < LO_TOTAL; o += G * NTHR) {
          float v;
          if (o < LO_A2) { const int m = o >> 14, r = o & 16383, chn = r >> 5, j = r & 31; v = gptr(a.in[IN_W2])[((size_t)m * 32 + j) * 512 + chn]; }
          else if (o < LO_V2) { const int q = o - LO_A2; const int m = q >> 14, r = q & 16383, chn = r >> 5, j = r & 31; v = gptr(a.in[IN_A2])[((size_t)m * 32 + j) * 512 + chn]; }
          else if (o < LO_G2) { const int q = o - LO_V2; const int m = q >> 14, r = q & 16383, chn = r >> 5, j = r & 31; v = gptr(a.in[IN_V2])[((size_t)m * 32 + j) * 512 + chn]; }
          else if (o < LO_V1) { const int q = o - LO_G2; const int m = q / 49152, r = q - m * 49152, chn = r / 96, j = r - chn * 96; v = gptr(a.in[IN_G2])[((size_t)m * 96 + j) * 512 + chn]; }
          else { const int q = o - LO_V1; const int m = q >> 14, r = q & 16383, j = r >> 9, chn = r & 511; v = gptr(a.in[IN_V1])[((size_t)m * 512 + chn) * 32 + j]; }
          LB[o] = (bf16)f2bf(v); } }
}

__device__ __forceinline__ void phase_norm(const Args& a, LAS unsigned char* lds, int vcu, int G, int l, int which_norm, bool moe) {
    const int tid = opaque_tid(), lane = tid & 63, wave = __builtin_amdgcn_readfirstlane(tid >> 6);
    unsigned char* ws = opaque_ptr(a.ws);
    LAS float* tabA = (LAS float*)lds; LAS float* tabB = tabA + 3072; LAS float* rwT = tabB + 3072;
    const float* MOD = (const float*)(ws + WS_MOD) + (size_t)l * 3 * 6144;
    const float* ng = a.in[which_norm ? IN_N2G : IN_N1G] + l * 1024;
    const int off_sh = which_norm ? 3072 : 0, off_sc = off_sh + 1024;
    for (int i = tid; i < 3072; i += NTHR) { const int w = i >> 10, c = i & 1023; tabA[i] = ng[c] * (1.0f + MOD[w * 6144 + off_sc + c]); tabB[i] = MOD[w * 6144 + off_sh + c]; }
    if (moe) { const float* rw = gptr(a.in[IN_ROUTER]) + (size_t)(l >> 1) * 1024 * 8; for (int i = tid; i < 8192; i += NTHR) { const int c = i >> 3, e = i & 7; rwT[e * 1024 + c] = rw[i]; } }
    __syncthreads();
    const bool f32lat = (l == 0 && which_norm == 0);
    const float* srcLat = gptr(a.in[IN_X]); const bf16* XB = (const bf16*)(__attribute__((address_space(1))) bf16*)a.out;
    const float* srcCtx = (l == 0 && which_norm == 0) ? gptr(a.in[IN_CTX]) : (const float*)(ws + WS_XC);
    bf16* HN = (bf16*)(ws + WS_HN);
    const int gw = vcu * NWAVES + wave, NGW = G * NWAVES;
    for (int Rb = gw * 2; Rb < NR; Rb += NGW * 2) {
        f32x4 v[2][4]; float ss[2]; int wsel[2], bsel[2];
#pragma unroll
        for (int u = 0; u < 2; ++u) { const int R = Rb + u; const int b = R / NPB, p = R - b * NPB; wsel[u] = (p < CL) ? 2 : b; bsel[u] = b;
            ss[u] = 0.f;
            if (p < CL || f32lat) { const float* xr = (p < CL) ? srcCtx + (size_t)(b * CL + p) * 1024 : srcLat + ((size_t)b * SEQ + (p - CL)) * 1024;
                const f32x4* x4 = (const f32x4*)xr + lane;
#pragma unroll
                for (int j = 0; j < 4; ++j) v[u][j] = x4[64 * j]; }
            else { const v2u* xq = (const v2u*)(XB + ((size_t)b * SEQ + (p - CL)) * 2048) + lane;
#pragma unroll
                for (int j = 0; j < 4; ++j) { const v2u w = xq[64 * j]; v[u][j] = (f32x4){bflo(w[0]), bfhi(w[0]), bflo(w[1]), bfhi(w[1])}; } }
#pragma unroll
            for (int j = 0; j < 4; ++j) ss[u] += (v[u][j][0] * v[u][j][0] + v[u][j][1] * v[u][j][1]) + (v[u][j][2] * v[u][j][2] + v[u][j][3] * v[u][j][3]); }
#pragma unroll
        for (int u = 0; u < 2; ++u) ss[u] = wave_sum(ss[u]);
#pragma unroll
        for (int u = 0; u < 2; ++u) { const int R = Rb + u; const int w = wsel[u];
            const float rstd = 1.0f / sqrtf(ss[u] * (1.0f / 1024.0f) + 1e-6f);
            const LAS f32x4* A4 = (const LAS f32x4*)(tabA + w * 1024) + lane; const LAS f32x4* B4 = (const LAS f32x4*)(tabB + w * 1024) + lane;
            unsigned long long* o8 = (unsigned long long*)(HN + (size_t)R * 1024) + lane;
#pragma unroll
            for (int j = 0; j < 4; ++j) { v[u][j] = (v[u][j] * rstd) * A4[64 * j] + B4[64 * j];
                o8[64 * j] = (unsigned long long)pk2(v[u][j][0], v[u][j][1]) | ((unsigned long long)pk2(v[u][j][2], v[u][j][3]) << 32); } }
        if (moe) {
            float lg[2][8];
#pragma unroll
            for (int u = 0; u < 2; ++u)
#pragma unroll
                for (int e = 0; e < 8; ++e) { const LAS f32x4* r4 = (const LAS f32x4*)(rwT + e * 1024) + lane; float s = 0.f;
#pragma unroll
                    for (int j = 0; j < 4; ++j) { const f32x4 rr = r4[64 * j]; s += (v[u][j][0] * rr[0] + v[u][j][1] * rr[1]) + (v[u][j][2] * rr[2] + v[u][j][3] * rr[3]); }
                    lg[u][e] = s; }
#pragma unroll
            for (int u = 0; u < 2; ++u)
#pragma unroll
                for (int e = 0; e < 8; ++e) lg[u][e] = wave_sum(lg[u][e]);
#pragma unroll
            for (int u = 0; u < 2; ++u) { const int R = Rb + u;
                int e1 = 0; float v1 = lg[u][0];
#pragma unroll
                for (int e = 1; e < 8; ++e) if (lg[u][e] > v1) { v1 = lg[u][e]; e1 = e; }
                int e2 = -1; float v2 = -3.0e38f;
#pragma unroll
                for (int e = 0; e < 8; ++e) if (e != e1 && lg[u][e] > v2) { v2 = lg[u][e]; e2 = e; }
                if (lane == 0) {
                    const float g1 = 1.0f / (1.0f + __expf(v2 - v1)), g2 = 1.0f - g1;
                    unsigned* cnt = (unsigned*)(ws + WS_CTL) + CW_CNT + ((l >> 1) * 8) * 64;
                    const unsigned p1 = atomicAdd(cnt + 64 * e1, 1u), p2 = atomicAdd(cnt + 64 * e2, 1u);
                    unsigned* ro = (unsigned*)(ws + WS_ROUTE) + (size_t)R * 8;
                    ro[0] = (unsigned)e1; ro[1] = (unsigned)e2; ro[2] = p1; ro[3] = p2; ro[4] = __float_as_uint(g1); ro[5] = __float_as_uint(g2);
                } }
        }
    }
    if (moe) {
        LAS float* scr = (LAS float*)(lds + 57344 + wave * 8704);
        const int li = l >> 1;
        constexpr int I_13 = 16 * (DFE / 32), I_2 = (DFE / 64) * 32;
        constexpr int NTK = 8 * (2 * I_13 + I_2);
        for (int it = gw; it < NTK; it += NGW) {
            const int e = it / (2 * I_13 + I_2); int r = it - e * (2 * I_13 + I_2);
            if (r < I_13) { transpose_matrix_item(gptr(a.in[IN_EW1]) + ((size_t)li * 8 + e) * DM * DFE, DM, DFE, (bf16*)(ws + WS_W13E) + (size_t)e * 2 * DFE * DM, r, 0, scr, lane); continue; }
            r -= I_13;
            if (r < I_13) { transpose_matrix_item(gptr(a.in[IN_EW3]) + ((size_t)li * 8 + e) * DM * DFE, DM, DFE, (bf16*)(ws + WS_W13E) + (size_t)e * 2 * DFE * DM, r, 1, scr, lane); continue; }
            r -= I_13;
            transpose_matrix_item(gptr(a.in[IN_EW2]) + ((size_t)li * 8 + e) * DFE * DM, DFE, DM, (bf16*)(ws + WS_W2E) + (size_t)e * DM * DFE, r, -1, scr, lane);
        }
    }
}
__device__ __forceinline__ unsigned hwpk2(float lo, float hi) { typedef float f2_t __attribute__((ext_vector_type(2))); typedef __bf16 b2_t __attribute__((ext_vector_type(2))); f2_t v = {lo, hi}; b2_t r = __builtin_convertvector(v, b2_t); return __builtin_bit_cast(unsigned, r); }
__device__ __forceinline__ unsigned hwbf(float f) { return hwpk2(f, 0.f) & 0xffffu; }
__device__ __forceinline__ void phase_prep(const Args& a, LAS unsigned char* lds, int G, int l, bool do_rope = true) {
    const int tid = opaque_tid(), lane = tid & 63, wave = __builtin_amdgcn_readfirstlane(tid >> 6), c16_ = lane & 15, q_ = lane >> 4;
    unsigned char* ws = opaque_ptr(a.ws);
    const bf16* P = (const bf16*)(ws + WS_PR); bf16* PA = (bf16*)(ws + WS_PA);
    _Float16* VV = (_Float16*)(ws + WS_VV); _Float16* VF = (_Float16*)(ws + WS_VFIRST); _Float16* GG = (_Float16*)(ws + WS_G);
    float* BON = (float*)(ws + WS_BONUS); const bf16* LB = (const bf16*)(ws + WS_LORA);
    LAS bf16* sP = (LAS bf16*)lds;
    LAS bf16* sWD = sP + 18 * 1536;
    LAS bf16* sAD = sWD + 16 * 64;
    LAS bf16* sGD = sAD + 16 * 64;
    LAS bf16* sVA = sGD + 16 * 96;
    LAS bf16* sVL = sVA + 16 * 512;
    LAS float* sPart = (LAS float*)(sVL + 16 * 32);
    const int h = wave;
    for (int tile = blockIdx.x; tile < NB * NCHUNK; tile += G) {
        int c16 = c16_, q = q_; asm volatile("" : "+v"(c16), "+v"(q));
        const int ch4 = h * 64 + 4 * c16;
        const int b = tile / NCHUNK, tt = tile - b * NCHUNK, p0 = tt * 16;
        const int seg_lo = (tt < 16) ? 0 : CL, seg_hi = (tt < 16) ? CL : NPB;
        const size_t R0 = (size_t)b * NPB + p0;
        for (int pc = tid; pc < 18 * 192; pc += NTHR) { const int rr = pc / 192, cc = pc - rr * 192; const int p = p0 - 1 + rr;
            v4u x = {0u, 0u, 0u, 0u}; if (p >= seg_lo && p < seg_hi) x = *(const v4u*)(P + ((size_t)b * NPB + p) * LDPR + cc * 8);
            *(LAS v4u*)(sP + rr * 1536 + cc * 8) = x; }
        for (int idx = tid; idx < 16 * 224; idx += NTHR) { const int i = idx / 224, cc = idx - i * 224; const float val = bf2f(P[(R0 + i) * LDPR + PC_LORA + cc]);
            if (cc < 64) sWD[i * 64 + cc] = (bf16)hwbf(tanh_f(val)); else if (cc < 128) sAD[i * 64 + cc - 64] = (bf16)hwbf(val); else sGD[i * 96 + cc - 128] = (bf16)hwbf(sigmoid_f(val)); }
        __syncthreads();
        f32x4 rs[4], ks[4], vs[4];
        { f32x4 rw[6], kw[6], vw[6]; const float* mu = gptr(a.in[IN_MU]) + (size_t)l * 3 * 2 * 512 + ch4;
          const f32x4 mur0 = *(const f32x4*)(mu), mur1 = *(const f32x4*)(mu + 512), muk0 = *(const f32x4*)(mu + 1024), muk1 = *(const f32x4*)(mu + 1536), muv0 = *(const f32x4*)(mu + 2048), muv1 = *(const f32x4*)(mu + 2560);
#pragma unroll
          for (int j = 0; j < 6; ++j) { const LAS bf16* rp = sP + (4 * q + j) * 1536 + ch4;
              const v2u xr = *(const LAS v2u*)(rp), xk = *(const LAS v2u*)(rp + 512), xv = *(const LAS v2u*)(rp + 1024);
              rw[j] = (f32x4){bflo(xr[0]), bfhi(xr[0]), bflo(xr[1]), bfhi(xr[1])}; kw[j] = (f32x4){bflo(xk[0]), bfhi(xk[0]), bflo(xk[1]), bfhi(xk[1])}; vw[j] = (f32x4){bflo(xv[0]), bfhi(xv[0]), bflo(xv[1]), bfhi(xv[1])}; }
#pragma unroll
          for (int i = 0; i < 4; ++i) { rs[i] = rw[i + 1] + mur0 * (rw[i] - rw[i + 1]) + mur1 * (rw[i + 2] - rw[i + 1]);
              ks[i] = kw[i + 1] + muk0 * (kw[i] - kw[i + 1]) + muk1 * (kw[i + 2] - kw[i + 1]);
              vs[i] = vw[i + 1] + muv0 * (vw[i] - vw[i + 1]) + muv1 * (vw[i + 2] - vw[i + 1]); } }
        f32x4 accV[4];
        if (l > 0) {
#pragma unroll
            for (int i = 0; i < 4; ++i) *(LAS v2u*)(sVA + (4 * q + i) * 512 + ch4) = (v2u){hwpk2(vs[i][0], vs[i][1]), hwpk2(vs[i][2], vs[i][3])};
            __syncthreads();
            { f32x4 pv0 = {0.f, 0.f, 0.f, 0.f}, pv1 = pv0; const bf16* v1b = LB + LO_V1 + (size_t)(l - 1) * 16384;
#pragma unroll
              for (int s2 = 0; s2 < 2; ++s2) { const sbf16x8 fa = *(const LAS sbf16x8*)(sVA + c16 * 512 + h * 64 + 32 * s2 + 8 * q);
                  const sbf16x8 fb0 = *(const sbf16x8*)(v1b + (size_t)c16 * 512 + h * 64 + 32 * s2 + 8 * q), fb1 = *(const sbf16x8*)(v1b + (size_t)(16 + c16) * 512 + h * 64 + 32 * s2 + 8 * q);
                  pv0 = __builtin_amdgcn_mfma_f32_16x16x32_bf16(fa, fb0, pv0, 0, 0, 0); pv1 = __builtin_amdgcn_mfma_f32_16x16x32_bf16(fa, fb1, pv1, 0, 0, 0); }
#pragma unroll
              for (int i = 0; i < 4; ++i) { sPart[(h * 16 + 4 * q + i) * 32 + c16] = pv0[i]; sPart[(h * 16 + 4 * q + i) * 32 + 16 + c16] = pv1[i]; } }
            __syncthreads();
            { float sacc = 0.f;
#pragma unroll
              for (int hh = 0; hh < 8; ++hh) sacc += sPart[hh * 512 + tid];
              sVL[tid] = (bf16)hwbf(sacc); }
            __syncthreads();
            { const sbf16x8 fa = *(const LAS sbf16x8*)(sVL + c16 * 32 + 8 * q); const bf16* v2b = LB + LO_V2 + ((size_t)(l - 1) * 512 + ch4) * 32 + 8 * q;
#pragma unroll
              for (int ct = 0; ct < 4; ++ct) { const sbf16x8 fb = *(const sbf16x8*)(v2b + ct * 32); accV[ct] = __builtin_amdgcn_mfma_f32_16x16x32_bf16(fa, fb, (f32x4){0.f, 0.f, 0.f, 0.f}, 0, 0, 0); } }
        }
        f32x4 vfin[4];
#pragma unroll
        for (int i = 0; i < 4; ++i) { const size_t R = R0 + 4 * q + i;
            if (l > 0) { const h4 vf = *(const h4*)(VF + R * 512 + ch4); const f32x4 v0p = *(const f32x4*)(gptr(a.in[IN_V0]) + (l - 1) * 512 + ch4);
#pragma unroll
                for (int cc = 0; cc < 4; ++cc) { const float vp = vs[i][cc]; vfin[i][cc] = vp + ((float)vf[cc] - vp) * sigmoid_f(v0p[cc] + accV[cc][i]); } }
            else { vfin[i] = vs[i]; *(h4*)(VF + R * 512 + ch4) = (h4){(_Float16)vs[i][0], (_Float16)vs[i][1], (_Float16)vs[i][2], (_Float16)vs[i][3]}; } }
        { f32x4 accG[4];
#pragma unroll
          for (int ct = 0; ct < 4; ++ct) accG[ct] = (f32x4){0.f, 0.f, 0.f, 0.f};
#pragma unroll
          for (int s3 = 0; s3 < 3; ++s3) { const sbf16x8 fa = *(const LAS sbf16x8*)(sGD + c16 * 96 + 32 * s3 + 8 * q); const bf16* g2b = LB + LO_G2 + ((size_t)l * 512 + ch4) * 96 + 32 * s3 + 8 * q;
#pragma unroll
              for (int ct = 0; ct < 4; ++ct) { const sbf16x8 fb = *(const sbf16x8*)(g2b + ct * 96); accG[ct] = __builtin_amdgcn_mfma_f32_16x16x32_bf16(fa, fb, accG[ct], 0, 0, 0); } }
#pragma unroll
          for (int i = 0; i < 4; ++i) *(h4*)(GG + (R0 + 4 * q + i) * 512 + ch4) = (h4){(_Float16)accG[0][i], (_Float16)accG[1][i], (_Float16)accG[2][i], (_Float16)accG[3][i]}; }
        f32x4 kkv[4]; const f32x4 kkp = *(const f32x4*)(gptr(a.in[IN_KK]) + l * 512 + ch4);
#pragma unroll
        for (int i = 0; i < 4; ++i) { const f32x4 t = ks[i] * kkp; float ss = (t[0] * t[0] + t[1] * t[1]) + (t[2] * t[2] + t[3] * t[3]); ss = dpp_rowsum16(ss);
            kkv[i] = t * __builtin_amdgcn_rsqf(fmaxf(ss, 1e-24f)); }
        float bon[4] = {0.f, 0.f, 0.f, 0.f};
        {
#pragma unroll
            for (int i = 0; i < 4; ++i) *(h4*)(VV + (R0 + 4 * q + i) * 512 + ch4) = (h4){(_Float16)vfin[i][0], (_Float16)vfin[i][1], (_Float16)vfin[i][2], (_Float16)vfin[i][3]};
        }
#pragma unroll 1
        for (int d = 0; d < 2; ++d) {
            f32x4 accW[4], accA[4]; const f32x4 w0d = *(const f32x4*)(gptr(a.in[IN_W0]) + (l * 2 + d) * 512 + ch4), a0d = *(const f32x4*)(gptr(a.in[IN_A0]) + (l * 2 + d) * 512 + ch4);
            const f32x4 kap = *(const f32x4*)(gptr(a.in[IN_KA]) + l * 512 + ch4), rkp = *(const f32x4*)(gptr(a.in[IN_RK]) + l * 512 + ch4);
            { const sbf16x8 fw = *(const LAS sbf16x8*)(sWD + c16 * 64 + 32 * d + 8 * q), fad = *(const LAS sbf16x8*)(sAD + c16 * 64 + 32 * d + 8 * q);
              const bf16* w2b = LB + LO_W2 + (((size_t)l * 2 + d) * 512 + ch4) * 32 + 8 * q; const bf16* a2b = LB + LO_A2 + (((size_t)l * 2 + d) * 512 + ch4) * 32 + 8 * q;
#pragma unroll
              for (int ct = 0; ct < 4; ++ct) { accW[ct] = __builtin_amdgcn_mfma_f32_16x16x32_bf16(fw, *(const sbf16x8*)(w2b + ct * 32), (f32x4){0.f, 0.f, 0.f, 0.f}, 0, 0, 0);
                  accA[ct] = __builtin_amdgcn_mfma_f32_16x16x32_bf16(fad, *(const sbf16x8*)(a2b + ct * 32), (f32x4){0.f, 0.f, 0.f, 0.f}, 0, 0, 0); } }
            f32x4 ee[4], bbv[4], kdv[4];
#pragma unroll
            for (int i = 0; i < 4; ++i)
#pragma unroll
                for (int cc = 0; cc < 4; ++cc) { const float e = 0.6065306597126334f * sigmoid_f(w0d[cc] + accW[cc][i]);
                    const float av = sigmoid_f(a0d[cc] + accA[cc][i]); const float kd = ks[i][cc] * (1.0f + (av - 1.0f) * kap[cc]);
                    ee[i][cc] = e; bbv[i][cc] = kkv[i][cc] * av; kdv[i][cc] = kd; bon[i] += rs[i][cc] * kd * rkp[cc]; }
            f32x4 qt_ = ee[0] + ee[1] + ee[2] + ee[3], base = {0.f, 0.f, 0.f, 0.f}, tot = {0.f, 0.f, 0.f, 0.f};
#pragma unroll
            for (int q2 = 0; q2 < 4; ++q2) { f32x4 o_;
#pragma unroll
                for (int cc = 0; cc < 4; ++cc) o_[cc] = __shfl(qt_[cc], c16 + 16 * q2);
                tot += o_; if (d == 0 ? (q2 < q) : (q2 > q)) base += o_; }
            f32x4 Lc[4];
            if (d == 0) { f32x4 run = base;
#pragma unroll
                for (int i = 0; i < 4; ++i) { run += ee[i]; Lc[i] = -run; } }
            else { f32x4 run = base;
#pragma unroll
                for (int i = 3; i >= 0; --i) { run += ee[i]; Lc[i] = -run; } }
            const int chain = (d * 2 + b) * 8 + h; const size_t ri = (size_t)chain * NCHUNK + scan_chunk_of(tt, d);
            bf16* pre = (bf16*)(ws + WS_PRE + ri * PRE_REC);
            if (q == 0) { f32x4 wc;
#pragma unroll
                for (int cc = 0; cc < 4; ++cc) wc[cc] = __expf(-tot[cc]);
                *(f32x4*)(ws + WS_WCB + ri * 256 + 16 * c16) = wc; }
#pragma unroll
            for (int i = 0; i < 4; ++i) { const int n = d ? 15 - (4 * q + i) : 4 * q + i; f32x4 at, bh, kh, rt;
#pragma unroll
                for (int cc = 0; cc < 4; ++cc) { const float Lci = Lc[i][cc]; const float Lp = Lci + ee[i][cc]; const float en = __expf(-Lci);
                    at[cc] = -kkv[i][cc] * __expf(Lp); bh[cc] = bbv[i][cc] * en; kh[cc] = kdv[i][cc] * en; rt[cc] = rs[i][cc] * __expf(Lci); }
                bf16* pp = pre + n * 64 + 4 * c16;
                *(v2u*)(pp) = (v2u){hwpk2(at[0], at[1]), hwpk2(at[2], at[3])}; *(v2u*)(pp + 1024) = (v2u){hwpk2(bh[0], bh[1]), hwpk2(bh[2], bh[3])};
                *(v2u*)(pp + 2048) = (v2u){hwpk2(kh[0], kh[1]), hwpk2(kh[2], kh[3])}; *(v2u*)(pp + 3072) = (v2u){hwpk2(rt[0], rt[1]), hwpk2(rt[2], rt[3])}; }
        }
#pragma unroll
        for (int i = 0; i < 4; ++i) { const float bs = dpp_rowsum16(bon[i]); if (c16 == 0) BON[(R0 + 4 * q + i) * 8 + h] = bs; }
        __syncthreads();
    }
    if (do_rope) { const float2* RT = (const float2*)(ws + WS_ROPE);
      const int nx = (NB * NCHUNK) % G; const bool skip = (nx > 0 && nx * 4 < G && (int)blockIdx.x < nx);
      const int gw = ((int)blockIdx.x - ((nx > 0 && nx * 4 < G) ? nx : 0)) * NWAVES + wave, NGW = (G - ((nx > 0 && nx * 4 < G) ? nx : 0)) * NWAVES; const int g = lane & 31, sub = lane >> 5;
      for (int rp = skip ? NR : gw; rp < NR / 2; rp += NGW) {
          const int R = rp * 2 + sub; const int b = R / NPB, p = R - b * NPB;
          v4u* pp = (v4u*)(PA + (size_t)R * LDPA + g * 32);
          v4u x[4];
#pragma unroll
          for (int j = 0; j < 4; ++j) x[j] = pp[j];
          if (p < CL && g >= 16) continue;
          float e[32];
#pragma unroll
          for (int j = 0; j < 4; ++j)
#pragma unroll
              for (int k = 0; k < 4; ++k) { e[j * 8 + 2 * k] = bflo(x[j][k]); e[j * 8 + 2 * k + 1] = bfhi(x[j][k]); }
          if (p >= CL) { const int t = p - CL; const int pos = (g & 1) ? (t & 63) : (t >> 6);
#pragma unroll
              for (int j = 0; j < 16; ++j) { const float2 cs = RT[pos * 16 + j]; const float x1 = e[j], x2 = e[16 + j]; e[j] = x1 * cs.x - x2 * cs.y; e[16 + j] = x1 * cs.y + x2 * cs.x; } }
          const float sc = (g < 16) ? QSCALE : 1.0f;
#pragma unroll
          for (int j = 0; j < 4; ++j) { v4u o;
#pragma unroll
              for (int k = 0; k < 4; ++k) o[k] = pk2(e[j * 8 + 2 * k] * sc, e[j * 8 + 2 * k + 1] * sc);
              pp[j] = o; }
      } }
}

__device__ __forceinline__ void phase_prep2(const Args& a, LAS unsigned char* lds, int vcu, int G) {
    const int tid = opaque_tid(), lane = tid & 63, wave = __builtin_amdgcn_readfirstlane(tid >> 6), t15 = lane & 15, q = lane >> 4;
    unsigned char* ws = opaque_ptr(a.ws);
    LAS unsigned char* wl = lds + wave * 16384;
    LAS bf16* sAt = (LAS bf16*)wl; LAS bf16* sBh = sAt + 1024; LAS bf16* sKh = sBh + 1024; LAS bf16* sRt = sKh + 1024; LAS bf16* sXT = sRt + 1024;
    LAS bf16* sBbT = sXT + 1024; LAS bf16* sKbT = sBbT + 1024;
    LAS float* sM = (LAS float*)(sKbT + 1024); LAS float* sQ = sM + 256;
    const int gw = vcu * NWAVES + wave, NGW = G * NWAVES;
    for (int task = gw; task < 32 * NCHUNK; task += NGW) {
        unsigned char* rec = ws + WS_OPS + (size_t)task * OPS_REC;
        unsigned vtp[8]; float wc_cur;
        { const v4u* pr = (const v4u*)(ws + WS_PRE + (size_t)task * PRE_REC) + lane; LAS v4u* dst = (LAS v4u*)sAt + lane;
          v4u t8[8];
#pragma unroll
          for (int j = 0; j < 8; ++j) t8[j] = pr[64 * j];
          const int chain = task / NCHUNK, c = task - chain * NCHUNK; const int d = chain >> 4, b = (chain >> 3) & 1, h = chain & 7;
          const _Float16* vvp = (const _Float16*)(ws + WS_VV) + (size_t)b * NPB * 512 + h * 64 + lane; _Float16 vh[16];
#pragma unroll
          for (int t = 0; t < 16; ++t) vh[t] = vvp[(size_t)scan_pos(c * 16 + t, d) * 512];
          wc_cur = ((const float*)(ws + WS_WCB + (size_t)task * 256))[lane];
#pragma unroll
          for (int j = 0; j < 8; ++j) dst[64 * j] = t8[j];
#pragma unroll
          for (int t = 0; t < 16; t += 2) vtp[t >> 1] = hwpk2((float)vh[t], (float)vh[t + 1]); }
        float xa[16];
        LDS_WAIT(); asm volatile("" ::: "memory");
        { v4u* vo = (v4u*)(rec + OR_VT) + lane * 2; vo[0] = (v4u){vtp[0], vtp[1], vtp[2], vtp[3]}; vo[1] = (v4u){vtp[4], vtp[5], vtp[6], vtp[7]}; }
        { const float wc = wc_cur; ((float*)(rec + OR_WC))[lane] = wc; float bhv[16], khv[16];
#pragma unroll
          for (int t = 0; t < 16; ++t) { xa[t] = bf2f(sAt[t * 64 + lane]); bhv[t] = bf2f(sBh[t * 64 + lane]) * wc; khv[t] = bf2f(sKh[t * 64 + lane]) * wc; }
          v4u o0, o1;
#pragma unroll
          for (int j = 0; j < 4; ++j) { o0[j] = hwpk2(bhv[2 * j], bhv[2 * j + 1]); o1[j] = hwpk2(bhv[8 + 2 * j], bhv[9 + 2 * j]); }
          ((LAS v4u*)(sBbT + lane * 16))[0] = o0; ((LAS v4u*)(sBbT + lane * 16))[1] = o1;
#pragma unroll
          for (int j = 0; j < 4; ++j) { o0[j] = hwpk2(khv[2 * j], khv[2 * j + 1]); o1[j] = hwpk2(khv[8 + 2 * j], khv[9 + 2 * j]); }
          ((LAS v4u*)(sKbT + lane * 16))[0] = o0; ((LAS v4u*)(sKbT + lane * 16))[1] = o1; }
        LDS_WAIT(); asm volatile("" ::: "memory");
        f32x4 mab = {0.f, 0.f, 0.f, 0.f}, mak = mab, mbr = mab, mkr = mab;
#pragma unroll
        for (int s2 = 0; s2 < 2; ++s2) {
            const sbf16x8 fa = *(const LAS sbf16x8*)(sAt + t15 * 64 + 32 * s2 + 8 * q), fb = *(const LAS sbf16x8*)(sBh + t15 * 64 + 32 * s2 + 8 * q);
            const sbf16x8 fk = *(const LAS sbf16x8*)(sKh + t15 * 64 + 32 * s2 + 8 * q), fr = *(const LAS sbf16x8*)(sRt + t15 * 64 + 32 * s2 + 8 * q);
            mab = __builtin_amdgcn_mfma_f32_16x16x32_bf16(fb, fa, mab, 0, 0, 0); mak = __builtin_amdgcn_mfma_f32_16x16x32_bf16(fk, fa, mak, 0, 0, 0);
            mbr = __builtin_amdgcn_mfma_f32_16x16x32_bf16(fb, fr, mbr, 0, 0, 0); mkr = __builtin_amdgcn_mfma_f32_16x16x32_bf16(fk, fr, mkr, 0, 0, 0);
        }
#pragma unroll
        for (int i = 0; i < 4; ++i) { const int j = 4 * q + i; if (j >= t15) { mab[i] = 0.f; mak[i] = 0.f; } if (j > t15) { mbr[i] = 0.f; mkr[i] = 0.f; } }
        *(LAS f32x4*)(sM + t15 * 16 + 4 * q) = mab;
        *(LAS f32x4*)(sQ + t15 * 16 + 4 * q) = mak;
        { v4u mt; mt[0] = hwpk2(mbr[0], mbr[1]); mt[1] = hwpk2(mbr[2], mbr[3]); mt[2] = hwpk2(mkr[0], mkr[1]); mt[3] = hwpk2(mkr[2], mkr[3]); ((v4u*)rec)[4 * 64 + lane] = mt; }
        LDS_WAIT(); asm volatile("" ::: "memory");
        float qv[16];
#pragma unroll
        for (int t = 0; t < 16; ++t) qv[t] = sQ[t * 16 + t15];
#pragma unroll
        for (int t = 1; t < 16; ++t) {
            float m[16];
#pragma unroll
            for (int j4 = 0; j4 < (t + 3) / 4; ++j4) { const f32x4 mm = *(const LAS f32x4*)(sM + t * 16 + 4 * j4); m[4 * j4] = mm[0]; m[4 * j4 + 1] = mm[1]; m[4 * j4 + 2] = mm[2]; m[4 * j4 + 3] = mm[3]; }
#pragma unroll
            for (int j = 0; j < t; ++j) { xa[t] += m[j] * xa[j]; qv[t] += m[j] * qv[j]; }
        }
        asm volatile("" ::: "memory");
#pragma unroll
        for (int t = 0; t < 16; ++t) { sXT[t * 64 + lane] = (bf16)hwbf(xa[t]); if (q == 0) sQ[t * 16 + t15] = qv[t]; }
        LDS_WAIT(); asm volatile("" ::: "memory");
        { v4u* R4 = (v4u*)rec;
#pragma unroll
          for (int s2 = 0; s2 < 2; ++s2) {
              const v2u x0 = *(const LAS v2u*)(sXT + t15 * 64 + 32 * s2 + 4 * q), x1 = *(const LAS v2u*)(sXT + t15 * 64 + 32 * s2 + 16 + 4 * q);
              R4[s2 * 64 + lane] = (v4u){x0[0], x0[1], x1[0], x1[1]};
              const v2u r0 = *(const LAS v2u*)(sRt + t15 * 64 + 32 * s2 + 4 * q), r1 = *(const LAS v2u*)(sRt + t15 * 64 + 32 * s2 + 16 + 4 * q);
              R4[(2 + s2) * 64 + lane] = (v4u){r0[0], r0[1], r1[0], r1[1]}; }
#pragma unroll
          for (int rt = 0; rt < 4; ++rt) {
              const v2u b0 = *(const LAS v2u*)(sBbT + (16 * rt + t15) * 16 + 4 * q), k0 = *(const LAS v2u*)(sKbT + (16 * rt + t15) * 16 + 4 * q);
              R4[(5 + rt) * 64 + lane] = (v4u){b0[0], b0[1], k0[0], k0[1]}; }
          const f32x4 qq = *(const LAS f32x4*)(sQ + t15 * 16 + 4 * q);
          ((v2u*)(rec + OR_QT))[lane] = (v2u){hwpk2(qq[0], qq[1]), hwpk2(qq[2], qq[3])}; }
        LDS_WAIT(); asm volatile("" ::: "memory");
    }
}

__device__ __forceinline__ void phase_mix(const Args& a, LAS unsigned char* lds, volatile LAS unsigned* MISC, int l, int ql, unsigned xcc, bool do_scan = true, bool do_attn = true) {
    const int tid = opaque_tid();
    unsigned char* ws = opaque_ptr(a.ws);
    unsigned* ctl = (unsigned*)(ws + WS_CTL);
    const bf16* P = (const bf16*)(ws + WS_PA);
    if (do_scan) { int xq = (int)(xcc & 7u), tried = 0;
      while (tried < 8) {
          if (tid == 0) MISC[16] = atomicAdd(ctl + CW_QS + (ql * 8 + xq) * 64, 1u);
          __syncthreads(); const unsigned idx = MISC[16]; __syncthreads();
          if (idx >= 2u) { xq = (xq + 1) & 7; ++tried; continue; }
#ifndef NO_SCAN
          scan_chain(xq * 4 + 2 * (int)idx, (const unsigned char*)(ws + WS_OPS), (float*)(ws + WS_Y), lds);
#endif
      } }
    if (do_attn) { const float* L = (const float*)(ws + WS_LAM); const float lam = L[l * 2], oml = L[l * 2 + 1];
      const float* subg = gptr(a.in[IN_SUBG]) + l * 128; bf16* AO = (bf16*)(ws + WS_HN);
      int xq = (int)(xcc & 7u), tried = 0;
      while (tried < 8) {
          if (tid == 0) MISC[16] = atomicAdd(ctl + CW_QA + (ql * 8 + xq) * 64, 1u);
          __syncthreads(); const unsigned idx = MISC[16]; __syncthreads();
          constexpr unsigned NWHOLE = 128 - ATT_SPLIT, NSL = ATT_SPLIT * ATT_SLICES;
          if (idx >= NWHOLE + NSL + 2u) { xq = (xq + 1) & 7; ++tried; continue; }
          const int b = xq >> 2, h = xq & 3;
#ifndef NO_ATTN
          if (idx < NWHOLE) att::attn_unit(P, b * NPB + CL + (int)idx * 128, b * NPB, NPB / 64, h, lam, oml, subg, AO, (char*)lds);
          else if (idx < NWHOLE + NSL) { const int su = (int)(idx - NWHOLE), k = su >> 2, sl = su & 3;
              const int t0 = (sl == 0) ? 0 : (sl == 1) ? 64 : (sl == 2) ? 128 : 194, nt = (sl < 2) ? 64 : 66;
              float* part = (float*)(ws + WS_APART) + ((size_t)(xq * ATT_SPLIT + k) * ATT_SLICES + sl) * (2 * 128 * 128);
              float* pst = (float*)(ws + WS_ASTAT) + ((size_t)(xq * ATT_SPLIT + k) * ATT_SLICES + sl) * (2 * 128 * 2);
              att::attn_unit(P, b * NPB + CL + ((int)NWHOLE + k) * 128, b * NPB + t0 * 64, nt, h, lam, oml, subg, AO, (char*)lds, part, pst); }
          else att::attn_unit(P, b * NPB + ((int)(idx - NWHOLE - NSL)) * 128, b * NPB, CL / 64, h, lam, oml, subg, AO, (char*)lds);
#endif
      } }
}

__device__ __forceinline__ void phase_finish(const Args& a, int G, int l) {
    const int tid = opaque_tid(), lane = tid & 63, wave = __builtin_amdgcn_readfirstlane(tid >> 6);
    unsigned char* ws = opaque_ptr(a.ws);
    const float* Y = (const float*)(ws + WS_Y); const _Float16* VV = (const _Float16*)(ws + WS_VV); const _Float16* GG = (const _Float16*)(ws + WS_G); const float* BON = (const float*)(ws + WS_BONUS);
    bf16* AO = (bf16*)(ws + WS_HN);
    const int ch = tid, h = wave, c = lane;
    const float lw = gptr(a.in[IN_LNW])[l * 512 + ch], lb = gptr(a.in[IN_LNB])[l * 512 + ch];
    {
        const float* L = (const float*)(ws + WS_LAM); const float lam = L[l * 2], oml = L[l * 2 + 1];
        for (int mt = blockIdx.x; mt < 8 * ATT_SPLIT; mt += G) { const int xq = mt / ATT_SPLIT, k = mt - xq * ATT_SPLIT; const int b = xq >> 2, h4 = xq & 3;
            att::attn_merge<ATT_SLICES>((const float*)(ws + WS_APART) + (size_t)mt * ATT_SLICES * (2 * 128 * 128), (const float*)(ws + WS_ASTAT) + (size_t)mt * ATT_SLICES * (2 * 128 * 2), (size_t)2 * 128 * 128, (size_t)2 * 128 * 2,
                                        b * NPB + CL + (128 - ATT_SPLIT + k) * 128, h4, lam, oml, gptr(a.in[IN_SUBG]) + l * 128, AO); }
    }
    { const int rsub = tid >> 7, c4 = (tid & 127) * 4, hh = (tid & 127) >> 4;
      const f32x4 lw4 = *(const f32x4*)(gptr(a.in[IN_LNW]) + l * 512 + c4), lb4 = *(const f32x4*)(gptr(a.in[IN_LNB]) + l * 512 + c4);
      for (int R0 = blockIdx.x * 4; R0 < NR; R0 += G * 4) {
        const int R = R0 + rsub;
        const f32x4 ya = *(const f32x4*)(Y + (size_t)R * 512 + c4), yb = *(const f32x4*)(Y + ((size_t)NR + R) * 512 + c4);
        const h4 vv = *(const h4*)(VV + (size_t)R * 512 + c4), gg = *(const h4*)(GG + (size_t)R * 512 + c4); const float bo = BON[(size_t)R * 8 + hh];
        f32x4 y = ya + yb;
        const float mean = dpp_rowsum16((y[0] + y[1]) + (y[2] + y[3])) * (1.0f / 64.0f);
        y = y - mean;
        const float var = dpp_rowsum16((y[0] * y[0] + y[1] * y[1]) + (y[2] * y[2] + y[3] * y[3])) * (1.0f / 64.0f);
        const float rs = __builtin_amdgcn_rsqf(var + 64e-5f);
        float o[4];
#pragma unroll
        for (int e = 0; e < 4; ++e) { float t = y[e] * rs * lw4[e] + lb4[e]; t += bo * (float)vv[e]; t *= (float)gg[e]; o[e] = t; }
        *(v2u*)(AO + (size_t)R * 1024 + 512 + c4) = (v2u){pk2(o[0], o[1]), pk2(o[2], o[3])};
      } }
}

__device__ __forceinline__ void ctx_gemm_resid(const bf16* __restrict__ A, const bf16* __restrict__ Bt, int K, const float* __restrict__ gate, const float* __restrict__ src, float* __restrict__ dst, int vcu, int G) {
    const int tid = opaque_tid(), lane = tid & 63, wave = __builtin_amdgcn_readfirstlane(tid >> 6), n16 = lane & 15, q = lane >> 4;
    for (int t = vcu * NWAVES + wave; t < 32 * 64; t += G * NWAVES) {
        const int rt = t >> 6, ct = t & 63; const int cr = rt * 16 + n16; const int b = cr >> 8, sidx = cr & 255;
        const bf16* ap = A + ((size_t)b * NPB + sidx) * K + 8 * q; const bf16* bp = Bt + (size_t)(ct * 16 + n16) * K + 8 * q;
        f32x4 acc = {0.f, 0.f, 0.f, 0.f};
#pragma unroll 8
        for (int s2 = 0; s2 < K / 32; ++s2) { const sbf16x8 fa = *(const sbf16x8*)(ap + 32 * s2), fb = *(const sbf16x8*)(bp + 32 * s2); acc = __builtin_amdgcn_mfma_f32_16x16x32_bf16(fb, fa, acc, 0, 0, 0); }
        const int col = ct * 16 + 4 * q; const f32x4 g = *(const f32x4*)(gate + col);
        const f32x4 x = *(const f32x4*)(src + (size_t)cr * 1024 + col);
        *(f32x4*)(dst + (size_t)cr * 1024 + col) = x + g * acc;
    }
}

__device__ __forceinline__ void phase_gather(const Args& a, int vcu, int G, int l) {
    const int tid = opaque_tid(), lane = tid & 63, wave = __builtin_amdgcn_readfirstlane(tid >> 6);
    unsigned char* ws = opaque_ptr(a.ws);
    const unsigned* cnt = (const unsigned*)(ws + WS_CTL) + CW_CNT + ((l >> 1) * 8) * 64;
    int off[8]; { int r = 0;
#pragma unroll
        for (int e = 0; e < 8; ++e) { off[e] = r; const int n = (int)__hip_atomic_load(cnt + 64 * e, __ATOMIC_RELAXED, __HIP_MEMORY_SCOPE_AGENT); r += ((n + 255) >> 8) << 8; } }
    const bf16* HN = (const bf16*)(ws + WS_HN); bf16* AG = (bf16*)(ws + WS_AG);
    const int gw = vcu * NWAVES + wave, NGW = G * NWAVES;
    for (int R = gw; R < NR; R += NGW) {
        unsigned* ro = (unsigned*)(ws + WS_ROUTE) + (size_t)R * 8;
        const int e1 = (int)ro[0], e2 = (int)ro[1]; const int p1 = (int)ro[2], p2 = (int)ro[3];
        int o1 = 0, o2 = 0;
#pragma unroll
        for (int e = 0; e < 8; ++e) { if (e == e1) o1 = off[e]; if (e == e2) o2 = off[e]; }
        const int s1 = o1 + p1, s2 = o2 + p2;
        const v4u* src = (const v4u*)(HN + (size_t)R * 1024) + lane * 2; const v4u x0 = src[0], x1 = src[1];
        v4u* d1 = (v4u*)(AG + (size_t)s1 * 1024) + lane * 2; v4u* d2 = (v4u*)(AG + (size_t)s2 * 1024) + lane * 2;
        d1[0] = x0; d1[1] = x1; d2[0] = x0; d2[1] = x1;
        if (lane == 0) { ro[6] = (unsigned)s1; ro[7] = (unsigned)s2; }
    }
}
__device__ __forceinline__ void phase_combine(const Args& a, LAS unsigned char* lds, int vcu, int G, int l) {
    const int tid = opaque_tid(), lane = tid & 63, wave = __builtin_amdgcn_readfirstlane(tid >> 6);
    unsigned char* ws = opaque_ptr(a.ws);
    const bf16* YE = (const bf16*)(ws + WS_YEXP);
    const float* MOD = (const float*)(ws + WS_MOD) + (size_t)l * 3 * 6144 + 5120;
    const bool last = (l == DEPTH - 1);
    LAS float* tabA = (LAS float*)lds; LAS float* tabB = tabA + 3072;
    if (!last) { const float* MODn = (const float*)(ws + WS_MOD) + (size_t)(l + 1) * 3 * 6144; const float* ng = gptr(a.in[IN_N1G]) + (l + 1) * 1024;
        for (int i = tid; i < 3072; i += NTHR) { const int w = i >> 10, c = i & 1023; tabA[i] = ng[c] * (1.0f + MODn[w * 6144 + 1024 + c]); tabB[i] = MODn[w * 6144 + c]; } }
    else { const float* fg = gptr(a.in[IN_FINALG]); for (int i = tid; i < 1024; i += NTHR) tabA[i] = fg[i]; }
    __syncthreads();
    bf16* HN = (bf16*)(ws + WS_HN);
    const int gw = vcu * NWAVES + wave, NGW = G * NWAVES;
    for (int R = gw; R < NR; R += NGW) {
        const int b = R / NPB, p = R - b * NPB; const int w = (p < CL) ? 2 : b;
        if (last && p < CL) continue;
        const unsigned* ro = (const unsigned*)(ws + WS_ROUTE) + (size_t)R * 8;
        const float g1 = __uint_as_float(ro[4]), g2 = __uint_as_float(ro[5]); const int s1 = (int)ro[6], s2 = (int)ro[7];
        const bool isctx = p < CL; const size_t rl = (size_t)b * SEQ + (isctx ? 0 : (p - CL));
        float* xr = isctx ? (float*)(ws + WS_XC) + (size_t)(b * CL + p) * 1024 : ((float*)(__attribute__((address_space(1))) float*)a.out) + rl * 1024;
        v4u* xb = (v4u*)xr;
        const f32x4* gt = (const f32x4*)(MOD + (size_t)w * 6144);
        const v4u* y1 = (const v4u*)(YE + (size_t)s1 * 1024); const v4u* y2 = (const v4u*)(YE + (size_t)s2 * 1024);
        f32x4 xv[4]; float ss = 0.f;
#pragma unroll
        for (int j = 0; j < 2; ++j) { const int c8 = lane + 64 * j;
            const v4u u1 = y1[c8], u2 = y2[c8]; f32x4 x0, x1; if (isctx) { const f32x4* xp = (const f32x4*)xr + c8 * 2; x0 = xp[0]; x1 = xp[1]; } else { const v4u xw = xb[c8]; x0 = (f32x4){bflo(xw[0]), bfhi(xw[0]), bflo(xw[1]), bfhi(xw[1])}; x1 = (f32x4){bflo(xw[2]), bfhi(xw[2]), bflo(xw[3]), bfhi(xw[3])}; } const f32x4 t0 = gt[c8 * 2], t1 = gt[c8 * 2 + 1];
            x0[0] += t0[0] * (g1 * bflo(u1[0]) + g2 * bflo(u2[0])); x0[1] += t0[1] * (g1 * bfhi(u1[0]) + g2 * bfhi(u2[0]));
            x0[2] += t0[2] * (g1 * bflo(u1[1]) + g2 * bflo(u2[1])); x0[3] += t0[3] * (g1 * bfhi(u1[1]) + g2 * bfhi(u2[1]));
            x1[0] += t1[0] * (g1 * bflo(u1[2]) + g2 * bflo(u2[2])); x1[1] += t1[1] * (g1 * bfhi(u1[2]) + g2 * bfhi(u2[2]));
            x1[2] += t1[2] * (g1 * bflo(u1[3]) + g2 * bflo(u2[3])); x1[3] += t1[3] * (g1 * bfhi(u1[3]) + g2 * bfhi(u2[3]));
            xv[2 * j] = x0; xv[2 * j + 1] = x1;
            ss += (x0[0] * x0[0] + x0[1] * x0[1]) + (x0[2] * x0[2] + x0[3] * x0[3]) + (x1[0] * x1[0] + x1[1] * x1[1]) + (x1[2] * x1[2] + x1[3] * x1[3]); }
        const float rstd = 1.0f / sqrtf(wave_sum(ss) * (1.0f / 1024.0f) + 1e-6f);
#pragma unroll
        for (int j = 0; j < 2; ++j) { const int c8 = lane + 64 * j;
            if (!last) { if (isctx) { f32x4* xp = (f32x4*)xr + c8 * 2; xp[0] = xv[2 * j]; xp[1] = xv[2 * j + 1]; } else xb[c8] = (v4u){pk2(xv[2 * j][0], xv[2 * j][1]), pk2(xv[2 * j][2], xv[2 * j][3]), pk2(xv[2 * j + 1][0], xv[2 * j + 1][1]), pk2(xv[2 * j + 1][2], xv[2 * j + 1][3])};
                const LAS f32x4* A4 = (const LAS f32x4*)(tabA + w * 1024) + c8 * 2; const LAS f32x4* B4 = (const LAS f32x4*)(tabB + w * 1024) + c8 * 2;
                const f32x4 h0 = (xv[2 * j] * rstd) * A4[0] + B4[0], h1 = (xv[2 * j + 1] * rstd) * A4[1] + B4[1];
                *((v4u*)(HN + (size_t)R * 1024) + c8) = (v4u){pk2(h0[0], h0[1]), pk2(h0[2], h0[3]), pk2(h1[0], h1[1]), pk2(h1[2], h1[3])}; }
            else { const LAS f32x4* A4 = (const LAS f32x4*)tabA + c8 * 2; f32x4* xp = (f32x4*)xr + c8 * 2; xp[0] = (xv[2 * j] * rstd) * A4[0]; xp[1] = (xv[2 * j + 1] * rstd) * A4[1]; } }
    }
}
__device__ __forceinline__ void phase_final(const Args& a, int vcu, int G) {
    const int tid = opaque_tid(), lane = tid & 63, wave = __builtin_amdgcn_readfirstlane(tid >> 6);
    const int gw = vcu * NWAVES + wave, NGW = G * NWAVES;
    const f32x4* g4 = (const f32x4*)gptr(a.in[IN_FINALG]) + lane;
    for (int r = gw; r < NB * SEQ; r += NGW) {
        f32x4* x4 = (f32x4*)(((float*)(__attribute__((address_space(1))) float*)a.out) + (size_t)r * 1024) + lane; f32x4 v[4]; float ss = 0.f;
#pragma unroll
        for (int j = 0; j < 4; ++j) { v[j] = x4[64 * j]; ss += (v[j][0] * v[j][0] + v[j][1] * v[j][1]) + (v[j][2] * v[j][2] + v[j][3] * v[j][3]); }
        const float rstd = 1.0f / sqrtf(wave_sum(ss) * (1.0f / 1024.0f) + 1e-6f);
#pragma unroll
        for (int j = 0; j < 4; ++j) x4[64 * j] = (v[j] * rstd) * g4[64 * j];
    }
}
#ifndef MK_MULTI
#define MK_MULTI 0
#endif
constexpr int N_PHASES = 1 + 10 + 12 + 9 + 12;

__global__ void __launch_bounds__(NTHR, 2) mk_fwd(Args args) {
    extern __shared__ __attribute__((aligned(16))) unsigned char lds_raw[];
    LAS unsigned char* lds = (LAS unsigned char*)lds_raw;
    volatile LAS unsigned* MISC = (volatile LAS unsigned*)(lds + MISC_OFF);
    const int tid = threadIdx.x;
    const int G = gridDim.x; const int bx = blockIdx.x; const int vcu = (G % 8 == 0) ? (bx % 8) * (G / 8) + bx / 8 : bx;
    unsigned char* ws = args.ws;
    unsigned* ctl = (unsigned*)(ws + WS_CTL);
    for (int u = tid; u < (LDS_BYTES - LDSCTL_OFF) / 4; u += NTHR) ((LAS unsigned*)(lds + LDSCTL_OFF))[u] = 0u;
    __syncthreads();
    const int lo = args.ph_lo, hi = args.ph_hi;
    XcdBarrier bar; bar.bar = ctl + CW_BAR; bar.x = xb_xcc_id(); bar.st = MISC + 8;
    if (hi - lo > 1) bar = xcd_barrier_post(ctl + CW_BAR, MISC + 8);
    const unsigned xcc = bar.x;
    int seq = 0;
#ifndef PH_MASK
#define PH_MASK 0xFFFFFFFFu
#endif
#define PH_ON(b) ((PH_MASK >> (b)) & 1u)
#ifndef DUP_SCAN
#define DUP_SCAN true
#endif
#ifndef DUP_ATTN
#define DUP_ATTN true
#endif
#ifndef DUP_MASK
#define DUP_MASK 0u
#endif
#define DUP_ON(b) ((DUP_MASK >> (b)) & 1u)
#define REP(b, stmt) do { if (PH_ON(b)) { stmt; if (DUP_ON(b)) { xcd_barrier(bar); stmt; } } } while (0)
#ifndef TMASK
#define TMASK 0u
#endif
    unsigned long long t_acc = 0ull, t_beg = 0ull; int t_kind = -1;
#define PH_KIND(k) t_kind = (k);
#define PH_BEGIN if (lo <= seq && seq < hi) { unsigned char* ws = opaque_ptr(args.ws); (void)ws; if (TMASK) t_beg = __builtin_amdgcn_s_memrealtime();
#define PH_END   if (seq + 1 < hi) xcd_barrier(bar); if (TMASK) { if (t_kind >= 0 && ((TMASK >> t_kind) & 1u)) t_acc += __builtin_amdgcn_s_memrealtime() - t_beg; t_kind = -1; } } ++seq;

    PH_BEGIN PH_KIND(0) REP(0, phase_prologue(args, lds, vcu, G)); PH_END

    for (int l = 0; l < DEPTH; ++l) {
        const bool moe = (l & 1) != 0;
        const float* MODl = (const float*)(ws + WS_MOD) + (size_t)l * 3 * 6144;
        if ((l & 1) == 0 && l > 0) {   } else {
        PH_BEGIN PH_KIND(1) if (PH_ON(1)) phase_norm(args, lds, vcu, G, l, 0, false); PH_END }
        PH_BEGIN PH_KIND(2) {
            pg8::Gemm g{(const pg8::bf16_t*)(ws + WS_HN), (const pg8::bf16_t*)(ws + WS_WINT) + (size_t)l * NINP * DM, NR, NINP, DM};
            pg8::StaticOrder S; S.init(NR, NINP, G, bx);
            pg8::EpiStoreSplit E{(pg8::bf16_t*)(ws + WS_PA), LDPA, (pg8::bf16_t*)(ws + WS_PR), LDPR, LDPA / 256, (const float*)(ws + WS_ROPE), QSCALE};
            REP(2, (pg8::gemm_phase<pg8::EpiStoreSplit, pg8::StaticOrder, true, true>(lds, g, S, E)));
        } PH_END
        PH_BEGIN PH_KIND(3) if (PH_ON(3)) { phase_prep(args, lds, G, l, false); if (DUP_ON(3)) { xcd_barrier(bar); phase_prep(args, lds, G, l, false); } } PH_END
        PH_BEGIN PH_KIND(15) REP(15, phase_prep2(args, lds, vcu, G)); PH_END
        PH_BEGIN PH_KIND(4) if (PH_ON(4)) { phase_mix(args, lds, MISC, l, l, xcc); if (DUP_ON(4)) { xcd_barrier(bar); phase_mix(args, lds, MISC, l, l + 4, xcc, DUP_SCAN, DUP_ATTN); } } PH_END
        PH_BEGIN PH_KIND(5) REP(5, phase_finish(args, G, l)); PH_END
        PH_BEGIN PH_KIND(6) {
            pg8::Gemm g{(const pg8::bf16_t*)(ws + WS_HN), (const pg8::bf16_t*)(ws + WS_WOUTT) + (size_t)l * DM * DM, NR, DM, DM};
            pg8::LatentOrder S; S.init(DM, G, bx);
            pg8::EpiResid E{(l == 0) ? gptr(args.in[IN_X]) : (const float*)nullptr, (pg8::bf16_t*)(__attribute__((address_space(1))) pg8::bf16_t*)args.out, MODl + 2048};
            if (PH_ON(6)) { ctx_gemm_resid((const bf16*)(ws + WS_HN), (const bf16*)(ws + WS_WOUTT) + (size_t)l * DM * DM, DM, MODl + 2 * 6144 + 2048, (l == 0) ? gptr(args.in[IN_CTX]) : (const float*)(ws + WS_XC), (float*)(ws + WS_XC), vcu, G);
                pg8::gemm_phase<pg8::EpiResid, pg8::LatentOrder, true, true>(lds, g, S, E); }
            if (DUP_ON(6)) { xcd_barrier(bar); pg8::EpiNull EN{(float*)(ws + WS_CTL) + 8}; pg8::gemm_phase<pg8::EpiNull, pg8::LatentOrder, true, true>(lds, g, S, EN); }
        } PH_END
        PH_BEGIN PH_KIND(7) if (PH_ON(7)) phase_norm(args, lds, vcu, G, l, 1, moe); PH_END
        if (!moe) {
            PH_BEGIN PH_KIND(8) {
                pg8::Gemm g{(const pg8::bf16_t*)(ws + WS_HN), (const pg8::bf16_t*)(ws + WS_W13T) + (size_t)(l >> 1) * 2 * DFF * DM, NR, 2 * DFF, DM};
                pg8::StaticOrder S; S.init(NR, 2 * DFF, G, bx);
                pg8::EpiSwiGLU E{(pg8::bf16_t*)(ws + WS_HF), DFF, 0};
                REP(8, (pg8::gemm_phase<pg8::EpiSwiGLU, pg8::StaticOrder, true, true>(lds, g, S, E)));
            } PH_END
            PH_BEGIN PH_KIND(9) {
                pg8::Gemm g{(const pg8::bf16_t*)(ws + WS_HF), (const pg8::bf16_t*)(ws + WS_W2T) + (size_t)(l >> 1) * DM * DFF, NR, DM, DFF};
                pg8::LatentOrder S; S.init(DM, G, bx);
                pg8::EpiResid E{(const float*)nullptr, (pg8::bf16_t*)(__attribute__((address_space(1))) pg8::bf16_t*)args.out, MODl + 5120};
                if (PH_ON(9)) { ctx_gemm_resid((const bf16*)(ws + WS_HF), (const bf16*)(ws + WS_W2T) + (size_t)(l >> 1) * DM * DFF, DFF, MODl + 2 * 6144 + 5120, (const float*)(ws + WS_XC), (float*)(ws + WS_XC), vcu, G);
                    pg8::gemm_phase<pg8::EpiResid, pg8::LatentOrder, true, true>(lds, g, S, E); }
                if (DUP_ON(9)) { xcd_barrier(bar); pg8::EpiNull EN{(float*)(ws + WS_CTL) + 8}; pg8::gemm_phase<pg8::EpiNull, pg8::LatentOrder, true, true>(lds, g, S, EN); }
            } PH_END
        } else {
            {
                const unsigned* cnt = (const unsigned*)ctl + CW_CNT + ((l >> 1) * 8) * 64;
                PH_BEGIN PH_KIND(10) if (PH_ON(10)) phase_gather(args, vcu, G, l); PH_END
                PH_BEGIN PH_KIND(11) {
                    pg8::Gemm g{(const pg8::bf16_t*)(ws + WS_AG), (const pg8::bf16_t*)(ws + WS_W13E), MOE_ROWS, 8 * 2 * DFE, DM};
                    pg8::MoeOrder S; S.init(cnt, (2 * DFE) / 256, G, bx);
                    pg8::EpiSwiGLU E{(pg8::bf16_t*)(ws + WS_HMOE), DFE, (2 * DFE) / 256};
                    REP(11, (pg8::gemm_phase<pg8::EpiSwiGLU, pg8::MoeOrder, true, true>(lds, g, S, E)));
                } PH_END
                PH_BEGIN PH_KIND(12) {
                    pg8::Gemm g{(const pg8::bf16_t*)(ws + WS_HMOE), (const pg8::bf16_t*)(ws + WS_W2E), MOE_ROWS, 8 * DM, DFE};
                    pg8::MoeOrder S; S.init(cnt, DM / 256, G, bx);
                    pg8::EpiStoreBf16 E{(pg8::bf16_t*)(ws + WS_YEXP), DM, DM / 256};
                    REP(12, (pg8::gemm_phase<pg8::EpiStoreBf16, pg8::MoeOrder, true, true>(lds, g, S, E)));
                } PH_END
                PH_BEGIN PH_KIND(13) if (PH_ON(13)) phase_combine(args, lds, vcu, G, l); PH_END
            }
        }
    }
#if defined(CLKPROBE) || defined(SEGPROBE)
    if (blockIdx.x == 0 && tid == 0) { const unsigned cpt = MISC[100]; const unsigned long long s0 = __builtin_amdgcn_s_memrealtime(); while (__builtin_amdgcn_s_memrealtime() - s0 < (unsigned long long)cpt * 100ull) { __builtin_amdgcn_s_sleep(8); } }
#endif
#if TMASK
    {
        if (blockIdx.x == 0 && tid == 0) { const float tms = (float)t_acc * 1e-5f; __hip_atomic_store((float*)(ctl + 16), sqrtf(100.0f * tms), __ATOMIC_RELAXED, __HIP_MEMORY_SCOPE_AGENT); }
        xcd_barrier(bar);
        const float cval = __hip_atomic_load((float*)(ctl + 16), __ATOMIC_RELAXED, __HIP_MEMORY_SCOPE_AGENT);
        for (size_t i = (size_t)blockIdx.x * NTHR + tid; i < (size_t)NB * SEQ * DM; i += (size_t)G * NTHR) ((float*)(__attribute__((address_space(1))) float*)args.out)[i] = cval;
    }
#endif
#undef PH_BEGIN
#undef PH_END
}

extern "C" void kernel_launch(void* const* d_in, const int* in_sizes, int n_in, void* d_out, int out_size, void* d_ws, size_t ws_size, hipStream_t stream) {
    static int grid = 0;
    if (grid == 0) {
        if (n_in != 34 || out_size != NB * SEQ * DM || ws_size < WS_END) { fprintf(stderr, "kernel_launch: unexpected shapes (n_in %d out %d ws %zu, need %zu)\n", n_in, out_size, ws_size, (size_t)WS_END); grid = -1; return; }
        int dev = 0, cus = 0, per_cu = 0;
        if (hipGetDevice(&dev) != hipSuccess || hipDeviceGetAttribute(&cus, hipDeviceAttributeMultiprocessorCount, dev) != hipSuccess) { grid = -1; return; }
        if (hipFuncSetAttribute((const void*)mk_fwd, hipFuncAttributeMaxDynamicSharedMemorySize, LDS_BYTES) != hipSuccess) { fprintf(stderr, "kernel_launch: hipFuncSetAttribute failed\n"); grid = -1; return; }
        if (hipOccupancyMaxActiveBlocksPerMultiprocessor(&per_cu, (const void*)mk_fwd, NTHR, LDS_BYTES) != hipSuccess || per_cu < 1) fprintf(stderr, "kernel_launch: occupancy query reports %d blocks per CU\n", per_cu);
        (void)hipGetLastError();
        grid = cus;
    }
    if (grid < 0) return;
    if (hipMemsetAsync((char*)d_ws + WS_CTL, 0, CTL_ZERO_BYTES, stream) != hipSuccess) return;
    Args a{};
    for (int i = 0; i < 34; ++i) a.in[i] = (const float*)d_in[i];
    a.out = (float*)d_out; a.ws = (unsigned char*)d_ws;
#if MK_MULTI
    for (int s = 0; s < N_PHASES; ++s) { a.ph_lo = s; a.ph_hi = s + 1; hipLaunchKernelGGL(mk_fwd, dim3(grid), dim3(NTHR), LDS_BYTES, stream, a); }
#else
    a.ph_lo = 0; a.ph_hi = N_PHASES;
    hipLaunchKernelGGL(mk_fwd, dim3(grid), dim3(NTHR), LDS_BYTES, stream, a);
#endif
    const hipError_t le = hipPeekAtLastError();
    if (le != hipSuccess) fprintf(stderr, "kernel_launch: launch failed: %s\n", hipGetErrorName(le));
}
```

```cpp
#include <hip/hip_runtime.h>
#include <cstdio>
#include <cstdint>
__device__ __forceinline__ int opaque_tid() { int t = (int)threadIdx.x; asm volatile("" : "+v"(t)); return t; }
template <class T> __device__ __forceinline__ T* opaque_ptr(T* p) { __attribute__((address_space(1))) T* g = (__attribute__((address_space(1))) T*)p; asm volatile("" : "+s"(g)); return (T*)g; }
template <class T> __device__ __forceinline__ const T* gptr(const T* p) { return (const T*)(const __attribute__((address_space(1))) T*)p; }
namespace pg8 {
#define PG8_LAS __attribute__((address_space(3)))
typedef unsigned short bf16_t;
typedef short bf16x8 __attribute__((ext_vector_type(8)));
typedef float f32x4 __attribute__((ext_vector_type(4)));
typedef unsigned u32x4 __attribute__((ext_vector_type(4)));
constexpr int BM = 256, BK = 64, HALF = 128, HTB = HALF * BK * 2  , STAGE_BYTES = 8 * HTB, NXCD = 8, WGM = 8;

__host__ __device__ __forceinline__ int lds_byte(int r, int c) { const int st = (r >> 4) * 2 + (c >> 5), rr = r & 15, cc = c & 31, ob = rr * 64 + cc * 2; return st * 1024 + (ob ^ (((ob >> 9) & 1) << 5)); }
__host__ __device__ __forceinline__ void stage_rc(int b, int& R, int& C) { const int st = b / 1024, sb = b % 1024, swz = sb ^ (((sb >> 9) & 1) << 5); R = (st >> 1) * 16 + swz / 64; C = (st & 1) * 32 + (swz % 64) / 2; }
__host__ __device__ __forceinline__ int perm32(int rho) { const int n = rho >> 4, i = rho & 15; return 8 * (i >> 2) + 4 * n + (i & 3); }

struct Unit { int pm, pn; };
struct Gemm { const bf16_t* A; const bf16_t* Bt; int M, N, K; };

struct StaticOrder {
    int nM, nN, nwg, G, c;
    __host__ __device__ void init(int M, int N, int G_, int c_) { nM = M / BM; nN = N / BM; nwg = nM * nN; G = G_; c = c_; }
    __host__ __device__ bool next(int i, Unit& u) const {
        const long L = (long)i * G + c; if (L >= nwg) return false;
        int wgid = (int)L; { const int q = nwg / NXCD, r = nwg % NXCD, xcd = wgid % NXCD, off = wgid / NXCD; wgid = (xcd < r ? xcd * (q + 1) : r * (q + 1) + (xcd - r) * q) + off; }
        const int nig = WGM * nN, gid = wgid / nig, fm = gid * WGM, gsz = (nM - fm) < WGM ? (nM - fm) : WGM;
        u.pm = fm + ((wgid % nig) % gsz); u.pn = (wgid % nig) / gsz; return true;
    }
    __device__ __forceinline__ void a_ready(const Unit&) const {}
    __device__ __forceinline__ void done(const Unit&) const {}
};

__device__ __forceinline__ unsigned cvt_pk_bf16(float lo, float hi) { unsigned r; asm volatile("v_cvt_pk_bf16_f32 %0, %1, %2" : "=v"(r) : "v"(lo), "v"(hi)); return r; }
typedef float f32x2 __attribute__((ext_vector_type(2)));
__device__ __forceinline__ float silu_acc(float a) { return a * __builtin_amdgcn_rcpf(1.0f + __builtin_amdgcn_exp2f(-1.4426950408889634f * a)); }
struct EpiStoreBf16 {
    static constexpr bool PERM = true, AFTER_DRAIN = false;
    bf16_t* O; int ldc; int ncolt;
    __device__ __forceinline__ void operator()(const f32x4 (&acc)[2][2][4][2], const Unit& u, int wr, int wc, int fr, int fq) const {
        const int row0 = u.pm * BM + wr * 64 + fr; const int pnl = ncolt ? (u.pn % ncolt) : u.pn;
        const int col0 = pnl * BM + wc * 32 + 8 * fq;
#pragma unroll
        for (int ai = 0; ai < 2; ++ai)
#pragma unroll
            for (int m = 0; m < 4; ++m) { bf16_t* rowp = O + (size_t)(row0 + ai * HALF + m * 16) * ldc + col0;
#pragma unroll
                for (int bj = 0; bj < 2; ++bj) { const f32x4 v0 = acc[ai][bj][m][0], v1 = acc[ai][bj][m][1];
                    u32x4 w; w.x = cvt_pk_bf16(v0[0], v0[1]); w.y = cvt_pk_bf16(v0[2], v0[3]); w.z = cvt_pk_bf16(v1[0], v1[1]); w.w = cvt_pk_bf16(v1[2], v1[3]);
                    *(__attribute__((address_space(1))) u32x4*)(rowp + bj * HALF) = w; } }
    }
};
struct EpiStoreSplit {
    static constexpr bool PERM = true, AFTER_DRAIN = false;
    bf16_t* O0; int ld0; bf16_t* O1; int ld1; int nt0; const float* RT  ; float qscale;
    __device__ __forceinline__ void operator()(const f32x4 (&acc)[2][2][4][2], const Unit& u, int wr, int wc, int fr, int fq) const {
        const int row0 = u.pm * BM + wr * 64 + fr; const bool first = u.pn < nt0; const int pnl = first ? u.pn : u.pn - nt0; const int ldc = first ? ld0 : ld1; bf16_t* O = first ? O0 : O1;
        const int col0 = pnl * BM + wc * 32 + 8 * fq;
        const int bb = u.pm / 65, jt = u.pm - bb * 65;
        if (u.pn < 4 && (jt != 0 || u.pn < 2)) {
            const float sc = (u.pn < 2) ? qscale : 1.0f; const bool hi = (fq >> 1) != 0;
#pragma unroll
            for (int ai = 0; ai < 2; ++ai)
#pragma unroll
                for (int m = 0; m < 4; ++m) { bf16_t* rowp = O + (size_t)(row0 + ai * HALF + m * 16) * ldc + col0;
                    f32x4 cs[4];
                    if (jt != 0) { const int t = (jt - 1) * 256 + ai * HALF + wr * 64 + m * 16 + fr; const int pos = (wc & 1) ? (t & 63) : (t >> 6);
                        const f32x4* cp = (const f32x4*)(RT + (size_t)(pos * 16 + 8 * (fq & 1)) * 2);
#pragma unroll
                        for (int k = 0; k < 4; ++k) cs[k] = cp[k]; }
#pragma unroll
                    for (int bj = 0; bj < 2; ++bj) { f32x4 v[2] = {acc[ai][bj][m][0], acc[ai][bj][m][1]};
                        if (jt != 0) {
#pragma unroll
                            for (int n = 0; n < 2; ++n)
#pragma unroll
                                for (int i = 0; i < 4; ++i) { const float xf = v[n][i]; const unsigned xv = __builtin_bit_cast(unsigned, xf);
                                    auto rr = __builtin_amdgcn_permlane32_swap(xv, xv, false, false);
                                    const unsigned r0 = rr[0], r1 = rr[1]; const float x1 = __builtin_bit_cast(float, r0), x2 = __builtin_bit_cast(float, r1);
                                    const int k = 4 * n + i; const float c = cs[k >> 1][(k & 1) * 2], s = cs[k >> 1][(k & 1) * 2 + 1];
                                    v[n][i] = hi ? (x1 * s + x2 * c) : (x1 * c - x2 * s); } }
                        u32x4 w; w.x = cvt_pk_bf16(v[0][0] * sc, v[0][1] * sc); w.y = cvt_pk_bf16(v[0][2] * sc, v[0][3] * sc); w.z = cvt_pk_bf16(v[1][0] * sc, v[1][1] * sc); w.w = cvt_pk_bf16(v[1][2] * sc, v[1][3] * sc);
                        *(__attribute__((address_space(1))) u32x4*)(rowp + bj * HALF) = w; } }
            return;
        }
#pragma unroll
        for (int ai = 0; ai < 2; ++ai)
#pragma unroll
            for (int m = 0; m < 4; ++m) { bf16_t* rowp = O + (size_t)(row0 + ai * HALF + m * 16) * ldc + col0;
#pragma unroll
                for (int bj = 0; bj < 2; ++bj) { const f32x4 v0 = acc[ai][bj][m][0], v1 = acc[ai][bj][m][1];
                    u32x4 w; w.x = cvt_pk_bf16(v0[0], v0[1]); w.y = cvt_pk_bf16(v0[2], v0[3]); w.z = cvt_pk_bf16(v1[0], v1[1]); w.w = cvt_pk_bf16(v1[2], v1[3]);
                    *(__attribute__((address_space(1))) u32x4*)(rowp + bj * HALF) = w; } }
    }
};
struct EpiSwiGLU {
    static constexpr bool PERM = true, AFTER_DRAIN = false;
    bf16_t* O; int ldc; int ncolt;
    __device__ __forceinline__ void operator()(const f32x4 (&acc)[2][2][4][2], const Unit& u, int wr, int wc, int fr, int fq) const {
        const int row0 = u.pm * BM + wr * 64 + fr; const int pnl = ncolt ? (u.pn % ncolt) : u.pn;
        const int col0 = pnl * HALF + wc * 32 + 8 * fq;
#pragma unroll
        for (int ai = 0; ai < 2; ++ai)
#pragma unroll
            for (int m = 0; m < 4; ++m) { bf16_t* rowp = O + (size_t)(row0 + ai * HALF + m * 16) * ldc + col0;
                const f32x4 a0 = acc[ai][0][m][0], a1 = acc[ai][0][m][1], b0 = acc[ai][1][m][0], b1 = acc[ai][1][m][1];
                u32x4 w;
                w.x = cvt_pk_bf16(silu_acc(a0[0]) * b0[0], silu_acc(a0[1]) * b0[1]); w.y = cvt_pk_bf16(silu_acc(a0[2]) * b0[2], silu_acc(a0[3]) * b0[3]);
                w.z = cvt_pk_bf16(silu_acc(a1[0]) * b1[0], silu_acc(a1[1]) * b1[1]); w.w = cvt_pk_bf16(silu_acc(a1[2]) * b1[2], silu_acc(a1[3]) * b1[3]);
                *(__attribute__((address_space(1))) u32x4*)rowp = w; }
    }
};
constexpr int XPITCH = 2048;
struct EpiResid {
    static constexpr bool PERM = true, AFTER_DRAIN = false;
    const float* srcF; bf16_t* X; const float* gate3;
    __device__ __forceinline__ void operator()(const f32x4 (&acc)[2][2][4][2], const Unit& u, int wr, int wc, int fr, int fq) const {
        const int b = u.pm / 65, j = u.pm - b * 65;
        const size_t r0 = (size_t)b * 16384 + (size_t)(j - 1) * 256;
        const float* gp = gate3 + (size_t)b * 6144;
        const int col0 = u.pn * BM + wc * 32 + 8 * fq;
        f32x4 gv[2][2];
#pragma unroll
        for (int bj = 0; bj < 2; ++bj)
#pragma unroll
            for (int n = 0; n < 2; ++n) gv[bj][n] = *(const f32x4*)(gp + col0 + bj * HALF + n * 4);
#pragma unroll
        for (int ai = 0; ai < 2; ++ai)
#pragma unroll
            for (int m = 0; m < 4; ++m) { const size_t row = r0 + (size_t)(ai * HALF + wr * 64 + m * 16 + fr);
#pragma unroll
                for (int bj = 0; bj < 2; ++bj) { const int c = col0 + bj * HALF; f32x4 x0, x1;
                    if (srcF != nullptr) { const __attribute__((address_space(1))) f32x4* sp = (const __attribute__((address_space(1))) f32x4*)(srcF + row * 1024 + c); x0 = sp[0]; x1 = sp[1]; }
                    else { const u32x4 w = *(const __attribute__((address_space(1))) u32x4*)(X + row * XPITCH + c);
                        x0 = (f32x4){__builtin_bit_cast(float, w.x << 16), __builtin_bit_cast(float, w.x & 0xffff0000u), __builtin_bit_cast(float, w.y << 16), __builtin_bit_cast(float, w.y & 0xffff0000u)};
                        x1 = (f32x4){__builtin_bit_cast(float, w.z << 16), __builtin_bit_cast(float, w.z & 0xffff0000u), __builtin_bit_cast(float, w.w << 16), __builtin_bit_cast(float, w.w & 0xffff0000u)}; }
                    const f32x4 y0 = x0 + gv[bj][0] * acc[ai][bj][m][0], y1 = x1 + gv[bj][1] * acc[ai][bj][m][1];
                    u32x4 o; o.x = cvt_pk_bf16(y0[0], y0[1]); o.y = cvt_pk_bf16(y0[2], y0[3]); o.z = cvt_pk_bf16(y1[0], y1[1]); o.w = cvt_pk_bf16(y1[2], y1[3]);
                    *(__attribute__((address_space(1))) u32x4*)(X + row * XPITCH + c) = o; }
                if (m & 1) asm volatile("" ::: "memory"); }
    }
};
struct LatentOrder {
    StaticOrder so;
    __device__ __forceinline__ void init(int N, int G_, int c_) { so.init(128 * BM, N, G_, c_); }
    __device__ __forceinline__ bool next(int i, Unit& u) const { if (!so.next(i, u)) return false; u.pm = u.pm + 1 + (u.pm >= 64 ? 1 : 0); return true; }
    __device__ __forceinline__ void a_ready(const Unit&) const {}
    __device__ __forceinline__ void done(const Unit&) const {}
};
struct EpiNull {
    static constexpr bool PERM = false, AFTER_DRAIN = false;
    float* sink;
    __device__ __forceinline__ void operator()(const f32x4 (&acc)[2][2][4][2], const Unit& u, int wr, int wc, int fr, int fq) const {
        float s = 0.f;
#pragma unroll
        for (int ai = 0; ai < 2; ++ai)
#pragma unroll
            for (int bj = 0; bj < 2; ++bj)
#pragma unroll
                for (int m = 0; m < 4; ++m)
#pragma unroll
                    for (int n = 0; n < 2; ++n) s += acc[ai][bj][m][n][0] + acc[ai][bj][m][n][1] + acc[ai][bj][m][n][2] + acc[ai][bj][m][n][3];
        if (s == 123456.789f) *sink = s;
    }
};
struct MoeOrder {
    int t0, t1, t2, t3, t4, t5, t6, t7; int ncol, G, c;
    __device__ __forceinline__ void init(const unsigned* cnt  , int ncol_, int G_, int c_) {
        ncol = ncol_; G = G_; c = c_;
#define MO_T(e) (((int)__hip_atomic_load(cnt + 64 * (e), __ATOMIC_RELAXED, __HIP_MEMORY_SCOPE_AGENT) + 255) >> 8)
        t0 = MO_T(0); t1 = MO_T(1); t2 = MO_T(2); t3 = MO_T(3); t4 = MO_T(4); t5 = MO_T(5); t6 = MO_T(6); t7 = MO_T(7);
#undef MO_T
    }
    __device__ __forceinline__ bool next(int i, Unit& u) const {
        int L = i * G + c;
        {
          const int U = (t0 + t1 + t2 + t3 + t4 + t5 + t6 + t7) * ncol; if (L >= U) return false;
          const int q = U / NXCD, r = U % NXCD, xcd = L % NXCD, off = L / NXCD; L = (xcd < r ? xcd * (q + 1) : r * (q + 1) + (xcd - r) * q) + off; }
        int e = 0, r0 = 0, te = t0; bool found = false;
#define MO_STEP(k, tk) if (!found) { if (L < (tk) * ncol) { e = (k); te = (tk); found = true; } else { L -= (tk) * ncol; r0 += (tk); } }
        MO_STEP(0, t0) MO_STEP(1, t1) MO_STEP(2, t2) MO_STEP(3, t3) MO_STEP(4, t4) MO_STEP(5, t5) MO_STEP(6, t6) MO_STEP(7, t7)
#undef MO_STEP
        if (!found) return false;
        const int nig = WGM * ncol, gid = L / nig, fm = gid * WGM, gsz = (te - fm) < WGM ? (te - fm) : WGM, rr = L - gid * nig;
        u.pm = r0 + fm + rr % gsz; u.pn = e * ncol + rr / gsz; return true;
    }
    __device__ __forceinline__ void a_ready(const Unit&) const {}
    __device__ __forceinline__ void done(const Unit&) const {}
};
template <class Epi, class Sched, bool ALIGN_EPI = false, bool SP2 = false>
__device__ __forceinline__ void gemm_phase(PG8_LAS unsigned char* lds, const Gemm g, const Sched& S, const Epi& E) {
    const int tid = opaque_tid(), wid = __builtin_amdgcn_readfirstlane(tid >> 6), lane = tid & 63, wr = wid >> 2, wc = wid & 3, fr = lane & 15, fq = lane >> 4;
    const int K = g.K, nt = K / BK;
    unsigned voffA[2], voffB[2];
#pragma unroll
    for (int i = 0; i < 2; ++i) { int R, C; stage_rc(tid * 16 + i * 8192, R, C); const int Rb = Epi::PERM ? ((R & ~31) + perm32(R & 31)) : R;
        voffA[i] = (unsigned)(R * K + C) * 2u; voffB[i] = (unsigned)(Rb * K + C) * 2u; }
    const size_t kstep = (size_t)(BK * 2);
    const size_t hstep = (size_t)HALF * K * 2;
    const size_t tstep = 2 * hstep;
    const unsigned ldsw = (unsigned)wid * 1024u;
    const int aoff = lds_byte(wr * 64 + fr, fq * 8), boff = lds_byte(wc * 32 + fr, fq * 8);
#define PG8_SA(b, h) (((b) * 2 + (h)) * HTB)
#define PG8_SB(b, h) ((4 + (b) * 2 + (h)) * HTB)
#define PG8_STAGE(bufoff, gbase, voff) do { _Pragma("unroll") for (int _i = 0; _i < 2; ++_i) \
        __builtin_amdgcn_global_load_lds((const unsigned*)((const char*)(gbase) + (voff)[_i]), (PG8_LAS unsigned*)(lds + (bufoff) + ldsw + _i * 8192), 16, 0, 0); } while (0)
#define PG8_LDA(dst, b, h) do { _Pragma("unroll") for (int m = 0; m < 4; ++m) _Pragma("unroll") for (int k = 0; k < 2; ++k) dst[m][k] = *(const PG8_LAS bf16x8*)(lds + PG8_SA(b, h) + aoff + m * 2048 + k * 1024); } while (0)
#define PG8_LDB(dst, b, h) do { _Pragma("unroll") for (int n = 0; n < 2; ++n) _Pragma("unroll") for (int k = 0; k < 2; ++k) dst[n][k] = *(const PG8_LAS bf16x8*)(lds + PG8_SB(b, h) + boff + n * 2048 + k * 1024); } while (0)
#define PG8_MMA(ai, bj, At, Bt) do { __builtin_amdgcn_s_setprio(1); _Pragma("unroll") for (int m = 0; m < 4; ++m) _Pragma("unroll") for (int n = 0; n < 2; ++n) _Pragma("unroll") for (int k = 0; k < 2; ++k) \
        acc[ai][bj][m][n] = __builtin_amdgcn_mfma_f32_16x16x32_bf16(Bt[n][k], At[m][k], acc[ai][bj][m][n], 0, 0, 0); __builtin_amdgcn_s_setprio(0); } while (0)
#define PG8_WAIT_V(n) asm volatile("s_waitcnt vmcnt(" #n ")" ::: "memory")
#define PG8_WAIT_L(n) asm volatile("s_waitcnt lgkmcnt(" #n ")" ::: "memory")
#define PG8_BAR __builtin_amdgcn_s_barrier()
#define PG8_SCHED __builtin_amdgcn_sched_barrier(0)
    Unit cur, nxt; int ui = 0;
    if (!S.next(0, cur)) return;
    f32x4 acc[2][2][4][2];
#pragma unroll
    for (int a = 0; a < 2; ++a)
#pragma unroll
        for (int b = 0; b < 2; ++b)
#pragma unroll
            for (int m = 0; m < 4; ++m)
#pragma unroll
                for (int n = 0; n < 2; ++n) acc[a][b][m][n] = (f32x4){0.f, 0.f, 0.f, 0.f};
    bf16x8 At[4][2], B0[2][2], B1[2][2];
    const char* cA = (const char*)g.A + (size_t)cur.pm * tstep; const char* cB = (const char*)g.Bt + (size_t)cur.pn * tstep;
    S.a_ready(cur);
    if constexpr (SP2) {
        PG8_STAGE(PG8_SB(0, 0), cB, voffB); PG8_STAGE(PG8_SB(0, 1), cB + hstep, voffB); PG8_STAGE(PG8_SA(0, 0), cA, voffA); PG8_STAGE(PG8_SA(0, 1), cA + hstep, voffA);
        if (wr == 1) PG8_BAR;
        PG8_WAIT_V(2); PG8_BAR;
        PG8_STAGE(PG8_SB(1, 0), cB + kstep, voffB); PG8_STAGE(PG8_SA(1, 0), cA + kstep, voffA); PG8_STAGE(PG8_SB(1, 1), cB + hstep + kstep, voffB);
        PG8_WAIT_V(6); PG8_BAR;
    } else {
        PG8_STAGE(PG8_SB(0, 0), cB, voffB); PG8_STAGE(PG8_SA(0, 0), cA, voffA); PG8_STAGE(PG8_SB(0, 1), cB + hstep, voffB); PG8_STAGE(PG8_SA(0, 1), cA + hstep, voffA);
        if (wr == 1) PG8_BAR;
        PG8_WAIT_V(4); PG8_BAR;
        PG8_STAGE(PG8_SB(1, 0), cB + kstep, voffB); PG8_STAGE(PG8_SA(1, 0), cA + kstep, voffA); PG8_STAGE(PG8_SB(1, 1), cB + hstep + kstep, voffB);
        PG8_WAIT_V(6); PG8_BAR;
    }
    for (;;) {
        const bool has_next = S.next(ui + 1, nxt);
        const char* nA = has_next ? (const char*)g.A + (size_t)nxt.pm * tstep : cA; const char* nB = has_next ? (const char*)g.Bt + (size_t)nxt.pn * tstep : cB;
        for (int t = 0; t < nt; t += 2) {
            const bool last = (t == nt - 2);
            const char* a1 = cA + (size_t)(t + 1) * kstep;
            const char* a2 = last ? nA : cA + (size_t)(t + 2) * kstep; const char* b2 = last ? nB : cB + (size_t)(t + 2) * kstep;
            const char* a3 = a2 + kstep; const char* b3 = b2 + kstep;
            if (last && has_next) S.a_ready(nxt);
            if constexpr (SP2) {
            PG8_LDB(B0, 0, 0); PG8_LDB(B1, 0, 1); PG8_SCHED; PG8_LDA(At, 0, 0); PG8_STAGE(PG8_SA(1, 1), a1 + hstep, voffA);
            PG8_WAIT_V(8); PG8_WAIT_L(0); PG8_BAR; PG8_MMA(0, 0, At, B0); PG8_MMA(0, 1, At, B1); PG8_BAR; PG8_SCHED;
            PG8_LDA(At, 0, 1); PG8_STAGE(PG8_SB(0, 0), b2, voffB); PG8_STAGE(PG8_SB(0, 1), b2 + hstep, voffB); PG8_STAGE(PG8_SA(0, 0), a2, voffA);
            PG8_WAIT_V(8); PG8_WAIT_L(0); PG8_BAR; PG8_MMA(1, 0, At, B0); PG8_MMA(1, 1, At, B1); PG8_BAR; PG8_SCHED;
            PG8_LDB(B0, 1, 0); PG8_LDB(B1, 1, 1); PG8_SCHED; PG8_LDA(At, 1, 0); PG8_STAGE(PG8_SA(0, 1), a2 + hstep, voffA);
            PG8_WAIT_V(8); PG8_WAIT_L(0); PG8_BAR; PG8_MMA(0, 0, At, B0); PG8_MMA(0, 1, At, B1); PG8_BAR; PG8_SCHED;
            PG8_LDA(At, 1, 1); PG8_STAGE(PG8_SB(1, 0), b3, voffB); PG8_STAGE(PG8_SB(1, 1), b3 + hstep, voffB); PG8_STAGE(PG8_SA(1, 0), a3, voffA);
            PG8_WAIT_V(8); PG8_WAIT_L(0); PG8_BAR; PG8_MMA(1, 0, At, B0); PG8_MMA(1, 1, At, B1); PG8_BAR; PG8_SCHED;
            } else {
            PG8_LDB(B0, 0, 0); PG8_SCHED; PG8_LDA(At, 0, 0); PG8_STAGE(PG8_SA(1, 1), a1 + hstep, voffA);
            PG8_WAIT_L(8); PG8_BAR; PG8_WAIT_L(0); PG8_MMA(0, 0, At, B0); PG8_BAR; PG8_SCHED;
            PG8_LDB(B1, 0, 1); PG8_STAGE(PG8_SB(0, 0), b2, voffB);
            PG8_BAR; PG8_WAIT_L(0); PG8_MMA(0, 1, At, B1); PG8_BAR;
            PG8_LDA(At, 0, 1); PG8_STAGE(PG8_SA(0, 0), a2, voffA);
            PG8_BAR; PG8_WAIT_L(0); PG8_MMA(1, 0, At, B0); PG8_BAR; PG8_SCHED;
            PG8_STAGE(PG8_SB(0, 1), b2 + hstep, voffB);
            PG8_WAIT_V(6); PG8_BAR; PG8_MMA(1, 1, At, B1); PG8_BAR;
            PG8_LDB(B0, 1, 0); PG8_SCHED; PG8_LDA(At, 1, 0); PG8_STAGE(PG8_SA(0, 1), a2 + hstep, voffA);
            PG8_WAIT_L(8); PG8_BAR; PG8_WAIT_L(0); PG8_MMA(0, 0, At, B0); PG8_BAR; PG8_SCHED;
            PG8_LDB(B1, 1, 1); PG8_STAGE(PG8_SB(1, 0), b3, voffB);
            PG8_BAR; PG8_WAIT_L(0); PG8_MMA(0, 1, At, B1); PG8_BAR;
            PG8_LDA(At, 1, 1); PG8_STAGE(PG8_SA(1, 0), a3, voffA);
            PG8_BAR; PG8_WAIT_L(0); PG8_MMA(1, 0, At, B0); PG8_BAR; PG8_SCHED;
            PG8_STAGE(PG8_SB(1, 1), b3 + hstep, voffB);
            PG8_WAIT_V(6); PG8_BAR; PG8_MMA(1, 1, At, B1); PG8_BAR;
            }
        }
        if constexpr (ALIGN_EPI) { if (wr == 0) PG8_BAR; }
        if constexpr (!Epi::AFTER_DRAIN) { E(acc, cur, wr, wc, fr, fq); S.done(cur); }
        if (!has_next) break;
#pragma unroll
        for (int a = 0; a < 2; ++a)
#pragma unroll
            for (int b = 0; b < 2; ++b)
#pragma unroll
                for (int m = 0; m < 4; ++m)
#pragma unroll
                    for (int n = 0; n < 2; ++n) acc[a][b][m][n] = (f32x4){0.f, 0.f, 0.f, 0.f};
        cur = nxt; cA = nA; cB = nB; ++ui;
        if constexpr (ALIGN_EPI) { if (wr == 1) PG8_BAR; }
    }
    PG8_WAIT_V(0);
    if constexpr (!ALIGN_EPI) { if (wr == 0) PG8_BAR; }
    PG8_BAR;
    if constexpr (Epi::AFTER_DRAIN) { E.fused(acc, cur, wr, wc, fr, fq, lds, wid, lane); S.done(cur); }
#undef PG8_SA
#undef PG8_SB
#undef PG8_STAGE
#undef PG8_LDA
#undef PG8_LDB
#undef PG8_MMA
#undef PG8_WAIT_V
#undef PG8_WAIT_L
#undef PG8_BAR
#undef PG8_SCHED
}
}
constexpr int NB = 2, SEQ = 16384, CL = 256, DM = 1024, NPB = SEQ + CL  , NR = NB * NPB  , DEPTH = 4;
constexpr int NIN = 3296, NINP = 3328, DFF = 2816, NEXP = 8, DFE = 3584;
constexpr int NWAVES = 8, NTHR = 512;
constexpr float QSCALE = 0.125f * 1.4426950408889634f;
constexpr int PC_Q = 0, PC_K = 512, PC_V = 1024, PC_R = 0, PC_RK = 512, PC_RV = 1024, PC_LORA = 1536;

constexpr size_t MiB = 1u << 20;
constexpr size_t WS_CTL = 0, CTL_ZERO_BYTES = 1 * MiB;
constexpr size_t WS_MOD = 1 * MiB;
constexpr size_t WS_ROPE = 2 * MiB;
constexpr size_t WS_LAM = 2 * MiB + 65536;
constexpr size_t WS_XC = 3 * MiB;
constexpr size_t WS_ROUTE = 5 * MiB;
constexpr size_t WS_WINT = 8 * MiB;
constexpr size_t WS_WOUTT = 34 * MiB;
constexpr size_t WS_W13T = 42 * MiB;
constexpr size_t WS_W2T = 64 * MiB;
constexpr size_t WS_VFIRST = 76 * MiB;
constexpr size_t WS_HN = 110 * MiB;
constexpr size_t WS_PA = 175 * MiB;
constexpr size_t WS_G = 273 * MiB;
constexpr size_t WS_BONUS = 306 * MiB;
constexpr size_t WS_OPS = 308 * MiB;
constexpr size_t WS_PR = 308 * MiB;
constexpr size_t WS_PRE = 715 * MiB;
constexpr int PRE_REC = 8192;
constexpr size_t WS_VV = 975 * MiB;
constexpr size_t WS_Y = 813 * MiB;
constexpr size_t WS_APART = 943 * MiB;
constexpr size_t WS_ASTAT = 1010 * MiB;
constexpr int ATT_SPLIT = 8, ATT_SLICES = 4;
constexpr size_t WS_LORA = 1008 * MiB;
constexpr size_t WS_WCB = 1012 * MiB;
constexpr size_t WS_END = 1021 * MiB;
constexpr int LO_W2 = 0, LO_A2 = 131072, LO_V2 = 262144, LO_G2 = 262144 + 49152, LO_V1 = 262144 + 49152 + 196608, LO_TOTAL = LO_V1 + 49152;
constexpr int LDPA = 1536, LDPR = 1792;
constexpr int OPS_REC = 12288, NCHUNK = NPB / 16;
constexpr int OR_QT = 9216, OR_VT = 9728, OR_WC = 11776;
constexpr size_t WS_HF = 175 * MiB;
constexpr int MOE_ROWS = 68608;
constexpr size_t WS_W2E = 175 * MiB;
constexpr size_t WS_W13E = 231 * MiB;
constexpr size_t WS_AG = 343 * MiB;
constexpr size_t WS_HMOE = 477 * MiB;
constexpr size_t WS_YEXP = 231 * MiB;
static_assert(WS_WINT + (size_t)4 * NINP * DM * 2 <= WS_WOUTT && WS_WOUTT + (size_t)4 * DM * DM * 2 <= WS_W13T && WS_W13T + (size_t)2 * 2 * DFF * DM * 2 <= WS_W2T && WS_W2T + (size_t)2 * DM * DFF * 2 <= WS_VFIRST, "ws map 1");
static_assert(WS_VFIRST + (size_t)NR * 512 * 2 <= WS_HN && WS_HN + (size_t)NR * DM * 2 <= WS_PA && WS_PA + (size_t)NR * LDPA * 2 <= WS_G && WS_G + (size_t)NR * 512 * 2 <= WS_BONUS && WS_BONUS + (size_t)NR * 8 * 4 <= WS_OPS, "ws map 2");
static_assert(WS_OPS + (size_t)32 * NCHUNK * OPS_REC <= WS_PRE && WS_PR + (size_t)NR * LDPR * 2 <= WS_PRE && WS_PRE + (size_t)32 * NCHUNK * PRE_REC <= WS_VV && WS_VV + (size_t)NR * 512 * 2 <= WS_LORA && WS_Y + (size_t)2 * NR * 512 * 4 <= WS_APART && WS_LORA + (size_t)LO_TOTAL * 2 <= WS_ASTAT, "ws map 3");
static_assert(WS_APART + (size_t)64 * 4 * 2 * 128 * 128 * 4 <= WS_VV && WS_ASTAT + (size_t)64 * 4 * 2 * 128 * 2 * 4 <= WS_WCB && WS_WCB + (size_t)32 * NCHUNK * 256 <= WS_END, "ws map 5");
static_assert(WS_HF + (size_t)NR * DFF * 2 <= WS_LORA && WS_W2E + (size_t)8 * DM * DFE * 2 <= WS_W13E && WS_W13E + (size_t)8 * 2 * DFE * DM * 2 <= WS_AG && WS_AG + (size_t)MOE_ROWS * DM * 2 <= WS_HMOE && WS_HMOE + (size_t)MOE_ROWS * DFE * 2 <= WS_LORA && WS_YEXP + (size_t)MOE_ROWS * DM * 2 <= WS_HMOE, "ws map 4");
constexpr int CW_TMO = 0;
constexpr int CW_BAR = 4096;
constexpr int CW_QS = 16384;
constexpr int CW_QA = 20480;
constexpr int CW_CNT = 24576;

constexpr int RING_BYTES = 131072;
constexpr int LDSCTL_OFF = RING_BYTES, MISC_OFF = LDSCTL_OFF + 320;
constexpr int LDS_BYTES = 147456;

#define GAS __attribute__((address_space(1)))
#define LAS __attribute__((address_space(3)))
typedef unsigned short bf16;
typedef unsigned v4u __attribute__((ext_vector_type(4)));
typedef unsigned v2u __attribute__((ext_vector_type(2)));
typedef float f32x4 __attribute__((ext_vector_type(4)));
typedef _Float16 h4 __attribute__((ext_vector_type(4)));
#define LDS_WAIT() asm volatile("s_waitcnt lgkmcnt(0)" ::: "memory")
__device__ __forceinline__ unsigned f2bf(float f) { unsigned u = __builtin_bit_cast(unsigned, f); return (u + 0x7fffu + ((u >> 16) & 1u)) >> 16; }
__device__ __forceinline__ unsigned pk2(float lo, float hi) { return f2bf(lo) | (f2bf(hi) << 16); }
__device__ __forceinline__ float bf2f(bf16 h) { return __builtin_bit_cast(float, (unsigned)h << 16); }
__device__ __forceinline__ float bflo(unsigned w) { return __builtin_bit_cast(float, w << 16); }
__device__ __forceinline__ float bfhi(unsigned w) { return __builtin_bit_cast(float, w & 0xffff0000u); }
__device__ __forceinline__ float sigmoid_f(float x) { return __builtin_amdgcn_rcpf(1.0f + __expf(-x)); }
__device__ __forceinline__ float tanh_f(float x) { return 1.0f - 2.0f * __builtin_amdgcn_rcpf(__expf(2.0f * x) + 1.0f); }
__device__ __forceinline__ float dpp_rowsum16(float x) {
    x += __builtin_bit_cast(float, __builtin_amdgcn_update_dpp(0, __builtin_bit_cast(int, x), 0xB1, 0xF, 0xF, true));
    x += __builtin_bit_cast(float, __builtin_amdgcn_update_dpp(0, __builtin_bit_cast(int, x), 0x4E, 0xF, 0xF, true));
    x += __builtin_bit_cast(float, __builtin_amdgcn_update_dpp(0, __builtin_bit_cast(int, x), 0x141, 0xF, 0xF, true));
    x += __builtin_bit_cast(float, __builtin_amdgcn_update_dpp(0, __builtin_bit_cast(int, x), 0x140, 0xF, 0xF, true));
    return x;
}
__device__ __forceinline__ float wave_sum(float v) {
    v = dpp_rowsum16(v);
    { const unsigned u = __float_as_uint(v); auto r = __builtin_amdgcn_permlane16_swap(u, u, false, false); const unsigned r0 = r[0], r1 = r[1]; v = __uint_as_float(r0) + __uint_as_float(r1); }
    { const unsigned u = __float_as_uint(v); auto r = __builtin_amdgcn_permlane32_swap(u, u, false, false); const unsigned r0 = r[0], r1 = r[1]; v = __uint_as_float(r0) + __uint_as_float(r1); }
    return v;
}
#define XB_TMO      128
#define XB_XCNT(j)  (256  + 64 * (j))
#define XB_XSUB(j)  (1280 + 64 * (j))
#define XB_XGEN(j)  (2304 + 64 * (j))
#define XB_TOP      3328
#define XB_TOPGEN   3392
#define XCD_BAR_WORDS 3456
#define XB_SPIN_CAP (1u << 18)

__device__ __forceinline__ unsigned xb_ld(unsigned* p)              { return __hip_atomic_load(p, __ATOMIC_RELAXED, __HIP_MEMORY_SCOPE_AGENT); }
__device__ __forceinline__ unsigned xb_add(unsigned* p, unsigned v) { return __hip_atomic_fetch_add(p, v, __ATOMIC_RELAXED, __HIP_MEMORY_SCOPE_AGENT); }
__device__ __forceinline__ unsigned xb_xcc_id() { return (unsigned)__builtin_amdgcn_s_getreg((3 << 11) | 20) & 0xFu; }
#define XB_SPIN(cond, bar) do { unsigned _sp = 0; while (cond) { __builtin_amdgcn_s_sleep(1); \
    if ((++_sp & 255u) == 0u) { if (xb_ld(&(bar)[XB_TMO])) break; if (_sp > XB_SPIN_CAP) { atomicAdd(&(bar)[XB_TMO], 1u); break; } } } } while (0)

struct XcdBarrier {
    unsigned* bar; unsigned x;
    volatile LAS unsigned* st;
};

__device__ __forceinline__ XcdBarrier xcd_barrier_post(unsigned* bar, volatile LAS unsigned* st) {
    XcdBarrier b; b.bar = bar; b.x = xb_xcc_id(); b.st = st;
    if (threadIdx.x == 0) (void)xb_add(&bar[XB_XCNT(b.x)], 1u);
    return b;
}
__device__ __forceinline__ void xcd_barrier_complete(unsigned* bar, unsigned x, unsigned& nloc, unsigned& nx) {
    const unsigned G = gridDim.x * gridDim.y * gridDim.z;
    unsigned sum, cnt, mine, sp = 0u;
    for (;;) {
        sum = 0u; cnt = 0u; mine = 0u;
#pragma unroll
        for (unsigned j = 0; j < 16; ++j) { const unsigned c = xb_ld(&bar[XB_XCNT(j)]); sum += c; cnt += (c > 0u) ? 1u : 0u; mine = (j == x) ? c : mine; }
        if (sum == G) break;
        __builtin_amdgcn_s_sleep(1);
        if ((++sp & 255u) == 0u) { if (xb_ld(&bar[XB_TMO])) break; if (sp > XB_SPIN_CAP) { atomicAdd(&bar[XB_TMO], 1u); break; } }
    }
    nloc = mine > 0u ? mine : 1u; nx = cnt > 0u ? cnt : 1u;
}

__device__ __forceinline__ void xcd_barrier(const XcdBarrier& b) {
    asm volatile("s_waitcnt vmcnt(0)" ::: "memory");
    __syncthreads();
    if (threadIdx.x == 0) {
        unsigned* bar = b.bar;
        __builtin_amdgcn_s_waitcnt(0);
        unsigned nloc = b.st[0], nx = b.st[1];
        if (nloc == 0u) { xcd_barrier_complete(bar, b.x, nloc, nx); b.st[0] = nloc; b.st[1] = nx; }
        const unsigned old = xb_add(&bar[XB_XSUB(b.x)], 1u);
        const unsigned gen = old / nloc;
        if (old + 1u == (gen + 1u) * nloc) {
            __builtin_amdgcn_fence(__ATOMIC_RELEASE, "agent");
            asm volatile("s_waitcnt vmcnt(0)" ::: "memory");
            const unsigned og = xb_add(&bar[XB_TOP], 1u);
            const unsigned tg = og / nx;
            if (og + 1u == (tg + 1u) * nx) xb_add(&bar[XB_TOPGEN], 1u);
            else XB_SPIN(xb_ld(&bar[XB_TOPGEN]) == tg, bar);
            __builtin_amdgcn_fence(__ATOMIC_ACQUIRE, "agent");
            xb_add(&bar[XB_XGEN(b.x)], 1u);
            asm volatile("s_waitcnt vmcnt(0)" ::: "memory");
        } else {
            XB_SPIN(xb_ld(&bar[XB_XGEN(b.x)]) == gen, bar);
            __builtin_amdgcn_fence(__ATOMIC_ACQUIRE, "agent");
            asm volatile("s_waitcnt vmcnt(0)" ::: "memory");
        }
    }
    __syncthreads();
}
struct Args { const float* in[34]; float* out; unsigned char* ws; int ph_lo, ph_hi; };
namespace att {
using bf16x8 = __attribute__((ext_vector_type(8))) short;
using s16x4  = __attribute__((ext_vector_type(4))) short;
using f32x16 = __attribute__((ext_vector_type(16))) float;
using u32x4  = __attribute__((ext_vector_type(4))) unsigned;
constexpr int KVBLK = 64;
constexpr size_t SHM_V = KVBLK * 128 * 2, SHM_K = KVBLK * 128 * 2;
constexpr float THR2 = 11.5f;
#define KSWZ(row, colB) ((row) * 256 + ((colB) ^ (((row) & 7) << 4)))
#define SBAR() __builtin_amdgcn_sched_barrier(0)
__device__ __forceinline__ int crow(int r, int hi) { return (r & 3) + 8 * (r >> 2) + 4 * hi; }
__device__ __forceinline__ unsigned cvtpk(float lo, float hi) { unsigned r; asm volatile("v_cvt_pk_bf16_f32 %0, %1, %2" : "=v"(r) : "v"(lo), "v"(hi)); return r; }
__device__ __forceinline__ bf16x8 ld8(const bf16* p) { return *reinterpret_cast<const bf16x8*>(p); }

#define MX3(a, b, c) __builtin_fmaxf(__builtin_fmaxf((a), (b)), (c))
__device__ __forceinline__ float rowmax32(const f32x16& p0, const f32x16& p1) {
  float a = MX3(p0[0], p0[1], p1[0]), b = MX3(p0[2], p0[3], p1[1]); a = MX3(a, p1[2], p1[3]);
#pragma unroll
  for (int r = 4; r < 16; r += 4) { a = MX3(a, p0[r], p0[r + 1]); b = MX3(b, p0[r + 2], p0[r + 3]); a = MX3(a, p1[r], p1[r + 1]); b = MX3(b, p1[r + 2], p1[r + 3]); }
  float m = __builtin_fmaxf(a, b);
  auto rr = __builtin_amdgcn_permlane32_swap(__float_as_uint(m), __float_as_uint(m), false, false);
  return __builtin_fmaxf(__uint_as_float(rr[0]), __uint_as_float(rr[1]));
}
__device__ __forceinline__ void firstSM(f32x16& p0, f32x16& p1, float& m_reg, f32x16& negm, float& alpha) {
  const float dl = rowmax32(p0, p1); m_reg = dl; alpha = 1.f;
#pragma unroll
  for (int r = 0; r < 16; ++r) { p0[r] = p0[r] - dl; p1[r] = p1[r] - dl; negm[r] = -dl; }
  asm volatile("" : "+v"(negm));
#pragma unroll
  for (int r = 0; r < 16; ++r) p0[r] = __builtin_amdgcn_exp2f(p0[r]);
}
__device__ __forceinline__ void finishSM(f32x16& p0, f32x16& p1, float alpha, float& l_reg, bf16x8& pa0, bf16x8& pa1, bf16x8& pa2, bf16x8& pa3) {
#pragma unroll
  for (int r = 0; r < 16; ++r) p1[r] = __builtin_amdgcn_exp2f(p1[r]);
  float ps = p0[0], pt = p0[1], pu = p0[2], pv = p0[3];
#pragma unroll
  for (int r = 4; r < 16; r += 4) { ps += p0[r]; pt += p0[r + 1]; pu += p0[r + 2]; pv += p0[r + 3]; }
#pragma unroll
  for (int r = 0; r < 16; r += 4) { ps += p1[r]; pt += p1[r + 1]; pu += p1[r + 2]; pv += p1[r + 3]; }
  ps = (ps + pt) + (pu + pv);
  { auto rr = __builtin_amdgcn_permlane32_swap(__float_as_uint(ps), __float_as_uint(ps), false, false);
    ps = __uint_as_float(rr[0]) + __uint_as_float(rr[1]); }
  l_reg = l_reg * alpha + ps;
#define PK4(P, BASE, OUT) do { u32x4 w = {cvtpk(P[BASE + 0], P[BASE + 1]), cvtpk(P[BASE + 2], P[BASE + 3]), cvtpk(P[BASE + 4], P[BASE + 5]), cvtpk(P[BASE + 6], P[BASE + 7])}; \
    OUT = *reinterpret_cast<bf16x8*>(&w); } while (0)
  PK4(p0, 0, pa0); PK4(p0, 8, pa1); PK4(p1, 0, pa2); PK4(p1, 8, pa3);
#undef PK4
}
__device__ __forceinline__ void qkt(f32x16& p0, f32x16& p1, const bf16* Ks, const bf16x8* qr, int r32, int hi, int cbase, const f32x16& negm) {
#pragma unroll
  for (int d0 = 0; d0 < 4; ++d0) { int cb = (cbase + d0 * 16 + hi * 8) * 2;
    bf16x8 b0 = *reinterpret_cast<const bf16x8*>((const char*)Ks + KSWZ(r32, cb));
    bf16x8 b1 = *reinterpret_cast<const bf16x8*>((const char*)Ks + KSWZ(32 + r32, cb));
    if (d0 == 0) { p0 = __builtin_amdgcn_mfma_f32_32x32x16_bf16(b0, qr[0], negm, 0, 0, 0); p1 = __builtin_amdgcn_mfma_f32_32x32x16_bf16(b1, qr[0], negm, 0, 0, 0); }
    else { p0 = __builtin_amdgcn_mfma_f32_32x32x16_bf16(b0, qr[d0], p0, 0, 0, 0); p1 = __builtin_amdgcn_mfma_f32_32x32x16_bf16(b1, qr[d0], p1, 0, 0, 0); } }
}
__device__ __forceinline__ int v_st(int k, int c) { const int kk = k;     return ((kk >> 3) * 4 + (c >> 5)) * 512 + ((kk & 7) * 32 + (c & 31)) * 2; }
__device__ __forceinline__ int v_rd_base(int lane) { return ((lane & 3) << 3) | (((lane >> 2) & 3) << 6) | (((lane >> 4) & 1) << 5) | (((lane >> 5) & 1) << 8); }
constexpr int v_rd_off(int d0, int ks, int half) { return d0 * 512 + ks * 4096 + half * 2048; }
template <int OFF> __device__ __forceinline__ s16x4 tr_read(int vb) {
  s16x4 r; asm volatile("ds_read_b64_tr_b16 %0, %1 offset:%2" : "=&v"(r) : "v"(vb), "i"(OFF) : "memory"); return r;
}
template <int D0> __device__ __forceinline__ void pv_one(f32x16& od, int vb, bf16x8 pa0, bf16x8 pa1, bf16x8 pa2, bf16x8 pa3) {
  const s16x4 l0 = tr_read<v_rd_off(D0, 0, 0)>(vb), h0 = tr_read<v_rd_off(D0, 0, 1)>(vb), l1 = tr_read<v_rd_off(D0, 1, 0)>(vb), h1 = tr_read<v_rd_off(D0, 1, 1)>(vb);
  const s16x4 l2 = tr_read<v_rd_off(D0, 2, 0)>(vb), h2 = tr_read<v_rd_off(D0, 2, 1)>(vb), l3 = tr_read<v_rd_off(D0, 3, 0)>(vb), h3 = tr_read<v_rd_off(D0, 3, 1)>(vb);
  asm volatile("s_waitcnt lgkmcnt(0)" ::: "memory"); SBAR();
#define PK(L, H) (bf16x8){L[0], L[1], L[2], L[3], H[0], H[1], H[2], H[3]}
  od = __builtin_amdgcn_mfma_f32_32x32x16_bf16(PK(l0, h0), pa0, od, 0, 0, 0);
  od = __builtin_amdgcn_mfma_f32_32x32x16_bf16(PK(l1, h1), pa1, od, 0, 0, 0);
  od = __builtin_amdgcn_mfma_f32_32x32x16_bf16(PK(l2, h2), pa2, od, 0, 0, 0);
  od = __builtin_amdgcn_mfma_f32_32x32x16_bf16(PK(l3, h3), pa3, od, 0, 0, 0);
#undef PK
}
__device__ __forceinline__ void pv_d0(f32x16* o, int vb, bf16x8 pa0, bf16x8 pa1, bf16x8 pa2, bf16x8 pa3) {
  pv_one<0>(o[0], vb, pa0, pa1, pa2, pa3); pv_one<1>(o[1], vb, pa0, pa1, pa2, pa3); pv_one<2>(o[2], vb, pa0, pa1, pa2, pa3); pv_one<3>(o[3], vb, pa0, pa1, pa2, pa3);
}

struct VFrag { s16x4 l0, h0, l1, h1, l2, h2, l3, h3; };
template <int D0> __device__ __forceinline__ void vf_read(VFrag& f, int vb) {
  f.l0 = tr_read<v_rd_off(D0, 0, 0)>(vb); f.h0 = tr_read<v_rd_off(D0, 0, 1)>(vb); f.l1 = tr_read<v_rd_off(D0, 1, 0)>(vb); f.h1 = tr_read<v_rd_off(D0, 1, 1)>(vb);
  f.l2 = tr_read<v_rd_off(D0, 2, 0)>(vb); f.h2 = tr_read<v_rd_off(D0, 2, 1)>(vb); f.l3 = tr_read<v_rd_off(D0, 3, 0)>(vb); f.h3 = tr_read<v_rd_off(D0, 3, 1)>(vb);
}
__device__ __forceinline__ void vf_mma(f32x16& od, const VFrag& f, bf16x8 pa0, bf16x8 pa1, bf16x8 pa2, bf16x8 pa3) {
#define PK(L, H) (bf16x8){L[0], L[1], L[2], L[3], H[0], H[1], H[2], H[3]}
  od = __builtin_amdgcn_mfma_f32_32x32x16_bf16(PK(f.l0, f.h0), pa0, od, 0, 0, 0);
  od = __builtin_amdgcn_mfma_f32_32x32x16_bf16(PK(f.l1, f.h1), pa1, od, 0, 0, 0);
  od = __builtin_amdgcn_mfma_f32_32x32x16_bf16(PK(f.l2, f.h2), pa2, od, 0, 0, 0);
  od = __builtin_amdgcn_mfma_f32_32x32x16_bf16(PK(f.l3, f.h3), pa3, od, 0, 0, 0);
#undef PK
}
#define LGK_WAIT(n) do { asm volatile("s_waitcnt lgkmcnt(" #n ")" ::: "memory"); SBAR(); } while (0)
__device__ __forceinline__ void pv_softmax(f32x16* o, int vb, bf16x8 pa0, bf16x8 pa1, bf16x8 pa2, bf16x8 pa3, f32x16& p0, f32x16& p1, float& m_reg, f32x16& negm, float& alpha) {
  VFrag fa, fb;
  vf_read<0>(fa, vb); vf_read<1>(fb, vb); LGK_WAIT(8);
  vf_mma(o[0], fa, pa0, pa1, pa2, pa3);
  const float pmax = rowmax32(p0, p1);
  vf_read<2>(fa, vb); LGK_WAIT(8);
  vf_mma(o[1], fb, pa0, pa1, pa2, pa3);
  alpha = 1.f;
  if (__builtin_expect(__any(pmax > THR2), 0)) { const float dl = __builtin_fmaxf(pmax, 0.f); m_reg += dl; alpha = __builtin_amdgcn_exp2f(-dl);
#pragma unroll
    for (int r = 0; r < 16; ++r) { p0[r] = p0[r] - dl; p1[r] = p1[r] - dl; negm[r] = -m_reg; }
    asm volatile("" : "+v"(negm)); }
#pragma unroll
  for (int r = 0; r < 4; ++r) p0[r] = __builtin_amdgcn_exp2f(p0[r]);
  vf_read<3>(fb, vb); LGK_WAIT(8);
  vf_mma(o[2], fa, pa0, pa1, pa2, pa3);
#pragma unroll
  for (int r = 4; r < 10; ++r) p0[r] = __builtin_amdgcn_exp2f(p0[r]);
  LGK_WAIT(0);
  vf_mma(o[3], fb, pa0, pa1, pa2, pa3);
#pragma unroll
  for (int r = 10; r < 16; ++r) p0[r] = __builtin_amdgcn_exp2f(p0[r]);
}

__device__ __forceinline__ void pvseg(f32x16* o, int vb, bf16x8 pa0, bf16x8 pa1, bf16x8 pa2, bf16x8 pa3, VFrag& fa, VFrag& fb) {
  vf_mma(o[0], fa, pa0, pa1, pa2, pa3); SBAR();
  vf_read<2>(fa, vb); SBAR();
  vf_mma(o[1], fb, pa0, pa1, pa2, pa3); SBAR();
  vf_read<3>(fb, vb); LGK_WAIT(8);
  vf_mma(o[2], fa, pa0, pa1, pa2, pa3); SBAR();
  LGK_WAIT(0);
  vf_mma(o[3], fb, pa0, pa1, pa2, pa3);
}
template <int OFF> __device__ __forceinline__ bf16x8 k_read(int ad) { bf16x8 r; asm volatile("ds_read_b128 %0, %1 offset:%2" : "=&v"(r) : "v"(ad), "i"(OFF) : "memory"); return r; }
__device__ __forceinline__ void mseg(f32x16& p0, f32x16& p1, f32x16* o, const int* kad, const bf16x8* qr, const f32x16& negm, int vb, bf16x8 pa0, bf16x8 pa1, bf16x8 pa2, bf16x8 pa3, VFrag& fa, VFrag& fb) {
  const bf16x8 ka0 = k_read<0>(kad[0]), kb0 = k_read<8192>(kad[0]), ka1 = k_read<0>(kad[1]), kb1 = k_read<8192>(kad[1]);
  const bf16x8 ka2 = k_read<0>(kad[2]), kb2 = k_read<8192>(kad[2]), ka3 = k_read<0>(kad[3]), kb3 = k_read<8192>(kad[3]);
  SBAR();
  vf_mma(o[0], fa, pa0, pa1, pa2, pa3); SBAR();
  vf_mma(o[1], fb, pa0, pa1, pa2, pa3); SBAR();
  LGK_WAIT(0);
  p0 = __builtin_amdgcn_mfma_f32_32x32x16_bf16(ka0, qr[0], negm, 0, 0, 0); p1 = __builtin_amdgcn_mfma_f32_32x32x16_bf16(kb0, qr[0], negm, 0, 0, 0);
  p0 = __builtin_amdgcn_mfma_f32_32x32x16_bf16(ka1, qr[1], p0, 0, 0, 0); p1 = __builtin_amdgcn_mfma_f32_32x32x16_bf16(kb1, qr[1], p1, 0, 0, 0);
  SBAR();
  vf_read<2>(fa, vb); SBAR();
  p0 = __builtin_amdgcn_mfma_f32_32x32x16_bf16(ka2, qr[2], p0, 0, 0, 0); p1 = __builtin_amdgcn_mfma_f32_32x32x16_bf16(kb2, qr[2], p1, 0, 0, 0);
  p0 = __builtin_amdgcn_mfma_f32_32x32x16_bf16(ka3, qr[3], p0, 0, 0, 0); p1 = __builtin_amdgcn_mfma_f32_32x32x16_bf16(kb3, qr[3], p1, 0, 0, 0);
  SBAR();
  vf_read<3>(fb, vb); LGK_WAIT(8);
  vf_mma(o[2], fa, pa0, pa1, pa2, pa3); SBAR();
  LGK_WAIT(0);
  vf_mma(o[3], fb, pa0, pa1, pa2, pa3);
}

__device__ __forceinline__ void attn_unit(const bf16* __restrict__ P, int qrow0, int krow0, int NT, int h, float lam, float oml, const float* __restrict__ subg, bf16* __restrict__ AO, char* lds, float* __restrict__ part = nullptr, float* __restrict__ pstat = nullptr) {
  constexpr int LDK = LDPA;
  const int tid = opaque_tid(), wid = __builtin_amdgcn_readfirstlane(tid >> 6), lane = tid & 63, r32 = lane & 31, hi = lane >> 5;
  const int mp = wid >> 2, wq = wid & 3;
  bf16* V_lds = (bf16*)lds; bf16* K_lds = (bf16*)(lds + 3 * SHM_V);
  float m_reg = 0.f, l_reg = 0; f32x16 o[4] = {}; bf16x8 qr[4]; f32x16 negm = f32x16{}; asm volatile("" : "+v"(negm));
  const bf16* Qw = P + (size_t)(qrow0 + wq * 32 + r32) * LDK + PC_Q + h * 128 + mp * 64 + hi * 8;
#pragma unroll
  for (int d0 = 0; d0 < 4; ++d0) qr[d0] = ld8(Qw + d0 * 16);
  const bf16* Kh = P + (size_t)krow0 * LDK + PC_K + h * 128; const bf16* Vh = P + (size_t)krow0 * LDK + PC_V + h * 128;
  const int cbase = mp * 64;
  const int u = tid & 255;
  const int kr = u >> 3, kcb = (cbase + (u & 7) * 8) * 2;
  const int vr = mp * 32 + (u >> 4), vc = (u & 15) * 8;
  const int vst0 = v_st(vr, vc), vst1 = v_st(vr + 16, vc), kst0 = KSWZ(kr, kcb), kst1 = KSWZ(kr + 32, kcb);
  const bf16* Kg = Kh + (size_t)kr * LDK + cbase + (u & 7) * 8; const bf16* Vg = Vh + (size_t)vr * LDK + vc;
  const int vb0 = (int)(uintptr_t)V_lds + v_rd_base(lane);
  int kad[4];
#pragma unroll
  for (int d0 = 0; d0 < 4; ++d0) kad[d0] = (int)(uintptr_t)K_lds + KSWZ(r32, (cbase + d0 * 16 + hi * 8) * 2);
  struct { bf16x8 v0, v1, k0, k1; } sA, sB;
#define SLOAD(S, k0_) do { const size_t ko_ = (size_t)(k0_) * LDK; S.v0 = ld8(Vg + ko_); S.v1 = ld8(Vg + ko_ + (size_t)16 * LDK); S.k0 = ld8(Kg + ko_); S.k1 = ld8(Kg + ko_ + (size_t)32 * LDK); } while (0)
#define SWRITE(S, voff) do { *(bf16x8*)((char*)V_lds + (voff) + vst0) = S.v0; *(bf16x8*)((char*)V_lds + (voff) + vst1) = S.v1; \
    *(bf16x8*)((char*)K_lds + kst0) = S.k0; *(bf16x8*)((char*)K_lds + kst1) = S.k1; } while (0)
#ifndef PRIO_M
#define PRIO_M 1
#endif
#define XBAR() asm volatile("s_waitcnt lgkmcnt(0)\n\ts_barrier" ::: "memory")
#define RESC(a) do { if (__any((a) < 1.f)) { \
    _Pragma("unroll") for (int d = 0; d < 4; ++d) _Pragma("unroll") for (int r = 0; r < 16; ++r) o[d][r] *= (a); } } while (0)
  f32x16 p0, p1; float alpha; bf16x8 pa0, pa1, pa2, pa3;
  const int lastk = (NT - 1) * KVBLK;
  SLOAD(sA, 0); SWRITE(sA, 0); SLOAD(sB, min(KVBLK, lastk)); SLOAD(sA, min(2 * KVBLK, lastk));
  XBAR();
  if (mp == 1) XBAR();
  qkt(p0, p1, K_lds, qr, r32, hi, cbase, negm);
  XBAR();
  firstSM(p0, p1, m_reg, negm, alpha);
  finishSM(p0, p1, alpha, l_reg, pa0, pa1, pa2, pa3);
  VFrag fa, fb;
  vf_read<0>(fa, vb0); vf_read<1>(fb, vb0);
  SWRITE(sB, (int)SHM_V); SLOAD(sB, min(3 * KVBLK, lastk));
  XBAR();
  int vsl = 0, wsl = 2 * (int)SHM_V;
#define STEP(S, t_) do { \
    SBAR(); __builtin_amdgcn_s_setprio(PRIO_M); mseg(p0, p1, o, kad, qr, negm, vb0 + vsl, pa0, pa1, pa2, pa3, fa, fb); SBAR(); __builtin_amdgcn_s_setprio(0); SBAR(); \
    XBAR(); \
    { const float pmax = rowmax32(p0, p1); alpha = 1.f; \
      if (__builtin_expect(__any(pmax > THR2), 0)) { const float dl = __builtin_fmaxf(pmax, 0.f); m_reg += dl; alpha = __builtin_amdgcn_exp2f(-dl); \
        _Pragma("unroll") for (int r = 0; r < 16; ++r) { p0[r] = p0[r] - dl; p1[r] = p1[r] - dl; negm[r] = -m_reg; } \
        asm volatile("" : "+v"(negm)); } \
      _Pragma("unroll") for (int r = 0; r < 16; ++r) p0[r] = __builtin_amdgcn_exp2f(p0[r]); \
      finishSM(p0, p1, alpha, l_reg, pa0, pa1, pa2, pa3); \
      RESC(alpha); } \
    vsl = (vsl == 2 * (int)SHM_V) ? 0 : vsl + (int)SHM_V; \
    SBAR(); vf_read<0>(fa, vb0 + vsl); vf_read<1>(fb, vb0 + vsl); SBAR(); \
    SWRITE(S, wsl); SLOAD(S, min(((t_) + 3) * KVBLK, lastk)); \
    XBAR(); \
    wsl = (wsl == 2 * (int)SHM_V) ? 0 : wsl + (int)SHM_V; } while (0)
  int t = 1;
#pragma unroll 1
  for (; t + 1 < NT; t += 2) { STEP(sA, t); STEP(sB, t + 1); }
  if (t < NT) STEP(sA, t);
#undef STEP
  SBAR(); pvseg(o, vb0 + vsl, pa0, pa1, pa2, pa3, fa, fb); SBAR();
  if (mp == 0) XBAR();
  if (part != nullptr) {
    float* pb = part + (size_t)mp * (128 * 128) + wq * 32 + r32;
#pragma unroll
    for (int r = 0; r < 16; ++r) { const int dvr = crow(r, hi);
#pragma unroll
      for (int d0 = 0; d0 < 4; ++d0) pb[(size_t)(d0 * 32 + dvr) * 128] = o[d0][r]; }
    if (hi == 0) { float2* st = (float2*)pstat + mp * 128 + wq * 32 + r32; *st = make_float2(m_reg, l_reg); }
    __syncthreads();
    return;
  }
  const float rl = __builtin_amdgcn_rcpf(l_reg);
  __syncthreads();
  { float* OB = (float*)lds + mp * (128 * 128) + wq * 32 + r32;
#pragma unroll
    for (int r = 0; r < 16; ++r) { const int dvr = crow(r, hi);
#pragma unroll
      for (int d0 = 0; d0 < 4; ++d0) OB[(d0 * 32 + dvr) * 128] = o[d0][r] * rl; } }
  __syncthreads();
  { const int row = tid >> 2, qd = tid & 3;
    const float* A1 = (const float*)lds + (qd * 32) * 128 + row; const float* B1 = A1 + 128 * 128;
    f32x4 dv[8]; float ss = 0.f;
#pragma unroll
    for (int j = 0; j < 8; ++j) {
#pragma unroll
      for (int e = 0; e < 4; ++e) dv[j][e] = A1[(4 * j + e) * 128] - lam * B1[(4 * j + e) * 128];
      ss += (dv[j][0] * dv[j][0] + dv[j][1] * dv[j][1]) + (dv[j][2] * dv[j][2] + dv[j][3] * dv[j][3]); }
    ss += __shfl_xor(ss, 1); ss += __shfl_xor(ss, 2);
    const float rstd = __builtin_amdgcn_rsqf(ss * (1.0f / 128.0f) + 1e-5f) ;
    const f32x4* g4 = (const f32x4*)(subg + qd * 32);
    bf16* op = AO + (size_t)(qrow0 + row) * DM + h * 128 + qd * 32;
#pragma unroll
    for (int j = 0; j < 4; ++j) { const f32x4 g0 = g4[2 * j], g1 = g4[2 * j + 1]; const f32x4 a = dv[2 * j] * rstd, b = dv[2 * j + 1] * rstd;
      u32x4 w; w.x = cvtpk(a[0] * g0[0] * oml, a[1] * g0[1] * oml); w.y = cvtpk(a[2] * g0[2] * oml, a[3] * g0[3] * oml);
      w.z = cvtpk(b[0] * g1[0] * oml, b[1] * g1[1] * oml); w.w = cvtpk(b[2] * g1[2] * oml, b[3] * g1[3] * oml);
      *(u32x4*)(op + j * 8) = w; } }
  __syncthreads();
#undef SLOAD
#undef SWRITE
#undef XBAR
#undef RESC
}
template <int NS> __device__ __forceinline__ void attn_merge(const float* __restrict__ part, const float* __restrict__ pstat, size_t slice_stride, size_t stat_stride, int qrow0, int h, float lam, float oml, const float* __restrict__ subg, bf16* __restrict__ AO) {
  const int tid = opaque_tid(); const int row = tid >> 2, qd = tid & 3;
  f32x4 om[2][8];
#pragma unroll
  for (int mp = 0; mp < 2; ++mp) {
    float mi[NS], li[NS]; float M = -3.0e38f;
#pragma unroll
    for (int i = 0; i < NS; ++i) { const float2 st = *((const float2*)(pstat + i * stat_stride) + mp * 128 + row); mi[i] = st.x; li[i] = st.y; M = fmaxf(M, st.x); }
    float L = 0.f;
#pragma unroll
    for (int j = 0; j < 8; ++j) om[mp][j] = (f32x4){0.f, 0.f, 0.f, 0.f};
#pragma unroll
    for (int i = 0; i < NS; ++i) { const float w = __builtin_amdgcn_exp2f(mi[i] - M); L += w * li[i];
      const float* p1 = part + i * slice_stride + (size_t)mp * (128 * 128) + (size_t)(qd * 32) * 128 + row;
#pragma unroll
      for (int j = 0; j < 8; ++j)
#pragma unroll
        for (int e = 0; e < 4; ++e) om[mp][j][e] += w * p1[(size_t)(4 * j + e) * 128]; }
    const float rl = 1.0f / L;
#pragma unroll
    for (int j = 0; j < 8; ++j) om[mp][j] = om[mp][j] * rl;
  }
  f32x4 dv[8]; float ss = 0.f;
#pragma unroll
  for (int j = 0; j < 8; ++j) { dv[j] = om[0][j] - lam * om[1][j]; ss += (dv[j][0] * dv[j][0] + dv[j][1] * dv[j][1]) + (dv[j][2] * dv[j][2] + dv[j][3] * dv[j][3]); }
  ss += __shfl_xor(ss, 1); ss += __shfl_xor(ss, 2);
  const float rstd = __builtin_amdgcn_rsqf(ss * (1.0f / 128.0f) + 1e-5f);
  const f32x4* g4 = (const f32x4*)(subg + qd * 32);
  bf16* op = AO + (size_t)(qrow0 + row) * DM + h * 128 + qd * 32;
#pragma unroll
  for (int j = 0; j < 4; ++j) { const f32x4 g0 = g4[2 * j], g1 = g4[2 * j + 1]; const f32x4 a = dv[2 * j] * rstd, b = dv[2 * j + 1] * rstd;
    u32x4 w; w.x = cvtpk(a[0] * g0[0] * oml, a[1] * g0[1] * oml); w.y = cvtpk(a[2] * g0[2] * oml, a[3] * g0[3] * oml);
    w.z = cvtpk(b[0] * g1[0] * oml, b[1] * g1[1] * oml); w.w = cvtpk(b[2] * g1[2] * oml, b[3] * g1[3] * oml);
    *(u32x4*)(op + j * 8) = w; }
}
#undef SBAR
}
__device__ __forceinline__ int scan_chunk_of(int tile, int d) { return d == 0 ? tile : (tile < CL / 16 ? (CL / 16 - 1) - tile : (NCHUNK + CL / 16 - 1) - tile); }
__device__ __forceinline__ int scan_pos(int n, int d) { return d == 0 ? n : (n < CL ? (CL - 1) - n : (NPB + CL - 1) - n); }
typedef short sbf16x8 __attribute__((ext_vector_type(8)));
typedef float f32x2_t __attribute__((ext_vector_type(2))); typedef __bf16 bf16x2_t __attribute__((ext_vector_type(2)));
__device__ __forceinline__ unsigned cvtpk_bf(float lo, float hi) { f32x2_t v = {lo, hi}; bf16x2_t b = __builtin_convertvector(v, bf16x2_t); return __builtin_bit_cast(unsigned, b); }
__device__ __forceinline__ void scan_chunk(const LAS unsigned char* rb, f32x4 (&S)[4], float* yo, int c, int d, int wid, int lane, int v15, int q) {
    const LAS sbf16x8* T8 = (const LAS sbf16x8*)rb + lane;
    const sbf16x8 XT0 = T8[0], XT1 = T8[64], RT0 = T8[128], RT1 = T8[192], MT = T8[256], BK0 = T8[320], BK1 = T8[384], BK2 = T8[448], BK3 = T8[512];
    const v2u qt = *(const LAS v2u*)(rb + OR_QT + lane * 8);
    const v2u vq = *(const LAS v2u*)(rb + OR_VT + ((wid * 16 + v15) * 16 + 4 * q) * 2);
    const LAS f32x4* W4 = (const LAS f32x4*)(rb + OR_WC) + q;
    const f32x4 wc0 = W4[0], wc1 = W4[4], wc2 = W4[8], wc3 = W4[12];
    v4u t;
    t[0] = cvtpk_bf(S[0][0], S[0][1]); t[1] = cvtpk_bf(S[0][2], S[0][3]); t[2] = cvtpk_bf(S[1][0], S[1][1]); t[3] = cvtpk_bf(S[1][2], S[1][3]);
    const sbf16x8 bs0 = __builtin_bit_cast(sbf16x8, t);
    t[0] = cvtpk_bf(S[2][0], S[2][1]); t[1] = cvtpk_bf(S[2][2], S[2][3]); t[2] = cvtpk_bf(S[3][0], S[3][1]); t[3] = cvtpk_bf(S[3][2], S[3][3]);
    const sbf16x8 bs1 = __builtin_bit_cast(sbf16x8, t);
    t[0] = vq[0]; t[1] = vq[1]; t[2] = 0u; t[3] = 0u; const sbf16x8 vz = __builtin_bit_cast(sbf16x8, t);
    t[0] = qt[0]; t[1] = qt[1]; t[2] = 0u; t[3] = 0u; const sbf16x8 qz = __builtin_bit_cast(sbf16x8, t);
    f32x4 D = (f32x4){0.f, 0.f, 0.f, 0.f};
    D = __builtin_amdgcn_mfma_f32_16x16x32_bf16(XT0, bs0, D, 0, 0, 0);
    D = __builtin_amdgcn_mfma_f32_16x16x32_bf16(XT1, bs1, D, 0, 0, 0);
    D = __builtin_amdgcn_mfma_f32_16x16x32_bf16(qz, vz, D, 0, 0, 0);
    f32x4 Yv = (f32x4){0.f, 0.f, 0.f, 0.f};
    Yv = __builtin_amdgcn_mfma_f32_16x16x32_bf16(RT0, bs0, Yv, 0, 0, 0);
    Yv = __builtin_amdgcn_mfma_f32_16x16x32_bf16(RT1, bs1, Yv, 0, 0, 0);
    t[0] = cvtpk_bf(D[0], D[1]); t[1] = cvtpk_bf(D[2], D[3]); t[2] = vq[0]; t[3] = vq[1]; const sbf16x8 dv = __builtin_bit_cast(sbf16x8, t);
    Yv = __builtin_amdgcn_mfma_f32_16x16x32_bf16(MT, dv, Yv, 0, 0, 0);
    S[0] = __builtin_amdgcn_mfma_f32_16x16x32_bf16(BK0, dv, S[0] * wc0, 0, 0, 0);
    S[1] = __builtin_amdgcn_mfma_f32_16x16x32_bf16(BK1, dv, S[1] * wc1, 0, 0, 0);
    S[2] = __builtin_amdgcn_mfma_f32_16x16x32_bf16(BK2, dv, S[2] * wc2, 0, 0, 0);
    S[3] = __builtin_amdgcn_mfma_f32_16x16x32_bf16(BK3, dv, S[3] * wc3, 0, 0, 0);
#pragma unroll
    for (int i = 0; i < 4; ++i) yo[(size_t)scan_pos(c * 16 + 4 * q + i, d) * 512] = Yv[i];
}
__device__ __forceinline__ void scan_chain(int chain0, const unsigned char* __restrict__ OPS, float* __restrict__ Y, LAS unsigned char* lds) {
    const int tid = opaque_tid(), wid = __builtin_amdgcn_readfirstlane(tid >> 6), lane = tid & 63, v15 = lane & 15, q = lane >> 4;
    const int grp = wid >> 2, wq = wid & 3; const int chain = chain0 + grp;
    const int d = chain >> 4, b = (chain >> 3) & 1, h = chain & 7;
    const unsigned char* recA = OPS + (size_t)chain0 * NCHUNK * OPS_REC; const unsigned char* recB = recA + (size_t)NCHUNK * OPS_REC;
    constexpr int PF = 4;
    v4u ga[PF], gb[PF], gc[PF];
#define SCL_LOAD(slot, c) do { if ((c) < NCHUNK) { const v4u* ra_ = (const v4u*)(recA + (size_t)(c) * OPS_REC); const v4u* rb_ = (const v4u*)(recB + (size_t)(c) * OPS_REC); \
        ga[slot] = ra_[tid]; gb[slot] = rb_[tid]; gc[slot] = (tid < 256) ? ra_[512 + tid] : rb_[256 + tid]; } } while (0)
#define SCL_WRITE(slot, buf) do { LAS v4u* oa_ = (LAS v4u*)(lds + (buf) * 2 * OPS_REC); LAS v4u* ob_ = oa_ + OPS_REC / 16; \
        oa_[tid] = ga[slot]; ob_[tid] = gb[slot]; if (tid < 256) oa_[512 + tid] = gc[slot]; else ob_[256 + tid] = gc[slot]; } while (0)
    f32x4 S[4];
#pragma unroll
    for (int rt = 0; rt < 4; ++rt) S[rt] = (f32x4){0.f, 0.f, 0.f, 0.f};
    float* yo = Y + ((size_t)d * NR + (size_t)b * NPB) * 512 + h * 64 + wq * 16 + v15;
    SCL_LOAD(0, 0); SCL_LOAD(1, 1); SCL_LOAD(2, 2); SCL_LOAD(3, 3);
    SCL_WRITE(0, 0); __syncthreads();
#define SCL_TRIP(c, slot) do { \
        const int buf = (c) & 1; \
        SCL_LOAD(slot, (c) + PF); \
        scan_chunk(lds + (buf * 2 + grp) * OPS_REC, S, yo, (c), d, wq, lane, v15, q); \
        if ((c) + 1 < NCHUNK) SCL_WRITE(((slot) + 1) & 3, buf ^ 1); \
        __syncthreads(); } while (0)
    for (int c = 0; c < NCHUNK; c += 4) { SCL_TRIP(c, 0); SCL_TRIP(c + 1, 1); SCL_TRIP(c + 2, 2); SCL_TRIP(c + 3, 3); }
#undef SCL_TRIP
#undef SCL_LOAD
#undef SCL_WRITE
}

__device__ __forceinline__ void transpose_item(const float* __restrict__ W, int K, int N, bf16* __restrict__ WT, int out_row0, int k0, int n0, LAS float* scr, int lane) {
    float tv[32];
#pragma unroll
    for (int i = 0; i < 32; ++i) tv[i] = W[(size_t)(k0 + 2 * i + (lane >> 5)) * N + n0 + (lane & 31)];
#pragma unroll
    for (int i = 0; i < 32; ++i) scr[(2 * i + (lane >> 5)) * 33 + (lane & 31)] = tv[i];
    LDS_WAIT(); asm volatile("" ::: "memory");
    const int c = lane & 7;
#pragma unroll
    for (int j = 0; j < 4; ++j) { const int n = (lane >> 3) + 8 * j; const LAS float* s = scr + (8 * c) * 33 + n;
        v4u o; o.x = pk2(s[0 * 33], s[1 * 33]); o.y = pk2(s[2 * 33], s[3 * 33]); o.z = pk2(s[4 * 33], s[5 * 33]); o.w = pk2(s[6 * 33], s[7 * 33]);
        *(v4u*)(WT + (size_t)(out_row0 + n) * K + k0 + 8 * c) = o; }
    LDS_WAIT(); asm volatile("" ::: "memory");
}
__device__ __forceinline__ void transpose_matrix_item(const float* W, int K, int N, bf16* WT, int item, int il_half  , LAS float* scr, int lane) {
    const int nblk = N / 32, kb = item / nblk, nb = item - kb * nblk, n0 = 32 * nb;
    const int orow = (il_half < 0) ? n0 : ((n0 >> 7) * 256 + il_half * 128 + (n0 & 127));
    transpose_item(W, K, N, WT, orow, 64 * kb, n0, scr, lane);
}

struct Ptrs {
    const float* in[34]; float* out; unsigned char* ws;
};
#define IN_X 0
#define IN_C 1
#define IN_CTX 2
#define IN_CCTX 3
#define IN_ADAW 4
#define IN_ADAB 5
#define IN_N1G 6
#define IN_N2G 7
#define IN_WIN 8
#define IN_WOUT 9
#define IN_DLAM 10
#define IN_SUBG 11
#define IN_MU 12
#define IN_W0 13
#define IN_W2 14
#define IN_A0 15
#define IN_A2 16
#define IN_V0 17
#define IN_V1 18
#define IN_V2 19
#define IN_G2 20
#define IN_KK 21
#define IN_KA 22
#define IN_RK 23
#define IN_LNW 24
#define IN_LNB 25
#define IN_FW1 26
#define IN_FW3 27
#define IN_FW2 28
#define IN_ROUTER 29
#define IN_EW1 30
#define IN_EW3 31
#define IN_EW2 32
#define IN_FINALG 33

__device__ __forceinline__ void phase_prologue(const Args& a, LAS unsigned char* lds, int vcu, int G) {
    const int tid = opaque_tid(), lane = tid & 63, wave = __builtin_amdgcn_readfirstlane(tid >> 6);
    unsigned char* ws = opaque_ptr(a.ws);
    LAS float* scr = (LAS float*)(lds + wave * 8704);
    LAS float* sl = (LAS float*)(lds + 73728);
    for (int i = tid; i < 3072; i += NTHR) { const float v = (i < 2048) ? gptr(a.in[IN_C])[i] : gptr(a.in[IN_CCTX])[i - 2048]; sl[i] = v * sigmoid_f(v); }
    __syncthreads();
    const int gw = vcu * NWAVES + wave, NGW = G * NWAVES;
    constexpr int T_MOD = 4 * 96;
    constexpr int I_WIN = 16 * (NIN / 32), I_WOUT = 16 * 32, I_F13 = 16 * (DFF / 32), I_F2 = (DFF / 64) * 32;
    constexpr int T_WIN = 4 * I_WIN, T_WOUT = 4 * I_WOUT, T_F1 = 2 * I_F13, T_F3 = 2 * I_F13, T_F2 = 2 * I_F2;
    constexpr int T_PAD = 4 * 32, T_ROPE = 64, T_LAM = 4;
    constexpr int NT = T_MOD + T_WIN + T_WOUT + T_F1 + T_F3 + T_F2 + T_PAD + T_ROPE + T_LAM;
    float* MOD = (float*)(ws + WS_MOD);
    if (gw % 5 == 0 && gw / 5 < T_MOD) { const int r = gw / 5;
        {
            const int l = r / 96, jg = r - l * 96; const float* aw = gptr(a.in[IN_ADAW]) + (size_t)l * 1024 * 6144 + jg * 64 + lane;
            float a0 = 0.f, a1 = 0.f, a2 = 0.f;
            for (int i0 = 0; i0 < 1024; i0 += 32) { float wv[32];
#pragma unroll
                for (int i = 0; i < 32; ++i) wv[i] = aw[(size_t)(i0 + i) * 6144];
#pragma unroll
                for (int i = 0; i < 32; ++i) { a0 += sl[i0 + i] * wv[i]; a1 += sl[1024 + i0 + i] * wv[i]; a2 += sl[2048 + i0 + i] * wv[i]; } }
            const float bb = gptr(a.in[IN_ADAB])[l * 6144 + jg * 64 + lane];
            MOD[(l * 3 + 0) * 6144 + jg * 64 + lane] = a0 + bb; MOD[(l * 3 + 1) * 6144 + jg * 64 + lane] = a1 + bb; MOD[(l * 3 + 2) * 6144 + jg * 64 + lane] = a2 + bb;
        }
    }
    for (int it = T_MOD + gw; it < NT; it += NGW) {
        int r = it - T_MOD;
        if (r < T_WIN) { const int l = r / I_WIN; transpose_matrix_item(gptr(a.in[IN_WIN]) + (size_t)l * DM * NIN, DM, NIN, (bf16*)(ws + WS_WINT) + (size_t)l * NINP * DM, r - l * I_WIN, -1, scr, lane); continue; }
        r -= T_WIN;
        if (r < T_WOUT) { const int l = r / I_WOUT; transpose_matrix_item(gptr(a.in[IN_WOUT]) + (size_t)l * DM * DM, DM, DM, (bf16*)(ws + WS_WOUTT) + (size_t)l * DM * DM, r - l * I_WOUT, -1, scr, lane); continue; }
        r -= T_WOUT;
        if (r < T_F1) { const int l = r / I_F13; transpose_matrix_item(gptr(a.in[IN_FW1]) + (size_t)l * DM * DFF, DM, DFF, (bf16*)(ws + WS_W13T) + (size_t)l * 2 * DFF * DM, r - l * I_F13, 0, scr, lane); continue; }
        r -= T_F1;
        if (r < T_F3) { const int l = r / I_F13; transpose_matrix_item(gptr(a.in[IN_FW3]) + (size_t)l * DM * DFF, DM, DFF, (bf16*)(ws + WS_W13T) + (size_t)l * 2 * DFF * DM, r - l * I_F13, 1, scr, lane); continue; }
        r -= T_F3;
        if (r < T_F2) { const int l = r / I_F2; transpose_matrix_item(gptr(a.in[IN_FW2]) + (size_t)l * DFF * DM, DFF, DM, (bf16*)(ws + WS_W2T) + (size_t)l * DM * DFF, r - l * I_F2, -1, scr, lane); continue; }
        r -= T_F2;
        if (r < T_PAD) { const int l = r >> 5, row = NIN + (r & 31); v4u z = {0u, 0u, 0u, 0u}; v4u* o = (v4u*)((bf16*)(ws + WS_WINT) + ((size_t)l * NINP + row) * DM) + lane * 2; o[0] = z; o[1] = z; continue; }
        r -= T_PAD;
        if (r < T_ROPE) { const int e = r * 64 + lane, pos = e >> 4, j = e & 15;
            const float inv = __builtin_amdgcn_exp2f(-(float)(2 * j) * (13.287712379549449f / 32.0f)); const float ang = (float)pos * inv;
            float2* T = (float2*)(ws + WS_ROPE); T[e] = make_float2(cosf(ang), sinf(ang)); continue; }
        r -= T_ROPE;
        { const int l = r; const float* lp = gptr(a.in[IN_DLAM]) + l * 256;
          const float s0 = wave_sum(lp[lane] * lp[64 + lane]), s1 = wave_sum(lp[128 + lane] * lp[192 + lane]);
          const float li = 0.8f - 0.6f * expf(-0.3f * (float)l);
          if (lane == 0) { float* L = (float*)(ws + WS_LAM); L[l * 2] = expf(s0) - expf(s1) + li; L[l * 2 + 1] = 1.0f - li; } }
    }
    { bf16* LB = (bf16*)(ws + WS_LORA);
      for (int o = (vcu * NTHR + tid); o < LO_TOTAL; o += G * NTHR) {
          float v;
          if (o < LO_A2) { const int m = o >> 14, r = o & 16383, chn = r >> 5, j = r & 31; v = gptr(a.in[IN_W2])[((size_t)m * 32 + j) * 512 + chn]; }
          else if (o < LO_V2) { const int q = o - LO_A2; const int m = q >> 14, r = q & 16383, chn = r >> 5, j = r & 31; v = gptr(a.in[IN_A2])[((size_t)m * 32 + j) * 512 + chn]; }
          else if (o < LO_G2) { const int q = o - LO_V2; const int m = q >> 14, r = q & 16383, chn = r >> 5, j = r & 31; v = gptr(a.in[IN_V2])[((size_t)m * 32 + j) * 512 + chn]; }
          else if (o < LO_V1) { const int q = o - LO_G2; const int m = q / 49152, r = q - m * 49152, chn = r / 96, j = r - chn * 96; v = gptr(a.in[IN_G2])[((size_t)m * 96 + j) * 512 + chn]; }
          else { const int q = o - LO_V1; const int m = q >> 14, r = q & 16383, j = r >> 9, chn = r & 511; v = gptr(a.in[IN_V1])[((size_t)m * 512 + chn) * 32 + j]; }
          LB[o] = (bf16)f2bf(v); } }
}

__device__ __forceinline__ void phase_norm(const Args& a, LAS unsigned char* lds, int vcu, int G, int l, int which_norm, bool moe) {
    const int tid = opaque_tid(), lane = tid & 63, wave = __builtin_amdgcn_readfirstlane(tid >> 6);
    unsigned char* ws = opaque_ptr(a.ws);
    LAS float* tabA = (LAS float*)lds; LAS float* tabB = tabA + 3072; LAS float* rwT = tabB + 3072;
    const float* MOD = (const float*)(ws + WS_MOD) + (size_t)l * 3 * 6144;
    const float* ng = a.in[which_norm ? IN_N2G : IN_N1G] + l * 1024;
    const int off_sh = which_norm ? 3072 : 0, off_sc = off_sh + 1024;
    for (int i = tid; i < 3072; i += NTHR) { const int w = i >> 10, c = i & 1023; tabA[i] = ng[c] * (1.0f + MOD[w * 6144 + off_sc + c]); tabB[i] = MOD[w * 6144 + off_sh + c]; }
    if (moe) { const float* rw = gptr(a.in[IN_ROUTER]) + (size_t)(l >> 1) * 1024 * 8; for (int i = tid; i < 8192; i += NTHR) { const int c = i >> 3, e = i & 7; rwT[e * 1024 + c] = rw[i]; }
        if (tid < 16) ((LAS unsigned*)(lds + 57344 + 4096))[tid] = 0u; }
    __syncthreads();
    const bool f32lat = (l == 0 && which_norm == 0);
    const float* srcLat = gptr(a.in[IN_X]); const bf16* XB = (const bf16*)(__attribute__((address_space(1))) bf16*)a.out;
    const float* srcCtx = (l == 0 && which_norm == 0) ? gptr(a.in[IN_CTX]) : (const float*)(ws + WS_XC);
    bf16* HN = (bf16*)(ws + WS_HN);
    const int gw = vcu * NWAVES + wave, NGW = G * NWAVES;
    int trip = 0;
    for (int Rb = gw * 2; Rb < NR; Rb += NGW * 2, ++trip) {
        f32x4 v[2][4]; float ss[2]; int wsel[2], bsel[2];
#pragma unroll
        for (int u = 0; u < 2; ++u) { const int R = Rb + u; const int b = R / NPB, p = R - b * NPB; wsel[u] = (p < CL) ? 2 : b; bsel[u] = b;
            ss[u] = 0.f;
            if (p < CL || f32lat) { const float* xr = (p < CL) ? srcCtx + (size_t)(b * CL + p) * 1024 : srcLat + ((size_t)b * SEQ + (p - CL)) * 1024;
                const f32x4* x4 = (const f32x4*)xr + lane;
#pragma unroll
                for (int j = 0; j < 4; ++j) v[u][j] = x4[64 * j]; }
            else { const v2u* xq = (const v2u*)(XB + ((size_t)b * SEQ + (p - CL)) * 2048) + lane;
#pragma unroll
                for (int j = 0; j < 4; ++j) { const v2u w = xq[64 * j]; v[u][j] = (f32x4){bflo(w[0]), bfhi(w[0]), bflo(w[1]), bfhi(w[1])}; } }
#pragma unroll
            for (int j = 0; j < 4; ++j) ss[u] += (v[u][j][0] * v[u][j][0] + v[u][j][1] * v[u][j][1]) + (v[u][j][2] * v[u][j][2] + v[u][j][3] * v[u][j][3]); }
#pragma unroll
        for (int u = 0; u < 2; ++u) ss[u] = wave_sum(ss[u]);
#pragma unroll
        for (int u = 0; u < 2; ++u) { const int R = Rb + u; const int w = wsel[u];
            const float rstd = 1.0f / sqrtf(ss[u] * (1.0f / 1024.0f) + 1e-6f);
            const LAS f32x4* A4 = (const LAS f32x4*)(tabA + w * 1024) + lane; const LAS f32x4* B4 = (const LAS f32x4*)(tabB + w * 1024) + lane;
            unsigned long long* o8 = (unsigned long long*)(HN + (size_t)R * 1024) + lane;
#pragma unroll
            for (int j = 0; j < 4; ++j) { v[u][j] = (v[u][j] * rstd) * A4[64 * j] + B4[64 * j];
                o8[64 * j] = (unsigned long long)pk2(v[u][j][0], v[u][j][1]) | ((unsigned long long)pk2(v[u][j][2], v[u][j][3]) << 32); } }
        if (moe) {
            float lg[2][8];
#pragma unroll
            for (int u = 0; u < 2; ++u)
#pragma unroll
                for (int e = 0; e < 8; ++e) { const LAS f32x4* r4 = (const LAS f32x4*)(rwT + e * 1024) + lane; float s = 0.f;
#pragma unroll
                    for (int j = 0; j < 4; ++j) { const f32x4 rr = r4[64 * j]; s += (v[u][j][0] * rr[0] + v[u][j][1] * rr[1]) + (v[u][j][2] * rr[2] + v[u][j][3] * rr[3]); }
                    lg[u][e] = s; }
#pragma unroll
            for (int u = 0; u < 2; ++u)
#pragma unroll
                for (int e = 0; e < 8; ++e) lg[u][e] = wave_sum(lg[u][e]);
#pragma unroll
            for (int u = 0; u < 2; ++u) { const int R = Rb + u;
                int e1 = 0; float v1 = lg[u][0];
#pragma unroll
                for (int e = 1; e < 8; ++e) if (lg[u][e] > v1) { v1 = lg[u][e]; e1 = e; }
                int e2 = -1; float v2 = -3.0e38f;
#pragma unroll
                for (int e = 0; e < 8; ++e) if (e != e1 && lg[u][e] > v2) { v2 = lg[u][e]; e2 = e; }
                if (lane == 0) {
                    const float g1 = 1.0f / (1.0f + __expf(v2 - v1)), g2 = 1.0f - g1;
                    LAS unsigned* lc = (LAS unsigned*)(lds + 57344 + 4096);
                    const unsigned lp1 = __hip_atomic_fetch_add(lc + e1, 1u, __ATOMIC_RELAXED, __HIP_MEMORY_SCOPE_WORKGROUP), lp2 = __hip_atomic_fetch_add(lc + e2, 1u, __ATOMIC_RELAXED, __HIP_MEMORY_SCOPE_WORKGROUP);
                    LAS unsigned* rb = (LAS unsigned*)(lds + 57344) + wave * 128 + (trip * 2 + u) * 6;
                    rb[0] = (unsigned)e1; rb[1] = (unsigned)e2; rb[2] = lp1; rb[3] = lp2; rb[4] = __float_as_uint(g1); rb[5] = __float_as_uint(g2);
                } }
        }
    }
    if (moe) {
        __syncthreads();
        LAS unsigned* lc = (LAS unsigned*)(lds + 57344 + 4096);
        if (tid < 8) { unsigned* cnt = (unsigned*)(ws + WS_CTL) + CW_CNT + ((l >> 1) * 8) * 64; lc[8 + tid] = atomicAdd(cnt + 64 * tid, lc[tid]); }
        __syncthreads();
        const int nrow = trip * 2;
        if (lane < nrow) { const LAS unsigned* rb = (const LAS unsigned*)(lds + 57344) + wave * 128 + lane * 6;
            const unsigned e1 = rb[0], e2 = rb[1]; const unsigned p1 = lc[8 + e1] + rb[2], p2 = lc[8 + e2] + rb[3];
            const int R = (gw + (lane >> 1) * NGW) * 2 + (lane & 1);
            unsigned* ro = (unsigned*)(ws + WS_ROUTE) + (size_t)R * 8;
            *(v4u*)ro = (v4u){e1, e2, p1, p2}; *(v2u*)(ro + 4) = (v2u){rb[4], rb[5]}; }
        __syncthreads();
    }
    if (moe) {
        LAS float* scr = (LAS float*)(lds + 57344 + wave * 8704);
        const int li = l >> 1;
        constexpr int I_13 = 16 * (DFE / 32), I_2 = (DFE / 64) * 32;
        constexpr int NTK = 8 * (2 * I_13 + I_2);
        for (int it = gw; it < NTK; it += NGW) {
            const int e = it / (2 * I_13 + I_2); int r = it - e * (2 * I_13 + I_2);
            if (r < I_13) { transpose_matrix_item(gptr(a.in[IN_EW1]) + ((size_t)li * 8 + e) * DM * DFE, DM, DFE, (bf16*)(ws + WS_W13E) + (size_t)e * 2 * DFE * DM, r, 0, scr, lane); continue; }
            r -= I_13;
            if (r < I_13) { transpose_matrix_item(gptr(a.in[IN_EW3]) + ((size_t)li * 8 + e) * DM * DFE, DM, DFE, (bf16*)(ws + WS_W13E) + (size_t)e * 2 * DFE * DM, r, 1, scr, lane); continue; }
            r -= I_13;
            transpose_matrix_item(gptr(a.in[IN_EW2]) + ((size_t)li * 8 + e) * DFE * DM, DFE, DM, (bf16*)(ws + WS_W2E) + (size_t)e * DM * DFE, r, -1, scr, lane);
        }
    }
}
__device__ __forceinline__ unsigned hwpk2(float lo, float hi) { typedef float f2_t __attribute__((ext_vector_type(2))); typedef __bf16 b2_t __attribute__((ext_vector_type(2))); f2_t v = {lo, hi}; b2_t r = __builtin_convertvector(v, b2_t); return __builtin_bit_cast(unsigned, r); }
__device__ __forceinline__ unsigned hwbf(float f) { return hwpk2(f, 0.f) & 0xffffu; }
__device__ __forceinline__ void phase_prep(const Args& a, LAS unsigned char* lds, int G, int l, bool do_rope = true) {
    const int tid = opaque_tid(), lane = tid & 63, wave = __builtin_amdgcn_readfirstlane(tid >> 6), c16_ = lane & 15, q_ = lane >> 4;
    unsigned char* ws = opaque_ptr(a.ws);
    const bf16* P = (const bf16*)(ws + WS_PR); bf16* PA = (bf16*)(ws + WS_PA);
    _Float16* VV = (_Float16*)(ws + WS_VV); _Float16* VF = (_Float16*)(ws + WS_VFIRST); _Float16* GG = (_Float16*)(ws + WS_G);
    float* BON = (float*)(ws + WS_BONUS); const bf16* LB = (const bf16*)(ws + WS_LORA);
    LAS bf16* sP = (LAS bf16*)lds;
    LAS bf16* sWD = sP + 18 * 1536;
    LAS bf16* sAD = sWD + 16 * 64;
    LAS bf16* sGD = sAD + 16 * 64;
    LAS bf16* sVA = sGD + 16 * 96;
    LAS bf16* sVL = sVA + 16 * 512;
    LAS float* sPart = (LAS float*)(sVL + 16 * 32);
    const int h = wave;
    for (int tile = blockIdx.x; tile < NB * NCHUNK; tile += G) {
        int c16 = c16_, q = q_; asm volatile("" : "+v"(c16), "+v"(q));
        const int ch4 = h * 64 + 4 * c16;
        const int b = tile / NCHUNK, tt = tile - b * NCHUNK, p0 = tt * 16;
        const int seg_lo = (tt < 16) ? 0 : CL, seg_hi = (tt < 16) ? CL : NPB;
        const size_t R0 = (size_t)b * NPB + p0;
        for (int pc = tid; pc < 18 * 192; pc += NTHR) { const int rr = pc / 192, cc = pc - rr * 192; const int p = p0 - 1 + rr;
            v4u x = {0u, 0u, 0u, 0u}; if (p >= seg_lo && p < seg_hi) x = *(const v4u*)(P + ((size_t)b * NPB + p) * LDPR + cc * 8);
            *(LAS v4u*)(sP + rr * 1536 + cc * 8) = x; }
        for (int idx = tid; idx < 16 * 224; idx += NTHR) { const int i = idx / 224, cc = idx - i * 224; const float val = bf2f(P[(R0 + i) * LDPR + PC_LORA + cc]);
            if (cc < 64) sWD[i * 64 + cc] = (bf16)hwbf(tanh_f(val)); else if (cc < 128) sAD[i * 64 + cc - 64] = (bf16)hwbf(val); else sGD[i * 96 + cc - 128] = (bf16)hwbf(sigmoid_f(val)); }
        __syncthreads();
        f32x4 rs[4], ks[4], vs[4];
        { f32x4 rw[6], kw[6], vw[6]; const float* mu = gptr(a.in[IN_MU]) + (size_t)l * 3 * 2 * 512 + ch4;
          const f32x4 mur0 = *(const f32x4*)(mu), mur1 = *(const f32x4*)(mu + 512), muk0 = *(const f32x4*)(mu + 1024), muk1 = *(const f32x4*)(mu + 1536), muv0 = *(const f32x4*)(mu + 2048), muv1 = *(const f32x4*)(mu + 2560);
#pragma unroll
          for (int j = 0; j < 6; ++j) { const LAS bf16* rp = sP + (4 * q + j) * 1536 + ch4;
              const v2u xr = *(const LAS v2u*)(rp), xk = *(const LAS v2u*)(rp + 512), xv = *(const LAS v2u*)(rp + 1024);
              rw[j] = (f32x4){bflo(xr[0]), bfhi(xr[0]), bflo(xr[1]), bfhi(xr[1])}; kw[j] = (f32x4){bflo(xk[0]), bfhi(xk[0]), bflo(xk[1]), bfhi(xk[1])}; vw[j] = (f32x4){bflo(xv[0]), bfhi(xv[0]), bflo(xv[1]), bfhi(xv[1])}; }
#pragma unroll
          for (int i = 0; i < 4; ++i) { rs[i] = rw[i + 1] + mur0 * (rw[i] - rw[i + 1]) + mur1 * (rw[i + 2] - rw[i + 1]);
              ks[i] = kw[i + 1] + muk0 * (kw[i] - kw[i + 1]) + muk1 * (kw[i + 2] - kw[i + 1]);
              vs[i] = vw[i + 1] + muv0 * (vw[i] - vw[i + 1]) + muv1 * (vw[i + 2] - vw[i + 1]); } }
        f32x4 accV[4];
        if (l > 0) {
#pragma unroll
            for (int i = 0; i < 4; ++i) *(LAS v2u*)(sVA + (4 * q + i) * 512 + ch4) = (v2u){hwpk2(vs[i][0], vs[i][1]), hwpk2(vs[i][2], vs[i][3])};
            __syncthreads();
            { f32x4 pv0 = {0.f, 0.f, 0.f, 0.f}, pv1 = pv0; const bf16* v1b = LB + LO_V1 + (size_t)(l - 1) * 16384;
#pragma unroll
              for (int s2 = 0; s2 < 2; ++s2) { const sbf16x8 fa = *(const LAS sbf16x8*)(sVA + c16 * 512 + h * 64 + 32 * s2 + 8 * q);
                  const sbf16x8 fb0 = *(const sbf16x8*)(v1b + (size_t)c16 * 512 + h * 64 + 32 * s2 + 8 * q), fb1 = *(const sbf16x8*)(v1b + (size_t)(16 + c16) * 512 + h * 64 + 32 * s2 + 8 * q);
                  pv0 = __builtin_amdgcn_mfma_f32_16x16x32_bf16(fa, fb0, pv0, 0, 0, 0); pv1 = __builtin_amdgcn_mfma_f32_16x16x32_bf16(fa, fb1, pv1, 0, 0, 0); }
#pragma unroll
              for (int i = 0; i < 4; ++i) { sPart[(h * 16 + 4 * q + i) * 32 + c16] = pv0[i]; sPart[(h * 16 + 4 * q + i) * 32 + 16 + c16] = pv1[i]; } }
            __syncthreads();
            { float sacc = 0.f;
#pragma unroll
              for (int hh = 0; hh < 8; ++hh) sacc += sPart[hh * 512 + tid];
              sVL[tid] = (bf16)hwbf(sacc); }
            __syncthreads();
            { const sbf16x8 fa = *(const LAS sbf16x8*)(sVL + c16 * 32 + 8 * q); const bf16* v2b = LB + LO_V2 + ((size_t)(l - 1) * 512 + ch4) * 32 + 8 * q;
#pragma unroll
              for (int ct = 0; ct < 4; ++ct) { const sbf16x8 fb = *(const sbf16x8*)(v2b + ct * 32); accV[ct] = __builtin_amdgcn_mfma_f32_16x16x32_bf16(fa, fb, (f32x4){0.f, 0.f, 0.f, 0.f}, 0, 0, 0); } }
        }
        f32x4 vfin[4];
#pragma unroll
        for (int i = 0; i < 4; ++i) { const size_t R = R0 + 4 * q + i;
            if (l > 0) { const h4 vf = *(const h4*)(VF + R * 512 + ch4); const f32x4 v0p = *(const f32x4*)(gptr(a.in[IN_V0]) + (l - 1) * 512 + ch4);
#pragma unroll
                for (int cc = 0; cc < 4; ++cc) { const float vp = vs[i][cc]; vfin[i][cc] = vp + ((float)vf[cc] - vp) * sigmoid_f(v0p[cc] + accV[cc][i]); } }
            else { vfin[i] = vs[i]; *(h4*)(VF + R * 512 + ch4) = (h4){(_Float16)vs[i][0], (_Float16)vs[i][1], (_Float16)vs[i][2], (_Float16)vs[i][3]}; } }
        { f32x4 accG[4];
#pragma unroll
          for (int ct = 0; ct < 4; ++ct) accG[ct] = (f32x4){0.f, 0.f, 0.f, 0.f};
#pragma unroll
          for (int s3 = 0; s3 < 3; ++s3) { const sbf16x8 fa = *(const LAS sbf16x8*)(sGD + c16 * 96 + 32 * s3 + 8 * q); const bf16* g2b = LB + LO_G2 + ((size_t)l * 512 + ch4) * 96 + 32 * s3 + 8 * q;
#pragma unroll
              for (int ct = 0; ct < 4; ++ct) { const sbf16x8 fb = *(const sbf16x8*)(g2b + ct * 96); accG[ct] = __builtin_amdgcn_mfma_f32_16x16x32_bf16(fa, fb, accG[ct], 0, 0, 0); } }
#pragma unroll
          for (int i = 0; i < 4; ++i) *(h4*)(GG + (R0 + 4 * q + i) * 512 + ch4) = (h4){(_Float16)accG[0][i], (_Float16)accG[1][i], (_Float16)accG[2][i], (_Float16)accG[3][i]}; }
        f32x4 kkv[4]; const f32x4 kkp = *(const f32x4*)(gptr(a.in[IN_KK]) + l * 512 + ch4);
#pragma unroll
        for (int i = 0; i < 4; ++i) { const f32x4 t = ks[i] * kkp; float ss = (t[0] * t[0] + t[1] * t[1]) + (t[2] * t[2] + t[3] * t[3]); ss = dpp_rowsum16(ss);
            kkv[i] = t * __builtin_amdgcn_rsqf(fmaxf(ss, 1e-24f)); }
        float bon[4] = {0.f, 0.f, 0.f, 0.f};
        {
#pragma unroll
            for (int i = 0; i < 4; ++i) *(h4*)(VV + (R0 + 4 * q + i) * 512 + ch4) = (h4){(_Float16)vfin[i][0], (_Float16)vfin[i][1], (_Float16)vfin[i][2], (_Float16)vfin[i][3]};
        }
#pragma unroll 1
        for (int d = 0; d < 2; ++d) {
            f32x4 accW[4], accA[4]; const f32x4 w0d = *(const f32x4*)(gptr(a.in[IN_W0]) + (l * 2 + d) * 512 + ch4), a0d = *(const f32x4*)(gptr(a.in[IN_A0]) + (l * 2 + d) * 512 + ch4);
            const f32x4 kap = *(const f32x4*)(gptr(a.in[IN_KA]) + l * 512 + ch4), rkp = *(const f32x4*)(gptr(a.in[IN_RK]) + l * 512 + ch4);
            { const sbf16x8 fw = *(const LAS sbf16x8*)(sWD + c16 * 64 + 32 * d + 8 * q), fad = *(const LAS sbf16x8*)(sAD + c16 * 64 + 32 * d + 8 * q);
              const bf16* w2b = LB + LO_W2 + (((size_t)l * 2 + d) * 512 + ch4) * 32 + 8 * q; const bf16* a2b = LB + LO_A2 + (((size_t)l * 2 + d) * 512 + ch4) * 32 + 8 * q;
#pragma unroll
              for (int ct = 0; ct < 4; ++ct) { accW[ct] = __builtin_amdgcn_mfma_f32_16x16x32_bf16(fw, *(const sbf16x8*)(w2b + ct * 32), (f32x4){0.f, 0.f, 0.f, 0.f}, 0, 0, 0);
                  accA[ct] = __builtin_amdgcn_mfma_f32_16x16x32_bf16(fad, *(const sbf16x8*)(a2b + ct * 32), (f32x4){0.f, 0.f, 0.f, 0.f}, 0, 0, 0); } }
            f32x4 ee[4], bbv[4], kdv[4];
#pragma unroll
            for (int i = 0; i < 4; ++i)
#pragma unroll
                for (int cc = 0; cc < 4; ++cc) { const float e = 0.6065306597126334f * sigmoid_f(w0d[cc] + accW[cc][i]);
                    const float av = sigmoid_f(a0d[cc] + accA[cc][i]); const float kd = ks[i][cc] * (1.0f + (av - 1.0f) * kap[cc]);
                    ee[i][cc] = e; bbv[i][cc] = kkv[i][cc] * av; kdv[i][cc] = kd; bon[i] += rs[i][cc] * kd * rkp[cc]; }
            f32x4 qt_ = ee[0] + ee[1] + ee[2] + ee[3], base = {0.f, 0.f, 0.f, 0.f}, tot = {0.f, 0.f, 0.f, 0.f};
#pragma unroll
            for (int q2 = 0; q2 < 4; ++q2) { f32x4 o_;
#pragma unroll
                for (int cc = 0; cc < 4; ++cc) o_[cc] = __shfl(qt_[cc], c16 + 16 * q2);
                tot += o_; if (d == 0 ? (q2 < q) : (q2 > q)) base += o_; }
            f32x4 Lc[4];
            if (d == 0) { f32x4 run = base;
#pragma unroll
                for (int i = 0; i < 4; ++i) { run += ee[i]; Lc[i] = -run; } }
            else { f32x4 run = base;
#pragma unroll
                for (int i = 3; i >= 0; --i) { run += ee[i]; Lc[i] = -run; } }
            const int chain = (d * 2 + b) * 8 + h; const size_t ri = (size_t)chain * NCHUNK + scan_chunk_of(tt, d);
            bf16* pre = (bf16*)(ws + WS_PRE + ri * PRE_REC);
            if (q == 0) { f32x4 wc;
#pragma unroll
                for (int cc = 0; cc < 4; ++cc) wc[cc] = __expf(-tot[cc]);
                *(f32x4*)(ws + WS_WCB + ri * 256 + 16 * c16) = wc; }
#pragma unroll
            for (int i = 0; i < 4; ++i) { const int n = d ? 15 - (4 * q + i) : 4 * q + i; f32x4 at, bh, kh, rt;
#pragma unroll
                for (int cc = 0; cc < 4; ++cc) { const float Lci = Lc[i][cc]; const float Lp = Lci + ee[i][cc]; const float en = __expf(-Lci);
                    at[cc] = -kkv[i][cc] * __expf(Lp); bh[cc] = bbv[i][cc] * en; kh[cc] = kdv[i][cc] * en; rt[cc] = rs[i][cc] * __expf(Lci); }
                bf16* pp = pre + n * 64 + 4 * c16;
                *(v2u*)(pp) = (v2u){hwpk2(at[0], at[1]), hwpk2(at[2], at[3])}; *(v2u*)(pp + 1024) = (v2u){hwpk2(bh[0], bh[1]), hwpk2(bh[2], bh[3])};
                *(v2u*)(pp + 2048) = (v2u){hwpk2(kh[0], kh[1]), hwpk2(kh[2], kh[3])}; *(v2u*)(pp + 3072) = (v2u){hwpk2(rt[0], rt[1]), hwpk2(rt[2], rt[3])}; }
        }
#pragma unroll
        for (int i = 0; i < 4; ++i) { const float bs = dpp_rowsum16(bon[i]); if (c16 == 0) BON[(R0 + 4 * q + i) * 8 + h] = bs; }
        __syncthreads();
    }
    if (do_rope) { const float2* RT = (const float2*)(ws + WS_ROPE);
      const int nx = (NB * NCHUNK) % G; const bool skip = (nx > 0 && nx * 4 < G && (int)blockIdx.x < nx);
      const int gw = ((int)blockIdx.x - ((nx > 0 && nx * 4 < G) ? nx : 0)) * NWAVES + wave, NGW = (G - ((nx > 0 && nx * 4 < G) ? nx : 0)) * NWAVES; const int g = lane & 31, sub = lane >> 5;
      for (int rp = skip ? NR : gw; rp < NR / 2; rp += NGW) {
          const int R = rp * 2 + sub; const int b = R / NPB, p = R - b * NPB;
          v4u* pp = (v4u*)(PA + (size_t)R * LDPA + g * 32);
          v4u x[4];
#pragma unroll
          for (int j = 0; j < 4; ++j) x[j] = pp[j];
          if (p < CL && g >= 16) continue;
          float e[32];
#pragma unroll
          for (int j = 0; j < 4; ++j)
#pragma unroll
              for (int k = 0; k < 4; ++k) { e[j * 8 + 2 * k] = bflo(x[j][k]); e[j * 8 + 2 * k + 1] = bfhi(x[j][k]); }
          if (p >= CL) { const int t = p - CL; const int pos = (g & 1) ? (t & 63) : (t >> 6);
#pragma unroll
              for (int j = 0; j < 16; ++j) { const float2 cs = RT[pos * 16 + j]; const float x1 = e[j], x2 = e[16 + j]; e[j] = x1 * cs.x - x2 * cs.y; e[16 + j] = x1 * cs.y + x2 * cs.x; } }
          const float sc = (g < 16) ? QSCALE : 1.0f;
#pragma unroll
          for (int j = 0; j < 4; ++j) { v4u o;
#pragma unroll
              for (int k = 0; k < 4; ++k) o[k] = pk2(e[j * 8 + 2 * k] * sc, e[j * 8 + 2 * k + 1] * sc);
              pp[j] = o; }
      } }
}

__device__ __forceinline__ void phase_prep2(const Args& a, LAS unsigned char* lds, int vcu, int G) {
    const int tid = opaque_tid(), lane = tid & 63, wave = __builtin_amdgcn_readfirstlane(tid >> 6), t15 = lane & 15, q = lane >> 4;
    unsigned char* ws = opaque_ptr(a.ws);
    LAS unsigned char* wl = lds + wave * 16384;
    LAS bf16* sAt = (LAS bf16*)wl; LAS bf16* sBh = sAt + 1024; LAS bf16* sKh = sBh + 1024; LAS bf16* sRt = sKh + 1024; LAS bf16* sXT = sRt + 1024;
    LAS bf16* sBbT = sXT + 1024; LAS bf16* sKbT = sBbT + 1024;
    LAS float* sM = (LAS float*)(sKbT + 1024); LAS float* sQ = sM + 256;
    const int gw = vcu * NWAVES + wave, NGW = G * NWAVES;
    for (int task = gw; task < 32 * NCHUNK; task += NGW) {
        unsigned char* rec = ws + WS_OPS + (size_t)task * OPS_REC;
        unsigned vtp[8]; float wc_cur;
        { const v4u* pr = (const v4u*)(ws + WS_PRE + (size_t)task * PRE_REC) + lane; LAS v4u* dst = (LAS v4u*)sAt + lane;
          v4u t8[8];
#pragma unroll
          for (int j = 0; j < 8; ++j) t8[j] = pr[64 * j];
          const int chain = task / NCHUNK, c = task - chain * NCHUNK; const int d = chain >> 4, b = (chain >> 3) & 1, h = chain & 7;
          const _Float16* vvp = (const _Float16*)(ws + WS_VV) + (size_t)b * NPB * 512 + h * 64 + lane; _Float16 vh[16];
#pragma unroll
          for (int t = 0; t < 16; ++t) vh[t] = vvp[(size_t)scan_pos(c * 16 + t, d) * 512];
          wc_cur = ((const float*)(ws + WS_WCB + (size_t)task * 256))[lane];
#pragma unroll
          for (int j = 0; j < 8; ++j) dst[64 * j] = t8[j];
#pragma unroll
          for (int t = 0; t < 16; t += 2) vtp[t >> 1] = hwpk2((float)vh[t], (float)vh[t + 1]); }
        float xa[16];
        LDS_WAIT(); asm volatile("" ::: "memory");
        { v4u* vo = (v4u*)(rec + OR_VT) + lane * 2; vo[0] = (v4u){vtp[0], vtp[1], vtp[2], vtp[3]}; vo[1] = (v4u){vtp[4], vtp[5], vtp[6], vtp[7]}; }
        { const float wc = wc_cur; ((float*)(rec + OR_WC))[lane] = wc; float bhv[16], khv[16];
#pragma unroll
          for (int t = 0; t < 16; ++t) { xa[t] = bf2f(sAt[t * 64 + lane]); bhv[t] = bf2f(sBh[t * 64 + lane]) * wc; khv[t] = bf2f(sKh[t * 64 + lane]) * wc; }
          v4u o0, o1;
#pragma unroll
          for (int j = 0; j < 4; ++j) { o0[j] = hwpk2(bhv[2 * j], bhv[2 * j + 1]); o1[j] = hwpk2(bhv[8 + 2 * j], bhv[9 + 2 * j]); }
          ((LAS v4u*)(sBbT + lane * 16))[0] = o0; ((LAS v4u*)(sBbT + lane * 16))[1] = o1;
#pragma unroll
          for (int j = 0; j < 4; ++j) { o0[j] = hwpk2(khv[2 * j], khv[2 * j + 1]); o1[j] = hwpk2(khv[8 + 2 * j], khv[9 + 2 * j]); }
          ((LAS v4u*)(sKbT + lane * 16))[0] = o0; ((LAS v4u*)(sKbT + lane * 16))[1] = o1; }
        LDS_WAIT(); asm volatile("" ::: "memory");
        f32x4 mab = {0.f, 0.f, 0.f, 0.f}, mak = mab, mbr = mab, mkr = mab;
#pragma unroll
        for (int s2 = 0; s2 < 2; ++s2) {
            const sbf16x8 fa = *(const LAS sbf16x8*)(sAt + t15 * 64 + 32 * s2 + 8 * q), fb = *(const LAS sbf16x8*)(sBh + t15 * 64 + 32 * s2 + 8 * q);
            const sbf16x8 fk = *(const LAS sbf16x8*)(sKh + t15 * 64 + 32 * s2 + 8 * q), fr = *(const LAS sbf16x8*)(sRt + t15 * 64 + 32 * s2 + 8 * q);
            mab = __builtin_amdgcn_mfma_f32_16x16x32_bf16(fb, fa, mab, 0, 0, 0); mak = __builtin_amdgcn_mfma_f32_16x16x32_bf16(fk, fa, mak, 0, 0, 0);
            mbr = __builtin_amdgcn_mfma_f32_16x16x32_bf16(fb, fr, mbr, 0, 0, 0); mkr = __builtin_amdgcn_mfma_f32_16x16x32_bf16(fk, fr, mkr, 0, 0, 0);
        }
#pragma unroll
        for (int i = 0; i < 4; ++i) { const int j = 4 * q + i; if (j >= t15) { mab[i] = 0.f; mak[i] = 0.f; } if (j > t15) { mbr[i] = 0.f; mkr[i] = 0.f; } }
        *(LAS f32x4*)(sM + t15 * 16 + 4 * q) = mab;
        *(LAS f32x4*)(sQ + t15 * 16 + 4 * q) = mak;
        { v4u mt; mt[0] = hwpk2(mbr[0], mbr[1]); mt[1] = hwpk2(mbr[2], mbr[3]); mt[2] = hwpk2(mkr[0], mkr[1]); mt[3] = hwpk2(mkr[2], mkr[3]); ((v4u*)rec)[4 * 64 + lane] = mt; }
        LDS_WAIT(); asm volatile("" ::: "memory");
        float qv[16];
#pragma unroll
        for (int t = 0; t < 16; ++t) qv[t] = sQ[t * 16 + t15];
#pragma unroll
        for (int t = 1; t < 16; ++t) {
            float m[16];
#pragma unroll
            for (int j4 = 0; j4 < (t + 3) / 4; ++j4) { const f32x4 mm = *(const LAS f32x4*)(sM + t * 16 + 4 * j4); m[4 * j4] = mm[0]; m[4 * j4 + 1] = mm[1]; m[4 * j4 + 2] = mm[2]; m[4 * j4 + 3] = mm[3]; }
#pragma unroll
            for (int j = 0; j < t; ++j) { xa[t] += m[j] * xa[j]; qv[t] += m[j] * qv[j]; }
        }
        asm volatile("" ::: "memory");
#pragma unroll
        for (int t = 0; t < 16; ++t) { sXT[t * 64 + lane] = (bf16)hwbf(xa[t]); if (q == 0) sQ[t * 16 + t15] = qv[t]; }
        LDS_WAIT(); asm volatile("" ::: "memory");
        { v4u* R4 = (v4u*)rec;
#pragma unroll
          for (int s2 = 0; s2 < 2; ++s2) {
              const v2u x0 = *(const LAS v2u*)(sXT + t15 * 64 + 32 * s2 + 4 * q), x1 = *(const LAS v2u*)(sXT + t15 * 64 + 32 * s2 + 16 + 4 * q);
              R4[s2 * 64 + lane] = (v4u){x0[0], x0[1], x1[0], x1[1]};
              const v2u r0 = *(const LAS v2u*)(sRt + t15 * 64 + 32 * s2 + 4 * q), r1 = *(const LAS v2u*)(sRt + t15 * 64 + 32 * s2 + 16 + 4 * q);
              R4[(2 + s2) * 64 + lane] = (v4u){r0[0], r0[1], r1[0], r1[1]}; }
#pragma unroll
          for (int rt = 0; rt < 4; ++rt) {
              const v2u b0 = *(const LAS v2u*)(sBbT + (16 * rt + t15) * 16 + 4 * q), k0 = *(const LAS v2u*)(sKbT + (16 * rt + t15) * 16 + 4 * q);
              R4[(5 + rt) * 64 + lane] = (v4u){b0[0], b0[1], k0[0], k0[1]}; }
          const f32x4 qq = *(const LAS f32x4*)(sQ + t15 * 16 + 4 * q);
          ((v2u*)(rec + OR_QT))[lane] = (v2u){hwpk2(qq[0], qq[1]), hwpk2(qq[2], qq[3])}; }
        LDS_WAIT(); asm volatile("" ::: "memory");
    }
}

__device__ __forceinline__ void phase_mix(const Args& a, LAS unsigned char* lds, volatile LAS unsigned* MISC, int l, int ql, unsigned xcc, bool do_scan = true, bool do_attn = true) {
    const int tid = opaque_tid();
    unsigned char* ws = opaque_ptr(a.ws);
    unsigned* ctl = (unsigned*)(ws + WS_CTL);
    const bf16* P = (const bf16*)(ws + WS_PA);
    if (do_scan) { int xq = (int)(xcc & 7u), tried = 0;
      while (tried < 8) {
          if (tid == 0) MISC[16] = atomicAdd(ctl + CW_QS + (ql * 8 + xq) * 64, 1u);
          __syncthreads(); const unsigned idx = MISC[16]; __syncthreads();
          if (idx >= 2u) { xq = (xq + 1) & 7; ++tried; continue; }
#ifndef NO_SCAN
          scan_chain(xq * 4 + 2 * (int)idx, (const unsigned char*)(ws + WS_OPS), (float*)(ws + WS_Y), lds);
#endif
      } }
    if (do_attn) { const float* L = (const float*)(ws + WS_LAM); const float lam = L[l * 2], oml = L[l * 2 + 1];
      const float* subg = gptr(a.in[IN_SUBG]) + l * 128; bf16* AO = (bf16*)(ws + WS_HN);
      int xq = (int)(xcc & 7u), tried = 0;
      while (tried < 8) {
          if (tid == 0) MISC[16] = atomicAdd(ctl + CW_QA + (ql * 8 + xq) * 64, 1u);
          __syncthreads(); const unsigned idx = MISC[16]; __syncthreads();
          constexpr unsigned NWHOLE = 128 - ATT_SPLIT, NSL = ATT_SPLIT * ATT_SLICES;
          if (idx >= NWHOLE + NSL + 2u) { xq = (xq + 1) & 7; ++tried; continue; }
          const int b = xq >> 2, h = xq & 3;
#ifndef NO_ATTN
          if (idx < NWHOLE) att::attn_unit(P, b * NPB + CL + (int)idx * 128, b * NPB, NPB / 64, h, lam, oml, subg, AO, (char*)lds);
          else if (idx < NWHOLE + NSL) { const int su = (int)(idx - NWHOLE), k = su >> 2, sl = su & 3;
              const int t0 = (sl == 0) ? 0 : (sl == 1) ? 64 : (sl == 2) ? 128 : 194, nt = (sl < 2) ? 64 : 66;
              float* part = (float*)(ws + WS_APART) + ((size_t)(xq * ATT_SPLIT + k) * ATT_SLICES + sl) * (2 * 128 * 128);
              float* pst = (float*)(ws + WS_ASTAT) + ((size_t)(xq * ATT_SPLIT + k) * ATT_SLICES + sl) * (2 * 128 * 2);
              att::attn_unit(P, b * NPB + CL + ((int)NWHOLE + k) * 128, b * NPB + t0 * 64, nt, h, lam, oml, subg, AO, (char*)lds, part, pst); }
          else att::attn_unit(P, b * NPB + ((int)(idx - NWHOLE - NSL)) * 128, b * NPB, CL / 64, h, lam, oml, subg, AO, (char*)lds);
#endif
      } }
}

__device__ __forceinline__ void phase_finish(const Args& a, int G, int l) {
    const int tid = opaque_tid(), lane = tid & 63, wave = __builtin_amdgcn_readfirstlane(tid >> 6);
    unsigned char* ws = opaque_ptr(a.ws);
    const float* Y = (const float*)(ws + WS_Y); const _Float16* VV = (const _Float16*)(ws + WS_VV); const _Float16* GG = (const _Float16*)(ws + WS_G); const float* BON = (const float*)(ws + WS_BONUS);
    bf16* AO = (bf16*)(ws + WS_HN);
    const int ch = tid, h = wave, c = lane;
    const float lw = gptr(a.in[IN_LNW])[l * 512 + ch], lb = gptr(a.in[IN_LNB])[l * 512 + ch];
    {
        const float* L = (const float*)(ws + WS_LAM); const float lam = L[l * 2], oml = L[l * 2 + 1];
        for (int mt = blockIdx.x; mt < 8 * ATT_SPLIT; mt += G) { const int xq = mt / ATT_SPLIT, k = mt - xq * ATT_SPLIT; const int b = xq >> 2, h4 = xq & 3;
            att::attn_merge<ATT_SLICES>((const float*)(ws + WS_APART) + (size_t)mt * ATT_SLICES * (2 * 128 * 128), (const float*)(ws + WS_ASTAT) + (size_t)mt * ATT_SLICES * (2 * 128 * 2), (size_t)2 * 128 * 128, (size_t)2 * 128 * 2,
                                        b * NPB + CL + (128 - ATT_SPLIT + k) * 128, h4, lam, oml, gptr(a.in[IN_SUBG]) + l * 128, AO); }
    }
    { const int rsub = tid >> 7, c4 = (tid & 127) * 4, hh = (tid & 127) >> 4;
      const f32x4 lw4 = *(const f32x4*)(gptr(a.in[IN_LNW]) + l * 512 + c4), lb4 = *(const f32x4*)(gptr(a.in[IN_LNB]) + l * 512 + c4);
      for (int R0 = blockIdx.x * 4; R0 < NR; R0 += G * 4) {
        const int R = R0 + rsub;
        const f32x4 ya = *(const f32x4*)(Y + (size_t)R * 512 + c4), yb = *(const f32x4*)(Y + ((size_t)NR + R) * 512 + c4);
        const h4 vv = *(const h4*)(VV + (size_t)R * 512 + c4), gg = *(const h4*)(GG + (size_t)R * 512 + c4); const float bo = BON[(size_t)R * 8 + hh];
        f32x4 y = ya + yb;
        const float mean = dpp_rowsum16((y[0] + y[1]) + (y[2] + y[3])) * (1.0f / 64.0f);
        y = y - mean;
        const float var = dpp_rowsum16((y[0] * y[0] + y[1] * y[1]) + (y[2] * y[2] + y[3] * y[3])) * (1.0f / 64.0f);
        const float rs = __builtin_amdgcn_rsqf(var + 64e-5f);
        float o[4];
#pragma unroll
        for (int e = 0; e < 4; ++e) { float t = y[e] * rs * lw4[e] + lb4[e]; t += bo * (float)vv[e]; t *= (float)gg[e]; o[e] = t; }
        *(v2u*)(AO + (size_t)R * 1024 + 512 + c4) = (v2u){pk2(o[0], o[1]), pk2(o[2], o[3])};
      } }
}

__device__ __forceinline__ void ctx_gemm_resid(const bf16* __restrict__ A, const bf16* __restrict__ Bt, int K, const float* __restrict__ gate, const float* __restrict__ src, float* __restrict__ dst, int vcu, int G) {
    const int tid = opaque_tid(), lane = tid & 63, wave = __builtin_amdgcn_readfirstlane(tid >> 6), n16 = lane & 15, q = lane >> 4;
    for (int t = vcu * NWAVES + wave; t < 32 * 64; t += G * NWAVES) {
        const int rt = t >> 6, ct = t & 63; const int cr = rt * 16 + n16; const int b = cr >> 8, sidx = cr & 255;
        const bf16* ap = A + ((size_t)b * NPB + sidx) * K + 8 * q; const bf16* bp = Bt + (size_t)(ct * 16 + n16) * K + 8 * q;
        f32x4 acc = {0.f, 0.f, 0.f, 0.f};
#pragma unroll 8
        for (int s2 = 0; s2 < K / 32; ++s2) { const sbf16x8 fa = *(const sbf16x8*)(ap + 32 * s2), fb = *(const sbf16x8*)(bp + 32 * s2); acc = __builtin_amdgcn_mfma_f32_16x16x32_bf16(fb, fa, acc, 0, 0, 0); }
        const int col = ct * 16 + 4 * q; const f32x4 g = *(const f32x4*)(gate + col);
        const f32x4 x = *(const f32x4*)(src + (size_t)cr * 1024 + col);
        *(f32x4*)(dst + (size_t)cr * 1024 + col) = x + g * acc;
    }
}

__device__ __forceinline__ void phase_gather(const Args& a, int vcu, int G, int l) {
    const int tid = opaque_tid(), lane = tid & 63, wave = __builtin_amdgcn_readfirstlane(tid >> 6);
    unsigned char* ws = opaque_ptr(a.ws);
    const unsigned* cnt = (const unsigned*)(ws + WS_CTL) + CW_CNT + ((l >> 1) * 8) * 64;
    int off[8]; { int r = 0;
#pragma unroll
        for (int e = 0; e < 8; ++e) { off[e] = r; const int n = (int)__hip_atomic_load(cnt + 64 * e, __ATOMIC_RELAXED, __HIP_MEMORY_SCOPE_AGENT); r += ((n + 255) >> 8) << 8; } }
    const bf16* HN = (const bf16*)(ws + WS_HN); bf16* AG = (bf16*)(ws + WS_AG);
    const int gw = vcu * NWAVES + wave, NGW = G * NWAVES;
    for (int R = gw; R < NR; R += NGW) {
        unsigned* ro = (unsigned*)(ws + WS_ROUTE) + (size_t)R * 8;
        const int e1 = (int)ro[0], e2 = (int)ro[1]; const int p1 = (int)ro[2], p2 = (int)ro[3];
        int o1 = 0, o2 = 0;
#pragma unroll
        for (int e = 0; e < 8; ++e) { if (e == e1) o1 = off[e]; if (e == e2) o2 = off[e]; }
        const int s1 = o1 + p1, s2 = o2 + p2;
        const v4u* src = (const v4u*)(HN + (size_t)R * 1024) + lane * 2; const v4u x0 = src[0], x1 = src[1];
        v4u* d1 = (v4u*)(AG + (size_t)s1 * 1024) + lane * 2; v4u* d2 = (v4u*)(AG + (size_t)s2 * 1024) + lane * 2;
        d1[0] = x0; d1[1] = x1; d2[0] = x0; d2[1] = x1;
        if (lane == 0) { ro[6] = (unsigned)s1; ro[7] = (unsigned)s2; }
    }
}
__device__ __forceinline__ void phase_combine(const Args& a, LAS unsigned char* lds, int vcu, int G, int l) {
    const int tid = opaque_tid(), lane = tid & 63, wave = __builtin_amdgcn_readfirstlane(tid >> 6);
    unsigned char* ws = opaque_ptr(a.ws);
    const bf16* YE = (const bf16*)(ws + WS_YEXP);
    const float* MOD = (const float*)(ws + WS_MOD) + (size_t)l * 3 * 6144 + 5120;
    const bool last = (l == DEPTH - 1);
    LAS float* tabA = (LAS float*)lds; LAS float* tabB = tabA + 3072;
    if (!last) { const float* MODn = (const float*)(ws + WS_MOD) + (size_t)(l + 1) * 3 * 6144; const float* ng = gptr(a.in[IN_N1G]) + (l + 1) * 1024;
        for (int i = tid; i < 3072; i += NTHR) { const int w = i >> 10, c = i & 1023; tabA[i] = ng[c] * (1.0f + MODn[w * 6144 + 1024 + c]); tabB[i] = MODn[w * 6144 + c]; } }
    else { const float* fg = gptr(a.in[IN_FINALG]); for (int i = tid; i < 1024; i += NTHR) tabA[i] = fg[i]; }
    __syncthreads();
    bf16* HN = (bf16*)(ws + WS_HN);
    const int gw = vcu * NWAVES + wave, NGW = G * NWAVES;
    for (int R = gw; R < NR; R += NGW) {
        const int b = R / NPB, p = R - b * NPB; const int w = (p < CL) ? 2 : b;
        if (last && p < CL) continue;
        const unsigned* ro = (const unsigned*)(ws + WS_ROUTE) + (size_t)R * 8;
        const float g1 = __uint_as_float(ro[4]), g2 = __uint_as_float(ro[5]); const int s1 = (int)ro[6], s2 = (int)ro[7];
        const bool isctx = p < CL; const size_t rl = (size_t)b * SEQ + (isctx ? 0 : (p - CL));
        float* xr = isctx ? (float*)(ws + WS_XC) + (size_t)(b * CL + p) * 1024 : ((float*)(__attribute__((address_space(1))) float*)a.out) + rl * 1024;
        v4u* xb = (v4u*)xr;
        const f32x4* gt = (const f32x4*)(MOD + (size_t)w * 6144);
        const v4u* y1 = (const v4u*)(YE + (size_t)s1 * 1024); const v4u* y2 = (const v4u*)(YE + (size_t)s2 * 1024);
        f32x4 xv[4]; float ss = 0.f;
#pragma unroll
        for (int j = 0; j < 2; ++j) { const int c8 = lane + 64 * j;
            const v4u u1 = y1[c8], u2 = y2[c8]; f32x4 x0, x1; if (isctx) { const f32x4* xp = (const f32x4*)xr + c8 * 2; x0 = xp[0]; x1 = xp[1]; } else { const v4u xw = xb[c8]; x0 = (f32x4){bflo(xw[0]), bfhi(xw[0]), bflo(xw[1]), bfhi(xw[1])}; x1 = (f32x4){bflo(xw[2]), bfhi(xw[2]), bflo(xw[3]), bfhi(xw[3])}; } const f32x4 t0 = gt[c8 * 2], t1 = gt[c8 * 2 + 1];
            x0[0] += t0[0] * (g1 * bflo(u1[0]) + g2 * bflo(u2[0])); x0[1] += t0[1] * (g1 * bfhi(u1[0]) + g2 * bfhi(u2[0]));
            x0[2] += t0[2] * (g1 * bflo(u1[1]) + g2 * bflo(u2[1])); x0[3] += t0[3] * (g1 * bfhi(u1[1]) + g2 * bfhi(u2[1]));
            x1[0] += t1[0] * (g1 * bflo(u1[2]) + g2 * bflo(u2[2])); x1[1] += t1[1] * (g1 * bfhi(u1[2]) + g2 * bfhi(u2[2]));
            x1[2] += t1[2] * (g1 * bflo(u1[3]) + g2 * bflo(u2[3])); x1[3] += t1[3] * (g1 * bfhi(u1[3]) + g2 * bfhi(u2[3]));
            xv[2 * j] = x0; xv[2 * j + 1] = x1;
            ss += (x0[0] * x0[0] + x0[1] * x0[1]) + (x0[2] * x0[2] + x0[3] * x0[3]) + (x1[0] * x1[0] + x1[1] * x1[1]) + (x1[2] * x1[2] + x1[3] * x1[3]); }
        const float rstd = 1.0f / sqrtf(wave_sum(ss) * (1.0f / 1024.0f) + 1e-6f);
#pragma unroll
        for (int j = 0; j < 2; ++j) { const int c8 = lane + 64 * j;
            if (!last) { if (isctx) { f32x4* xp = (f32x4*)xr + c8 * 2; xp[0] = xv[2 * j]; xp[1] = xv[2 * j + 1]; } else xb[c8] = (v4u){pk2(xv[2 * j][0], xv[2 * j][1]), pk2(xv[2 * j][2], xv[2 * j][3]), pk2(xv[2 * j + 1][0], xv[2 * j + 1][1]), pk2(xv[2 * j + 1][2], xv[2 * j + 1][3])};
                const LAS f32x4* A4 = (const LAS f32x4*)(tabA + w * 1024) + c8 * 2; const LAS f32x4* B4 = (const LAS f32x4*)(tabB + w * 1024) + c8 * 2;
                const f32x4 h0 = (xv[2 * j] * rstd) * A4[0] + B4[0], h1 = (xv[2 * j + 1] * rstd) * A4[1] + B4[1];
                *((v4u*)(HN + (size_t)R * 1024) + c8) = (v4u){pk2(h0[0], h0[1]), pk2(h0[2], h0[3]), pk2(h1[0], h1[1]), pk2(h1[2], h1[3])}; }
            else { const LAS f32x4* A4 = (const LAS f32x4*)tabA + c8 * 2; f32x4* xp = (f32x4*)xr + c8 * 2; xp[0] = (xv[2 * j] * rstd) * A4[0]; xp[1] = (xv[2 * j + 1] * rstd) * A4[1]; } }
    }
}
__device__ __forceinline__ void phase_final(const Args& a, int vcu, int G) {
    const int tid = opaque_tid(), lane = tid & 63, wave = __builtin_amdgcn_readfirstlane(tid >> 6);
    const int gw = vcu * NWAVES + wave, NGW = G * NWAVES;
    const f32x4* g4 = (const f32x4*)gptr(a.in[IN_FINALG]) + lane;
    for (int r = gw; r < NB * SEQ; r += NGW) {
        f32x4* x4 = (f32x4*)(((float*)(__attribute__((address_space(1))) float*)a.out) + (size_t)r * 1024) + lane; f32x4 v[4]; float ss = 0.f;
#pragma unroll
        for (int j = 0; j < 4; ++j) { v[j] = x4[64 * j]; ss += (v[j][0] * v[j][0] + v[j][1] * v[j][1]) + (v[j][2] * v[j][2] + v[j][3] * v[j][3]); }
        const float rstd = 1.0f / sqrtf(wave_sum(ss) * (1.0f / 1024.0f) + 1e-6f);
#pragma unroll
        for (int j = 0; j < 4; ++j) x4[64 * j] = (v[j] * rstd) * g4[64 * j];
    }
}
#ifndef MK_MULTI
#define MK_MULTI 0
#endif
constexpr int N_PHASES = 1 + 10 + 12 + 9 + 12;

__global__ void __launch_bounds__(NTHR, 2) mk_fwd(Args args) {
    extern __shared__ __attribute__((aligned(16))) unsigned char lds_raw[];
    LAS unsigned char* lds = (LAS unsigned char*)lds_raw;
    volatile LAS unsigned* MISC = (volatile LAS unsigned*)(lds + MISC_OFF);
    const int tid = threadIdx.x;
    const int G = gridDim.x; const int bx = blockIdx.x; const int vcu = (G % 8 == 0) ? (bx % 8) * (G / 8) + bx / 8 : bx;
    unsigned char* ws = args.ws;
    unsigned* ctl = (unsigned*)(ws + WS_CTL);
    for (int u = tid; u < (LDS_BYTES - LDSCTL_OFF) / 4; u += NTHR) ((LAS unsigned*)(lds + LDSCTL_OFF))[u] = 0u;
    __syncthreads();
    const int lo = args.ph_lo, hi = args.ph_hi;
    XcdBarrier bar; bar.bar = ctl + CW_BAR; bar.x = xb_xcc_id(); bar.st = MISC + 8;
    if (hi - lo > 1) bar = xcd_barrier_post(ctl + CW_BAR, MISC + 8);
    const unsigned xcc = bar.x;
    int seq = 0;
#ifndef PH_MASK
#define PH_MASK 0xFFFFFFFFu
#endif
#define PH_ON(b) ((PH_MASK >> (b)) & 1u)
#ifndef DUP_SCAN
#define DUP_SCAN true
#endif
#ifndef DUP_ATTN
#define DUP_ATTN true
#endif
#ifndef DUP_MASK
#define DUP_MASK 0u
#endif
#define DUP_ON(b) ((DUP_MASK >> (b)) & 1u)
#define REP(b, stmt) do { if (PH_ON(b)) { stmt; if (DUP_ON(b)) { xcd_barrier(bar); stmt; } } } while (0)
#ifndef TMASK
#define TMASK 0u
#endif
    unsigned long long t_acc = 0ull, t_beg = 0ull; int t_kind = -1;
#define PH_KIND(k) t_kind = (k);
#define PH_BEGIN if (lo <= seq && seq < hi) { unsigned char* ws = opaque_ptr(args.ws); (void)ws; if (TMASK) t_beg = __builtin_amdgcn_s_memrealtime();
#define PH_END   if (seq + 1 < hi) xcd_barrier(bar); if (TMASK) { if (t_kind >= 0 && ((TMASK >> t_kind) & 1u)) t_acc += __builtin_amdgcn_s_memrealtime() - t_beg; t_kind = -1; } } ++seq;

    PH_BEGIN PH_KIND(0) REP(0, phase_prologue(args, lds, vcu, G)); PH_END

    for (int l = 0; l < DEPTH; ++l) {
        const bool moe = (l & 1) != 0;
        const float* MODl = (const float*)(ws + WS_MOD) + (size_t)l * 3 * 6144;
        if ((l & 1) == 0 && l > 0) {   } else {
        PH_BEGIN PH_KIND(1) if (PH_ON(1)) phase_norm(args, lds, vcu, G, l, 0, false); PH_END }
        PH_BEGIN PH_KIND(2) {
            pg8::Gemm g{(const pg8::bf16_t*)(ws + WS_HN), (const pg8::bf16_t*)(ws + WS_WINT) + (size_t)l * NINP * DM, NR, NINP, DM};
            pg8::StaticOrder S; S.init(NR, NINP, G, bx);
            pg8::EpiStoreSplit E{(pg8::bf16_t*)(ws + WS_PA), LDPA, (pg8::bf16_t*)(ws + WS_PR), LDPR, LDPA / 256, (const float*)(ws + WS_ROPE), QSCALE};
            REP(2, (pg8::gemm_phase<pg8::EpiStoreSplit, pg8::StaticOrder, true, true>(lds, g, S, E)));
        } PH_END
        PH_BEGIN PH_KIND(3) if (PH_ON(3)) { phase_prep(args, lds, G, l, false); if (DUP_ON(3)) { xcd_barrier(bar); phase_prep(args, lds, G, l, false); } } PH_END
        PH_BEGIN PH_KIND(15) REP(15, phase_prep2(args, lds, vcu, G)); PH_END
        PH_BEGIN PH_KIND(4) if (PH_ON(4)) { phase_mix(args, lds, MISC, l, l, xcc); if (DUP_ON(4)) { xcd_barrier(bar); phase_mix(args, lds, MISC, l, l + 4, xcc, DUP_SCAN, DUP_ATTN); } } PH_END
        PH_BEGIN PH_KIND(5) REP(5, phase_finish(args, G, l)); PH_END
        PH_BEGIN PH_KIND(6) {
            pg8::Gemm g{(const pg8::bf16_t*)(ws + WS_HN), (const pg8::bf16_t*)(ws + WS_WOUTT) + (size_t)l * DM * DM, NR, DM, DM};
            pg8::LatentOrder S; S.init(DM, G, bx);
            pg8::EpiResid E{(l == 0) ? gptr(args.in[IN_X]) : (const float*)nullptr, (pg8::bf16_t*)(__attribute__((address_space(1))) pg8::bf16_t*)args.out, MODl + 2048};
            if (PH_ON(6)) { ctx_gemm_resid((const bf16*)(ws + WS_HN), (const bf16*)(ws + WS_WOUTT) + (size_t)l * DM * DM, DM, MODl + 2 * 6144 + 2048, (l == 0) ? gptr(args.in[IN_CTX]) : (const float*)(ws + WS_XC), (float*)(ws + WS_XC), vcu, G);
                pg8::gemm_phase<pg8::EpiResid, pg8::LatentOrder, true, true>(lds, g, S, E); }
            if (DUP_ON(6)) { xcd_barrier(bar); pg8::EpiNull EN{(float*)(ws + WS_CTL) + 8}; pg8::gemm_phase<pg8::EpiNull, pg8::LatentOrder, true, true>(lds, g, S, EN); }
        } PH_END
        PH_BEGIN PH_KIND(7) if (PH_ON(7)) phase_norm(args, lds, vcu, G, l, 1, moe); PH_END
        if (!moe) {
            PH_BEGIN PH_KIND(8) {
                pg8::Gemm g{(const pg8::bf16_t*)(ws + WS_HN), (const pg8::bf16_t*)(ws + WS_W13T) + (size_t)(l >> 1) * 2 * DFF * DM, NR, 2 * DFF, DM};
                pg8::StaticOrder S; S.init(NR, 2 * DFF, G, bx);
                pg8::EpiSwiGLU E{(pg8::bf16_t*)(ws + WS_HF), DFF, 0};
                REP(8, (pg8::gemm_phase<pg8::EpiSwiGLU, pg8::StaticOrder, true, true>(lds, g, S, E)));
            } PH_END
            PH_BEGIN PH_KIND(9) {
                pg8::Gemm g{(const pg8::bf16_t*)(ws + WS_HF), (const pg8::bf16_t*)(ws + WS_W2T) + (size_t)(l >> 1) * DM * DFF, NR, DM, DFF};
                pg8::LatentOrder S; S.init(DM, G, bx);
                pg8::EpiResid E{(const float*)nullptr, (pg8::bf16_t*)(__attribute__((address_space(1))) pg8::bf16_t*)args.out, MODl + 5120};
                if (PH_ON(9)) { ctx_gemm_resid((const bf16*)(ws + WS_HF), (const bf16*)(ws + WS_W2T) + (size_t)(l >> 1) * DM * DFF, DFF, MODl + 2 * 6144 + 5120, (const float*)(ws + WS_XC), (float*)(ws + WS_XC), vcu, G);
                    pg8::gemm_phase<pg8::EpiResid, pg8::LatentOrder, true, true>(lds, g, S, E); }
                if (DUP_ON(9)) { xcd_barrier(bar); pg8::EpiNull EN{(float*)(ws + WS_CTL) + 8}; pg8::gemm_phase<pg8::EpiNull, pg8::LatentOrder, true, true>(lds, g, S, EN); }
            } PH_END
        } else {
            {
                const unsigned* cnt = (const unsigned*)ctl + CW_CNT + ((l >> 1) * 8) * 64;
                PH_BEGIN PH_KIND(10) if (PH_ON(10)) phase_gather(args, vcu, G, l); PH_END
                PH_BEGIN PH_KIND(11) {
                    pg8::Gemm g{(const pg8::bf16_t*)(ws + WS_AG), (const pg8::bf16_t*)(ws + WS_W13E), MOE_ROWS, 8 * 2 * DFE, DM};
                    pg8::MoeOrder S; S.init(cnt, (2 * DFE) / 256, G, bx);
                    pg8::EpiSwiGLU E{(pg8::bf16_t*)(ws + WS_HMOE), DFE, (2 * DFE) / 256};
                    REP(11, (pg8::gemm_phase<pg8::EpiSwiGLU, pg8::MoeOrder, true, true>(lds, g, S, E)));
                } PH_END
                PH_BEGIN PH_KIND(12) {
                    pg8::Gemm g{(const pg8::bf16_t*)(ws + WS_HMOE), (const pg8::bf16_t*)(ws + WS_W2E), MOE_ROWS, 8 * DM, DFE};
                    pg8::MoeOrder S; S.init(cnt, DM / 256, G, bx);
                    pg8::EpiStoreBf16 E{(pg8::bf16_t*)(ws + WS_YEXP), DM, DM / 256};
                    REP(12, (pg8::gemm_phase<pg8::EpiStoreBf16, pg8::MoeOrder, true, true>(lds, g, S, E)));
                } PH_END
                PH_BEGIN PH_KIND(13) if (PH_ON(13)) phase_combine(args, lds, vcu, G, l); PH_END
            }
        }
    }
#if defined(CLKPROBE) || defined(SEGPROBE)
    if (blockIdx.x == 0 && tid == 0) { const unsigned cpt = MISC[100]; const unsigned long long s0 = __builtin_amdgcn_s_memrealtime(); while (__builtin_amdgcn_s_memrealtime() - s0 < (unsigned long long)cpt * 100ull) { __builtin_amdgcn_s_sleep(8); } }
#endif
#if TMASK
    {
        if (blockIdx.x == 0 && tid == 0) { const float tms = (float)t_acc * 1e-5f; __hip_atomic_store((float*)(ctl + 16), sqrtf(100.0f * tms), __ATOMIC_RELAXED, __HIP_MEMORY_SCOPE_AGENT); }
        xcd_barrier(bar);
        const float cval = __hip_atomic_load((float*)(ctl + 16), __ATOMIC_RELAXED, __HIP_MEMORY_SCOPE_AGENT);
        for (size_t i = (size_t)blockIdx.x * NTHR + tid; i < (size_t)NB * SEQ * DM; i += (size_t)G * NTHR) ((float*)(__attribute__((address_space(1))) float*)args.out)[i] = cval;
    }
#endif
#undef PH_BEGIN
#undef PH_END
}

extern "C" void kernel_launch(void* const* d_in, const int* in_sizes, int n_in, void* d_out, int out_size, void* d_ws, size_t ws_size, hipStream_t stream) {
    static int grid = 0;
    if (grid == 0) {
        if (n_in != 34 || out_size != NB * SEQ * DM || ws_size < WS_END) { fprintf(stderr, "kernel_launch: unexpected shapes (n_in %d out %d ws %zu, need %zu)\n", n_in, out_size, ws_size, (size_t)WS_END); grid = -1; return; }
        int dev = 0, cus = 0, per_cu = 0;
        if (hipGetDevice(&dev) != hipSuccess || hipDeviceGetAttribute(&cus, hipDeviceAttributeMultiprocessorCount, dev) != hipSuccess) { grid = -1; return; }
        if (hipFuncSetAttribute((const void*)mk_fwd, hipFuncAttributeMaxDynamicSharedMemorySize, LDS_BYTES) != hipSuccess) { fprintf(stderr, "kernel_launch: hipFuncSetAttribute failed\n"); grid = -1; return; }
        if (hipOccupancyMaxActiveBlocksPerMultiprocessor(&per_cu, (const void*)mk_fwd, NTHR, LDS_BYTES) != hipSuccess || per_cu < 1) fprintf(stderr, "kernel_launch: occupancy query reports %d blocks per CU\n", per_cu);
        (void)hipGetLastError();
        grid = cus;
    }
    if (grid < 0) return;
    if (hipMemsetAsync((char*)d_ws + WS_CTL, 0, CTL_ZERO_BYTES, stream) != hipSuccess) return;
    Args a{};
    for (int i = 0; i < 34; ++i) a.in[i] = (const float*)d_in[i];
    a.out = (float*)d_out; a.ws = (unsigned char*)d_ws;
#if MK_MULTI
    for (int s = 0; s < N_PHASES; ++s) { a.ph_lo = s; a.ph_hi = s + 1; hipLaunchKernelGGL(mk_fwd, dim3(grid), dim3(NTHR), LDS_BYTES, stream, a); }
#else
    a.ph_lo = 0; a.ph_hi = N_PHASES;
    hipLaunchKernelGGL(mk_fwd, dim3(grid), dim3(NTHR), LDS_BYTES, stream, a);
#endif
    const hipError_t le = hipPeekAtLastError();
    if (le != hipSuccess) fprintf(stderr, "kernel_launch: launch failed: %s\n", hipGetErrorName(le));
}
```
